# Optimizing an MI355X kernel written in HIP

```python
import jax, jax.numpy as jnp
from jax import lax
import numpy as np

D_MODEL = 1024
BATCH = 8
SEQ = 2048
DEPTH = 2
DEC_BATCH = 128
DEC_SEQ = 1
PAST_LEN = 16384
PAGE_SIZE = 128

N_META = 16
D_MIX = D_MODEL
DN_HEADS = 4
DN_DK = D_MIX // 8
DN_DV = D_MIX // 8
DN_W = DN_HEADS * DN_DV
LRU_W = D_MIX // 4
LRU_BLOCKS = 4
LRU_BD = LRU_W // LRU_BLOCKS
LRU_C = 8.0
RET_HEADS = 4
RET_DK = D_MIX // 16
RET_DV = D_MIX // 16
RET_W = RET_HEADS * RET_DV
CONV_W = 4
CHUNK = 64
D_FF = 128 * ((8 * D_MODEL // 3 + 127) // 128)
ROPE_BASE = 10000.0
EPS = 1e-6
IN_SIZES = (3 * DN_W, DN_HEADS, DN_HEADS, DN_W,
            LRU_W, LRU_W,
            RET_HEADS * RET_DK, RET_HEADS * RET_DK, RET_W, RET_W)
D_IN = sum(IN_SIZES)

kernel_name = 'hybrid_deltanet_rglru_retention_step'


def _split_offsets():
    out, s = [], 0
    for n in IN_SIZES[:-1]:
        s += n
        out.append(s)
    return out


def _rmsnorm(x, w):
    xf = x.astype(jnp.float32)
    y = xf * lax.rsqrt(jnp.mean(xf * xf, axis=-1, keepdims=True) + EPS)
    return (y * w.astype(jnp.float32)).astype(x.dtype)


def _swiglu(x, w_in, w_out):
    gate, up = jnp.split(x @ w_in, 2, axis=-1)
    return (jax.nn.silu(gate) * up) @ w_out


def _causal_conv(x, buf, w):
    T = x.shape[1]
    xp = jnp.concatenate([buf.astype(x.dtype), x], axis=1)
    y = xp[:, 0:T] * w[0]
    for j in range(1, CONV_W):
        y = y + xp[:, j:j + T] * w[j]
    return y, xp[:, T:]


def _l2norm(x):
    return x * lax.rsqrt(jnp.sum(x * x, axis=-1, keepdims=True) + EPS)


def _rope(x, pos):
    half = x.shape[-1] // 2
    inv = ROPE_BASE ** (-jnp.arange(half, dtype=jnp.float32) / half)
    ang = pos.astype(jnp.float32)[:, None] * inv[None, :]
    cos = jnp.cos(ang)[None, :, None, :]
    sin = jnp.sin(ang)[None, :, None, :]
    x1, x2 = x[..., :half], x[..., half:]
    return jnp.concatenate([x1 * cos - x2 * sin, x1 * sin + x2 * cos], axis=-1)


def _decay_masks(G):
    C = G.shape[-1]
    t = jnp.arange(C)
    diff = G[..., :, None] - G[..., None, :]
    strict = jnp.exp(jnp.where(t[:, None] > t[None, :], diff, -jnp.inf))
    incl = jnp.exp(jnp.where(t[:, None] >= t[None, :], diff, -jnp.inf))
    return strict, incl


def _delta_step(S0, q, k, v, g, beta):
    dv = v.shape[-1]
    G = jnp.cumsum(g, axis=-1)
    eG = jnp.exp(G)
    dec_strict, dec_incl = _decay_masks(G)
    A = beta[..., :, None] * jnp.einsum('bhtd,bhid->bhti', k, k) * dec_strict
    rhs = jnp.concatenate([beta[..., None] * v, (beta * eG)[..., None] * k], axis=-1)
    sol = lax.linalg.triangular_solve(A, rhs, left_side=True, lower=True, unit_diagonal=True)
    U = sol[..., :dv] - jnp.einsum('bhtd,bhde->bhte', sol[..., dv:], S0)
    o = (eG[..., None] * jnp.einsum('bhtd,bhde->bhte', q, S0)
         + jnp.einsum('bhti,bhie->bhte', jnp.einsum('bhtd,bhid->bhti', q, k) * dec_incl, U))
    GC = G[..., -1]
    S = (jnp.exp(GC)[..., None, None] * S0
         + jnp.einsum('bhid,bhie->bhde', k * jnp.exp(GC[..., None] - G)[..., None], U))
    return o, S


def _ret_step(S0, q, k, v, g):
    G = jnp.cumsum(g, axis=-1)
    _, dec_incl = _decay_masks(G)
    o = (jnp.exp(G)[..., None] * jnp.einsum('bhtd,bhde->bhte', q, S0)
         + jnp.einsum('bhti,bhie->bhte', jnp.einsum('bhtd,bhid->bhti', q, k) * dec_incl, v))
    GC = G[..., -1]
    S = (jnp.exp(GC)[..., None, None] * S0
         + jnp.einsum('bhid,bhie->bhde', k * jnp.exp(GC[..., None] - G)[..., None], v))
    return o, S


def _run_chunks(step, S0, xs):
    o_lead, S = step(S0, *[a[:, :, :N_META] for a in xs])
    rest = [a[:, :, N_META:] for a in xs]
    T = rest[0].shape[2]
    n = T // CHUNK

    def to_chunks(a):
        return jnp.moveaxis(a.reshape(a.shape[:2] + (n, CHUNK) + a.shape[3:]), 2, 0)

    def body(S_c, c):
        o_c, S_n = step(S_c, *c)
        return S_n, o_c

    S, o_rest = lax.scan(body, S, tuple(to_chunks(a) for a in rest))
    o_rest = jnp.moveaxis(o_rest, 0, 2)
    o_rest = o_rest.reshape(o_rest.shape[:2] + (T,) + o_rest.shape[4:])
    return jnp.concatenate([o_lead, o_rest], axis=2), S


def _lin_op(c1, c2):
    a1, b1 = c1
    a2, b2 = c2
    return a1 * a2, a2 * b1 + b2


def _token_mix(u, pos, st, w_in, dn_conv_w, dn_a_log, dn_dt_bias, dn_norm_w,
               lru_conv_w, lru_conv_b, lru_wa, lru_ba, lru_wx, lru_bx, lru_lambda, w_out):
    f32 = jnp.float32
    B, T, _ = u.shape
    if st is None:
        S_dn0 = jnp.zeros((B, DN_HEADS, DN_DK, DN_DV), f32)
        buf_dn = jnp.zeros((B, CONV_W - 1, 3 * DN_W), u.dtype)
        h0 = jnp.zeros((B, LRU_W), f32)
        buf_lru = jnp.zeros((B, CONV_W - 1, LRU_W), u.dtype)
        S_ret0 = jnp.zeros((B, RET_HEADS, RET_DK, RET_DV), f32)
    else:
        S_dn0, buf_dn, h0, buf_lru, S_ret0 = st
        S_dn0, h0, S_ret0 = S_dn0.astype(f32), h0.astype(f32), S_ret0.astype(f32)
    proj = u @ w_in
    (dn_qkv, dn_a, dn_b, dn_z, lru_x, lru_y,
     ret_q, ret_k, ret_v, ret_g) = jnp.split(proj, _split_offsets(), axis=-1)

    qkv, buf_dn_new = _causal_conv(dn_qkv, buf_dn, dn_conv_w)
    qkv = jax.nn.silu(qkv).astype(f32)
    q, k, v = jnp.split(qkv, 3, axis=-1)
    q = jnp.swapaxes(_l2norm(q.reshape(B, T, DN_HEADS, DN_DK)), 1, 2) * (DN_DK ** -0.5)
    k = jnp.swapaxes(_l2norm(k.reshape(B, T, DN_HEADS, DN_DK)), 1, 2)
    v = jnp.swapaxes(v.reshape(B, T, DN_HEADS, DN_DV), 1, 2)
    g = -jnp.exp(dn_a_log.astype(f32)) * jax.nn.softplus(dn_a.astype(f32) + dn_dt_bias.astype(f32))
    g = jnp.swapaxes(g, 1, 2)
    beta = jnp.swapaxes(jax.nn.sigmoid(dn_b.astype(f32)), 1, 2)
    if st is None:
        o_dn, S_dn = _run_chunks(_delta_step, S_dn0, (q, k, v, g, beta))
    else:
        o_dn, S_dn = _delta_step(S_dn0, q, k, v, g, beta)
    o_dn = jnp.swapaxes(o_dn, 1, 2)
    o_dn = o_dn * lax.rsqrt(jnp.mean(o_dn * o_dn, axis=-1, keepdims=True) + EPS) * dn_norm_w.astype(f32)
    o_dn = (o_dn * jax.nn.silu(dn_z.astype(f32).reshape(B, T, DN_HEADS, DN_DV))).reshape(B, T, DN_W)

    xl, buf_lru_new = _causal_conv(lru_x, buf_lru, lru_conv_w)
    xl = (xl + lru_conv_b).astype(f32)
    xb = xl.reshape(B, T, LRU_BLOCKS, LRU_BD)
    r = jax.nn.sigmoid(jnp.einsum('btnd,nde->btne', xb, lru_wa.astype(f32)).reshape(B, T, LRU_W) + lru_ba.astype(f32))
    i = jax.nn.sigmoid(jnp.einsum('btnd,nde->btne', xb, lru_wx.astype(f32)).reshape(B, T, LRU_W) + lru_bx.astype(f32))
    log_a = -LRU_C * r * jax.nn.softplus(-lru_lambda.astype(f32))
    a = jnp.exp(log_a)
    b = jnp.sqrt(jnp.maximum(-jnp.expm1(2.0 * log_a), 0.0)) * (i * xl)
    b = b.at[:, 0].add(a[:, 0] * h0)
    _, h = lax.associative_scan(_lin_op, (a, b), axis=1)
    h_new = h[:, -1]
    o_lru = h * jax.nn.gelu(lru_y.astype(f32))

    rq = jnp.swapaxes(_rope(ret_q.astype(f32).reshape(B, T, RET_HEADS, RET_DK), pos), 1, 2)
    rk = jnp.swapaxes(_rope(ret_k.astype(f32).reshape(B, T, RET_HEADS, RET_DK), pos), 1, 2) * (RET_DK ** -0.5)
    rv = jnp.swapaxes(ret_v.astype(f32).reshape(B, T, RET_HEADS, RET_DV), 1, 2)
    log_gamma = jnp.log1p(-jnp.exp2(-5.0 - jnp.arange(RET_HEADS, dtype=f32)))
    g_ret = jnp.broadcast_to(log_gamma[None, :, None], (B, RET_HEADS, T))
    if st is None:
        o_ret, S_ret = _run_chunks(_ret_step, S_ret0, (rq, rk, rv, g_ret))
    else:
        o_ret, S_ret = _ret_step(S_ret0, rq, rk, rv, g_ret)
    o_ret = jnp.swapaxes(o_ret, 1, 2)
    mu = jnp.mean(o_ret, axis=-1, keepdims=True)
    var = jnp.mean(jnp.square(o_ret - mu), axis=-1, keepdims=True)
    o_ret = ((o_ret - mu) * lax.rsqrt(var + EPS)).reshape(B, T, RET_W) * jax.nn.silu(ret_g.astype(f32))

    o = jnp.concatenate([o_dn, o_lru, o_ret], axis=-1).astype(u.dtype) @ w_out
    return o, (S_dn, buf_dn_new, h_new, buf_lru_new, S_ret)


def _layer(x, pos, st, n1, f1_in, f1_out, n2, w_in, dn_conv_w, dn_a_log, dn_dt_bias, dn_norm_w,
           lru_conv_w, lru_conv_b, lru_wa, lru_ba, lru_wx, lru_bx, lru_lambda, w_out, n3, f2_in, f2_out):
    x = x + 0.5 * _swiglu(_rmsnorm(x, n1), f1_in, f1_out)
    m, new_st = _token_mix(_rmsnorm(x, n2), pos, st, w_in, dn_conv_w, dn_a_log, dn_dt_bias, dn_norm_w,
                           lru_conv_w, lru_conv_b, lru_wa, lru_ba, lru_wx, lru_bx, lru_lambda, w_out)
    x = x + m
    x = x + 0.5 * _swiglu(_rmsnorm(x, n3), f2_in, f2_out)
    return x, new_st


def setup_inputs(seed: int = 0) -> dict:
    key = jax.random.key(seed)
    ks = jax.random.split(key, 32)
    f32 = jnp.float32
    nrm = lambda k, s, sc: jax.random.normal(k, s, f32) * sc
    gain = lambda k, s: 1.0 + 0.01 * jax.random.normal(k, s, f32)
    dt = jnp.exp(jax.random.uniform(ks[20], (DEPTH, DN_HEADS), f32, np.log(1e-3), np.log(1e-1)))
    a_pow = jax.random.uniform(ks[21], (DEPTH, LRU_W), f32, 0.9, 0.999)
    sig_l = a_pow ** (1.0 / LRU_C)
    return {
        'x_prompt': nrm(ks[0], (BATCH, SEQ, D_MODEL), 1.0),
        'x_sample': nrm(ks[1], (DEC_BATCH, DEC_SEQ, D_MODEL), 1.0),
        'state_dn': nrm(ks[2], (DEPTH, DEC_BATCH, DN_HEADS, DN_DK, DN_DV), DN_DK ** -0.5),
        'state_dn_conv': nrm(ks[3], (DEPTH, DEC_BATCH, CONV_W - 1, 3 * DN_W), 1.0),
        'state_lru': nrm(ks[4], (DEPTH, DEC_BATCH, LRU_W), 1.0),
        'state_lru_conv': nrm(ks[5], (DEPTH, DEC_BATCH, CONV_W - 1, LRU_W), 1.0),
        'state_ret': nrm(ks[6], (DEPTH, DEC_BATCH, RET_HEADS, RET_DK, RET_DV), 1.0),
        'meta_tokens': nrm(ks[7], (N_META, D_MODEL), 1.0),
        'norm_ffn1': gain(ks[8], (DEPTH, D_MODEL)),
        'w_ffn1_in': nrm(ks[9], (DEPTH, D_MODEL, 2 * D_FF), D_MODEL ** -0.5),
        'w_ffn1_out': nrm(ks[10], (DEPTH, D_FF, D_MODEL), D_FF ** -0.5),
        'norm_mix': gain(ks[11], (DEPTH, D_MODEL)),
        'w_in': nrm(ks[12], (DEPTH, D_MODEL, D_IN), D_MODEL ** -0.5),
        'dn_conv_w': nrm(ks[13], (DEPTH, CONV_W, 3 * DN_W), CONV_W ** -0.5),
        'dn_a_log': jnp.log(jax.random.uniform(ks[14], (DEPTH, DN_HEADS), f32, 1.0, 16.0)),
        'dn_dt_bias': dt + jnp.log(-jnp.expm1(-dt)),
        'dn_norm_w': gain(ks[15], (DEPTH, DN_DV)),
        'lru_conv_w': nrm(ks[16], (DEPTH, CONV_W, LRU_W), CONV_W ** -0.5),
        'lru_conv_b': nrm(ks[17], (DEPTH, LRU_W), 0.01),
        'lru_wa': nrm(ks[18], (DEPTH, LRU_BLOCKS, LRU_BD, LRU_BD), LRU_BD ** -0.5),
        'lru_ba': nrm(ks[19], (DEPTH, LRU_W), 0.01),
        'lru_wx': nrm(ks[22], (DEPTH, LRU_BLOCKS, LRU_BD, LRU_BD), LRU_BD ** -0.5),
        'lru_bx': nrm(ks[23], (DEPTH, LRU_W), 0.01),
        'lru_lambda': jnp.log(sig_l) - jnp.log1p(-sig_l),
        'w_out': nrm(ks[24], (DEPTH, D_MIX, D_MODEL), D_MIX ** -0.5),
        'norm_ffn2': gain(ks[25], (DEPTH, D_MODEL)),
        'w_ffn2_in': nrm(ks[26], (DEPTH, D_MODEL, 2 * D_FF), D_MODEL ** -0.5),
        'w_ffn2_out': nrm(ks[27], (DEPTH, D_FF, D_MODEL), D_FF ** -0.5),
        'norm_final': gain(ks[28], (D_MODEL,)),
    }


def reference(x_prompt, x_sample, state_dn, state_dn_conv, state_lru, state_lru_conv, state_ret,
              meta_tokens, norm_ffn1, w_ffn1_in, w_ffn1_out, norm_mix, w_in, dn_conv_w, dn_a_log,
              dn_dt_bias, dn_norm_w, lru_conv_w, lru_conv_b, lru_wa, lru_ba, lru_wx, lru_bx, lru_lambda,
              w_out, norm_ffn2, w_ffn2_in, w_ffn2_out, norm_final):
    B = x_prompt.shape[0]
    meta = jnp.broadcast_to(meta_tokens.astype(x_prompt.dtype)[None], (B, N_META, D_MODEL))
    xp = jnp.concatenate([meta, x_prompt], axis=1)
    xs = x_sample
    pos_p = jnp.arange(xp.shape[1])
    pos_s = PAST_LEN + jnp.arange(xs.shape[1])
    new_p, new_s = [], []
    for l in range(DEPTH):
        w_l = (norm_ffn1[l], w_ffn1_in[l], w_ffn1_out[l], norm_mix[l], w_in[l], dn_conv_w[l], dn_a_log[l],
               dn_dt_bias[l], dn_norm_w[l], lru_conv_w[l], lru_conv_b[l], lru_wa[l], lru_ba[l], lru_wx[l],
               lru_bx[l], lru_lambda[l], w_out[l], norm_ffn2[l], w_ffn2_in[l], w_ffn2_out[l])
        xp, st_p = _layer(xp, pos_p, None, *w_l)
        st_in = (state_dn[l], state_dn_conv[l], state_lru[l], state_lru_conv[l], state_ret[l])
        xs, st_s = _layer(xs, pos_s, st_in, *w_l)
        new_p.append(st_p)
        new_s.append(st_s)
    y_prompt = _rmsnorm(xp, norm_final)[:, N_META:]
    y_sample = _rmsnorm(xs, norm_final)
    dn_p, dn_conv_p, lru_p, lru_conv_p, ret_p = [jnp.stack([s[j] for s in new_p]) for j in range(5)]
    dn_s, dn_conv_s, lru_s, lru_conv_s, ret_s = [jnp.stack([s[j] for s in new_s]) for j in range(5)]
    return (y_prompt, y_sample, dn_p, dn_conv_p, lru_p, lru_conv_p, ret_p,
            dn_s, dn_conv_s, lru_s, lru_conv_s, ret_s)
```

```cpp
#include <hip/hip_runtime.h>
#include <cstdio>
#include <cstdint>
namespace pg8 {
#define PG8_LAS __attribute__((address_space(3)))
typedef unsigned short bf16_t;
typedef short bf16x8 __attribute__((ext_vector_type(8)));
typedef float f32x4 __attribute__((ext_vector_type(4)));
typedef unsigned u32x4 __attribute__((ext_vector_type(4)));
constexpr int BM = 256, BK = 64, HALF = 128, HTB = HALF * BK * 2  , STAGE_BYTES = 8 * HTB, NXCD = 8, WGM = 8;

__host__ __device__ __forceinline__ int lds_byte(int r, int c) { const int st = (r >> 4) * 2 + (c >> 5), rr = r & 15, cc = c & 31, ob = rr * 64 + cc * 2; return st * 1024 + (ob ^ (((ob >> 9) & 1) << 5)); }
__host__ __device__ __forceinline__ void stage_rc(int b, int& R, int& C) { const int st = b / 1024, sb = b % 1024, swz = sb ^ (((sb >> 9) & 1) << 5); R = (st >> 1) * 16 + swz / 64; C = (st & 1) * 32 + (swz % 64) / 2; }
__host__ __device__ __forceinline__ int perm32(int rho) { const int n = rho >> 4, i = rho & 15; return 8 * (i >> 2) + 4 * n + (i & 3); }

struct Unit { int pm, pn, kt0, nkt, part; };
struct Gemm { const bf16_t* A; const bf16_t* Bt; int M, N, K; float* slab; int nparts; };

struct StaticOrder {
    int nM, nN, nwg, G, c;
    __host__ __device__ void init(int M, int N, int G_, int c_) { nM = M / BM; nN = N / BM; nwg = nM * nN; G = G_; c = c_; }
    __host__ __device__ bool next(int i, Unit& u) const {
        const long L = (long)i * G + c; if (L >= nwg) { u.pm = 0; u.pn = 0; u.kt0 = 0; u.nkt = 0; u.part = -1; return false; }
        int wgid = (int)L; { const int q = nwg / NXCD, r = nwg % NXCD, xcd = wgid % NXCD, off = wgid / NXCD; wgid = (xcd < r ? xcd * (q + 1) : r * (q + 1) + (xcd - r) * q) + off; }
        const int nig = WGM * nN, gid = wgid / nig, fm = gid * WGM, gsz = (nM - fm) < WGM ? (nM - fm) : WGM;
        u.pm = fm + ((wgid % nig) % gsz); u.pn = (wgid % nig) / gsz; u.kt0 = 0; u.nkt = 0; u.part = -1; return true;
    }
    __device__ __forceinline__ void a_ready(const Unit&) const {}
    __device__ __forceinline__ void done(const Unit&) const {}
};

__device__ __forceinline__ unsigned cvt_pk_bf16(float lo, float hi) { unsigned r; asm volatile("v_cvt_pk_bf16_f32 %0, %1, %2" : "=v"(r) : "v"(lo), "v"(hi)); return r; }
struct SplitOrder {
    StaticOrder so; int nparts;
    __host__ __device__ void init(int K, int G_, int c_) { so.init(64 * BM, 1024, G_, c_); nparts = K / BK / 4; }
    __host__ __device__ bool next(int i, Unit& u) const {
        Unit f; const bool full = so.next(i, f);
        const int L = i * so.G + so.c - so.nwg; const bool part = (L >= 0) && (L < 4 * nparts);
        const int q = part ? L / nparts : 0, p = part ? L % nparts : 0;
        Unit r; r.pm = full ? f.pm : 64; r.pn = full ? f.pn : q; r.kt0 = full ? 0 : 4 * p; r.nkt = full ? 0 : 4; r.part = full ? -1 : p;
        u = r; return full || part;
    }
    __device__ __forceinline__ void a_ready(const Unit&) const {}
    __device__ __forceinline__ void done(const Unit&) const {}
};
__device__ __forceinline__ void slab_dump(const f32x4 (&acc)[2][2][4][2], const Unit& u, float* slab, int nparts, int wr, int wc, int fr, int fq) {
    float* base = slab + (size_t)(u.pn * nparts + u.part) * 65536 + (size_t)(wr * 64 + fr) * 256 + wc * 32 + 8 * fq;
#pragma unroll
    for (int ai = 0; ai < 2; ++ai)
#pragma unroll
        for (int m = 0; m < 4; ++m)
#pragma unroll
            for (int bj = 0; bj < 2; ++bj) { float* p = base + (size_t)(ai * HALF + m * 16) * 256 + bj * HALF; *(f32x4*)p = acc[ai][bj][m][0]; *(f32x4*)(p + 4) = acc[ai][bj][m][1]; }
}
typedef unsigned u32x2 __attribute__((ext_vector_type(2)));
__device__ __forceinline__ float fast_sigmoid(float x) { return __builtin_amdgcn_rcpf(1.0f + __expf(-x)); }
__device__ __forceinline__ float fast_silu(float x) { return x * fast_sigmoid(x); }
constexpr int NP_ROWS = 16384;

struct EpiSwiglu {
    static constexpr bool PERM = true, AFTER_DRAIN = false;
    bf16_t* H; int ldh; const unsigned long long* ss;
    __device__ __forceinline__ void operator()(const f32x4 (&acc)[2][2][4][2], const Unit& u, int wr, int wc, int fr, int fq) const {
        const int row0 = u.pm * BM + wr * 64 + fr, col0 = u.pn * 128 + wc * 32 + 8 * fq;
#pragma unroll
        for (int ai = 0; ai < 2; ++ai)
#pragma unroll
            for (int m = 0; m < 4; ++m) {
                const int row = row0 + ai * HALF + m * 16;
                const float rs = __builtin_amdgcn_rsqf((float)ss[row] * (1.0f / (1024.0f * 1048576.0f)) + 1e-6f);
                float hv[8];
#pragma unroll
                for (int n = 0; n < 2; ++n)
#pragma unroll
                    for (int e = 0; e < 4; ++e) { const float g = acc[ai][0][m][n][e] * rs, up = acc[ai][1][m][n][e] * rs; hv[4 * n + e] = fast_silu(g) * up; }
                u32x4 w; w.x = cvt_pk_bf16(hv[0], hv[1]); w.y = cvt_pk_bf16(hv[2], hv[3]); w.z = cvt_pk_bf16(hv[4], hv[5]); w.w = cvt_pk_bf16(hv[6], hv[7]);
                *(u32x4*)(H + (size_t)row * ldh + col0) = w;
            }
    }
};
struct EpiProj {
    static constexpr bool PERM = true, AFTER_DRAIN = false;
    bf16_t* PA; bf16_t* PB; const unsigned long long* ss;
    __device__ __forceinline__ void operator()(const f32x4 (&acc)[2][2][4][2], const Unit& u, int wr, int wc, int fr, int fq) const {
        const int row0 = u.pm * BM + wr * 64 + fr;
        bf16_t* base; int ld, colt;
        if (u.pn < 7) { base = PA; ld = 1792; colt = u.pn * 256; } else { base = PB; ld = 2048; colt = (u.pn - 7) * 256; }
        const int col0 = colt + wc * 32 + 8 * fq;
#pragma unroll
        for (int ai = 0; ai < 2; ++ai)
#pragma unroll
            for (int m = 0; m < 4; ++m) {
                const int row = row0 + ai * HALF + m * 16;
                const float rs = __builtin_amdgcn_rsqf((float)ss[row] * (1.0f / (1024.0f * 1048576.0f)) + 1e-6f);
                bf16_t* rowp = base + (size_t)row * ld + col0;
#pragma unroll
                for (int bj = 0; bj < 2; ++bj) { const f32x4 v0 = acc[ai][bj][m][0] * rs, v1 = acc[ai][bj][m][1] * rs;
                    u32x4 w; w.x = cvt_pk_bf16(v0[0], v0[1]); w.y = cvt_pk_bf16(v0[2], v0[3]); w.z = cvt_pk_bf16(v1[0], v1[1]); w.w = cvt_pk_bf16(v1[2], v1[3]);
                    *(u32x4*)(rowp + bj * HALF) = w; }
            }
    }
};
struct EpiResid {
    static constexpr bool PERM = true, AFTER_DRAIN = false;
    const float* xin_lo; float* xout_lo; float* xe; bf16_t* xb; unsigned long long* ssn; float scale;
    __device__ __forceinline__ void operator()(const f32x4 (&acc)[2][2][4][2], const Unit& u, int wr, int wc, int fr, int fq) const {
        const int row0 = u.pm * BM + wr * 64 + fr, col0 = u.pn * BM + wc * 32 + 8 * fq;
        const bool lo = (u.pm * BM) < NP_ROWS;
#pragma unroll
        for (int ai = 0; ai < 2; ++ai)
#pragma unroll
            for (int m = 0; m < 4; ++m) {
                const int row = row0 + ai * HALF + m * 16;
                const float* xi = lo ? xin_lo + (size_t)row * 1024 : xe + (size_t)(row - NP_ROWS) * 1024;
                float* xo = lo ? xout_lo + (size_t)row * 1024 : xe + (size_t)(row - NP_ROWS) * 1024;
                float sq = 0.f;
#pragma unroll
                for (int bj = 0; bj < 2; ++bj) { const int c = col0 + bj * HALF;
                    f32x4 a0 = *(const f32x4*)(xi + c), a1 = *(const f32x4*)(xi + c + 4);
                    a0 = a0 + acc[ai][bj][m][0] * scale; a1 = a1 + acc[ai][bj][m][1] * scale;
                    *(f32x4*)(xo + c) = a0; *(f32x4*)(xo + c + 4) = a1;
                    u32x4 w; w.x = cvt_pk_bf16(a0[0], a0[1]); w.y = cvt_pk_bf16(a0[2], a0[3]); w.z = cvt_pk_bf16(a1[0], a1[1]); w.w = cvt_pk_bf16(a1[2], a1[3]);
                    *(u32x4*)(xb + (size_t)row * 1024 + c) = w;
                    sq += (a0[0] * a0[0] + a0[1] * a0[1]) + (a0[2] * a0[2] + a0[3] * a0[3]) + (a1[0] * a1[0] + a1[1] * a1[1]) + (a1[2] * a1[2] + a1[3] * a1[3]); }
                sq += __builtin_bit_cast(float, __builtin_amdgcn_ds_bpermute((fr + 16 * (fq ^ 1)) << 2, __builtin_bit_cast(int, sq))); sq += __builtin_bit_cast(float, __builtin_amdgcn_ds_bpermute((fr + 16 * (fq ^ 2)) << 2, __builtin_bit_cast(int, sq)));
                if (fq == 0) atomicAdd(ssn + row, (unsigned long long)(sq * 1048576.0f + 0.5f));
            }
    }
};
template <class Epi, class Sched, bool ALIGN_EPI = false, bool SP2 = false>
__device__ __forceinline__ void gemm_phase(PG8_LAS unsigned char* lds, const Gemm g, const Sched& S, const Epi& E, const int tid_in) {
    int tid_ = tid_in; asm volatile("" : "+v"(tid_));
    const int tid = tid_, wid = __builtin_amdgcn_readfirstlane(tid >> 6), lane = tid & 63, wr = wid >> 2, wc = wid & 3, fr = lane & 15, fq = lane >> 4;
    const int K = g.K, nt = K / BK;
    unsigned voffA[2], voffB[2];
#pragma unroll
    for (int i = 0; i < 2; ++i) { int R, C; stage_rc(tid * 16 + i * 8192, R, C); const int Rb = Epi::PERM ? ((R & ~31) + perm32(R & 31)) : R;
        voffA[i] = (unsigned)(R * K + C) * 2u; voffB[i] = (unsigned)(Rb * K + C) * 2u; }
    const size_t kstep = (size_t)(BK * 2);
    const size_t hstep = (size_t)HALF * K * 2;
    const size_t tstep = 2 * hstep;
    const unsigned ldsw = (unsigned)wid * 1024u;
    const int aoff = lds_byte(wr * 64 + fr, fq * 8), boff = lds_byte(wc * 32 + fr, fq * 8);
#define PG8_SA(b, h) (((b) * 2 + (h)) * HTB)
#define PG8_SB(b, h) ((4 + (b) * 2 + (h)) * HTB)
#define PG8_STAGE(bufoff, gbase, voff) do { _Pragma("unroll") for (int _i = 0; _i < 2; ++_i) \
        __builtin_amdgcn_global_load_lds((const unsigned*)((const char*)(gbase) + (voff)[_i]), (PG8_LAS unsigned*)(lds + (bufoff) + ldsw + _i * 8192), 16, 0, 0); } while (0)
#define PG8_LDA(dst, b, h) do { _Pragma("unroll") for (int m = 0; m < 4; ++m) _Pragma("unroll") for (int k = 0; k < 2; ++k) dst[m][k] = *(const PG8_LAS bf16x8*)(lds + PG8_SA(b, h) + aoff + m * 2048 + k * 1024); } while (0)
#define PG8_LDB(dst, b, h) do { _Pragma("unroll") for (int n = 0; n < 2; ++n) _Pragma("unroll") for (int k = 0; k < 2; ++k) dst[n][k] = *(const PG8_LAS bf16x8*)(lds + PG8_SB(b, h) + boff + n * 2048 + k * 1024); } while (0)
#define PG8_MMA(ai, bj, At, Bt) do { __builtin_amdgcn_s_setprio(1); _Pragma("unroll") for (int m = 0; m < 4; ++m) _Pragma("unroll") for (int n = 0; n < 2; ++n) _Pragma("unroll") for (int k = 0; k < 2; ++k) \
        acc[ai][bj][m][n] = __builtin_amdgcn_mfma_f32_16x16x32_bf16(Bt[n][k], At[m][k], acc[ai][bj][m][n], 0, 0, 0); __builtin_amdgcn_s_setprio(0); } while (0)
#define PG8_WAIT_V(n) asm volatile("s_waitcnt vmcnt(" #n ")" ::: "memory")
#define PG8_WAIT_L(n) asm volatile("s_waitcnt lgkmcnt(" #n ")" ::: "memory")
#define PG8_BAR __builtin_amdgcn_s_barrier()
#define PG8_SCHED __builtin_amdgcn_sched_barrier(0)
    Unit cur, nxt; int ui = 0;
    if (!S.next(0, cur)) return;
    f32x4 acc[2][2][4][2];
#pragma unroll
    for (int a = 0; a < 2; ++a)
#pragma unroll
        for (int b = 0; b < 2; ++b)
#pragma unroll
            for (int m = 0; m < 4; ++m)
#pragma unroll
                for (int n = 0; n < 2; ++n) acc[a][b][m][n] = (f32x4){0.f, 0.f, 0.f, 0.f};
    bf16x8 At[4][2], B0[2][2], B1[2][2];
    int cnt = cur.nkt > 0 ? cur.nkt : nt;
    const char* cA = (const char*)g.A + (size_t)cur.pm * tstep + (size_t)cur.kt0 * kstep; const char* cB = (const char*)g.Bt + (size_t)cur.pn * tstep + (size_t)cur.kt0 * kstep;
    S.a_ready(cur);
    if constexpr (SP2) {
        PG8_STAGE(PG8_SB(0, 0), cB, voffB); PG8_STAGE(PG8_SB(0, 1), cB + hstep, voffB); PG8_STAGE(PG8_SA(0, 0), cA, voffA); PG8_STAGE(PG8_SA(0, 1), cA + hstep, voffA);
        if (wr == 1) PG8_BAR;
        PG8_WAIT_V(2); PG8_BAR;
        PG8_STAGE(PG8_SB(1, 0), cB + kstep, voffB); PG8_STAGE(PG8_SA(1, 0), cA + kstep, voffA); PG8_STAGE(PG8_SB(1, 1), cB + hstep + kstep, voffB);
        PG8_WAIT_V(6); PG8_BAR;
    } else {
        PG8_STAGE(PG8_SB(0, 0), cB, voffB); PG8_STAGE(PG8_SA(0, 0), cA, voffA); PG8_STAGE(PG8_SB(0, 1), cB + hstep, voffB); PG8_STAGE(PG8_SA(0, 1), cA + hstep, voffA);
        if (wr == 1) PG8_BAR;
        PG8_WAIT_V(4); PG8_BAR;
        PG8_STAGE(PG8_SB(1, 0), cB + kstep, voffB); PG8_STAGE(PG8_SA(1, 0), cA + kstep, voffA); PG8_STAGE(PG8_SB(1, 1), cB + hstep + kstep, voffB);
        PG8_WAIT_V(6); PG8_BAR;
    }
    for (;;) {
        const bool has_next = S.next(ui + 1, nxt);
        const char* nA = has_next ? (const char*)g.A + (size_t)nxt.pm * tstep + (size_t)nxt.kt0 * kstep : cA; const char* nB = has_next ? (const char*)g.Bt + (size_t)nxt.pn * tstep + (size_t)nxt.kt0 * kstep : cB;
        for (int t = 0; t < cnt; t += 2) {
            const bool last = (t == cnt - 2);
            const char* a1 = cA + (size_t)(t + 1) * kstep;
            const char* a2 = last ? nA : cA + (size_t)(t + 2) * kstep; const char* b2 = last ? nB : cB + (size_t)(t + 2) * kstep;
            const char* a3 = a2 + kstep; const char* b3 = b2 + kstep;
            if (last && has_next) S.a_ready(nxt);
            if constexpr (SP2) {
            PG8_LDB(B0, 0, 0); PG8_LDB(B1, 0, 1); PG8_SCHED; PG8_LDA(At, 0, 0); PG8_STAGE(PG8_SA(1, 1), a1 + hstep, voffA);
            PG8_WAIT_V(8); PG8_WAIT_L(0); PG8_BAR; PG8_MMA(0, 0, At, B0); PG8_MMA(0, 1, At, B1); PG8_BAR; PG8_SCHED;
            PG8_LDA(At, 0, 1); PG8_STAGE(PG8_SB(0, 0), b2, voffB); PG8_STAGE(PG8_SB(0, 1), b2 + hstep, voffB); PG8_STAGE(PG8_SA(0, 0), a2, voffA);
            PG8_WAIT_V(8); PG8_WAIT_L(0); PG8_BAR; PG8_MMA(1, 0, At, B0); PG8_MMA(1, 1, At, B1); PG8_BAR; PG8_SCHED;
            PG8_LDB(B0, 1, 0); PG8_LDB(B1, 1, 1); PG8_SCHED; PG8_LDA(At, 1, 0); PG8_STAGE(PG8_SA(0, 1), a2 + hstep, voffA);
            PG8_WAIT_V(8); PG8_WAIT_L(0); PG8_BAR; PG8_MMA(0, 0, At, B0); PG8_MMA(0, 1, At, B1); PG8_BAR; PG8_SCHED;
            PG8_LDA(At, 1, 1); PG8_STAGE(PG8_SB(1, 0), b3, voffB); PG8_STAGE(PG8_SB(1, 1), b3 + hstep, voffB); PG8_STAGE(PG8_SA(1, 0), a3, voffA);
            PG8_WAIT_V(8); PG8_WAIT_L(0); PG8_BAR; PG8_MMA(1, 0, At, B0); PG8_MMA(1, 1, At, B1); PG8_BAR; PG8_SCHED;
            } else {
            PG8_LDB(B0, 0, 0); PG8_SCHED; PG8_LDA(At, 0, 0); PG8_STAGE(PG8_SA(1, 1), a1 + hstep, voffA);
            PG8_WAIT_L(8); PG8_BAR; PG8_WAIT_L(0); PG8_MMA(0, 0, At, B0); PG8_BAR; PG8_SCHED;
            PG8_LDB(B1, 0, 1); PG8_STAGE(PG8_SB(0, 0), b2, voffB);
            PG8_BAR; PG8_WAIT_L(0); PG8_MMA(0, 1, At, B1); PG8_BAR;
            PG8_LDA(At, 0, 1); PG8_STAGE(PG8_SA(0, 0), a2, voffA);
            PG8_BAR; PG8_WAIT_L(0); PG8_MMA(1, 0, At, B0); PG8_BAR; PG8_SCHED;
            PG8_STAGE(PG8_SB(0, 1), b2 + hstep, voffB);
            PG8_WAIT_V(6); PG8_BAR; PG8_MMA(1, 1, At, B1); PG8_BAR;
            PG8_LDB(B0, 1, 0); PG8_SCHED; PG8_LDA(At, 1, 0); PG8_STAGE(PG8_SA(0, 1), a2 + hstep, voffA);
            PG8_WAIT_L(8); PG8_BAR; PG8_WAIT_L(0); PG8_MMA(0, 0, At, B0); PG8_BAR; PG8_SCHED;
            PG8_LDB(B1, 1, 1); PG8_STAGE(PG8_SB(1, 0), b3, voffB);
            PG8_BAR; PG8_WAIT_L(0); PG8_MMA(0, 1, At, B1); PG8_BAR;
            PG8_LDA(At, 1, 1); PG8_STAGE(PG8_SA(1, 0), a3, voffA);
            PG8_BAR; PG8_WAIT_L(0); PG8_MMA(1, 0, At, B0); PG8_BAR; PG8_SCHED;
            PG8_STAGE(PG8_SB(1, 1), b3 + hstep, voffB);
            PG8_WAIT_V(6); PG8_BAR; PG8_MMA(1, 1, At, B1); PG8_BAR;
            }
        }
        if constexpr (ALIGN_EPI) { if (wr == 0) PG8_BAR; }
        if constexpr (!Epi::AFTER_DRAIN) { if (cur.part >= 0) slab_dump(acc, cur, g.slab, g.nparts, wr, wc, fr, fq); else E(acc, cur, wr, wc, fr, fq); S.done(cur); }
        if (!has_next) break;
#pragma unroll
        for (int a = 0; a < 2; ++a)
#pragma unroll
            for (int b = 0; b < 2; ++b)
#pragma unroll
                for (int m = 0; m < 4; ++m)
#pragma unroll
                    for (int n = 0; n < 2; ++n) acc[a][b][m][n] = (f32x4){0.f, 0.f, 0.f, 0.f};
        cur = nxt; cA = nA; cB = nB; ++ui; cnt = cur.nkt > 0 ? cur.nkt : nt;
        if constexpr (ALIGN_EPI) { if (wr == 1) PG8_BAR; }
    }
    PG8_WAIT_V(0);
    if constexpr (!ALIGN_EPI) { if (wr == 0) PG8_BAR; }
    PG8_BAR;
    if constexpr (Epi::AFTER_DRAIN) { E.fused(acc, cur, wr, wc, fr, fq, lds, wid, lane); S.done(cur); }
#undef PG8_SA
#undef PG8_SB
#undef PG8_STAGE
#undef PG8_LDA
#undef PG8_LDB
#undef PG8_MMA
#undef PG8_WAIT_V
#undef PG8_WAIT_L
#undef PG8_BAR
#undef PG8_SCHED
}
}

constexpr int DM = 1024, NROWS = 16640, NPROMPT = 16384, NMETAROWS = 128, SROW0 = 16512;
constexpr int DFF = 2816, NCHUNK = 33, NB = 8, NSAMP = 128;
constexpr int PA_LD = 1792, PB_LD = 2048, DIN_PAD = 3840;
constexpr float EPS = 1e-6f;
constexpr size_t MiB = 1u << 20;
constexpr size_t WS_CTL = 0, WS_SS = 1 * MiB, CTL_ZERO_BYTES = 2 * MiB;
constexpr size_t WS_ROPE = 2 * MiB;
constexpr size_t WS_XE = 3 * MiB;
constexpr size_t WS_LWT = 6 * MiB;
constexpr size_t WS_GCA = 4 * MiB, WS_CA = 4 * MiB + 65536, WS_CB = WS_CA + 524288;
constexpr size_t WS_WT = 8 * MiB;
constexpr size_t WT_F1I = 0, WT_F1O = 11534336, WT_WIN = 17301504, WT_WOUT = 25165824, WT_F2I = 27262976, WT_F2O = 38797312, WT_END = 44564480;
constexpr size_t WS_XB = 52 * MiB;
constexpr size_t WS_R = 86 * MiB;
constexpr size_t WS_H = WS_R, WS_PA = WS_R, WS_O = WS_R, WS_PB = 144 * MiB, WS_DNI = 210 * MiB, WS_LA = 285 * MiB, WS_LB = 294 * MiB, WS_END = 303 * MiB;
static_assert(WS_SS + (size_t)7 * NROWS * 8 <= CTL_ZERO_BYTES, "ss arrays inside the memset");
static_assert(WS_WT + WT_END <= WS_XB && WS_XB + (size_t)NROWS * DM * 2 <= WS_R && WS_H + (size_t)NROWS * DFF * 2 <= WS_END, "ws map");
static_assert(WS_PA + (size_t)NROWS * PA_LD * 2 <= WS_PB && WS_PB + (size_t)NROWS * PB_LD * 2 <= WS_DNI, "ws map 2");
constexpr size_t WS_SLAB = WS_DNI;
constexpr int DNI_ITEM = 73728;
constexpr int DNI_W = 0, DNI_QG = 16384, DNI_KDT = 32768, DNI_UVT = 49152, DNI_P = 65536;
static_assert(WS_DNI + (size_t)1056 * DNI_ITEM <= WS_LA && WS_LA + (size_t)NROWS * 256 * 2 <= WS_LB && WS_LB + (size_t)NROWS * 256 * 2 <= WS_END, "ws map 3");
constexpr int CW_BAR = 4096;
constexpr size_t O_YP = 0, O_YS = 16777216, O_DNP = O_YS + 131072, O_DNCP = O_DNP + 1048576, O_LRUP = O_DNCP + 73728, O_LRUCP = O_LRUP + 4096, O_RETP = O_LRUCP + 12288,
                 O_DNS = O_RETP + 262144, O_DNCS = O_DNS + 16777216, O_LRUS = O_DNCS + 1179648, O_LRUCS = O_LRUS + 65536, O_RETS = O_LRUCS + 196608, O_END = O_RETS + 4194304;
constexpr int LDS_BYTES = 155648, MISC_OFF = LDS_BYTES - 256;
constexpr int NWAVES = 8, NTHREADS = 512;

#define GAS __attribute__((address_space(1)))
#define LAS __attribute__((address_space(3)))
typedef unsigned short bf16;
typedef float f32x4 __attribute__((ext_vector_type(4)));
typedef float f32x16 __attribute__((ext_vector_type(16)));
typedef short bf16x8 __attribute__((ext_vector_type(8)));
typedef unsigned u32x4 __attribute__((ext_vector_type(4)));
typedef unsigned u32x2 __attribute__((ext_vector_type(2)));
#define DI __device__ __forceinline__
DI unsigned f2bf(float f) { return (unsigned)__builtin_bit_cast(unsigned short, (__bf16)f); }
typedef __bf16 hwbf16x2 __attribute__((ext_vector_type(2)));
typedef float f32x2 __attribute__((ext_vector_type(2)));
DI unsigned pk2(float lo, float hi) { const f32x2 v = {lo, hi}; return __builtin_bit_cast(unsigned, __builtin_convertvector(v, hwbf16x2)); }
DI float bflo(unsigned w) { return __builtin_bit_cast(float, w << 16); }
DI float bfhi(unsigned w) { return __builtin_bit_cast(float, w & 0xffff0000u); }
DI f32x4 ld4bf(const bf16* p) { const u32x2 v = *(const u32x2*)p; return (f32x4){bflo(v.x), bfhi(v.x), bflo(v.y), bfhi(v.y)}; }
DI float bf1(bf16 b) { return __builtin_bit_cast(float, (unsigned)b << 16); }
DI float sigm(float x) { return __builtin_amdgcn_rcpf(1.0f + __expf(-x)); }
DI float silu(float x) { return x * sigm(x); }
DI float softplus(float x) { return x > 20.f ? x : log1pf(__expf(x)); }
DI float gelu_tanh(float y) { const float u = 0.7978845608028654f * (y + 0.044715f * y * y * y); const float t = 1.0f - 2.0f * __builtin_amdgcn_rcpf(__expf(2.0f * u) + 1.0f); return 0.5f * y * (1.0f + t); }
DI float xshfl(float v, int src) { return __builtin_bit_cast(float, __builtin_amdgcn_ds_bpermute(src << 2, __builtin_bit_cast(int, v))); }
DI float wave_sum(float v, int lane) {
#pragma unroll
    for (int o = 1; o < 64; o <<= 1) v += xshfl(v, lane ^ o);
    return v;
}
#define MFMA32(a, b, c) __builtin_amdgcn_mfma_f32_32x32x16_bf16((a), (b), (c), 0, 0, 0)
DI int crow(int reg, int hh) { return (reg & 3) + 8 * (reg >> 2) + 4 * hh; }

typedef GAS unsigned gu32;
#define RLX_AGENT __ATOMIC_RELAXED, __HIP_MEMORY_SCOPE_AGENT
#define XB_TMO      128
#define XB_XCNT(j)  (256  + 64 * (j))
#define XB_XSUB(j)  (1280 + 64 * (j))
#define XB_XGEN(j)  (2304 + 64 * (j))
#define XB_TOP      3328
#define XB_TOPGEN   3392
#define XCD_BAR_WORDS 3456
#define XB_SPIN_CAP (1u << 18)

__device__ __forceinline__ unsigned xb_ld(unsigned* p)              { return __hip_atomic_load(p, __ATOMIC_RELAXED, __HIP_MEMORY_SCOPE_AGENT); }
__device__ __forceinline__ unsigned xb_add(unsigned* p, unsigned v) { return __hip_atomic_fetch_add(p, v, __ATOMIC_RELAXED, __HIP_MEMORY_SCOPE_AGENT); }
__device__ __forceinline__ unsigned xb_xcc_id() { return (unsigned)__builtin_amdgcn_s_getreg((3 << 11) | 20) & 0xFu; }
#define XB_SPIN(cond, bar) do { unsigned _sp = 0; while (cond) { __builtin_amdgcn_s_sleep(1); \
    if ((++_sp & 255u) == 0u) { if (xb_ld(&(bar)[XB_TMO])) break; if (_sp > XB_SPIN_CAP) { atomicAdd(&(bar)[XB_TMO], 1u); break; } } } } while (0)

struct XcdBarrier {
    unsigned* bar; unsigned x;
    volatile LAS unsigned* st;
};

__device__ __forceinline__ XcdBarrier xcd_barrier_post(unsigned* bar, volatile LAS unsigned* st) {
    XcdBarrier b; b.bar = bar; b.x = xb_xcc_id(); b.st = st;
    if (threadIdx.x == 0) (void)xb_add(&bar[XB_XCNT(b.x)], 1u);
    return b;
}
__device__ __forceinline__ void xcd_barrier_complete(unsigned* bar, unsigned x, unsigned& nloc, unsigned& nx) {
    const unsigned G = gridDim.x * gridDim.y * gridDim.z;
    unsigned sum, cnt, mine, sp = 0u;
    for (;;) {
        sum = 0u; cnt = 0u; mine = 0u;
#pragma unroll
        for (unsigned j = 0; j < 16; ++j) { const unsigned c = xb_ld(&bar[XB_XCNT(j)]); sum += c; cnt += (c > 0u) ? 1u : 0u; mine = (j == x) ? c : mine; }
        if (sum == G) break;
        __builtin_amdgcn_s_sleep(1);
        if ((++sp & 255u) == 0u) { if (xb_ld(&bar[XB_TMO])) break; if (sp > XB_SPIN_CAP) { atomicAdd(&bar[XB_TMO], 1u); break; } }
    }
    nloc = mine > 0u ? mine : 1u; nx = cnt > 0u ? cnt : 1u;
}

__device__ __forceinline__ void xcd_barrier(const XcdBarrier& b, const int tid) {
    asm volatile("s_waitcnt vmcnt(0)" ::: "memory");
    __syncthreads();
    if (tid == 0) {
        unsigned* bar = b.bar;
        __builtin_amdgcn_s_waitcnt(0);
        unsigned nloc = b.st[0], nx = b.st[1];
        if (nloc == 0u) { xcd_barrier_complete(bar, b.x, nloc, nx); b.st[0] = nloc; b.st[1] = nx; }
        const unsigned old = xb_add(&bar[XB_XSUB(b.x)], 1u);
        const unsigned gen = old / nloc;
        if (old + 1u == (gen + 1u) * nloc) {
            __builtin_amdgcn_fence(__ATOMIC_RELEASE, "agent");
            asm volatile("s_waitcnt vmcnt(0)" ::: "memory");
            const unsigned og = xb_add(&bar[XB_TOP], 1u);
            const unsigned tg = og / nx;
            if (og + 1u == (tg + 1u) * nx) xb_add(&bar[XB_TOPGEN], 1u);
            else XB_SPIN(xb_ld(&bar[XB_TOPGEN]) == tg, bar);
            __builtin_amdgcn_fence(__ATOMIC_ACQUIRE, "agent");
            xb_add(&bar[XB_XGEN(b.x)], 1u);
            asm volatile("s_waitcnt vmcnt(0)" ::: "memory");
        } else {
            XB_SPIN(xb_ld(&bar[XB_XGEN(b.x)]) == gen, bar);
            __builtin_amdgcn_fence(__ATOMIC_ACQUIRE, "agent");
            asm volatile("s_waitcnt vmcnt(0)" ::: "memory");
        }
    }
    __syncthreads();
}

struct Args { const float* in[29]; float* out; unsigned char* ws; int ph_lo, ph_hi; };
typedef const float* const __attribute__((address_space(4))) * kargp_t;
DI const float* inp(int i) { kargp_t p = (kargp_t)__builtin_amdgcn_kernarg_segment_ptr(); asm volatile("" : "+s"(p)); return (const float*)(const GAS float*)(unsigned long long)p[i]; }
struct Ctx {
    float* out; unsigned char* ws;
    unsigned char* lds;
    int tid, lane, wave, G, bid;
};
DI Ctx fresh(const Ctx& C0) { Ctx C = C0; int t = C0.tid; asm volatile("" : "+v"(t)); C.tid = t; C.lane = t & 63; C.wave = __builtin_amdgcn_readfirstlane(t >> 6); return C; }
enum { I_XP = 0, I_XS, I_SDN, I_SDNC, I_SLRU, I_SLRUC, I_SRET, I_META, I_NF1, I_WF1I, I_WF1O, I_NMIX, I_WIN, I_DNCW, I_ALOG, I_DTB, I_DNNW, I_LCW, I_LCB, I_LWA, I_LBA, I_LWX, I_LBX, I_LLAM,
       I_WOUT, I_NF2, I_WF2I, I_WF2O, I_NFIN };

template <int MODE> DI int colmap(int n) {
    if (MODE == 0) return n;
    if (MODE == 1) { const int pn = n >> 8, bj = (n >> 7) & 1, j = n & 127; return bj * DFF + 128 * pn + j; }
    return n < 1544 ? n : (n < 1792 ? -1 : n - 248);
}
template <int MODE> DI void convert_item(const float* W, int K, int Nsrc, int Ndst, const float* scale, bf16* WT, float* scr, int item, int lane) {
    const int nblk = Ndst / 32, kb = item / nblk, nb = item % nblk, k0 = 64 * kb, n0 = 32 * nb;
    const int sc = colmap<MODE>(n0 + (lane & 31));
#pragma unroll 8
    for (int i = 0; i < 32; ++i) { const int kk = 2 * i + (lane >> 5); float v = 0.f; if (sc >= 0) v = W[(size_t)(k0 + kk) * Nsrc + sc]; if (scale) v *= scale[k0 + kk]; scr[kk * 33 + (lane & 31)] = v; }
    asm volatile("s_waitcnt lgkmcnt(0)" ::: "memory");
    const int c = lane & 7;
#pragma unroll
    for (int j = 0; j < 4; ++j) { const int n = (lane >> 3) + 8 * j; const float* s = scr + (8 * c) * 33 + n;
        u32x4 o; o.x = pk2(s[0 * 33], s[1 * 33]); o.y = pk2(s[2 * 33], s[3 * 33]); o.z = pk2(s[4 * 33], s[5 * 33]); o.w = pk2(s[6 * 33], s[7 * 33]);
        *(u32x4*)(WT + (size_t)(n0 + n) * K + k0 + 8 * c) = o; }
    asm volatile("s_waitcnt lgkmcnt(0)" ::: "memory");
}
DI void convert_set(const Ctx& C, int l, int set, int gw, int nwaves) {
    float* scr = (float*)(C.lds + C.wave * 16384);
    constexpr int I1 = 16 * 176, I2 = 44 * 32, I3 = 16 * 120, I4 = 16 * 32;
    unsigned char* wt = C.ws + WS_WT;
    if (set == 0 || set == 2 || set == 3) {
        const int lo_ = (set == 3) ? I1 : 0, hi_ = (set == 2) ? I1 : I1 + I2 + I3;
        for (int it = lo_ + gw; it < hi_; it += nwaves) { int r = it;
            if (r < I1) { convert_item<1>(inp(I_WF1I) + (size_t)l * DM * 2 * DFF, DM, 2 * DFF, 2 * DFF, inp(I_NF1) + l * DM, (bf16*)(wt + WT_F1I), scr, r, C.lane); continue; } r -= I1;
            if (r < I2) { convert_item<0>(inp(I_WF1O) + (size_t)l * DFF * DM, DFF, DM, DM, nullptr, (bf16*)(wt + WT_F1O), scr, r, C.lane); continue; } r -= I2;
            convert_item<2>(inp(I_WIN) + (size_t)l * DM * 3592, DM, 3592, DIN_PAD, inp(I_NMIX) + l * DM, (bf16*)(wt + WT_WIN), scr, r, C.lane); }
    } else {
        for (int it = gw; it < I1 + I2 + I4; it += nwaves) { int r = it;
            if (r < I1) { convert_item<1>(inp(I_WF2I) + (size_t)l * DM * 2 * DFF, DM, 2 * DFF, 2 * DFF, inp(I_NF2) + l * DM, (bf16*)(wt + WT_F2I), scr, r, C.lane); continue; } r -= I1;
            if (r < I2) { convert_item<0>(inp(I_WF2O) + (size_t)l * DFF * DM, DFF, DM, DM, nullptr, (bf16*)(wt + WT_F2O), scr, r, C.lane); continue; } r -= I2;
            convert_item<0>(inp(I_WOUT) + (size_t)l * DM * DM, DM, DM, DM, nullptr, (bf16*)(wt + WT_WOUT), scr, r, C.lane); }
    }
}
DI void convert_lru_weights(const Ctx& C) {
    const int g = C.bid * NTHREADS + C.tid;
    if (g < 2 * 2 * 4 * 64 * 64) { const int l = g >> 15, mat = (g >> 14) & 1, n = (g >> 12) & 3, e = (g >> 6) & 63, d = g & 63;
        const float v = inp(mat ? I_LWX : I_LWA)[(size_t)((l * 4 + n) * 64 + d) * 64 + e]; ((bf16*)(C.ws + WS_LWT))[g] = (bf16)f2bf(v); }
}
DI void sincos_d(double ang, double& s, double& c) {
    const double TWO_PI = 6.283185307179586476925286766559, HALF_PI = 1.5707963267948966192313216916398;
    double n = __builtin_rint(ang / TWO_PI); double r = ang - n * TWO_PI;
    double k = __builtin_rint(r / HALF_PI); double y = r - k * HALF_PI;
    const double y2 = y * y;
    double sp = 1.0 / 1307674368000.0; sp = sp * y2 - 1.0 / 6227020800.0; sp = sp * y2 + 1.0 / 39916800.0; sp = sp * y2 - 1.0 / 362880.0; sp = sp * y2 + 1.0 / 5040.0; sp = sp * y2 - 1.0 / 120.0; sp = sp * y2 + 1.0 / 6.0;
    const double sy = y - y * y2 * sp;
    double cp = 1.0 / 20922789888000.0; cp = cp * y2 - 1.0 / 87178291200.0; cp = cp * y2 + 1.0 / 479001600.0; cp = cp * y2 - 1.0 / 3628800.0; cp = cp * y2 + 1.0 / 40320.0; cp = cp * y2 - 1.0 / 720.0; cp = cp * y2 + 1.0 / 24.0;
    const double cy = 1.0 - 0.5 * y2 + y2 * y2 * cp;
    const int q = ((int)k) & 3;
    s = (q == 0) ? sy : (q == 1) ? cy : (q == 2) ? -sy : -cy;
    c = (q == 0) ? cy : (q == 1) ? -sy : (q == 2) ? -cy : sy;
}
DI void p0_rows(const Ctx& C) {
    const int gw = C.bid * NWAVES + C.wave, NGW = C.G * NWAVES;
    unsigned long long* ss0 = (unsigned long long*)(C.ws + WS_SS); bf16* XB = (bf16*)(C.ws + WS_XB); float* XE = (float*)(C.ws + WS_XE);
    for (int row = gw; row < NROWS; row += NGW) {
        const float* src = row < NPROMPT ? inp(I_XP) + (size_t)row * DM : (row < SROW0 ? inp(I_META) + (size_t)((row - NPROMPT) & 15) * DM : inp(I_XS) + (size_t)(row - SROW0) * DM);
        f32x4 v[4]; float s = 0.f;
#pragma unroll
        for (int j = 0; j < 4; ++j) { v[j] = *(const f32x4*)(src + 4 * C.lane + 256 * j); s += (v[j].x * v[j].x + v[j].y * v[j].y) + (v[j].z * v[j].z + v[j].w * v[j].w); }
        s = wave_sum(s, C.lane);
        if (C.lane == 0) ss0[row] = (unsigned long long)(s * 1048576.0f + 0.5f);
#pragma unroll
        for (int j = 0; j < 4; ++j) { u32x2 w; w.x = pk2(v[j].x, v[j].y); w.y = pk2(v[j].z, v[j].w); *(u32x2*)(XB + (size_t)row * DM + 4 * C.lane + 256 * j) = w;
            if (row >= NPROMPT) *(f32x4*)(XE + (size_t)(row - NPROMPT) * DM + 4 * C.lane + 256 * j) = v[j]; }
    }
    float* rope = (float*)(C.ws + WS_ROPE);
    for (int e = C.bid * NTHREADS + C.tid; e < 2065 * 32; e += C.G * NTHREADS) {
        const int p = e >> 5, i = e & 31; double inv = 1.0; for (int k = 0; k < i; ++k) inv *= 0.7498942093324558;
        const double pos = (p == 2064) ? 16384.0 : (double)p; double s, c; sincos_d(pos * inv, s, c);
        rope[2 * e] = (float)c; rope[2 * e + 1] = (float)s;
    }
}
DI void final_norm(const Ctx& C) {
    const int gw = C.bid * NWAVES + C.wave, NGW = C.G * NWAVES;
    const unsigned long long* ss = (const unsigned long long*)(C.ws + WS_SS) + 6 * NROWS; const float* XE = (const float*)(C.ws + WS_XE); const float* nw = inp(I_NFIN);
    f32x4 w[4];
#pragma unroll
    for (int j = 0; j < 4; ++j) w[j] = *(const f32x4*)(nw + 4 * C.lane + 256 * j);
    for (int it = gw; it < NPROMPT + NSAMP; it += NGW) {
        const int row = it < NPROMPT ? it : SROW0 + (it - NPROMPT);
        const float* src = it < NPROMPT ? C.out + O_YP + (size_t)row * DM : XE + (size_t)(row - NPROMPT) * DM;
        float* dst = it < NPROMPT ? C.out + O_YP + (size_t)row * DM : C.out + O_YS + (size_t)(it - NPROMPT) * DM;
        const float rs = 1.0f / sqrtf((float)ss[row] * (1.0f / (1024.0f * 1048576.0f)) + EPS);
#pragma unroll
        for (int j = 0; j < 4; ++j) { const f32x4 v = *(const f32x4*)(src + 4 * C.lane + 256 * j); *(f32x4*)(dst + 4 * C.lane + 256 * j) = v * rs * w[j]; }
    }
}

DI void fix_rows(const Ctx& C, int nparts, float scale, unsigned long long* ssn) {
    const int gw = C.bid * NWAVES + C.wave, NGW = C.G * NWAVES;
    const float* slab = (const float*)(C.ws + WS_SLAB); float* XE = (float*)(C.ws + WS_XE); bf16* XB = (bf16*)(C.ws + WS_XB);
    for (int job = gw; job < 256 * 4; job += NGW) {
        const int r = job >> 2, pn = job & 3;
        const float* sp = slab + (size_t)(pn * nparts) * 65536 + (size_t)r * 256 + 4 * C.lane;
        f32x4 a = (f32x4){0.f, 0.f, 0.f, 0.f};
        for (int p = 0; p < nparts; ++p) a = a + *(const f32x4*)(sp + (size_t)p * 65536);
        float* xp = XE + (size_t)r * DM + 256 * pn + 4 * C.lane;
        const f32x4 x = *(const f32x4*)xp + a * scale;
        *(f32x4*)xp = x;
        u32x2 w; w.x = pk2(x.x, x.y); w.y = pk2(x.z, x.w); *(u32x2*)(XB + (size_t)(NPROMPT + r) * DM + 256 * pn + 4 * C.lane) = w;
        const float sq = wave_sum((x.x * x.x + x.y * x.y) + (x.z * x.z + x.w * x.w), C.lane);
        if (C.lane == 0) atomicAdd(ssn + NPROMPT + r, (unsigned long long)(sq * 1048576.0f + 0.5f));
    }
}

DI void final_fix_norm(const Ctx& C, int nparts, float scale) {
    const int gw = C.bid * NWAVES + C.wave, NGW = C.G * NWAVES;
    const unsigned long long* ss = (const unsigned long long*)(C.ws + WS_SS) + 6 * NROWS; const float* nw = inp(I_NFIN);
    const float* slab = (const float*)(C.ws + WS_SLAB); const float* XE = (const float*)(C.ws + WS_XE); const bf16* XB = (const bf16*)(C.ws + WS_XB);
    f32x4 w[4];
#pragma unroll
    for (int j = 0; j < 4; ++j) w[j] = *(const f32x4*)(nw + 4 * C.lane + 256 * j);
    for (int it = gw; it < NPROMPT + NSAMP; it += NGW) {
        if (it < NSAMP) {
            const int r = 128 + it; f32x4 x[4]; float sq = 0.f;
#pragma unroll
            for (int pn = 0; pn < 4; ++pn) { const float* sp = slab + (size_t)(pn * nparts) * 65536 + (size_t)r * 256 + 4 * C.lane; f32x4 a = (f32x4){0.f, 0.f, 0.f, 0.f};
                for (int p = 0; p < nparts; ++p) a = a + *(const f32x4*)(sp + (size_t)p * 65536);
                x[pn] = *(const f32x4*)(XE + (size_t)r * DM + 256 * pn + 4 * C.lane) + a * scale; sq += (x[pn].x * x[pn].x + x[pn].y * x[pn].y) + (x[pn].z * x[pn].z + x[pn].w * x[pn].w); }
            const float rs = 1.0f / sqrtf(wave_sum(sq, C.lane) * (1.0f / 1024.0f) + EPS);
#pragma unroll
            for (int pn = 0; pn < 4; ++pn) *(f32x4*)(C.out + O_YS + (size_t)it * DM + 256 * pn + 4 * C.lane) = x[pn] * rs * w[pn];
        } else { const int row = it - NSAMP;
            const float rs = 1.0f / sqrtf((float)ss[row] * (1.0f / (1024.0f * 1048576.0f)) + EPS);
#pragma unroll
            for (int j = 0; j < 4; ++j) { const f32x4 v = ld4bf(XB + (size_t)row * DM + 4 * C.lane + 256 * j); *(f32x4*)(C.out + O_YP + (size_t)row * DM + 4 * C.lane + 256 * j) = v * rs * w[j]; } }
    }
}
DI int chunk_row0(int b, int c) { return c == 0 ? NPROMPT + 16 * b : b * 2048 + 64 * (c - 1); }
DI int halo_row(int b, int c, int back) { return c == 0 ? -1 : (c == 1 ? NPROMPT + 16 * b + 16 - back : b * 2048 + 64 * (c - 1) - back); }

constexpr int N1_R = 0, N1_QB = 52736, N1_KB = 70144, N1_RT = 87552, N1_SM = 124416, N1_CW = 126464, N1_AB = 0, N1_AD = 9216, N1_TD = 14336, N1_WS = 18432;
#define MFMA16(a, b, c) __builtin_amdgcn_mfma_f32_16x16x32_bf16((a), (b), (c), 0, 0, 0)
DI void m1_dn_item(const Ctx& C, int l, int b, int c, int h) {
    const int tid = C.tid, lane = C.lane, wid = C.wave;
    bf16* R = (bf16*)(C.lds + N1_R); bf16* QB = (bf16*)(C.lds + N1_QB); bf16* KB = (bf16*)(C.lds + N1_KB); bf16* RT = (bf16*)(C.lds + N1_RT);
    float* sm = (float*)(C.lds + N1_SM); float* CW = (float*)(C.lds + N1_CW);
    bf16* AB = (bf16*)(C.lds + N1_AB); float* AD = (float*)(C.lds + N1_AD); bf16* TD = (bf16*)(C.lds + N1_TD); bf16* WS = (bf16*)(C.lds + N1_WS);
    const bf16* PA = (const bf16*)(C.ws + WS_PA);
    const int L = (c == 0) ? 16 : 64, row0 = chunk_row0(b, c), item = (b * NCHUNK + c) * 4 + h;
    unsigned char* dni = C.ws + WS_DNI + (size_t)item * DNI_ITEM;
    { u32x4 rv[7];
#pragma unroll
      for (int k = 0; k < 7; ++k) { const int p = tid + 512 * k; rv[k] = (u32x4){0u, 0u, 0u, 0u};
          if (p < 67 * 48) { const int ri = p / 48, pc = p % 48, t = ri - 3; int row = -1;
              if (t < 0) row = halo_row(b, c, -t); else if (t < L) row = row0 + t;
              if (row >= 0) rv[k] = *(const u32x4*)(PA + (size_t)row * PA_LD + (pc >> 4) * 512 + h * 128 + 8 * (pc & 15)); } }
      f32x4 cwv = (f32x4){0.f, 0.f, 0.f, 0.f};
      if (tid < 384) { const int tap = tid / 96, q4 = tid % 96; cwv = *(const f32x4*)(inp(I_DNCW) + (size_t)l * 4 * 1536 + tap * 1536 + (q4 >> 5) * 512 + h * 128 + 4 * (q4 & 31)); }
      if (wid == 7) {
          const int t = lane; float g = 0.f, be = 0.f;
          if (t < L) { const bf16* pr = PA + (size_t)(row0 + t) * PA_LD + 1536 + h; const float a = bf1(pr[0]), bb = bf1(pr[4]);
              g = -__expf(inp(I_ALOG)[l * 4 + h]) * softplus(a + inp(I_DTB)[l * 4 + h]); be = sigm(bb); }
          float G = g;
#pragma unroll
          for (int o = 1; o < 64; o <<= 1) { const float v = xshfl(G, (lane - o) & 63); if (lane >= o) G += v; }
          const float GC = xshfl(G, 63);
          sm[t] = G; sm[64 + t] = be; sm[128 + t] = __expf(G); sm[192 + t] = __expf(GC - G);
          if (lane == 0) ((float*)(C.ws + WS_GCA))[item] = __expf(GC);
      }
#pragma unroll
      for (int k = 0; k < 7; ++k) { const int p = tid + 512 * k; if (p < 67 * 48) *(u32x4*)((unsigned char*)R + (p / 48) * 784 + (p % 48) * 16) = rv[k]; }
      if (tid < 384) { const int tap = tid / 96, q4 = tid % 96; *(f32x4*)(CW + tap * 384 + 4 * q4) = cwv; } }
    __syncthreads();
    { const int t = tid >> 3, cg = tid & 7; const bool live = t < L;
#pragma unroll
      for (int part = 0; part < 2; ++part) {
          float y[16];
#pragma unroll
          for (int j = 0; j < 16; ++j) y[j] = 0.f;
          u32x4 x3[2] = {(u32x4){0u, 0u, 0u, 0u}, (u32x4){0u, 0u, 0u, 0u}};
#pragma unroll
          for (int tap = 0; tap < 4; ++tap)
#pragma unroll
              for (int hf = 0; hf < 2; ++hf) { const u32x4 xv = *(const u32x4*)(R + (t + tap) * 392 + part * 128 + 16 * cg + 8 * hf); if (tap == 3) x3[hf] = xv;
                  const f32x4 w0 = *(const f32x4*)(CW + tap * 384 + part * 128 + 16 * cg + 8 * hf), w1 = *(const f32x4*)(CW + tap * 384 + part * 128 + 16 * cg + 8 * hf + 4);
                  y[8 * hf + 0] += w0.x * bflo(xv.x); y[8 * hf + 1] += w0.y * bfhi(xv.x); y[8 * hf + 2] += w0.z * bflo(xv.y); y[8 * hf + 3] += w0.w * bfhi(xv.y);
                  y[8 * hf + 4] += w1.x * bflo(xv.z); y[8 * hf + 5] += w1.y * bfhi(xv.z); y[8 * hf + 6] += w1.z * bflo(xv.w); y[8 * hf + 7] += w1.w * bfhi(xv.w); }
          float ss = 0.f;
#pragma unroll
          for (int j = 0; j < 16; ++j) { y[j] = live ? silu(y[j]) : 0.f; ss += y[j] * y[j]; }
          ss += xshfl(ss, lane ^ 1); ss += xshfl(ss, lane ^ 2); ss += xshfl(ss, lane ^ 4);
          const float sc = __builtin_amdgcn_rsqf(ss + EPS) * (part == 0 ? 0.08838834764831845f : 1.0f);
          bf16* dst = (part == 0 ? QB : KB) + t * 136 + 16 * cg;
          *(u32x4*)(dst) = (u32x4){pk2(y[0] * sc, y[1] * sc), pk2(y[2] * sc, y[3] * sc), pk2(y[4] * sc, y[5] * sc), pk2(y[6] * sc, y[7] * sc)};
          *(u32x4*)(dst + 8) = (u32x4){pk2(y[8] * sc, y[9] * sc), pk2(y[10] * sc, y[11] * sc), pk2(y[12] * sc, y[13] * sc), pk2(y[14] * sc, y[15] * sc)};
          if (part == 0) { const float sq = sc * sm[128 + t]; bf16* qo = (bf16*)(dni + DNI_QG) + t * 128 + 16 * cg;
              *(u32x4*)(qo) = (u32x4){pk2(y[0] * sq, y[1] * sq), pk2(y[2] * sq, y[3] * sq), pk2(y[4] * sq, y[5] * sq), pk2(y[6] * sq, y[7] * sq)};
              *(u32x4*)(qo + 8) = (u32x4){pk2(y[8] * sq, y[9] * sq), pk2(y[10] * sq, y[11] * sq), pk2(y[12] * sq, y[13] * sq), pk2(y[14] * sq, y[15] * sq)}; }
          else if (cg == 0) sm[256 + t] = sc;
          if (c == NCHUNK - 1 && t >= 61) { float* co = C.out + O_DNCP + ((size_t)(l * NB + b) * 3 + (t - 61)) * 1536 + part * 512 + h * 128 + 16 * cg;
#pragma unroll
              for (int hf = 0; hf < 2; ++hf) { *(f32x4*)(co + 8 * hf) = (f32x4){bflo(x3[hf].x), bfhi(x3[hf].x), bflo(x3[hf].y), bfhi(x3[hf].y)}; *(f32x4*)(co + 8 * hf + 4) = (f32x4){bflo(x3[hf].z), bfhi(x3[hf].z), bflo(x3[hf].w), bfhi(x3[hf].w)}; } }
      } }
    { const int t = tid >> 3, cg = tid & 7;
      if (t < L) { bf16* zp = (bf16*)(C.ws + WS_PB) + (size_t)(row0 + t) * PB_LD + h * 128 + 16 * cg; const float* nw = inp(I_DNNW) + l * 128 + 16 * cg;
          const u32x4 z0 = *(const u32x4*)(zp), z1 = *(const u32x4*)(zp + 8); const unsigned zw[8] = {z0.x, z0.y, z0.z, z0.w, z1.x, z1.y, z1.z, z1.w}; unsigned gw[8];
#pragma unroll
          for (int i = 0; i < 4; ++i) { const f32x4 g = *(const f32x4*)(nw + 4 * i);
              gw[2 * i] = pk2(g.x * silu(bflo(zw[2 * i])), g.y * silu(bfhi(zw[2 * i]))); gw[2 * i + 1] = pk2(g.z * silu(bflo(zw[2 * i + 1])), g.w * silu(bfhi(zw[2 * i + 1]))); }
          *(u32x4*)(zp) = (u32x4){gw[0], gw[1], gw[2], gw[3]}; *(u32x4*)(zp + 8) = (u32x4){gw[4], gw[5], gw[6], gw[7]}; } }
    __syncthreads();
    if (wid < 4) {
        const int part = 1 + (tid >> 7), rr = tid & 127, cq = rr & 31, tq = rr >> 5, t0 = 16 * tq;
        const float* cw = inp(I_DNCW) + (size_t)l * 4 * 1536 + part * 512 + h * 128 + 4 * cq;
        const f32x4 w0 = *(const f32x4*)(cw), w1 = *(const f32x4*)(cw + 1536), w2 = *(const f32x4*)(cw + 2 * 1536), w3 = *(const f32x4*)(cw + 3 * 1536);
        const bf16* rp = R + part * 128 + 4 * cq;
        f32x4 x0 = ld4bf(rp + (t0 + 0) * 392), x1 = ld4bf(rp + (t0 + 1) * 392), x2 = ld4bf(rp + (t0 + 2) * 392);
        unsigned rtw[4][8], kdw[4][8];
#pragma unroll
        for (int i2 = 0; i2 < 8; ++i2) {
            f32x4 rta[2], kda[2];
#pragma unroll
            for (int u = 0; u < 2; ++u) { const int t = t0 + 2 * i2 + u; const f32x4 x3 = ld4bf(rp + (t + 3) * 392);
                f32x4 y = w0 * x0 + w1 * x1 + w2 * x2 + w3 * x3; x0 = x1; x1 = x2; x2 = x3;
                y = (t < L) ? (f32x4){silu(y.x), silu(y.y), silu(y.z), silu(y.w)} : (f32x4){0.f, 0.f, 0.f, 0.f};
                if (c == NCHUNK - 1 && part == 2 && t >= 61) *(f32x4*)(C.out + O_DNCP + ((size_t)(l * NB + b) * 3 + (t - 61)) * 1536 + 1024 + h * 128 + 4 * cq) = x3;
                if (part == 1) { const f32x4 n = y * sm[256 + t]; rta[u] = n * (sm[64 + t] * sm[128 + t]); kda[u] = n * sm[192 + t]; }
                else { rta[u] = y * sm[64 + t]; kda[u] = rta[u]; } }
#pragma unroll
            for (int jj = 0; jj < 4; ++jj) { rtw[jj][i2] = pk2(rta[0][jj], rta[1][jj]); kdw[jj][i2] = pk2(kda[0][jj], kda[1][jj]); }
        }
        const int colb = (part == 1 ? 128 : 0) + 4 * cq;
#pragma unroll
        for (int jj = 0; jj < 4; ++jj) { bf16* d = RT + (colb + jj) * 72 + t0;
            *(u32x4*)(d) = (u32x4){rtw[jj][0], rtw[jj][1], rtw[jj][2], rtw[jj][3]}; *(u32x4*)(d + 8) = (u32x4){rtw[jj][4], rtw[jj][5], rtw[jj][6], rtw[jj][7]};
            if (part == 1) { bf16* ko = (bf16*)(dni + DNI_KDT) + (4 * cq + jj) * 64 + t0;
                *(u32x4*)(ko) = (u32x4){kdw[jj][0], kdw[jj][1], kdw[jj][2], kdw[jj][3]}; *(u32x4*)(ko + 8) = (u32x4){kdw[jj][4], kdw[jj][5], kdw[jj][6], kdw[jj][7]}; } }
    }
    __syncthreads();
    { const int kind = wid >> 2, ti = (wid >> 1) & 1, tj = wid & 1, r = lane & 31, hh = lane >> 5;
      const bf16* Aop = KB + (32 * ti + r) * 136 + 8 * hh; const bf16* Bop = (kind ? QB : KB) + (32 * tj + r) * 136 + 8 * hh;
      f32x16 acc;
#pragma unroll
      for (int i = 0; i < 16; ++i) acc[i] = 0.f;
#pragma unroll
      for (int ks = 0; ks < 8; ++ks) { const bf16x8 a = *(const bf16x8*)(Aop + 16 * ks), bq = *(const bf16x8*)(Bop + 16 * ks); acc = MFMA32(a, bq, acc); }
      const int t = 32 * tj + r; const float Gt = sm[t], bet = sm[64 + t];
#pragma unroll
      for (int g4 = 0; g4 < 4; ++g4) { const int i0 = 32 * ti + 8 * g4 + 4 * hh; float o[4];
#pragma unroll
          for (int e = 0; e < 4; ++e) { const int i = i0 + e; const float dec = __expf(Gt - sm[i]); const float v = acc[4 * g4 + e] * dec;
              o[e] = kind ? (t >= i ? v : 0.f) : (t > i ? bet * v : 0.f); }
          if (kind == 0) { const bool diag = (i0 >> 4) == (t >> 4);
              u32x2 w; w.x = diag ? 0u : pk2(-o[0], -o[1]); w.y = diag ? 0u : pk2(-o[2], -o[3]); *(u32x2*)(AB + t * 72 + i0) = w;
              if (diag) *(f32x4*)(AD + ((t >> 4) * 16 + (t & 15)) * 20 + (i0 & 15)) = (f32x4){o[0], o[1], o[2], o[3]}; }
          else { u32x2 w; w.x = pk2(o[0], o[1]); w.y = pk2(o[2], o[3]); *(u32x2*)((bf16*)(dni + DNI_P) + t * 64 + i0) = w; } } }
    __syncthreads();
    if (wid == 0) { const int blk = lane >> 4, j = lane & 15; float x[16];
#pragma unroll
        for (int t = 0; t < 16; ++t) x[t] = 0.f;
#pragma unroll
        for (int t = 0; t < 16; ++t) { float s = (t == j) ? 1.0f : 0.f;
#pragma unroll
            for (int s4 = 0; s4 < (t + 3) / 4; ++s4) { const f32x4 a = *(const f32x4*)(AD + (blk * 16 + t) * 20 + 4 * s4);
                s -= a.x * x[4 * s4]; s -= a.y * x[4 * s4 + 1]; s -= a.z * x[4 * s4 + 2]; s -= a.w * x[4 * s4 + 3]; }
            x[t] = s; }
#pragma unroll
        for (int t = 0; t < 16; ++t) { TD[(blk * 16 + t) * 32 + j] = (bf16)f2bf(x[t] - ((t == j) ? 1.0f : 0.f)); TD[(blk * 16 + t) * 32 + 16 + j] = (bf16)0; } }
    __syncthreads();
    { const int cl = lane & 15, kq = lane >> 4, c0 = 32 * wid;
#pragma unroll
      for (int i = 0; i < 4; ++i) {
          f32x4 acc[2];
#pragma unroll
          for (int nf = 0; nf < 2; ++nf) acc[nf] = ld4bf(RT + (c0 + 16 * nf + cl) * 72 + 16 * i + 4 * kq);
          if (i >= 1) {
#pragma unroll
              for (int ks = 0; ks < (i == 3 ? 2 : 1); ++ks) { const bf16x8 a = *(const bf16x8*)(AB + (16 * i + cl) * 72 + 32 * ks + 8 * kq);
#pragma unroll
                  for (int nf = 0; nf < 2; ++nf) { const bf16x8 bb = *(const bf16x8*)(RT + (c0 + 16 * nf + cl) * 72 + 32 * ks + 8 * kq); acc[nf] = MFMA16(a, bb, acc[nf]); } } }
#pragma unroll
          for (int nf = 0; nf < 2; ++nf) { u32x2 w; w.x = pk2(acc[nf].x, acc[nf].y); w.y = pk2(acc[nf].z, acc[nf].w); *(u32x2*)(RT + (c0 + 16 * nf + cl) * 72 + 16 * i + 4 * kq) = w; }
          asm volatile("" ::: "memory");
          const bf16x8 a2 = *(const bf16x8*)(TD + (i * 16 + cl) * 32 + 8 * kq);
#pragma unroll
          for (int nf = 0; nf < 2; ++nf) { bf16x8 b2 = *(const bf16x8*)(RT + (c0 + 16 * nf + cl) * 72 + 16 * i + 8 * (kq & 1));
              if (kq >= 2) b2 = (bf16x8){0, 0, 0, 0, 0, 0, 0, 0};
              acc[nf] = MFMA16(a2, b2, acc[nf]);
              u32x2 w; w.x = pk2(acc[nf].x, acc[nf].y); w.y = pk2(acc[nf].z, acc[nf].w); *(u32x2*)(RT + (c0 + 16 * nf + cl) * 72 + 16 * i + 4 * kq) = w;
              if (wid >= 4) { const int d = c0 - 128 + 16 * nf + cl; bf16* wp = WS + (16 * i + 4 * kq) * 136 + d;
                  wp[0] = (bf16)(w.x & 0xffffu); wp[136] = (bf16)(w.x >> 16); wp[272] = (bf16)(w.y & 0xffffu); wp[408] = (bf16)(w.y >> 16); } }
          asm volatile("" ::: "memory");
      } }
    __syncthreads();
#pragma unroll
    for (int k = 0; k < 2; ++k) { const int p = tid + 512 * k;
        *(u32x4*)(dni + DNI_UVT + 16 * p) = *(const u32x4*)((const unsigned char*)RT + (p >> 3) * 144 + (p & 7) * 16);
        *(u32x4*)(dni + DNI_W + 16 * p) = *(const u32x4*)((const unsigned char*)WS + (p >> 4) * 272 + (p & 15) * 16); }
    __syncthreads();
}

constexpr int L1_XL = 0, L1_WT = 33792, L1_LA = 33792, L1_LB = 70656, L1_XCH = 107520;
DI void m1_lru_item(const Ctx& C, int l, int b, int c) {
    const int tid = C.tid, lane = C.lane, wid = C.wave, r = lane & 31, hh = lane >> 5;
    bf16* XL = (bf16*)(C.lds + L1_XL); bf16* WT = (bf16*)(C.lds + L1_WT); bf16* LA = (bf16*)(C.lds + L1_LA); bf16* LB = (bf16*)(C.lds + L1_LB); float* xch = (float*)(C.lds + L1_XCH);
    const bf16* PB = (const bf16*)(C.ws + WS_PB);
    const int L = (c == 0) ? 16 : 64, row0 = chunk_row0(b, c);
    {
      u32x4 wv[8];
#pragma unroll
      for (int k = 0; k < 8; ++k) wv[k] = *(const u32x4*)(C.ws + WS_LWT + (size_t)l * 65536 + (size_t)(tid + 512 * k) * 16);
      const int cq = tid & 63, tq = tid >> 6, col = 4 * cq, t0 = 8 * tq;
      const float* cw = inp(I_LCW) + (size_t)l * 4 * 256 + col;
      const f32x4 w0 = *(const f32x4*)(cw), w1 = *(const f32x4*)(cw + 256), w2 = *(const f32x4*)(cw + 512), w3 = *(const f32x4*)(cw + 768), bias = *(const f32x4*)(inp(I_LCB) + l * 256 + col);
      f32x4 x0 = (f32x4){0.f, 0.f, 0.f, 0.f}, x1 = x0, x2 = x0;
      if (t0 < L) {
          if (t0 == 0) { const int r3 = halo_row(b, c, 3); if (r3 >= 0) { x0 = ld4bf(PB + (size_t)r3 * PB_LD + 512 + col); x1 = ld4bf(PB + (size_t)(r3 + 1) * PB_LD + 512 + col); x2 = ld4bf(PB + (size_t)(r3 + 2) * PB_LD + 512 + col); } }
          else { x0 = ld4bf(PB + (size_t)(row0 + t0 - 3) * PB_LD + 512 + col); x1 = ld4bf(PB + (size_t)(row0 + t0 - 2) * PB_LD + 512 + col); x2 = ld4bf(PB + (size_t)(row0 + t0 - 1) * PB_LD + 512 + col); }
      }
#pragma unroll
      for (int i = 0; i < 8; ++i) { const int t = t0 + i; f32x4 y = (f32x4){0.f, 0.f, 0.f, 0.f};
          if (t < L) { const f32x4 x3 = ld4bf(PB + (size_t)(row0 + t) * PB_LD + 512 + col); y = w0 * x0 + w1 * x1 + w2 * x2 + w3 * x3 + bias;
              if (c == NCHUNK - 1 && t >= 61) *(f32x4*)(C.out + O_LRUCP + ((size_t)(l * NB + b) * 3 + (t - 61)) * 256 + col) = x3;
              x0 = x1; x1 = x2; x2 = x3; }
          u32x2 w; w.x = pk2(y.x, y.y); w.y = pk2(y.z, y.w); *(u32x2*)(XL + t * 264 + col) = w; }
#pragma unroll
      for (int k = 0; k < 8; ++k) { const int p = tid + 512 * k; *(u32x4*)((unsigned char*)WT + (p >> 3) * 144 + (p & 7) * 16) = wv[k]; } }
    __syncthreads();
    const int n = wid >> 1, eh = wid & 1, e = n * 64 + 32 * eh + r;
    f32x16 pa[2], px[2];
#pragma unroll
    for (int th = 0; th < 2; ++th)
#pragma unroll
        for (int i = 0; i < 16; ++i) { pa[th][i] = 0.f; px[th][i] = 0.f; }
#pragma unroll
    for (int ks = 0; ks < 4; ++ks) {
        const bf16x8 ba_ = *(const bf16x8*)(WT + ((0 * 4 + n) * 64 + 32 * eh + r) * 72 + 16 * ks + 8 * hh), bx_ = *(const bf16x8*)(WT + ((1 * 4 + n) * 64 + 32 * eh + r) * 72 + 16 * ks + 8 * hh);
#pragma unroll
        for (int th = 0; th < 2; ++th) { const bf16x8 a = *(const bf16x8*)(XL + (32 * th + r) * 264 + n * 64 + 16 * ks + 8 * hh); pa[th] = MFMA32(a, ba_, pa[th]); px[th] = MFMA32(a, bx_, px[th]); } }
    __syncthreads();
    { const float ba = inp(I_LBA)[l * 256 + e], bx = inp(I_LBX)[l * 256 + e], sp = softplus(-inp(I_LLAM)[l * 256 + e]);
#pragma unroll
      for (int th = 0; th < 2; ++th)
#pragma unroll
          for (int g4 = 0; g4 < 4; ++g4) { float la4[4], bm4[4];
#pragma unroll
              for (int k = 0; k < 4; ++k) { const int t = 32 * th + 8 * g4 + 4 * hh + k; const float xv = bf1(XL[t * 264 + e]);
                  const float rg = sigm(pa[th][4 * g4 + k] + ba), ig = sigm(px[th][4 * g4 + k] + bx), la = -8.0f * rg * sp;
                  la4[k] = (t < L) ? la : 0.f; bm4[k] = (t < L) ? sqrtf(fmaxf(1.0f - __expf(2.0f * la), 0.f)) * (ig * xv) : 0.f; }
              u32x2 w; w.x = pk2(la4[0], la4[1]); w.y = pk2(la4[2], la4[3]); *(u32x2*)(LA + e * 72 + 32 * th + 8 * g4 + 4 * hh) = w;
              w.x = pk2(bm4[0], bm4[1]); w.y = pk2(bm4[2], bm4[3]); *(u32x2*)(LB + e * 72 + 32 * th + 8 * g4 + 4 * hh) = w; } }
    __syncthreads();
    { const int ec = tid & 255, th = tid >> 8; float ar[32], ai[32];
#pragma unroll
      for (int i = 0; i < 4; ++i) { const u32x4 la = *(const u32x4*)(LA + ec * 72 + 32 * th + 8 * i), lb = *(const u32x4*)(LB + ec * 72 + 32 * th + 8 * i);
          const unsigned lw[4] = {la.x, la.y, la.z, la.w}, bw[4] = {lb.x, lb.y, lb.z, lb.w};
#pragma unroll
          for (int k = 0; k < 4; ++k) { ar[8 * i + 2 * k] = __expf(bflo(lw[k])); ar[8 * i + 2 * k + 1] = __expf(bfhi(lw[k])); ai[8 * i + 2 * k] = bflo(bw[k]); ai[8 * i + 2 * k + 1] = bfhi(bw[k]); } }
      { float hl = 0.f, ac = 1.f;
#pragma unroll
        for (int t = 0; t < 32; ++t) { hl = ar[t] * hl + ai[t]; ac *= ar[t]; ai[t] = hl; ar[t] = ac; } }
      if (th == 0) { xch[2 * ec] = ai[31]; xch[2 * ec + 1] = ar[31]; }
      __syncthreads();
      if (th == 1) { const float h0 = xch[2 * ec], a0 = xch[2 * ec + 1];
#pragma unroll
        for (int t = 0; t < 32; ++t) { ai[t] = ar[t] * h0 + ai[t]; ar[t] = ar[t] * a0; }
        ((float*)(C.ws + WS_CA))[(size_t)(b * NCHUNK + c) * 256 + ec] = ar[31]; ((float*)(C.ws + WS_CB))[(size_t)(b * NCHUNK + c) * 256 + ec] = ai[31]; }
      bf16* AC = (bf16*)(C.ws + WS_LA); bf16* HL = (bf16*)(C.ws + WS_LB);
#pragma unroll
      for (int t = 0; t < 32; ++t) { const int tt = 32 * th + t;
          if (tt < L) { AC[(size_t)(row0 + tt) * 256 + ec] = (bf16)f2bf(ar[t]); HL[(size_t)(row0 + tt) * 256 + ec] = (bf16)f2bf(ai[t]); } } }
    __syncthreads();
}
DI void m1_phase(const Ctx& C0, int l) {
    constexpr int NDN = NB * NCHUNK * 4, NLRU = NB * NCHUNK;
#ifndef M1_SUB
#define M1_SUB 3
#endif
    for (int it = C0.bid; it < NDN + NLRU; it += C0.G) {
        const Ctx C = fresh(C0);
#ifndef M1_DUP
#define M1_DUP 0
#endif
        if (it < NDN) { if (M1_SUB & 1) { const int h = it & 3, bc = it >> 2; for (int rep = 0; rep < ((M1_DUP & 1) ? 2 : 1); ++rep) { const Ctx Cr = fresh(C0); m1_dn_item(Cr, l, bc / NCHUNK, bc % NCHUNK, h); } } }
        else if (M1_SUB & 2) { const int bc = it - NDN; for (int rep = 0; rep < ((M1_DUP & 2) ? 2 : 1); ++rep) { const Ctx Cr = fresh(C0); m1_lru_item(Cr, l, bc / NCHUNK, bc % NCHUNK); } }
    }
}
constexpr int M2_WL = 0, M2_QL = 17408, M2_PL = 34816, M2_KL = 44032, M2_UT = 62464, M2_ST = 80896, M2_OS = 115712;
DI void m2_dn(const Ctx& C, int l, int b, int h) {
    const int tid = C.tid, lane = C.lane, wid = C.wave, tm = wid >> 2, tn = wid & 3, r = lane & 31, hh = lane >> 5;
    bf16* WL = (bf16*)(C.lds + M2_WL); bf16* QL = (bf16*)(C.lds + M2_QL); bf16* PL = (bf16*)(C.lds + M2_PL); bf16* KL = (bf16*)(C.lds + M2_KL);
    bf16* UT = (bf16*)(C.lds + M2_UT); bf16* ST = (bf16*)(C.lds + M2_ST); float* OS = (float*)(C.lds + M2_OS);
    const bf16* PB = (const bf16*)(C.ws + WS_PB); bf16* O = (bf16*)(C.ws + WS_O); const float* GCA = (const float*)(C.ws + WS_GCA);
    f32x16 S0, S1;
#pragma unroll
    for (int i = 0; i < 16; ++i) { S0[i] = 0.f; S1[i] = 0.f; }
    for (int i = tid; i < 128 * 136 / 2; i += NTHREADS) ((unsigned*)ST)[i] = 0u;
    u32x4 pre[7];
    const unsigned char* dni0 = C.ws + WS_DNI + (size_t)((b * NCHUNK) * 4 + h) * DNI_ITEM;
#define M2_LOAD(dn) do { \
        pre[0] = *(const u32x4*)((dn) + DNI_W + 16 * tid); pre[1] = *(const u32x4*)((dn) + DNI_W + 16 * (tid + 512)); \
        pre[2] = *(const u32x4*)((dn) + DNI_QG + 16 * tid); pre[3] = *(const u32x4*)((dn) + DNI_QG + 16 * (tid + 512)); \
        pre[4] = *(const u32x4*)((dn) + DNI_P + 16 * tid); \
        pre[5] = *(const u32x4*)((dn) + DNI_KDT + 16 * tid); pre[6] = *(const u32x4*)((dn) + DNI_KDT + 16 * (tid + 512)); } while (0)
#define M2_STORE() do { \
        { const int p = tid; *(u32x4*)((unsigned char*)WL + (p >> 4) * 272 + (p & 15) * 16) = pre[0]; *(u32x4*)((unsigned char*)QL + (p >> 4) * 272 + (p & 15) * 16) = pre[2]; \
          *(u32x4*)((unsigned char*)PL + (p >> 3) * 144 + (p & 7) * 16) = pre[4]; *(u32x4*)((unsigned char*)KL + (p >> 3) * 144 + (p & 7) * 16) = pre[5]; } \
        { const int p = tid + 512; *(u32x4*)((unsigned char*)WL + (p >> 4) * 272 + (p & 15) * 16) = pre[1]; *(u32x4*)((unsigned char*)QL + (p >> 4) * 272 + (p & 15) * 16) = pre[3]; \
          *(u32x4*)((unsigned char*)KL + (p >> 3) * 144 + (p & 7) * 16) = pre[6]; } } while (0)
    M2_LOAD(dni0);
    M2_STORE();
    const int nt_ = tid >> 3, nsg = tid & 7;
    u32x2 uv[4], uvn[4]; u32x4 zz[2], zzn[2]; float egc, egcn;
#define M2_LOAD2(cc, UV, ZZ, EG) do { const unsigned char* dn_ = C.ws + WS_DNI + (size_t)((b * NCHUNK + (cc)) * 4 + h) * DNI_ITEM; \
        const bf16* uvt_ = (const bf16*)(dn_ + DNI_UVT) + (32 * tn + r) * 64 + 32 * tm + 4 * hh; \
        _Pragma("unroll") for (int g4 = 0; g4 < 4; ++g4) UV[g4] = *(const u32x2*)(uvt_ + 8 * g4); \
        EG = GCA[(b * NCHUNK + (cc)) * 4 + h]; \
        const int vr_ = ((cc) > 0 || nt_ < 16) ? chunk_row0(b, (cc)) + nt_ : chunk_row0(b, (cc)); \
        const bf16* zp_ = PB + (size_t)vr_ * PB_LD + h * 128 + 16 * nsg; ZZ[0] = *(const u32x4*)(zp_); ZZ[1] = *(const u32x4*)(zp_ + 8); } while (0)
    M2_LOAD2(0, uv, zz, egc);
    asm volatile("" :: "v"(uv[0]), "v"(uv[1]), "v"(uv[2]), "v"(uv[3]), "v"(zz[0]), "v"(zz[1]), "v"(egc));
    __syncthreads();
    u32x4 zzp[2] = {zz[0], zz[1]};
#define M2_NORM(cc) do { const int t = tid >> 3, sg = tid & 7; f32x4 v[4]; float s = 0.f; \
        _Pragma("unroll") for (int i = 0; i < 4; ++i) { v[i] = *(const f32x4*)(OS + t * 132 + 16 * sg + 4 * i); s += (v[i].x * v[i].x + v[i].y * v[i].y) + (v[i].z * v[i].z + v[i].w * v[i].w); } \
        s += xshfl(s, lane ^ 1); s += xshfl(s, lane ^ 2); s += xshfl(s, lane ^ 4); \
        const float rs = __builtin_amdgcn_rsqf(s * (1.0f / 128.0f) + EPS); \
        if ((cc) > 0 || t < 16) { const int row = chunk_row0(b, (cc)) + t; unsigned w[8]; \
            const unsigned zw[8] = {zzp[0].x, zzp[0].y, zzp[0].z, zzp[0].w, zzp[1].x, zzp[1].y, zzp[1].z, zzp[1].w}; \
            _Pragma("unroll") for (int i = 0; i < 4; ++i) { const f32x4 z = (f32x4){bflo(zw[2 * i]), bfhi(zw[2 * i]), bflo(zw[2 * i + 1]), bfhi(zw[2 * i + 1])};     \
                w[2 * i] = pk2(v[i].x * rs * z.x, v[i].y * rs * z.y); w[2 * i + 1] = pk2(v[i].z * rs * z.z, v[i].w * rs * z.w); } \
            bf16* op = O + (size_t)row * DM + h * 128 + 16 * sg; \
            *(u32x4*)(op) = (u32x4){w[0], w[1], w[2], w[3]}; *(u32x4*)(op + 8) = (u32x4){w[4], w[5], w[6], w[7]}; } } while (0)
    for (int c = 0; c < NCHUNK; ++c) {
        const int item = (b * NCHUNK + c) * 4 + h;
        const unsigned char* dni = C.ws + WS_DNI + (size_t)item * DNI_ITEM;
        if (c + 1 < NCHUNK) { M2_LOAD(dni + 4 * DNI_ITEM); M2_LOAD2(c + 1, uvn, zzn, egcn); }
        f32x16 ws, qs;
#pragma unroll
        for (int i = 0; i < 16; ++i) { ws[i] = 0.f; qs[i] = 0.f; }
#pragma unroll
        for (int ks = 0; ks < 4; ++ks) {
            const bf16x8 bfr = *(const bf16x8*)(ST + (32 * tn + r) * 136 + 16 * ks + 8 * hh);
            const bf16x8 aw = *(const bf16x8*)(WL + (32 * tm + r) * 136 + 16 * ks + 8 * hh), aq = *(const bf16x8*)(QL + (32 * tm + r) * 136 + 16 * ks + 8 * hh);
            ws = MFMA32(aw, bfr, ws); qs = MFMA32(aq, bfr, qs); }
        if (c > 0) M2_NORM(c - 1);
#pragma unroll
        for (int ks = 4; ks < 8; ++ks) {
            const bf16x8 bfr = *(const bf16x8*)(ST + (32 * tn + r) * 136 + 16 * ks + 8 * hh);
            const bf16x8 aw = *(const bf16x8*)(WL + (32 * tm + r) * 136 + 16 * ks + 8 * hh), aq = *(const bf16x8*)(QL + (32 * tm + r) * 136 + 16 * ks + 8 * hh);
            ws = MFMA32(aw, bfr, ws); qs = MFMA32(aq, bfr, qs); }
        {
#pragma unroll
          for (int g4 = 0; g4 < 4; ++g4) { const f32x4 uf = (f32x4){bflo(uv[g4].x), bfhi(uv[g4].x), bflo(uv[g4].y), bfhi(uv[g4].y)};
              u32x2 w; w.x = pk2(uf.x - ws[4 * g4], uf.y - ws[4 * g4 + 1]); w.y = pk2(uf.z - ws[4 * g4 + 2], uf.w - ws[4 * g4 + 3]);
              *(u32x2*)(UT + (32 * tn + r) * 72 + 32 * tm + 8 * g4 + 4 * hh) = w; } }
        __syncthreads();
        { S0 = S0 * egc; S1 = S1 * egc;
#pragma unroll
          for (int ks = 0; ks < 4; ++ks) {
              const bf16x8 bfr = *(const bf16x8*)(UT + (32 * tn + r) * 72 + 16 * ks + 8 * hh);
              const bf16x8 ap = *(const bf16x8*)(PL + (32 * tm + r) * 72 + 16 * ks + 8 * hh);
              const bf16x8 a0 = *(const bf16x8*)(KL + (64 * tm + r) * 72 + 16 * ks + 8 * hh), a1 = *(const bf16x8*)(KL + (64 * tm + 32 + r) * 72 + 16 * ks + 8 * hh);
              qs = MFMA32(ap, bfr, qs); S0 = MFMA32(a0, bfr, S0); S1 = MFMA32(a1, bfr, S1); } }
        __syncthreads();
#pragma unroll
        for (int g4 = 0; g4 < 4; ++g4) {
            u32x2 w; w.x = pk2(S0[4 * g4], S0[4 * g4 + 1]); w.y = pk2(S0[4 * g4 + 2], S0[4 * g4 + 3]); *(u32x2*)(ST + (32 * tn + r) * 136 + 64 * tm + 8 * g4 + 4 * hh) = w;
            w.x = pk2(S1[4 * g4], S1[4 * g4 + 1]); w.y = pk2(S1[4 * g4 + 2], S1[4 * g4 + 3]); *(u32x2*)(ST + (32 * tn + r) * 136 + 64 * tm + 32 + 8 * g4 + 4 * hh) = w; }
#pragma unroll
        for (int i = 0; i < 16; ++i) OS[(32 * tm + crow(i, hh)) * 132 + 32 * tn + r] = qs[i];
        zzp[0] = zz[0]; zzp[1] = zz[1];
        if (c + 1 < NCHUNK) { M2_STORE();
#pragma unroll
            for (int g4 = 0; g4 < 4; ++g4) uv[g4] = uvn[g4];
            zz[0] = zzn[0]; zz[1] = zzn[1]; egc = egcn; }
        __syncthreads();
    }
    M2_NORM(NCHUNK - 1);
#undef M2_NORM
#undef M2_LOAD
#undef M2_LOAD2
#undef M2_STORE
    { float* so = C.out + O_DNP + ((size_t)((l * NB + b) * 4 + h)) * 16384;
#pragma unroll
      for (int i = 0; i < 16; ++i) { so[(size_t)(64 * tm + crow(i, hh)) * 128 + 32 * tn + r] = S0[i]; so[(size_t)(64 * tm + 32 + crow(i, hh)) * 128 + 32 * tn + r] = S1[i]; } }
}

constexpr int R_QL = 0, R_QG = 9216, R_KL = 18432, R_KDT = 27648, R_VT = 36864, R_ST = 46080, R_PL = 55296, R_OS = 64512, R_GL = 81920;
DI void m2_ret(const Ctx& C, int l, int b, int h) {
    const int tid = C.tid, lane = C.lane, wid = C.wave, r = lane & 31, hh = lane >> 5;
    bf16* QL = (bf16*)(C.lds + R_QL); bf16* QG = (bf16*)(C.lds + R_QG); bf16* KL = (bf16*)(C.lds + R_KL); bf16* KDT = (bf16*)(C.lds + R_KDT); bf16* VT = (bf16*)(C.lds + R_VT);
    bf16* ST = (bf16*)(C.lds + R_ST); bf16* PL = (bf16*)(C.lds + R_PL); float* OS = (float*)(C.lds + R_OS); bf16* GL = (bf16*)(C.lds + R_GL);
    const bf16* PB = (const bf16*)(C.ws + WS_PB); bf16* O = (bf16*)(C.ws + WS_O); const float* rope = (const float*)(C.ws + WS_ROPE);
    const float lg = (h == 0) ? -0.0317486983145803f : (h == 1) ? -0.015748356968139168f : (h == 2) ? -0.007843177461025893f : -0.003913899321136329f;
    f32x16 acc;
#pragma unroll
    for (int i = 0; i < 16; ++i) acc[i] = 0.f;
    for (int i = tid; i < 64 * 72 / 2; i += NTHREADS) ((unsigned*)ST)[i] = 0u;
    __syncthreads();
    u32x2 rq1, rq2, rk1, rk2; u32x4 rv, rg; f32x4 rc0, rc1;
    u32x2 nq1, nq2, nk1, nk2; u32x4 nv, ng; f32x4 nc0, nc1;
#define R_LOAD(cc, Q1, Q2, K1, K2, VV, GV, C0_, C1_) do { const int t_ = tid >> 3, j_ = tid & 7; const int L_ = ((cc) == 0) ? 16 : 64; \
        const bf16* pr_ = PB + (size_t)(chunk_row0(b, (cc)) + (t_ < L_ ? t_ : 0)) * PB_LD; \
        Q1 = *(const u32x2*)(pr_ + 1024 + 64 * h + 4 * j_); Q2 = *(const u32x2*)(pr_ + 1024 + 64 * h + 32 + 4 * j_); K1 = *(const u32x2*)(pr_ + 1280 + 64 * h + 4 * j_); K2 = *(const u32x2*)(pr_ + 1280 + 64 * h + 32 + 4 * j_); \
        VV = *(const u32x4*)(pr_ + 1536 + 64 * h + 8 * j_); GV = *(const u32x4*)(pr_ + 1792 + 64 * h + 8 * j_); \
        const float* rp_ = rope + ((size_t)((((cc) == 0) ? 0 : 16 + 64 * ((cc) - 1)) + t_) * 32 + 4 * j_) * 2; C0_ = *(const f32x4*)(rp_); C1_ = *(const f32x4*)(rp_ + 4); } while (0)
    R_LOAD(0, rq1, rq2, rk1, rk2, rv, rg, rc0, rc1);
    asm volatile("" :: "v"(rq1), "v"(rq2), "v"(rk1), "v"(rk2), "v"(rv), "v"(rg), "v"(rc0), "v"(rc1));
    for (int c = 0; c < NCHUNK; ++c) {
        const int L = (c == 0) ? 16 : 64, row0 = chunk_row0(b, c);
        if (c + 1 < NCHUNK) R_LOAD(c + 1, nq1, nq2, nk1, nk2, nv, ng, nc0, nc1);
        { const int t = tid >> 3, j = tid & 7;
          f32x4 q1 = (f32x4){0.f, 0.f, 0.f, 0.f}, q2 = q1, k1 = q1, k2 = q1; u32x4 vv = (u32x4){0u, 0u, 0u, 0u}, gv = vv;
          if (t < L) { q1 = (f32x4){bflo(rq1.x), bfhi(rq1.x), bflo(rq1.y), bfhi(rq1.y)}; q2 = (f32x4){bflo(rq2.x), bfhi(rq2.x), bflo(rq2.y), bfhi(rq2.y)};
              k1 = (f32x4){bflo(rk1.x), bfhi(rk1.x), bflo(rk1.y), bfhi(rk1.y)}; k2 = (f32x4){bflo(rk2.x), bfhi(rk2.x), bflo(rk2.y), bfhi(rk2.y)}; vv = rv; gv = rg; }
          const f32x4 cs0 = rc0, cs1 = rc1;
          const float cc[4] = {cs0.x, cs0.z, cs1.x, cs1.z}, sn[4] = {cs0.y, cs0.w, cs1.y, cs1.w};
          const float dq = __expf(lg * (float)(t + 1)), dk = (t < L) ? 0.125f * __expf(lg * (float)(L - 1 - t)) : 0.f;
          float qa[4], qb[4], ka[4], kb[4];
#pragma unroll
          for (int e = 0; e < 4; ++e) { qa[e] = q1[e] * cc[e] - q2[e] * sn[e]; qb[e] = q1[e] * sn[e] + q2[e] * cc[e]; ka[e] = k1[e] * cc[e] - k2[e] * sn[e]; kb[e] = k1[e] * sn[e] + k2[e] * cc[e]; }
          u32x2 w;
          w.x = pk2(qa[0], qa[1]); w.y = pk2(qa[2], qa[3]); *(u32x2*)(QL + t * 72 + 4 * j) = w; w.x = pk2(qb[0], qb[1]); w.y = pk2(qb[2], qb[3]); *(u32x2*)(QL + t * 72 + 32 + 4 * j) = w;
          w.x = pk2(qa[0] * dq, qa[1] * dq); w.y = pk2(qa[2] * dq, qa[3] * dq); *(u32x2*)(QG + t * 72 + 4 * j) = w; w.x = pk2(qb[0] * dq, qb[1] * dq); w.y = pk2(qb[2] * dq, qb[3] * dq); *(u32x2*)(QG + t * 72 + 32 + 4 * j) = w;
          w.x = pk2(ka[0] * 0.125f, ka[1] * 0.125f); w.y = pk2(ka[2] * 0.125f, ka[3] * 0.125f); *(u32x2*)(KL + t * 72 + 4 * j) = w;
          w.x = pk2(kb[0] * 0.125f, kb[1] * 0.125f); w.y = pk2(kb[2] * 0.125f, kb[3] * 0.125f); *(u32x2*)(KL + t * 72 + 32 + 4 * j) = w;
#pragma unroll
          for (int e = 0; e < 4; ++e) { KDT[(4 * j + e) * 72 + t] = (bf16)f2bf(ka[e] * dk); KDT[(32 + 4 * j + e) * 72 + t] = (bf16)f2bf(kb[e] * dk); }
          const unsigned vw[4] = {vv.x, vv.y, vv.z, vv.w};
#pragma unroll
          for (int e = 0; e < 4; ++e) { VT[(8 * j + 2 * e) * 72 + t] = (bf16)(vw[e] & 0xffffu); VT[(8 * j + 2 * e + 1) * 72 + t] = (bf16)(vw[e] >> 16); }
          *(u32x4*)(GL + t * 72 + 8 * j) = gv; }
        __syncthreads();
        if (wid < 4) { const int ti = wid >> 1, tj = wid & 1; f32x16 p;
#pragma unroll
            for (int i = 0; i < 16; ++i) p[i] = 0.f;
#pragma unroll
            for (int ks = 0; ks < 4; ++ks) { const bf16x8 a = *(const bf16x8*)(KL + (32 * ti + r) * 72 + 16 * ks + 8 * hh), bq = *(const bf16x8*)(QL + (32 * tj + r) * 72 + 16 * ks + 8 * hh); p = MFMA32(a, bq, p); }
            const int t = 32 * tj + r;
#pragma unroll
            for (int g4 = 0; g4 < 4; ++g4) { const int i0 = 32 * ti + 8 * g4 + 4 * hh; float o[4];
#pragma unroll
                for (int e = 0; e < 4; ++e) { const int i = i0 + e; o[e] = (t >= i) ? p[4 * g4 + e] * __expf(lg * (float)(t - i)) : 0.f; }
                u32x2 w; w.x = pk2(o[0], o[1]); w.y = pk2(o[2], o[3]); *(u32x2*)(PL + t * 72 + i0) = w; }
        } else { const int tm = (wid >> 1) & 1, en = wid & 1;
#pragma unroll
            for (int i = 0; i < 16; ++i) acc[i] = 0.f;
#pragma unroll
            for (int ks = 0; ks < 4; ++ks) { const bf16x8 a = *(const bf16x8*)(QG + (32 * tm + r) * 72 + 16 * ks + 8 * hh), bs = *(const bf16x8*)(ST + (32 * en + r) * 72 + 16 * ks + 8 * hh); acc = MFMA32(a, bs, acc); }
        }
        __syncthreads();
        if (wid < 4) { const int dm = wid >> 1, en = wid & 1; acc = acc * __expf(lg * (float)L);
#pragma unroll
            for (int ks = 0; ks < 4; ++ks) { const bf16x8 a = *(const bf16x8*)(KDT + (32 * dm + r) * 72 + 16 * ks + 8 * hh), bv = *(const bf16x8*)(VT + (32 * en + r) * 72 + 16 * ks + 8 * hh); acc = MFMA32(a, bv, acc); }
        } else { const int tm = (wid >> 1) & 1, en = wid & 1;
#pragma unroll
            for (int ks = 0; ks < 4; ++ks) { const bf16x8 a = *(const bf16x8*)(PL + (32 * tm + r) * 72 + 16 * ks + 8 * hh), bv = *(const bf16x8*)(VT + (32 * en + r) * 72 + 16 * ks + 8 * hh); acc = MFMA32(a, bv, acc); }
        }
        __syncthreads();
        if (wid < 4) { const int dm = wid >> 1, en = wid & 1;
#pragma unroll
            for (int g4 = 0; g4 < 4; ++g4) { u32x2 w; w.x = pk2(acc[4 * g4], acc[4 * g4 + 1]); w.y = pk2(acc[4 * g4 + 2], acc[4 * g4 + 3]); *(u32x2*)(ST + (32 * en + r) * 72 + 32 * dm + 8 * g4 + 4 * hh) = w; }
        } else { const int tm = (wid >> 1) & 1, en = wid & 1;
#pragma unroll
            for (int i = 0; i < 16; ++i) OS[(32 * tm + crow(i, hh)) * 68 + 32 * en + r] = acc[i];
        }
        __syncthreads();
        { const int t = tid >> 3, sg = tid & 7; const f32x4 v0 = *(const f32x4*)(OS + t * 68 + 8 * sg), v1 = *(const f32x4*)(OS + t * 68 + 8 * sg + 4);
          float s = (v0.x + v0.y) + (v0.z + v0.w) + (v1.x + v1.y) + (v1.z + v1.w);
          s += xshfl(s, lane ^ 1); s += xshfl(s, lane ^ 2); s += xshfl(s, lane ^ 4);
          const float mu = s * (1.0f / 64.0f);
          const f32x4 d0 = v0 - mu, d1 = v1 - mu; float q = (d0.x * d0.x + d0.y * d0.y) + (d0.z * d0.z + d0.w * d0.w) + (d1.x * d1.x + d1.y * d1.y) + (d1.z * d1.z + d1.w * d1.w);
          q += xshfl(q, lane ^ 1); q += xshfl(q, lane ^ 2); q += xshfl(q, lane ^ 4);
          const float rs = __builtin_amdgcn_rsqf(q * (1.0f / 64.0f) + EPS);
          if (t < L) { const u32x4 gv = *(const u32x4*)(GL + t * 72 + 8 * sg); u32x4 w;
              w.x = pk2(d0.x * rs * silu(bflo(gv.x)), d0.y * rs * silu(bfhi(gv.x))); w.y = pk2(d0.z * rs * silu(bflo(gv.y)), d0.w * rs * silu(bfhi(gv.y)));
              w.z = pk2(d1.x * rs * silu(bflo(gv.z)), d1.y * rs * silu(bfhi(gv.z))); w.w = pk2(d1.z * rs * silu(bflo(gv.w)), d1.w * rs * silu(bfhi(gv.w)));
              *(u32x4*)(O + (size_t)(row0 + t) * DM + 768 + 64 * h + 8 * sg) = w; } }
        if (c + 1 < NCHUNK) { rq1 = nq1; rq2 = nq2; rk1 = nk1; rk2 = nk2; rv = nv; rg = ng; rc0 = nc0; rc1 = nc1; }
        __syncthreads();
    }
#undef R_LOAD
    if (wid < 4) { const int dm = wid >> 1, en = wid & 1; float* so = C.out + O_RETP + ((size_t)((l * NB + b) * 4 + h)) * 4096;
#pragma unroll
        for (int i = 0; i < 16; ++i) so[(size_t)(32 * dm + crow(i, hh)) * 64 + 32 * en + r] = acc[i]; }
}

DI void m2_lru_item(const Ctx& C, int l, int b, int c) {
    const int e = C.tid & 255, th = C.tid >> 8;
    const bf16* AC = (const bf16*)(C.ws + WS_LA); const bf16* HL = (const bf16*)(C.ws + WS_LB); const bf16* PB = (const bf16*)(C.ws + WS_PB); bf16* O = (bf16*)(C.ws + WS_O);
    const float* CA = (const float*)(C.ws + WS_CA) + (size_t)(b * NCHUNK) * 256 + e; const float* CB = (const float*)(C.ws + WS_CB) + (size_t)(b * NCHUNK) * 256 + e;
    float hin = 0.f;
#pragma unroll 8
    for (int cc = 0; cc < c; ++cc) hin = CA[cc * 256] * hin + CB[cc * 256];
    const int L = (c == 0) ? 16 : 64, row0 = chunk_row0(b, c);
#pragma unroll 8
    for (int t = 0; t < 32; ++t) { const int tt = 32 * th + t;
        if (tt < L) { const size_t row = (size_t)(row0 + tt);
            const float hv = bf1(AC[row * 256 + e]) * hin + bf1(HL[row * 256 + e]);
            O[row * DM + 512 + e] = (bf16)f2bf(hv * gelu_tanh(bf1(PB[row * PB_LD + 768 + e]))); } }
    if (c == NCHUNK - 1 && th == 1) C.out[O_LRUP + (size_t)(l * NB + b) * 256 + e] = CA[c * 256] * hin + CB[c * 256];
}
DI void ms_dn(const Ctx& C, int l, int s, int h) {
    const int tid = C.tid, lane = C.lane, wid = C.wave, row = SROW0 + s;
    float* sh = (float*)C.lds; float* scal = sh + 384; float* Ush = sh + 400; float* osh = sh + 528; float* red = sh + 1024;
    const bf16* PA = (const bf16*)(C.ws + WS_PA); const bf16* PB = (const bf16*)(C.ws + WS_PB); bf16* O = (bf16*)(C.ws + WS_O);
    const int e4 = tid & 31, dg = tid >> 5;
    const float* S0p = inp(I_SDN) + ((size_t)((l * NSAMP + s) * 4 + h) * 128) * 128;
    f32x4 sv[8];
#pragma unroll
    for (int i = 0; i < 8; ++i) sv[i] = *(const f32x4*)(S0p + (size_t)(8 * dg + i) * 128 + 4 * e4);
    const int part = tid >> 7, d_ = tid & 127, col = (part < 3 ? part : 0) * 512 + h * 128 + d_;
    const float* buf = inp(I_SDNC) + ((size_t)(l * NSAMP + s) * 3) * 1536 + col; const float* cw = inp(I_DNCW) + (size_t)l * 4 * 1536 + col;
    const float x0 = buf[0], x1 = buf[1536], x2 = buf[3072], x3 = bf1(PA[(size_t)row * PA_LD + col]), c0 = cw[0], c1 = cw[1536], c2 = cw[3072], c3 = cw[4608];
    const float a_ = bf1(PA[(size_t)row * PA_LD + 1536 + h]), b_ = bf1(PA[(size_t)row * PA_LD + 1540 + h]), alog = inp(I_ALOG)[l * 4 + h], dtb = inp(I_DTB)[l * 4 + h];
    const float z0 = bf1(PB[(size_t)row * PB_LD + h * 128 + lane]), z1 = bf1(PB[(size_t)row * PB_LD + h * 128 + 64 + lane]), nw0 = inp(I_DNNW)[l * 128 + lane], nw1 = inp(I_DNNW)[l * 128 + 64 + lane];
    if (tid < 384) { sh[part * 128 + d_] = silu(c0 * x0 + c1 * x1 + c2 * x2 + c3 * x3);
        float* co = C.out + O_DNCS + ((size_t)(l * NSAMP + s) * 3) * 1536 + col; co[0] = x1; co[1536] = x2; co[3072] = x3; }
    __syncthreads();
    if (wid < 2) { const float v0 = sh[wid * 128 + lane], v1 = sh[wid * 128 + 64 + lane]; const float ss = wave_sum(v0 * v0 + v1 * v1, lane);
        const float sc = __builtin_amdgcn_rsqf(ss + EPS) * (wid == 0 ? 0.08838834764831845f : 1.0f); sh[wid * 128 + lane] = v0 * sc; sh[wid * 128 + 64 + lane] = v1 * sc; }
    __syncthreads();
    if (wid == 0) { const float qk = wave_sum(sh[lane] * sh[128 + lane] + sh[64 + lane] * sh[192 + lane], lane);
        if (lane == 0) { const float g = -__expf(alog) * softplus(a_ + dtb); scal[0] = qk; scal[1] = __expf(g); scal[2] = sigm(b_); } }
    f32x4 kS = (f32x4){0.f, 0.f, 0.f, 0.f}, qS = kS;
#pragma unroll
    for (int i = 0; i < 8; ++i) { const int d = 8 * dg + i; kS = kS + sv[i] * sh[128 + d]; qS = qS + sv[i] * sh[d]; }
    *(f32x4*)(red + dg * 256 + 4 * e4) = kS; *(f32x4*)(red + dg * 256 + 128 + 4 * e4) = qS;
    __syncthreads();
    if (tid < 128) { float ks = 0.f, qs = 0.f;
#pragma unroll
        for (int g = 0; g < 16; ++g) { ks += red[g * 256 + tid]; qs += red[g * 256 + 128 + tid]; }
        const float eG = scal[1], U = scal[2] * (sh[256 + tid] - eG * ks); Ush[tid] = U; osh[tid] = eG * qs + scal[0] * U; }
    __syncthreads();
    { const f32x4 U4 = *(const f32x4*)(Ush + 4 * e4); const float eG = scal[1];
      float* So = C.out + O_DNS + ((size_t)((l * NSAMP + s) * 4 + h) * 128) * 128;
#pragma unroll
      for (int i = 0; i < 8; ++i) { const int d = 8 * dg + i; *(f32x4*)(So + (size_t)d * 128 + 4 * e4) = sv[i] * eG + U4 * sh[128 + d]; } }
    if (wid == 0) { const float o0 = osh[lane], o1 = osh[lane + 64]; const float ss = wave_sum(o0 * o0 + o1 * o1, lane); const float rs = __builtin_amdgcn_rsqf(ss * (1.0f / 128.0f) + EPS);
        bf16* op = O + (size_t)row * DM + h * 128;
        op[lane] = (bf16)f2bf(o0 * rs * nw0 * silu(z0)); op[lane + 64] = (bf16)f2bf(o1 * rs * nw1 * silu(z1)); }
    __syncthreads();
}
DI void ms_ret(const Ctx& C, int l, int s, int h) {
    const int tid = C.tid, lane = C.lane, wid = C.wave, row = SROW0 + s;
    float* sh = (float*)C.lds; float* osh = sh + 256; float* red = sh + 1024;
    const bf16* PB = (const bf16*)(C.ws + WS_PB); bf16* O = (bf16*)(C.ws + WS_O); const float* rope = (const float*)(C.ws + WS_ROPE) + (size_t)2064 * 32 * 2;
    const float gam = 1.0f - exp2f(-5.0f - (float)h);
    const bf16* pr = PB + (size_t)row * PB_LD;
    const int e4 = tid & 15, dg = tid >> 4;
    const float* S0p = inp(I_SRET) + ((size_t)((l * NSAMP + s) * 4 + h) * 64) * 64;
    f32x4 sv[2];
#pragma unroll
    for (int i = 0; i < 2; ++i) sv[i] = *(const f32x4*)(S0p + (size_t)(2 * dg + i) * 64 + 4 * e4);
    const int i_ = tid & 31;
    const float q1 = bf1(pr[1024 + 64 * h + i_]), q2 = bf1(pr[1024 + 64 * h + 32 + i_]), k1 = bf1(pr[1280 + 64 * h + i_]), k2 = bf1(pr[1280 + 64 * h + 32 + i_]), cr = rope[2 * i_], sr = rope[2 * i_ + 1];
    const float vv = bf1(pr[1536 + 64 * h + lane]), gg = bf1(pr[1792 + 64 * h + lane]);
    if (tid < 32) { sh[i_] = q1 * cr - q2 * sr; sh[32 + i_] = q1 * sr + q2 * cr; sh[64 + i_] = 0.125f * (k1 * cr - k2 * sr); sh[96 + i_] = 0.125f * (k1 * sr + k2 * cr); }
    else if (tid >= 64 && tid < 128) sh[128 + lane] = vv;
    __syncthreads();
    if (wid == 0) { const float qk = wave_sum(sh[lane] * sh[64 + lane], lane); if (lane == 0) sh[192] = qk; }
    f32x4 qS = (f32x4){0.f, 0.f, 0.f, 0.f};
#pragma unroll
    for (int i = 0; i < 2; ++i) { const int d = 2 * dg + i; qS = qS + sv[i] * sh[d]; }
    *(f32x4*)(red + dg * 64 + 4 * e4) = qS;
    __syncthreads();
    if (tid < 64) { float qs = 0.f;
#pragma unroll
        for (int g = 0; g < 32; ++g) qs += red[g * 64 + tid];
        osh[tid] = gam * qs + sh[192] * sh[128 + tid]; }
    { const f32x4 v4 = *(const f32x4*)(sh + 128 + 4 * e4); float* So = C.out + O_RETS + ((size_t)((l * NSAMP + s) * 4 + h) * 64) * 64;
#pragma unroll
      for (int i = 0; i < 2; ++i) { const int d = 2 * dg + i; *(f32x4*)(So + (size_t)d * 64 + 4 * e4) = sv[i] * gam + v4 * sh[64 + d]; } }
    __syncthreads();
    if (wid == 0) { const float o = osh[lane]; const float mu = wave_sum(o, lane) * (1.0f / 64.0f); const float d = o - mu; const float var = wave_sum(d * d, lane) * (1.0f / 64.0f);
        O[(size_t)row * DM + 768 + 64 * h + lane] = (bf16)f2bf(d * __builtin_amdgcn_rsqf(var + EPS) * silu(gg)); }
    __syncthreads();
}
DI void ms_lru(const Ctx& C, int l, int s) {
    const int tid = C.tid, row = SROW0 + s; float* sh = (float*)C.lds;
    const bf16* PB = (const bf16*)(C.ws + WS_PB); bf16* O = (bf16*)(C.ws + WS_O);
    const int e = tid & 255, n = e >> 6, ee = e & 63;
    u32x4 wa8[8], wx8[8];
    { const unsigned char* wp = C.ws + WS_LWT + (size_t)l * 65536 + (size_t)((n * 64 + ee) * 64) * 2;
#pragma unroll
      for (int i = 0; i < 8; ++i) { wa8[i] = *(const u32x4*)(wp + 16 * i); wx8[i] = *(const u32x4*)(wp + 32768 + 16 * i); } }
    const float* buf = inp(I_SLRUC) + ((size_t)(l * NSAMP + s) * 3) * 256 + e; const float* cw = inp(I_LCW) + (size_t)l * 4 * 256 + e;
    const float x0 = buf[0], x1 = buf[256], x2 = buf[512], x3 = bf1(PB[(size_t)row * PB_LD + 512 + e]);
    const float xl = cw[0] * x0 + cw[256] * x1 + cw[512] * x2 + cw[768] * x3 + inp(I_LCB)[l * 256 + e];
    const float ba = inp(I_LBA)[l * 256 + e], bx = inp(I_LBX)[l * 256 + e], lam = inp(I_LLAM)[l * 256 + e], h0 = inp(I_SLRU)[(size_t)(l * NSAMP + s) * 256 + e], yv = bf1(PB[(size_t)row * PB_LD + 768 + e]);
    if (tid < 256) { sh[e] = xl; float* co = C.out + O_LRUCS + ((size_t)(l * NSAMP + s) * 3) * 256 + e; co[0] = x1; co[256] = x2; co[512] = x3; }
    __syncthreads();
    if (tid < 256) { float ar = 0.f, ai = 0.f;
#pragma unroll
        for (int i = 0; i < 8; ++i) { const unsigned aw[4] = {wa8[i].x, wa8[i].y, wa8[i].z, wa8[i].w}, xw[4] = {wx8[i].x, wx8[i].y, wx8[i].z, wx8[i].w};
#pragma unroll
            for (int k = 0; k < 4; ++k) { const float xa = sh[n * 64 + 8 * i + 2 * k], xb = sh[n * 64 + 8 * i + 2 * k + 1];
                ar += xa * bflo(aw[k]) + xb * bfhi(aw[k]); ai += xa * bflo(xw[k]) + xb * bfhi(xw[k]); } }
        const float rg = sigm(ar + ba), ig = sigm(ai + bx), la = -8.0f * rg * softplus(-lam);
        const float a = __expf(la), bm = sqrtf(fmaxf(1.0f - __expf(2.0f * la), 0.f)) * (ig * xl);
        const float hn = a * h0 + bm;
        C.out[O_LRUS + (size_t)(l * NSAMP + s) * 256 + e] = hn;
        O[(size_t)row * DM + 512 + e] = (bf16)f2bf(hn * gelu_tanh(yv)); }
    __syncthreads();
}
DI void m2_phase(const Ctx& C0, int l) {
    const int bid = C0.bid;
#ifndef M2_SUB
#define M2_SUB 0xf
#endif
#ifndef M2_DUP
#define M2_DUP 0
#endif
    if (bid < 32) { if (M2_SUB & 1) { for (int rep = 0; rep < ((M2_DUP & 1) ? 2 : 1); ++rep) { const Ctx Cr = fresh(C0); m2_dn(Cr, l, bid >> 2, bid & 3); __syncthreads(); } } return; }
    if (bid < 64) { if (M2_SUB & 2) { for (int rep = 0; rep < ((M2_DUP & 2) ? 2 : 1); ++rep) { const Ctx Cr = fresh(C0); m2_ret(Cr, l, (bid - 32) >> 2, (bid - 32) & 3); __syncthreads(); } } }
    else if (M2_SUB & 8) { const int nb = C0.G - 64;
        for (int rep = 0; rep < ((M2_DUP & 8) ? 2 : 1); ++rep)
        for (int it = bid - 64; it < NB * NCHUNK + NSAMP * 9; it += nb) { const Ctx C = fresh(C0);
            if (it < NB * NCHUNK) { m2_lru_item(C, l, it / NCHUNK, it % NCHUNK); }
            else { const int s = (it - NB * NCHUNK) / 9, k = (it - NB * NCHUNK) % 9;
                if (k < 4) ms_dn(C, l, s, k); else if (k < 8) ms_ret(C, l, s, k - 4); else ms_lru(C, l, s); } } }
    { const Ctx C = fresh(C0); __syncthreads();
      const int gw = (bid - 32) * NWAVES + C.wave, nw = (C0.G - 32) * NWAVES;
      convert_set(C, l, 1, gw, nw);
      if (l + 1 < 2) convert_set(C, l + 1, 0, gw, nw); }
}
constexpr int N_PHASES = 17;
#ifndef PH_MASK
#define PH_MASK 0x3ff
#endif
#define PH_EN(k) ((PH_MASK >> (k)) & 1)
#ifndef MK_PER_PHASE
#define MK_PER_PHASE 0
#endif
__global__ void __launch_bounds__(NTHREADS, 2) hybrid_fwd(Args args) {
    extern __shared__ __attribute__((aligned(16))) unsigned char lds[];
    Ctx C0;
    C0.out = args.out; C0.ws = args.ws; C0.lds = lds;
    C0.tid = threadIdx.x; C0.lane = C0.tid & 63; C0.wave = __builtin_amdgcn_readfirstlane(C0.tid >> 6); C0.G = gridDim.x; C0.bid = blockIdx.x;
    const int wave0 = C0.wave;
    volatile LAS unsigned* MISC = (volatile LAS unsigned*)((LAS unsigned char*)lds + MISC_OFF);
    if (C0.tid < 64) MISC[C0.tid] = 0u;
    __syncthreads();
    XcdBarrier bar; bar.bar = (unsigned*)(C0.ws + WS_CTL) + CW_BAR; bar.x = 0; bar.st = nullptr;
    const int lo = args.ph_lo, hi = args.ph_hi;
    if (hi - lo > 1) bar = xcd_barrier_post((unsigned*)(C0.ws + WS_CTL) + CW_BAR, MISC + 8);
    LAS unsigned char* ldsl = (LAS unsigned char*)lds;
    if (lo == 0) {
        if (PH_EN(9)) { const Ctx C = fresh(C0); p0_rows(C); convert_lru_weights(C); convert_set(C, 0, 0, C.bid * NWAVES + C.wave, C.G * NWAVES); }
        if (1 < hi) { XcdBarrier b2 = bar; asm volatile("" : "+s"(b2.bar), "+s"(b2.x)); int t0 = C0.tid; asm volatile("" : "+v"(t0)); xcd_barrier(b2, t0); }
    }
#define GRID_BAR_IN() do { XcdBarrier b4 = bar; asm volatile("" : "+s"(b4.bar), "+s"(b4.x)); xcd_barrier(b4, C.tid); } while (0)
    for (int ph = (lo == 0 ? 1 : lo); ph < hi; ++ph) {
#ifndef DUP_MASK
#define DUP_MASK 0
#endif
        const int nrep = ((DUP_MASK >> ((ph - 1) % 8)) & 1) ? 2 : 1;
        for (int rep = 0; rep < nrep; ++rep) {
        Ctx C = C0;
        { int ln = (int)__builtin_amdgcn_mbcnt_hi(~0u, __builtin_amdgcn_mbcnt_lo(~0u, 0u)); int wv = wave0; asm volatile("" : "+v"(ln), "+s"(wv)); C.lane = ln; C.wave = wv; C.tid = wv * 64 + ln; }
        { unsigned long long w = (unsigned long long)C0.ws, o = (unsigned long long)C0.out; asm volatile("" : "+s"(w), "+s"(o));
          C.ws = (unsigned char*)(GAS unsigned char*)w; C.out = (float*)(GAS float*)o; }
        { int bb = C0.bid, gg = C0.G; asm volatile("" : "+s"(bb), "+s"(gg)); C.bid = bb; C.G = gg; }
        unsigned long long* SS = (unsigned long long*)(C.ws + WS_SS);
        bf16* XB = (bf16*)(C.ws + WS_XB); bf16* H = (bf16*)(C.ws + WS_H); bf16* PA = (bf16*)(C.ws + WS_PA); bf16* PB = (bf16*)(C.ws + WS_PB); bf16* O = (bf16*)(C.ws + WS_O);
        float* XE = (float*)(C.ws + WS_XE); unsigned char* wt = C.ws + WS_WT;
            if (rep) { XcdBarrier b3 = bar; asm volatile("" : "+s"(b3.bar), "+s"(b3.x)); xcd_barrier(b3, C.tid); }
            const int l = (ph - 1) / 8, k = (ph - 1) % 8;
            unsigned long long* ss_in1 = SS + (size_t)(3 * l) * NROWS;
            if (k == 0 && PH_EN(0)) {
                pg8::Gemm g{XB, (const bf16*)(wt + WT_F1I), NROWS, 2 * DFF, DM, nullptr, 0}; pg8::StaticOrder S; S.init(NROWS, 2 * DFF, C.G, C.bid);
                pg8::EpiSwiglu E{H, DFF, ss_in1};
                pg8::gemm_phase<pg8::EpiSwiglu, pg8::StaticOrder, true, true>(ldsl, g, S, E, C.tid);
            } else if (k == 1 && PH_EN(1)) {
                pg8::Gemm g{H, (const bf16*)(wt + WT_F1O), NROWS, DM, DFF, (float*)(C.ws + WS_SLAB), DFF / 256}; pg8::SplitOrder S; S.init(DFF, C.G, C.bid);
                pg8::EpiResid E{l == 0 ? inp(I_XP) : C.out + O_YP, C.out + O_YP, XE, XB, ss_in1 + NROWS, 0.5f};
                pg8::gemm_phase<pg8::EpiResid, pg8::SplitOrder, true, true>(ldsl, g, S, E, C.tid);
                GRID_BAR_IN(); fix_rows(C, g.nparts, E.scale, E.ssn);
            } else if (k == 2 && PH_EN(2)) {
                pg8::Gemm g{XB, (const bf16*)(wt + WT_WIN), NROWS, DIN_PAD, DM, nullptr, 0}; pg8::StaticOrder S; S.init(NROWS, DIN_PAD, C.G, C.bid);
                pg8::EpiProj E{PA, PB, ss_in1 + NROWS};
                pg8::gemm_phase<pg8::EpiProj, pg8::StaticOrder, true, true>(ldsl, g, S, E, C.tid);
            } else if (k == 3 && PH_EN(3)) { m1_phase(C, l);
            } else if (k == 4 && PH_EN(4)) { m2_phase(C, l);
            } else if (k == 5 && PH_EN(5)) {
                pg8::Gemm g{O, (const bf16*)(wt + WT_WOUT), NROWS, DM, DM, (float*)(C.ws + WS_SLAB), DM / 256}; pg8::SplitOrder S; S.init(DM, C.G, C.bid);
                pg8::EpiResid E{C.out + O_YP, C.out + O_YP, XE, XB, ss_in1 + 2 * NROWS, 1.0f};
                pg8::gemm_phase<pg8::EpiResid, pg8::SplitOrder, true, true>(ldsl, g, S, E, C.tid);
                GRID_BAR_IN(); fix_rows(C, g.nparts, E.scale, E.ssn);
            } else if (k == 6 && PH_EN(6)) {
                pg8::Gemm g{XB, (const bf16*)(wt + WT_F2I), NROWS, 2 * DFF, DM, nullptr, 0}; pg8::StaticOrder S; S.init(NROWS, 2 * DFF, C.G, C.bid);
                pg8::EpiSwiglu E{H, DFF, ss_in1 + 2 * NROWS};
                pg8::gemm_phase<pg8::EpiSwiglu, pg8::StaticOrder, true, true>(ldsl, g, S, E, C.tid);
            } else if (k == 7 && PH_EN(7)) {
                pg8::Gemm g{H, (const bf16*)(wt + WT_F2O), NROWS, DM, DFF, (float*)(C.ws + WS_SLAB), DFF / 256}; pg8::SplitOrder S; S.init(DFF, C.G, C.bid);
                pg8::EpiResid E{C.out + O_YP, C.out + O_YP, XE, XB, ss_in1 + 3 * NROWS, 0.5f};
                pg8::gemm_phase<pg8::EpiResid, pg8::SplitOrder, true, true>(ldsl, g, S, E, C.tid);
                GRID_BAR_IN(); if (l == 0) fix_rows(C, g.nparts, E.scale, E.ssn); else final_fix_norm(C, g.nparts, E.scale);
            }
        }
        if (ph + 1 < hi) { XcdBarrier b2 = bar; asm volatile("" : "+s"(b2.bar), "+s"(b2.x)); int ln = (int)__builtin_amdgcn_mbcnt_hi(~0u, __builtin_amdgcn_mbcnt_lo(~0u, 0u)); int wv = wave0; asm volatile("" : "+v"(ln), "+s"(wv)); xcd_barrier(b2, wv * 64 + ln); }
    }
}

extern "C" void kernel_launch(void* const* d_in, const int* in_sizes, int n_in, void* d_out, int out_size, void* d_ws, size_t ws_size, hipStream_t stream) {
    static int grid = 0;
    if (grid == 0) {
        if (n_in != 29 || out_size != (int)O_END || ws_size < WS_END) { fprintf(stderr, "kernel_launch: unexpected shapes: n_in %d out %d ws %zu (need %zu)\n", n_in, out_size, ws_size, (size_t)WS_END); grid = -1; return; }
        int dev = 0, cus = 0, per_cu = 0;
        if (hipGetDevice(&dev) != hipSuccess || hipDeviceGetAttribute(&cus, hipDeviceAttributeMultiprocessorCount, dev) != hipSuccess) { grid = -1; return; }
        if (hipFuncSetAttribute((const void*)hybrid_fwd, hipFuncAttributeMaxDynamicSharedMemorySize, LDS_BYTES) != hipSuccess) { fprintf(stderr, "kernel_launch: hipFuncSetAttribute failed\n"); grid = -1; return; }
        if (hipOccupancyMaxActiveBlocksPerMultiprocessor(&per_cu, (const void*)hybrid_fwd, NTHREADS, LDS_BYTES) != hipSuccess || per_cu < 1) { fprintf(stderr, "kernel_launch: occupancy query says %d blocks per CU\n", per_cu); grid = -1; return; }
        (void)hipGetLastError();
        grid = cus;
        if (grid < 128) { fprintf(stderr, "kernel_launch: %d CUs: too few for this kernel's phase-role split\n", grid); grid = -1; return; }
    }
    if (grid < 0) return;
    if (hipMemsetAsync((char*)d_ws + WS_CTL, 0, CTL_ZERO_BYTES, stream) != hipSuccess) return;
    Args a{};
    for (int i = 0; i < 29; ++i) a.in[i] = (const float*)d_in[i];
    a.out = (float*)d_out; a.ws = (unsigned char*)d_ws;
#if MK_PER_PHASE
    for (int ph = 0; ph < N_PHASES; ++ph) { a.ph_lo = ph; a.ph_hi = ph + 1; hipLaunchKernelGGL(hybrid_fwd, dim3(grid), dim3(NTHREADS), LDS_BYTES, stream, a); }
#else
    a.ph_lo = 0; a.ph_hi = N_PHASES; hipLaunchKernelGGL(hybrid_fwd, dim3(grid), dim3(NTHREADS), LDS_BYTES, stream, a);
#endif
}
```

```cpp
#include <hip/hip_runtime.h>
#include <cstdio>
#include <cstdint>
namespace pg8 {
#define PG8_LAS __attribute__((address_space(3)))
typedef unsigned short bf16_t;
typedef short bf16x8 __attribute__((ext_vector_type(8)));
typedef float f32x4 __attribute__((ext_vector_type(4)));
typedef unsigned u32x4 __attribute__((ext_vector_type(4)));
constexpr int BM = 256, BK = 64, HALF = 128, HTB = HALF * BK * 2  , STAGE_BYTES = 8 * HTB, NXCD = 8, WGM = 8;

__host__ __device__ __forceinline__ int lds_byte(int r, int c) { const int st = (r >> 4) * 2 + (c >> 5), rr = r & 15, cc = c & 31, ob = rr * 64 + cc * 2; return st * 1024 + (ob ^ (((ob >> 9) & 1) << 5)); }
__host__ __device__ __forceinline__ void stage_rc(int b, int& R, int& C) { const int st = b / 1024, sb = b % 1024, swz = sb ^ (((sb >> 9) & 1) << 5); R = (st >> 1) * 16 + swz / 64; C = (st & 1) * 32 + (swz % 64) / 2; }
__host__ __device__ __forceinline__ int perm32(int rho) { const int n = rho >> 4, i = rho & 15; return 8 * (i >> 2) + 4 * n + (i & 3); }

struct Unit { int pm, pn, kt0, nkt, part; };
struct Gemm { const bf16_t* A; const bf16_t* Bt; int M, N, K; float* slab; int nparts; };

struct StaticOrder {
    int nM, nN, nwg, G, c;
    __host__ __device__ void init(int M, int N, int G_, int c_) { nM = M / BM; nN = N / BM; nwg = nM * nN; G = G_; c = c_; }
    __host__ __device__ bool next(int i, Unit& u) const {
        const long L = (long)i * G + c; if (L >= nwg) { u.pm = 0; u.pn = 0; u.kt0 = 0; u.nkt = 0; u.part = -1; return false; }
        int wgid = (int)L; { const int q = nwg / NXCD, r = nwg % NXCD, xcd = wgid % NXCD, off = wgid / NXCD; wgid = (xcd < r ? xcd * (q + 1) : r * (q + 1) + (xcd - r) * q) + off; }
        const int nig = WGM * nN, gid = wgid / nig, fm = gid * WGM, gsz = (nM - fm) < WGM ? (nM - fm) : WGM;
        u.pm = fm + ((wgid % nig) % gsz); u.pn = (wgid % nig) / gsz; u.kt0 = 0; u.nkt = 0; u.part = -1; return true;
    }
    __device__ __forceinline__ void a_ready(const Unit&) const {}
    __device__ __forceinline__ void done(const Unit&) const {}
};

__device__ __forceinline__ unsigned cvt_pk_bf16(float lo, float hi) { unsigned r; asm volatile("v_cvt_pk_bf16_f32 %0, %1, %2" : "=v"(r) : "v"(lo), "v"(hi)); return r; }
struct SplitOrder {
    StaticOrder so; int nparts;
    __host__ __device__ void init(int K, int G_, int c_) { so.init(64 * BM, 1024, G_, c_); nparts = K / BK / 4; }
    __host__ __device__ bool next(int i, Unit& u) const {
        Unit f; const bool full = so.next(i, f);
        const int L = i * so.G + so.c - so.nwg; const bool part = (L >= 0) && (L < 4 * nparts);
        const int q = part ? L / nparts : 0, p = part ? L % nparts : 0;
        Unit r; r.pm = full ? f.pm : 64; r.pn = full ? f.pn : q; r.kt0 = full ? 0 : 4 * p; r.nkt = full ? 0 : 4; r.part = full ? -1 : p;
        u = r; return full || part;
    }
    __device__ __forceinline__ void a_ready(const Unit&) const {}
    __device__ __forceinline__ void done(const Unit&) const {}
};
__device__ __forceinline__ void slab_dump(const f32x4 (&acc)[2][2][4][2], const Unit& u, float* slab, int nparts, int wr, int wc, int fr, int fq) {
    float* base = slab + (size_t)(u.pn * nparts + u.part) * 65536 + (size_t)(wr * 64 + fr) * 256 + wc * 32 + 8 * fq;
#pragma unroll
    for (int ai = 0; ai < 2; ++ai)
#pragma unroll
        for (int m = 0; m < 4; ++m)
#pragma unroll
            for (int bj = 0; bj < 2; ++bj) { float* p = base + (size_t)(ai * HALF + m * 16) * 256 + bj * HALF; *(f32x4*)p = acc[ai][bj][m][0]; *(f32x4*)(p + 4) = acc[ai][bj][m][1]; }
}
typedef unsigned u32x2 __attribute__((ext_vector_type(2)));
__device__ __forceinline__ float fast_sigmoid(float x) { return __builtin_amdgcn_rcpf(1.0f + __expf(-x)); }
__device__ __forceinline__ float fast_silu(float x) { return x * fast_sigmoid(x); }
constexpr int NP_ROWS = 16384;

struct EpiSwiglu {
    static constexpr bool PERM = true, AFTER_DRAIN = false;
    bf16_t* H; int ldh; const unsigned long long* ss;
    __device__ __forceinline__ void operator()(const f32x4 (&acc)[2][2][4][2], const Unit& u, int wr, int wc, int fr, int fq) const {
        const int row0 = u.pm * BM + wr * 64 + fr, col0 = u.pn * 128 + wc * 32 + 8 * fq;
#pragma unroll
        for (int ai = 0; ai < 2; ++ai)
#pragma unroll
            for (int m = 0; m < 4; ++m) {
                const int row = row0 + ai * HALF + m * 16;
                const float rs = __builtin_amdgcn_rsqf((float)ss[row] * (1.0f / (1024.0f * 1048576.0f)) + 1e-6f);
                float hv[8];
#pragma unroll
                for (int n = 0; n < 2; ++n)
#pragma unroll
                    for (int e = 0; e < 4; ++e) { const float g = acc[ai][0][m][n][e] * rs, up = acc[ai][1][m][n][e] * rs; hv[4 * n + e] = fast_silu(g) * up; }
                u32x4 w; w.x = cvt_pk_bf16(hv[0], hv[1]); w.y = cvt_pk_bf16(hv[2], hv[3]); w.z = cvt_pk_bf16(hv[4], hv[5]); w.w = cvt_pk_bf16(hv[6], hv[7]);
                *(u32x4*)(H + (size_t)row * ldh + col0) = w;
            }
    }
};
struct EpiProj {
    static constexpr bool PERM = true, AFTER_DRAIN = false;
    bf16_t* PA; bf16_t* PB; const unsigned long long* ss;
    __device__ __forceinline__ void operator()(const f32x4 (&acc)[2][2][4][2], const Unit& u, int wr, int wc, int fr, int fq) const {
        const int row0 = u.pm * BM + wr * 64 + fr;
        bf16_t* base; int ld, colt;
        if (u.pn < 7) { base = PA; ld = 1792; colt = u.pn * 256; } else { base = PB; ld = 2048; colt = (u.pn - 7) * 256; }
        const int col0 = colt + wc * 32 + 8 * fq;
#pragma unroll
        for (int ai = 0; ai < 2; ++ai)
#pragma unroll
            for (int m = 0; m < 4; ++m) {
                const int row = row0 + ai * HALF + m * 16;
                const float rs = __builtin_amdgcn_rsqf((float)ss[row] * (1.0f / (1024.0f * 1048576.0f)) + 1e-6f);
                bf16_t* rowp = base + (size_t)row * ld + col0;
#pragma unroll
                for (int bj = 0; bj < 2; ++bj) { const f32x4 v0 = acc[ai][bj][m][0] * rs, v1 = acc[ai][bj][m][1] * rs;
                    u32x4 w; w.x = cvt_pk_bf16(v0[0], v0[1]); w.y = cvt_pk_bf16(v0[2], v0[3]); w.z = cvt_pk_bf16(v1[0], v1[1]); w.w = cvt_pk_bf16(v1[2], v1[3]);
                    *(u32x4*)(rowp + bj * HALF) = w; }
            }
    }
};
struct EpiResid {
    static constexpr bool PERM = true, AFTER_DRAIN = false;
    const float* xin_lo; float* xout_lo; float* xe; bf16_t* xb; unsigned long long* ssn; float scale;
    __device__ __forceinline__ void operator()(const f32x4 (&acc)[2][2][4][2], const Unit& u, int wr, int wc, int fr, int fq) const {
        const int row0 = u.pm * BM + wr * 64 + fr, col0 = u.pn * BM + wc * 32 + 8 * fq;
        const bool lo = (u.pm * BM) < NP_ROWS;
#pragma unroll
        for (int ai = 0; ai < 2; ++ai)
#pragma unroll
            for (int m = 0; m < 4; ++m) {
                const int row = row0 + ai * HALF + m * 16;
                const float* xi = lo ? xin_lo + (size_t)row * 1024 : xe + (size_t)(row - NP_ROWS) * 1024;
                float* xo = lo ? xout_lo + (size_t)row * 1024 : xe + (size_t)(row - NP_ROWS) * 1024;
                float sq = 0.f;
#pragma unroll
                for (int bj = 0; bj < 2; ++bj) { const int c = col0 + bj * HALF;
                    f32x4 a0 = *(const f32x4*)(xi + c), a1 = *(const f32x4*)(xi + c + 4);
                    a0 = a0 + acc[ai][bj][m][0] * scale; a1 = a1 + acc[ai][bj][m][1] * scale;
                    *(f32x4*)(xo + c) = a0; *(f32x4*)(xo + c + 4) = a1;
                    u32x4 w; w.x = cvt_pk_bf16(a0[0], a0[1]); w.y = cvt_pk_bf16(a0[2], a0[3]); w.z = cvt_pk_bf16(a1[0], a1[1]); w.w = cvt_pk_bf16(a1[2], a1[3]);
                    *(u32x4*)(xb + (size_t)row * 1024 + c) = w;
                    sq += (a0[0] * a0[0] + a0[1] * a0[1]) + (a0[2] * a0[2] + a0[3] * a0[3]) + (a1[0] * a1[0] + a1[1] * a1[1]) + (a1[2] * a1[2] + a1[3] * a1[3]); }
                sq += __builtin_bit_cast(float, __builtin_amdgcn_ds_bpermute((fr + 16 * (fq ^ 1)) << 2, __builtin_bit_cast(int, sq))); sq += __builtin_bit_cast(float, __builtin_amdgcn_ds_bpermute((fr + 16 * (fq ^ 2)) << 2, __builtin_bit_cast(int, sq)));
                if (fq == 0) atomicAdd(ssn + row, (unsigned long long)(sq * 1048576.0f + 0.5f));
            }
    }
};
template <class Epi, class Sched, bool ALIGN_EPI = false, bool SP2 = false>
__device__ __forceinline__ void gemm_phase(PG8_LAS unsigned char* lds, const Gemm g, const Sched& S, const Epi& E, const int tid_in) {
    int tid_ = tid_in; asm volatile("" : "+v"(tid_));
    const int tid = tid_, wid = __builtin_amdgcn_readfirstlane(tid >> 6), lane = tid & 63, wr = wid >> 2, wc = wid & 3, fr = lane & 15, fq = lane >> 4;
    const int K = g.K, nt = K / BK;
    unsigned voffA[2], voffB[2];
#pragma unroll
    for (int i = 0; i < 2; ++i) { int R, C; stage_rc(tid * 16 + i * 8192, R, C); const int Rb = Epi::PERM ? ((R & ~31) + perm32(R & 31)) : R;
        voffA[i] = (unsigned)(R * K + C) * 2u; voffB[i] = (unsigned)(Rb * K + C) * 2u; }
    const size_t kstep = (size_t)(BK * 2);
    const size_t hstep = (size_t)HALF * K * 2;
    const size_t tstep = 2 * hstep;
    const unsigned ldsw = (unsigned)wid * 1024u;
    const int aoff = lds_byte(wr * 64 + fr, fq * 8), boff = lds_byte(wc * 32 + fr, fq * 8);
#define PG8_SA(b, h) (((b) * 2 + (h)) * HTB)
#define PG8_SB(b, h) ((4 + (b) * 2 + (h)) * HTB)
#define PG8_STAGE(bufoff, gbase, voff) do { _Pragma("unroll") for (int _i = 0; _i < 2; ++_i) \
        __builtin_amdgcn_global_load_lds((const unsigned*)((const char*)(gbase) + (voff)[_i]), (PG8_LAS unsigned*)(lds + (bufoff) + ldsw + _i * 8192), 16, 0, 0); } while (0)
#define PG8_LDA(dst, b, h) do { _Pragma("unroll") for (int m = 0; m < 4; ++m) _Pragma("unroll") for (int k = 0; k < 2; ++k) dst[m][k] = *(const PG8_LAS bf16x8*)(lds + PG8_SA(b, h) + aoff + m * 2048 + k * 1024); } while (0)
#define PG8_LDB(dst, b, h) do { _Pragma("unroll") for (int n = 0; n < 2; ++n) _Pragma("unroll") for (int k = 0; k < 2; ++k) dst[n][k] = *(const PG8_LAS bf16x8*)(lds + PG8_SB(b, h) + boff + n * 2048 + k * 1024); } while (0)
#define PG8_MMA(ai, bj, At, Bt) do { __builtin_amdgcn_s_setprio(1); _Pragma("unroll") for (int m = 0; m < 4; ++m) _Pragma("unroll") for (int n = 0; n < 2; ++n) _Pragma("unroll") for (int k = 0; k < 2; ++k) \
        acc[ai][bj][m][n] = __builtin_amdgcn_mfma_f32_16x16x32_bf16(Bt[n][k], At[m][k], acc[ai][bj][m][n], 0, 0, 0); __builtin_amdgcn_s_setprio(0); } while (0)
#define PG8_WAIT_V(n) asm volatile("s_waitcnt vmcnt(" #n ")" ::: "memory")
#define PG8_WAIT_L(n) asm volatile("s_waitcnt lgkmcnt(" #n ")" ::: "memory")
#define PG8_BAR __builtin_amdgcn_s_barrier()
#define PG8_SCHED __builtin_amdgcn_sched_barrier(0)
    Unit cur, nxt; int ui = 0;
    if (!S.next(0, cur)) return;
    f32x4 acc[2][2][4][2];
#pragma unroll
    for (int a = 0; a < 2; ++a)
#pragma unroll
        for (int b = 0; b < 2; ++b)
#pragma unroll
            for (int m = 0; m < 4; ++m)
#pragma unroll
                for (int n = 0; n < 2; ++n) acc[a][b][m][n] = (f32x4){0.f, 0.f, 0.f, 0.f};
    bf16x8 At[4][2], B0[2][2], B1[2][2];
    int cnt = cur.nkt > 0 ? cur.nkt : nt;
    const char* cA = (const char*)g.A + (size_t)cur.pm * tstep + (size_t)cur.kt0 * kstep; const char* cB = (const char*)g.Bt + (size_t)cur.pn * tstep + (size_t)cur.kt0 * kstep;
    S.a_ready(cur);
    if constexpr (SP2) {
        PG8_STAGE(PG8_SB(0, 0), cB, voffB); PG8_STAGE(PG8_SB(0, 1), cB + hstep, voffB); PG8_STAGE(PG8_SA(0, 0), cA, voffA); PG8_STAGE(PG8_SA(0, 1), cA + hstep, voffA);
        if (wr == 1) PG8_BAR;
        PG8_WAIT_V(2); PG8_BAR;
        PG8_STAGE(PG8_SB(1, 0), cB + kstep, voffB); PG8_STAGE(PG8_SA(1, 0), cA + kstep, voffA); PG8_STAGE(PG8_SB(1, 1), cB + hstep + kstep, voffB);
        PG8_WAIT_V(6); PG8_BAR;
    } else {
        PG8_STAGE(PG8_SB(0, 0), cB, voffB); PG8_STAGE(PG8_SA(0, 0), cA, voffA); PG8_STAGE(PG8_SB(0, 1), cB + hstep, voffB); PG8_STAGE(PG8_SA(0, 1), cA + hstep, voffA);
        if (wr == 1) PG8_BAR;
        PG8_WAIT_V(4); PG8_BAR;
        PG8_STAGE(PG8_SB(1, 0), cB + kstep, voffB); PG8_STAGE(PG8_SA(1, 0), cA + kstep, voffA); PG8_STAGE(PG8_SB(1, 1), cB + hstep + kstep, voffB);
        PG8_WAIT_V(6); PG8_BAR;
    }
    for (;;) {
        const bool has_next = S.next(ui + 1, nxt);
        const char* nA = has_next ? (const char*)g.A + (size_t)nxt.pm * tstep + (size_t)nxt.kt0 * kstep : cA; const char* nB = has_next ? (const char*)g.Bt + (size_t)nxt.pn * tstep + (size_t)nxt.kt0 * kstep : cB;
        for (int t = 0; t < cnt; t += 2) {
            const bool last = (t == cnt - 2);
            const char* a1 = cA + (size_t)(t + 1) * kstep;
            const char* a2 = last ? nA : cA + (size_t)(t + 2) * kstep; const char* b2 = last ? nB : cB + (size_t)(t + 2) * kstep;
            const char* a3 = a2 + kstep; const char* b3 = b2 + kstep;
            if (last && has_next) S.a_ready(nxt);
            if constexpr (SP2) {
            PG8_LDB(B0, 0, 0); PG8_LDB(B1, 0, 1); PG8_SCHED; PG8_LDA(At, 0, 0); PG8_STAGE(PG8_SA(1, 1), a1 + hstep, voffA);
            PG8_WAIT_V(8); PG8_WAIT_L(0); PG8_BAR; PG8_MMA(0, 0, At, B0); PG8_MMA(0, 1, At, B1); PG8_BAR; PG8_SCHED;
            PG8_LDA(At, 0, 1); PG8_STAGE(PG8_SB(0, 0), b2, voffB); PG8_STAGE(PG8_SB(0, 1), b2 + hstep, voffB); PG8_STAGE(PG8_SA(0, 0), a2, voffA);
            PG8_WAIT_V(8); PG8_WAIT_L(0); PG8_BAR; PG8_MMA(1, 0, At, B0); PG8_MMA(1, 1, At, B1); PG8_BAR; PG8_SCHED;
            PG8_LDB(B0, 1, 0); PG8_LDB(B1, 1, 1); PG8_SCHED; PG8_LDA(At, 1, 0); PG8_STAGE(PG8_SA(0, 1), a2 + hstep, voffA);
            PG8_WAIT_V(8); PG8_WAIT_L(0); PG8_BAR; PG8_MMA(0, 0, At, B0); PG8_MMA(0, 1, At, B1); PG8_BAR; PG8_SCHED;
            PG8_LDA(At, 1, 1); PG8_STAGE(PG8_SB(1, 0), b3, voffB); PG8_STAGE(PG8_SB(1, 1), b3 + hstep, voffB); PG8_STAGE(PG8_SA(1, 0), a3, voffA);
            PG8_WAIT_V(8); PG8_WAIT_L(0); PG8_BAR; PG8_MMA(1, 0, At, B0); PG8_MMA(1, 1, At, B1); PG8_BAR; PG8_SCHED;
            } else {
            PG8_LDB(B0, 0, 0); PG8_SCHED; PG8_LDA(At, 0, 0); PG8_STAGE(PG8_SA(1, 1), a1 + hstep, voffA);
            PG8_WAIT_L(8); PG8_BAR; PG8_WAIT_L(0); PG8_MMA(0, 0, At, B0); PG8_BAR; PG8_SCHED;
            PG8_LDB(B1, 0, 1); PG8_STAGE(PG8_SB(0, 0), b2, voffB);
            PG8_BAR; PG8_WAIT_L(0); PG8_MMA(0, 1, At, B1); PG8_BAR;
            PG8_LDA(At, 0, 1); PG8_STAGE(PG8_SA(0, 0), a2, voffA);
            PG8_BAR; PG8_WAIT_L(0); PG8_MMA(1, 0, At, B0); PG8_BAR; PG8_SCHED;
            PG8_STAGE(PG8_SB(0, 1), b2 + hstep, voffB);
            PG8_WAIT_V(6); PG8_BAR; PG8_MMA(1, 1, At, B1); PG8_BAR;
            PG8_LDB(B0, 1, 0); PG8_SCHED; PG8_LDA(At, 1, 0); PG8_STAGE(PG8_SA(0, 1), a2 + hstep, voffA);
            PG8_WAIT_L(8); PG8_BAR; PG8_WAIT_L(0); PG8_MMA(0, 0, At, B0); PG8_BAR; PG8_SCHED;
            PG8_LDB(B1, 1, 1); PG8_STAGE(PG8_SB(1, 0), b3, voffB);
            PG8_BAR; PG8_WAIT_L(0); PG8_MMA(0, 1, At, B1); PG8_BAR;
            PG8_LDA(At, 1, 1); PG8_STAGE(PG8_SA(1, 0), a3, voffA);
            PG8_BAR; PG8_WAIT_L(0); PG8_MMA(1, 0, At, B0); PG8_BAR; PG8_SCHED;
            PG8_STAGE(PG8_SB(1, 1), b3 + hstep, voffB);
            PG8_WAIT_V(6); PG8_BAR; PG8_MMA(1, 1, At, B1); PG8_BAR;
            }
        }
        if constexpr (ALIGN_EPI) { if (wr == 0) PG8_BAR; }
        if constexpr (!Epi::AFTER_DRAIN) { if (cur.part >= 0) slab_dump(acc, cur, g.slab, g.nparts, wr, wc, fr, fq); else E(acc, cur, wr, wc, fr, fq); S.done(cur); }
        if (!has_next) break;
#pragma unroll
        for (int a = 0; a < 2; ++a)
#pragma unroll
            for (int b = 0; b < 2; ++b)
#pragma unroll
                for (int m = 0; m < 4; ++m)
#pragma unroll
                    for (int n = 0; n < 2; ++n) acc[a][b][m][n] = (f32x4){0.f, 0.f, 0.f, 0.f};
        cur = nxt; cA = nA; cB = nB; ++ui; cnt = cur.nkt > 0 ? cur.nkt : nt;
        if constexpr (ALIGN_EPI) { if (wr == 1) PG8_BAR; }
    }
    PG8_WAIT_V(0);
    if constexpr (!ALIGN_EPI) { if (wr == 0) PG8_BAR; }
    PG8_BAR;
    if constexpr (Epi::AFTER_DRAIN) { E.fused(acc, cur, wr, wc, fr, fq, lds, wid, lane); S.done(cur); }
#undef PG8_SA
#undef PG8_SB
#undef PG8_STAGE
#undef PG8_LDA
#undef PG8_LDB
#undef PG8_MMA
#undef PG8_WAIT_V
#undef PG8_WAIT_L
#undef PG8_BAR
#undef PG8_SCHED
}
}

constexpr int DM = 1024, NROWS = 16640, NPROMPT = 16384, NMETAROWS = 128, SROW0 = 16512;
constexpr int DFF = 2816, NCHUNK = 33, NB = 8, NSAMP = 128;
constexpr int PA_LD = 1792, PB_LD = 2048, DIN_PAD = 3840;
constexpr float EPS = 1e-6f;
constexpr size_t MiB = 1u << 20;
constexpr size_t WS_CTL = 0, WS_SS = 1 * MiB, CTL_ZERO_BYTES = 2 * MiB;
constexpr size_t WS_ROPE = 2 * MiB;
constexpr size_t WS_XE = 3 * MiB;
constexpr size_t WS_LWT = 6 * MiB;
constexpr size_t WS_GCA = 4 * MiB, WS_CA = 4 * MiB + 65536, WS_CB = WS_CA + 524288;
constexpr size_t WS_WT = 8 * MiB;
constexpr size_t WT_F1I = 0, WT_F1O = 11534336, WT_WIN = 17301504, WT_WOUT = 25165824, WT_F2I = 27262976, WT_F2O = 38797312, WT_END = 44564480;
constexpr size_t WS_XB = 52 * MiB;
constexpr size_t WS_R = 86 * MiB;
constexpr size_t WS_H = WS_R, WS_PA = WS_R, WS_O = WS_R, WS_PB = 144 * MiB, WS_DNI = 210 * MiB, WS_LA = 285 * MiB, WS_LB = 294 * MiB, WS_END = 303 * MiB;
static_assert(WS_SS + (size_t)7 * NROWS * 8 <= CTL_ZERO_BYTES, "ss arrays inside the memset");
static_assert(WS_WT + WT_END <= WS_XB && WS_XB + (size_t)NROWS * DM * 2 <= WS_R && WS_H + (size_t)NROWS * DFF * 2 <= WS_END, "ws map");
static_assert(WS_PA + (size_t)NROWS * PA_LD * 2 <= WS_PB && WS_PB + (size_t)NROWS * PB_LD * 2 <= WS_DNI, "ws map 2");
constexpr size_t WS_SLAB = WS_DNI;
constexpr int DNI_ITEM = 73728;
constexpr int DNI_W = 0, DNI_QG = 16384, DNI_KDT = 32768, DNI_UVT = 49152, DNI_P = 65536;
static_assert(WS_DNI + (size_t)1056 * DNI_ITEM <= WS_LA && WS_LA + (size_t)NROWS * 256 * 2 <= WS_LB && WS_LB + (size_t)NROWS * 256 * 2 <= WS_END, "ws map 3");
constexpr int CW_BAR = 4096;
constexpr size_t O_YP = 0, O_YS = 16777216, O_DNP = O_YS + 131072, O_DNCP = O_DNP + 1048576, O_LRUP = O_DNCP + 73728, O_LRUCP = O_LRUP + 4096, O_RETP = O_LRUCP + 12288,
                 O_DNS = O_RETP + 262144, O_DNCS = O_DNS + 16777216, O_LRUS = O_DNCS + 1179648, O_LRUCS = O_LRUS + 65536, O_RETS = O_LRUCS + 196608, O_END = O_RETS + 4194304;
constexpr int LDS_BYTES = 155648, MISC_OFF = LDS_BYTES - 256;
constexpr int NWAVES = 8, NTHREADS = 512;

#define GAS __attribute__((address_space(1)))
#define LAS __attribute__((address_space(3)))
typedef unsigned short bf16;
typedef float f32x4 __attribute__((ext_vector_type(4)));
typedef float f32x16 __attribute__((ext_vector_type(16)));
typedef short bf16x8 __attribute__((ext_vector_type(8)));
typedef unsigned u32x4 __attribute__((ext_vector_type(4)));
typedef unsigned u32x2 __attribute__((ext_vector_type(2)));
#define DI __device__ __forceinline__
DI unsigned f2bf(float f) { return (unsigned)__builtin_bit_cast(unsigned short, (__bf16)f); }
typedef __bf16 hwbf16x2 __attribute__((ext_vector_type(2)));
typedef float f32x2 __attribute__((ext_vector_type(2)));
DI unsigned pk2(float lo, float hi) { const f32x2 v = {lo, hi}; return __builtin_bit_cast(unsigned, __builtin_convertvector(v, hwbf16x2)); }
DI float bflo(unsigned w) { return __builtin_bit_cast(float, w << 16); }
DI float bfhi(unsigned w) { return __builtin_bit_cast(float, w & 0xffff0000u); }
DI f32x4 ld4bf(const bf16* p) { const u32x2 v = *(const u32x2*)p; return (f32x4){bflo(v.x), bfhi(v.x), bflo(v.y), bfhi(v.y)}; }
DI float bf1(bf16 b) { return __builtin_bit_cast(float, (unsigned)b << 16); }
DI float sigm(float x) { return __builtin_amdgcn_rcpf(1.0f + __expf(-x)); }
DI float silu(float x) { return x * sigm(x); }
DI float softplus(float x) { return x > 20.f ? x : log1pf(__expf(x)); }
DI float gelu_tanh(float y) { const float u = 0.7978845608028654f * (y + 0.044715f * y * y * y); const float t = 1.0f - 2.0f * __builtin_amdgcn_rcpf(__expf(2.0f * u) + 1.0f); return 0.5f * y * (1.0f + t); }
DI float xshfl(float v, int src) { return __builtin_bit_cast(float, __builtin_amdgcn_ds_bpermute(src << 2, __builtin_bit_cast(int, v))); }
DI float wave_sum(float v, int lane) {
#pragma unroll
    for (int o = 1; o < 64; o <<= 1) v += xshfl(v, lane ^ o);
    return v;
}
#define MFMA32(a, b, c) __builtin_amdgcn_mfma_f32_32x32x16_bf16((a), (b), (c), 0, 0, 0)
DI int crow(int reg, int hh) { return (reg & 3) + 8 * (reg >> 2) + 4 * hh; }

typedef GAS unsigned gu32;
#define RLX_AGENT __ATOMIC_RELAXED, __HIP_MEMORY_SCOPE_AGENT
#define XB_TMO      128
#define XB_XCNT(j)  (256  + 64 * (j))
#define XB_XSUB(j)  (1280 + 64 * (j))
#define XB_XGEN(j)  (2304 + 64 * (j))
#define XB_TOP      3328
#define XB_TOPGEN   3392
#define XCD_BAR_WORDS 3456
#define XB_SPIN_CAP (1u << 18)

__device__ __forceinline__ unsigned xb_ld(unsigned* p)              { return __hip_atomic_load(p, __ATOMIC_RELAXED, __HIP_MEMORY_SCOPE_AGENT); }
__device__ __forceinline__ unsigned xb_add(unsigned* p, unsigned v) { return __hip_atomic_fetch_add(p, v, __ATOMIC_RELAXED, __HIP_MEMORY_SCOPE_AGENT); }
__device__ __forceinline__ unsigned xb_xcc_id() { return (unsigned)__builtin_amdgcn_s_getreg((3 << 11) | 20) & 0xFu; }
#define XB_SPIN(cond, bar) do { unsigned _sp = 0; while (cond) { __builtin_amdgcn_s_sleep(1); \
    if ((++_sp & 255u) == 0u) { if (xb_ld(&(bar)[XB_TMO])) break; if (_sp > XB_SPIN_CAP) { atomicAdd(&(bar)[XB_TMO], 1u); break; } } } } while (0)

struct XcdBarrier {
    unsigned* bar; unsigned x;
    volatile LAS unsigned* st;
};

__device__ __forceinline__ XcdBarrier xcd_barrier_post(unsigned* bar, volatile LAS unsigned* st) {
    XcdBarrier b; b.bar = bar; b.x = xb_xcc_id(); b.st = st;
    if (threadIdx.x == 0) (void)xb_add(&bar[XB_XCNT(b.x)], 1u);
    return b;
}
__device__ __forceinline__ void xcd_barrier_complete(unsigned* bar, unsigned x, unsigned& nloc, unsigned& nx) {
    const unsigned G = gridDim.x * gridDim.y * gridDim.z;
    unsigned sum, cnt, mine, sp = 0u;
    for (;;) {
        sum = 0u; cnt = 0u; mine = 0u;
#pragma unroll
        for (unsigned j = 0; j < 16; ++j) { const unsigned c = xb_ld(&bar[XB_XCNT(j)]); sum += c; cnt += (c > 0u) ? 1u : 0u; mine = (j == x) ? c : mine; }
        if (sum == G) break;
        __builtin_amdgcn_s_sleep(1);
        if ((++sp & 255u) == 0u) { if (xb_ld(&bar[XB_TMO])) break; if (sp > XB_SPIN_CAP) { atomicAdd(&bar[XB_TMO], 1u); break; } }
    }
    nloc = mine > 0u ? mine : 1u; nx = cnt > 0u ? cnt : 1u;
}

__device__ __forceinline__ void xcd_barrier(const XcdBarrier& b, const int tid) {
    asm volatile("s_waitcnt vmcnt(0)" ::: "memory");
    __syncthreads();
    if (tid == 0) {
        unsigned* bar = b.bar;
        __builtin_amdgcn_s_waitcnt(0);
        unsigned nloc = b.st[0], nx = b.st[1];
        if (nloc == 0u) { xcd_barrier_complete(bar, b.x, nloc, nx); b.st[0] = nloc; b.st[1] = nx; }
        const unsigned old = xb_add(&bar[XB_XSUB(b.x)], 1u);
        const unsigned gen = old / nloc;
        if (old + 1u == (gen + 1u) * nloc) {
            __builtin_amdgcn_fence(__ATOMIC_RELEASE, "agent");
            asm volatile("s_waitcnt vmcnt(0)" ::: "memory");
            const unsigned og = xb_add(&bar[XB_TOP], 1u);
            const unsigned tg = og / nx;
            if (og + 1u == (tg + 1u) * nx) xb_add(&bar[XB_TOPGEN], 1u);
            else XB_SPIN(xb_ld(&bar[XB_TOPGEN]) == tg, bar);
            __builtin_amdgcn_fence(__ATOMIC_ACQUIRE, "agent");
            xb_add(&bar[XB_XGEN(b.x)], 1u);
            asm volatile("s_waitcnt vmcnt(0)" ::: "memory");
        } else {
            XB_SPIN(xb_ld(&bar[XB_XGEN(b.x)]) == gen, bar);
            __builtin_amdgcn_fence(__ATOMIC_ACQUIRE, "agent");
            asm volatile("s_waitcnt vmcnt(0)" ::: "memory");
        }
    }
    __syncthreads();
}

struct Args { const float* in[29]; float* out; unsigned char* ws; int ph_lo, ph_hi; };
typedef const float* const __attribute__((address_space(4))) * kargp_t;
DI const float* inp(int i) { kargp_t p = (kargp_t)__builtin_amdgcn_kernarg_segment_ptr(); asm volatile("" : "+s"(p)); return (const float*)(const GAS float*)(unsigned long long)p[i]; }
struct Ctx {
    float* out; unsigned char* ws;
    unsigned char* lds;
    int tid, lane, wave, G, bid;
};
DI Ctx fresh(const Ctx& C0) { Ctx C = C0; int t = C0.tid; asm volatile("" : "+v"(t)); C.tid = t; C.lane = t & 63; C.wave = __builtin_amdgcn_readfirstlane(t >> 6); return C; }
enum { I_XP = 0, I_XS, I_SDN, I_SDNC, I_SLRU, I_SLRUC, I_SRET, I_META, I_NF1, I_WF1I, I_WF1O, I_NMIX, I_WIN, I_DNCW, I_ALOG, I_DTB, I_DNNW, I_LCW, I_LCB, I_LWA, I_LBA, I_LWX, I_LBX, I_LLAM,
       I_WOUT, I_NF2, I_WF2I, I_WF2O, I_NFIN };

template <int MODE> DI int colmap(int n) {
    if (MODE == 0) return n;
    if (MODE == 1) { const int pn = n >> 8, bj = (n >> 7) & 1, j = n & 127; return bj * DFF + 128 * pn + j; }
    return n < 1544 ? n : (n < 1792 ? -1 : n - 248);
}
template <int MODE> DI void convert_item(const float* W, int K, int Nsrc, int Ndst, const float* scale, bf16* WT, float* scr, int item, int lane) {
    const int nblk = Ndst / 32, kb = item / nblk, nb = item % nblk, k0 = 64 * kb, n0 = 32 * nb;
    const int sc = colmap<MODE>(n0 + (lane & 31));
    float wv[32];
#pragma unroll
    for (int i = 0; i < 32; ++i) { const int kk = 2 * i + (lane >> 5); wv[i] = (sc >= 0) ? W[(size_t)(k0 + kk) * Nsrc + sc] : 0.f; }
#pragma unroll
    for (int i = 0; i < 32; ++i) { const int kk = 2 * i + (lane >> 5); float v = wv[i]; if (scale) v *= scale[k0 + kk]; scr[kk * 33 + (lane & 31)] = v; }
    asm volatile("s_waitcnt lgkmcnt(0)" ::: "memory");
    const int c = lane & 7;
#pragma unroll
    for (int j = 0; j < 4; ++j) { const int n = (lane >> 3) + 8 * j; const float* s = scr + (8 * c) * 33 + n;
        u32x4 o; o.x = pk2(s[0 * 33], s[1 * 33]); o.y = pk2(s[2 * 33], s[3 * 33]); o.z = pk2(s[4 * 33], s[5 * 33]); o.w = pk2(s[6 * 33], s[7 * 33]);
        *(u32x4*)(WT + (size_t)(n0 + n) * K + k0 + 8 * c) = o; }
    asm volatile("s_waitcnt lgkmcnt(0)" ::: "memory");
}
DI void convert_set(const Ctx& C, int l, int set, int gw, int nwaves) {
    float* scr = (float*)(C.lds + C.wave * 16384);
    constexpr int I1 = 16 * 176, I2 = 44 * 32, I3 = 16 * 120, I4 = 16 * 32;
    unsigned char* wt = C.ws + WS_WT;
    if (set == 0 || set == 2 || set == 3) {
        const int lo_ = (set == 3) ? I1 : 0, hi_ = (set == 2) ? I1 : I1 + I2 + I3;
        for (int it = lo_ + gw; it < hi_; it += nwaves) { int r = it;
            if (r < I1) { convert_item<1>(inp(I_WF1I) + (size_t)l * DM * 2 * DFF, DM, 2 * DFF, 2 * DFF, inp(I_NF1) + l * DM, (bf16*)(wt + WT_F1I), scr, r, C.lane); continue; } r -= I1;
            if (r < I2) { convert_item<0>(inp(I_WF1O) + (size_t)l * DFF * DM, DFF, DM, DM, nullptr, (bf16*)(wt + WT_F1O), scr, r, C.lane); continue; } r -= I2;
            convert_item<2>(inp(I_WIN) + (size_t)l * DM * 3592, DM, 3592, DIN_PAD, inp(I_NMIX) + l * DM, (bf16*)(wt + WT_WIN), scr, r, C.lane); }
    } else {
        for (int it = gw; it < I1 + I2 + I4; it += nwaves) { int r = it;
            if (r < I1) { convert_item<1>(inp(I_WF2I) + (size_t)l * DM * 2 * DFF, DM, 2 * DFF, 2 * DFF, inp(I_NF2) + l * DM, (bf16*)(wt + WT_F2I), scr, r, C.lane); continue; } r -= I1;
            if (r < I2) { convert_item<0>(inp(I_WF2O) + (size_t)l * DFF * DM, DFF, DM, DM, nullptr, (bf16*)(wt + WT_F2O), scr, r, C.lane); continue; } r -= I2;
            convert_item<0>(inp(I_WOUT) + (size_t)l * DM * DM, DM, DM, DM, nullptr, (bf16*)(wt + WT_WOUT), scr, r, C.lane); }
    }
}
DI void convert_lru_weights(const Ctx& C) {
    const int g = C.bid * NTHREADS + C.tid;
    if (g < 2 * 2 * 4 * 64 * 64) { const int l = g >> 15, mat = (g >> 14) & 1, n = (g >> 12) & 3, e = (g >> 6) & 63, d = g & 63;
        const float v = inp(mat ? I_LWX : I_LWA)[(size_t)((l * 4 + n) * 64 + d) * 64 + e]; ((bf16*)(C.ws + WS_LWT))[g] = (bf16)f2bf(v); }
}
DI void sincos_d(double ang, double& s, double& c) {
    const double TWO_PI = 6.283185307179586476925286766559, HALF_PI = 1.5707963267948966192313216916398;
    double n = __builtin_rint(ang / TWO_PI); double r = ang - n * TWO_PI;
    double k = __builtin_rint(r / HALF_PI); double y = r - k * HALF_PI;
    const double y2 = y * y;
    double sp = 1.0 / 1307674368000.0; sp = sp * y2 - 1.0 / 6227020800.0; sp = sp * y2 + 1.0 / 39916800.0; sp = sp * y2 - 1.0 / 362880.0; sp = sp * y2 + 1.0 / 5040.0; sp = sp * y2 - 1.0 / 120.0; sp = sp * y2 + 1.0 / 6.0;
    const double sy = y - y * y2 * sp;
    double cp = 1.0 / 20922789888000.0; cp = cp * y2 - 1.0 / 87178291200.0; cp = cp * y2 + 1.0 / 479001600.0; cp = cp * y2 - 1.0 / 3628800.0; cp = cp * y2 + 1.0 / 40320.0; cp = cp * y2 - 1.0 / 720.0; cp = cp * y2 + 1.0 / 24.0;
    const double cy = 1.0 - 0.5 * y2 + y2 * y2 * cp;
    const int q = ((int)k) & 3;
    s = (q == 0) ? sy : (q == 1) ? cy : (q == 2) ? -sy : -cy;
    c = (q == 0) ? cy : (q == 1) ? -sy : (q == 2) ? -cy : sy;
}
DI void p0_rows(const Ctx& C) {
    const int gw = C.bid * NWAVES + C.wave, NGW = C.G * NWAVES;
    unsigned long long* ss0 = (unsigned long long*)(C.ws + WS_SS); bf16* XB = (bf16*)(C.ws + WS_XB); float* XE = (float*)(C.ws + WS_XE);
    for (int row = gw; row < NROWS; row += NGW) {
        const float* src = row < NPROMPT ? inp(I_XP) + (size_t)row * DM : (row < SROW0 ? inp(I_META) + (size_t)((row - NPROMPT) & 15) * DM : inp(I_XS) + (size_t)(row - SROW0) * DM);
        f32x4 v[4]; float s = 0.f;
#pragma unroll
        for (int j = 0; j < 4; ++j) { v[j] = *(const f32x4*)(src + 4 * C.lane + 256 * j); s += (v[j].x * v[j].x + v[j].y * v[j].y) + (v[j].z * v[j].z + v[j].w * v[j].w); }
        s = wave_sum(s, C.lane);
        if (C.lane == 0) ss0[row] = (unsigned long long)(s * 1048576.0f + 0.5f);
#pragma unroll
        for (int j = 0; j < 4; ++j) { u32x2 w; w.x = pk2(v[j].x, v[j].y); w.y = pk2(v[j].z, v[j].w); *(u32x2*)(XB + (size_t)row * DM + 4 * C.lane + 256 * j) = w;
            if (row >= NPROMPT) *(f32x4*)(XE + (size_t)(row - NPROMPT) * DM + 4 * C.lane + 256 * j) = v[j]; }
    }
    float* rope = (float*)(C.ws + WS_ROPE);
    for (int e = C.bid * NTHREADS + C.tid; e < 2065 * 32; e += C.G * NTHREADS) {
        const int p = e >> 5, i = e & 31; double inv = 1.0; for (int k = 0; k < i; ++k) inv *= 0.7498942093324558;
        const double pos = (p == 2064) ? 16384.0 : (double)p; double s, c; sincos_d(pos * inv, s, c);
        rope[2 * e] = (float)c; rope[2 * e + 1] = (float)s;
    }
}
DI void final_norm(const Ctx& C) {
    const int gw = C.bid * NWAVES + C.wave, NGW = C.G * NWAVES;
    const unsigned long long* ss = (const unsigned long long*)(C.ws + WS_SS) + 6 * NROWS; const float* XE = (const float*)(C.ws + WS_XE); const float* nw = inp(I_NFIN);
    f32x4 w[4];
#pragma unroll
    for (int j = 0; j < 4; ++j) w[j] = *(const f32x4*)(nw + 4 * C.lane + 256 * j);
    for (int it = gw; it < NPROMPT + NSAMP; it += NGW) {
        const int row = it < NPROMPT ? it : SROW0 + (it - NPROMPT);
        const float* src = it < NPROMPT ? C.out + O_YP + (size_t)row * DM : XE + (size_t)(row - NPROMPT) * DM;
        float* dst = it < NPROMPT ? C.out + O_YP + (size_t)row * DM : C.out + O_YS + (size_t)(it - NPROMPT) * DM;
        const float rs = 1.0f / sqrtf((float)ss[row] * (1.0f / (1024.0f * 1048576.0f)) + EPS);
#pragma unroll
        for (int j = 0; j < 4; ++j) { const f32x4 v = *(const f32x4*)(src + 4 * C.lane + 256 * j); *(f32x4*)(dst + 4 * C.lane + 256 * j) = v * rs * w[j]; }
    }
}

DI void fix_rows(const Ctx& C, int nparts, float scale, unsigned long long* ssn) {
    const int gw = C.bid * NWAVES + C.wave, NGW = C.G * NWAVES;
    const float* slab = (const float*)(C.ws + WS_SLAB); float* XE = (float*)(C.ws + WS_XE); bf16* XB = (bf16*)(C.ws + WS_XB);
    for (int job = gw; job < 256 * 4; job += NGW) {
        const int r = job >> 2, pn = job & 3;
        const float* sp = slab + (size_t)(pn * nparts) * 65536 + (size_t)r * 256 + 4 * C.lane;
        f32x4 a = (f32x4){0.f, 0.f, 0.f, 0.f};
        for (int p = 0; p < nparts; ++p) a = a + *(const f32x4*)(sp + (size_t)p * 65536);
        float* xp = XE + (size_t)r * DM + 256 * pn + 4 * C.lane;
        const f32x4 x = *(const f32x4*)xp + a * scale;
        *(f32x4*)xp = x;
        u32x2 w; w.x = pk2(x.x, x.y); w.y = pk2(x.z, x.w); *(u32x2*)(XB + (size_t)(NPROMPT + r) * DM + 256 * pn + 4 * C.lane) = w;
        const float sq = wave_sum((x.x * x.x + x.y * x.y) + (x.z * x.z + x.w * x.w), C.lane);
        if (C.lane == 0) atomicAdd(ssn + NPROMPT + r, (unsigned long long)(sq * 1048576.0f + 0.5f));
    }
}

DI void final_fix_norm(const Ctx& C, int nparts, float scale) {
    const int gw = C.bid * NWAVES + C.wave, NGW = C.G * NWAVES;
    const unsigned long long* ss = (const unsigned long long*)(C.ws + WS_SS) + 6 * NROWS; const float* nw = inp(I_NFIN);
    const float* slab = (const float*)(C.ws + WS_SLAB); const float* XE = (const float*)(C.ws + WS_XE); const bf16* XB = (const bf16*)(C.ws + WS_XB);
    f32x4 w[4];
#pragma unroll
    for (int j = 0; j < 4; ++j) w[j] = *(const f32x4*)(nw + 4 * C.lane + 256 * j);
    for (int it = gw; it < NPROMPT + NSAMP; it += NGW) {
        if (it < NSAMP) {
            const int r = 128 + it; f32x4 x[4]; float sq = 0.f;
#pragma unroll
            for (int pn = 0; pn < 4; ++pn) { const float* sp = slab + (size_t)(pn * nparts) * 65536 + (size_t)r * 256 + 4 * C.lane; f32x4 a = (f32x4){0.f, 0.f, 0.f, 0.f};
                for (int p = 0; p < nparts; ++p) a = a + *(const f32x4*)(sp + (size_t)p * 65536);
                x[pn] = *(const f32x4*)(XE + (size_t)r * DM + 256 * pn + 4 * C.lane) + a * scale; sq += (x[pn].x * x[pn].x + x[pn].y * x[pn].y) + (x[pn].z * x[pn].z + x[pn].w * x[pn].w); }
            const float rs = 1.0f / sqrtf(wave_sum(sq, C.lane) * (1.0f / 1024.0f) + EPS);
#pragma unroll
            for (int pn = 0; pn < 4; ++pn) *(f32x4*)(C.out + O_YS + (size_t)it * DM + 256 * pn + 4 * C.lane) = x[pn] * rs * w[pn];
        } else { const int row = it - NSAMP;
            const float rs = 1.0f / sqrtf((float)ss[row] * (1.0f / (1024.0f * 1048576.0f)) + EPS);
#pragma unroll
            for (int j = 0; j < 4; ++j) { const f32x4 v = ld4bf(XB + (size_t)row * DM + 4 * C.lane + 256 * j); *(f32x4*)(C.out + O_YP + (size_t)row * DM + 4 * C.lane + 256 * j) = v * rs * w[j]; } }
    }
}
DI int chunk_row0(int b, int c) { return c == 0 ? NPROMPT + 16 * b : b * 2048 + 64 * (c - 1); }
DI int halo_row(int b, int c, int back) { return c == 0 ? -1 : (c == 1 ? NPROMPT + 16 * b + 16 - back : b * 2048 + 64 * (c - 1) - back); }

constexpr int N1_R = 0, N1_QB = 52736, N1_KB = 70144, N1_RT = 87552, N1_SM = 124416, N1_CW = 126464, N1_AB = 0, N1_AD = 9216, N1_TD = 14336, N1_WS = 18432;
#define MFMA16(a, b, c) __builtin_amdgcn_mfma_f32_16x16x32_bf16((a), (b), (c), 0, 0, 0)
DI void m1_dn_item(const Ctx& C, int l, int b, int c, int h) {
    const int tid = C.tid, lane = C.lane, wid = C.wave;
    bf16* R = (bf16*)(C.lds + N1_R); bf16* QB = (bf16*)(C.lds + N1_QB); bf16* KB = (bf16*)(C.lds + N1_KB); bf16* RT = (bf16*)(C.lds + N1_RT);
    float* sm = (float*)(C.lds + N1_SM); float* CW = (float*)(C.lds + N1_CW);
    bf16* AB = (bf16*)(C.lds + N1_AB); float* AD = (float*)(C.lds + N1_AD); bf16* TD = (bf16*)(C.lds + N1_TD); bf16* WS = (bf16*)(C.lds + N1_WS);
    const bf16* PA = (const bf16*)(C.ws + WS_PA);
    const int L = (c == 0) ? 16 : 64, row0 = chunk_row0(b, c), item = (b * NCHUNK + c) * 4 + h;
    unsigned char* dni = C.ws + WS_DNI + (size_t)item * DNI_ITEM;
    { u32x4 rv[7];
#pragma unroll
      for (int k = 0; k < 7; ++k) { const int p = tid + 512 * k; rv[k] = (u32x4){0u, 0u, 0u, 0u};
          if (p < 67 * 48) { const int ri = p / 48, pc = p % 48, t = ri - 3; int row = -1;
              if (t < 0) row = halo_row(b, c, -t); else if (t < L) row = row0 + t;
              if (row >= 0) rv[k] = *(const u32x4*)(PA + (size_t)row * PA_LD + (pc >> 4) * 512 + h * 128 + 8 * (pc & 15)); } }
      f32x4 cwv = (f32x4){0.f, 0.f, 0.f, 0.f};
      if (tid < 384) { const int tap = tid / 96, q4 = tid % 96; cwv = *(const f32x4*)(inp(I_DNCW) + (size_t)l * 4 * 1536 + tap * 1536 + (q4 >> 5) * 512 + h * 128 + 4 * (q4 & 31)); }
      if (wid == 7) {
          const int t = lane; float g = 0.f, be = 0.f;
          if (t < L) { const bf16* pr = PA + (size_t)(row0 + t) * PA_LD + 1536 + h; const float a = bf1(pr[0]), bb = bf1(pr[4]);
              g = -__expf(inp(I_ALOG)[l * 4 + h]) * softplus(a + inp(I_DTB)[l * 4 + h]); be = sigm(bb); }
          float G = g;
#pragma unroll
          for (int o = 1; o < 64; o <<= 1) { const float v = xshfl(G, (lane - o) & 63); if (lane >= o) G += v; }
          const float GC = xshfl(G, 63);
          sm[t] = G; sm[64 + t] = be; sm[128 + t] = __expf(G); sm[192 + t] = __expf(GC - G);
          if (lane == 0) ((float*)(C.ws + WS_GCA))[item] = __expf(GC);
      }
#pragma unroll
      for (int k = 0; k < 7; ++k) { const int p = tid + 512 * k; if (p < 67 * 48) *(u32x4*)((unsigned char*)R + (p / 48) * 784 + (p % 48) * 16) = rv[k]; }
      if (tid < 384) { const int tap = tid / 96, q4 = tid % 96; *(f32x4*)(CW + tap * 384 + 4 * q4) = cwv; } }
    __syncthreads();
    { const int t = tid >> 3, cg = tid & 7; const bool live = t < L;
#pragma unroll
      for (int part = 0; part < 2; ++part) {
          float y[16];
#pragma unroll
          for (int j = 0; j < 16; ++j) y[j] = 0.f;
          u32x4 x3[2] = {(u32x4){0u, 0u, 0u, 0u}, (u32x4){0u, 0u, 0u, 0u}};
#pragma unroll
          for (int tap = 0; tap < 4; ++tap)
#pragma unroll
              for (int hf = 0; hf < 2; ++hf) { const u32x4 xv = *(const u32x4*)(R + (t + tap) * 392 + part * 128 + 16 * cg + 8 * hf); if (tap == 3) x3[hf] = xv;
                  const f32x4 w0 = *(const f32x4*)(CW + tap * 384 + part * 128 + 16 * cg + 8 * hf), w1 = *(const f32x4*)(CW + tap * 384 + part * 128 + 16 * cg + 8 * hf + 4);
                  y[8 * hf + 0] += w0.x * bflo(xv.x); y[8 * hf + 1] += w0.y * bfhi(xv.x); y[8 * hf + 2] += w0.z * bflo(xv.y); y[8 * hf + 3] += w0.w * bfhi(xv.y);
                  y[8 * hf + 4] += w1.x * bflo(xv.z); y[8 * hf + 5] += w1.y * bfhi(xv.z); y[8 * hf + 6] += w1.z * bflo(xv.w); y[8 * hf + 7] += w1.w * bfhi(xv.w); }
          float ss = 0.f;
#pragma unroll
          for (int j = 0; j < 16; ++j) { y[j] = live ? silu(y[j]) : 0.f; ss += y[j] * y[j]; }
          ss += xshfl(ss, lane ^ 1); ss += xshfl(ss, lane ^ 2); ss += xshfl(ss, lane ^ 4);
          const float sc = __builtin_amdgcn_rsqf(ss + EPS) * (part == 0 ? 0.08838834764831845f : 1.0f);
          bf16* dst = (part == 0 ? QB : KB) + t * 136 + 16 * cg;
          *(u32x4*)(dst) = (u32x4){pk2(y[0] * sc, y[1] * sc), pk2(y[2] * sc, y[3] * sc), pk2(y[4] * sc, y[5] * sc), pk2(y[6] * sc, y[7] * sc)};
          *(u32x4*)(dst + 8) = (u32x4){pk2(y[8] * sc, y[9] * sc), pk2(y[10] * sc, y[11] * sc), pk2(y[12] * sc, y[13] * sc), pk2(y[14] * sc, y[15] * sc)};
          if (part == 0) { const float sq = sc * sm[128 + t]; bf16* qo = (bf16*)(dni + DNI_QG) + t * 128 + 16 * cg;
              *(u32x4*)(qo) = (u32x4){pk2(y[0] * sq, y[1] * sq), pk2(y[2] * sq, y[3] * sq), pk2(y[4] * sq, y[5] * sq), pk2(y[6] * sq, y[7] * sq)};
              *(u32x4*)(qo + 8) = (u32x4){pk2(y[8] * sq, y[9] * sq), pk2(y[10] * sq, y[11] * sq), pk2(y[12] * sq, y[13] * sq), pk2(y[14] * sq, y[15] * sq)}; }
          else if (cg == 0) sm[256 + t] = sc;
          if (c == NCHUNK - 1 && t >= 61) { float* co = C.out + O_DNCP + ((size_t)(l * NB + b) * 3 + (t - 61)) * 1536 + part * 512 + h * 128 + 16 * cg;
#pragma unroll
              for (int hf = 0; hf < 2; ++hf) { *(f32x4*)(co + 8 * hf) = (f32x4){bflo(x3[hf].x), bfhi(x3[hf].x), bflo(x3[hf].y), bfhi(x3[hf].y)}; *(f32x4*)(co + 8 * hf + 4) = (f32x4){bflo(x3[hf].z), bfhi(x3[hf].z), bflo(x3[hf].w), bfhi(x3[hf].w)}; } }
      } }
    { const int t = tid >> 3, cg = tid & 7;
      if (t < L) { bf16* zp = (bf16*)(C.ws + WS_PB) + (size_t)(row0 + t) * PB_LD + h * 128 + 16 * cg; const float* nw = inp(I_DNNW) + l * 128 + 16 * cg;
          const u32x4 z0 = *(const u32x4*)(zp), z1 = *(const u32x4*)(zp + 8); const unsigned zw[8] = {z0.x, z0.y, z0.z, z0.w, z1.x, z1.y, z1.z, z1.w}; unsigned gw[8];
#pragma unroll
          for (int i = 0; i < 4; ++i) { const f32x4 g = *(const f32x4*)(nw + 4 * i);
              gw[2 * i] = pk2(g.x * silu(bflo(zw[2 * i])), g.y * silu(bfhi(zw[2 * i]))); gw[2 * i + 1] = pk2(g.z * silu(bflo(zw[2 * i + 1])), g.w * silu(bfhi(zw[2 * i + 1]))); }
          *(u32x4*)(zp) = (u32x4){gw[0], gw[1], gw[2], gw[3]}; *(u32x4*)(zp + 8) = (u32x4){gw[4], gw[5], gw[6], gw[7]}; } }
    __syncthreads();
    if (wid < 4) {
        const int part = 1 + (tid >> 7), rr = tid & 127, cq = rr & 31, tq = rr >> 5, t0 = 16 * tq;
        const float* cw = inp(I_DNCW) + (size_t)l * 4 * 1536 + part * 512 + h * 128 + 4 * cq;
        const f32x4 w0 = *(const f32x4*)(cw), w1 = *(const f32x4*)(cw + 1536), w2 = *(const f32x4*)(cw + 2 * 1536), w3 = *(const f32x4*)(cw + 3 * 1536);
        const bf16* rp = R + part * 128 + 4 * cq;
        f32x4 x0 = ld4bf(rp + (t0 + 0) * 392), x1 = ld4bf(rp + (t0 + 1) * 392), x2 = ld4bf(rp + (t0 + 2) * 392);
        unsigned rtw[4][8], kdw[4][8];
#pragma unroll
        for (int i2 = 0; i2 < 8; ++i2) {
            f32x4 rta[2], kda[2];
#pragma unroll
            for (int u = 0; u < 2; ++u) { const int t = t0 + 2 * i2 + u; const f32x4 x3 = ld4bf(rp + (t + 3) * 392);
                f32x4 y = w0 * x0 + w1 * x1 + w2 * x2 + w3 * x3; x0 = x1; x1 = x2; x2 = x3;
                y = (t < L) ? (f32x4){silu(y.x), silu(y.y), silu(y.z), silu(y.w)} : (f32x4){0.f, 0.f, 0.f, 0.f};
                if (c == NCHUNK - 1 && part == 2 && t >= 61) *(f32x4*)(C.out + O_DNCP + ((size_t)(l * NB + b) * 3 + (t - 61)) * 1536 + 1024 + h * 128 + 4 * cq) = x3;
                if (part == 1) { const f32x4 n = y * sm[256 + t]; rta[u] = n * (sm[64 + t] * sm[128 + t]); kda[u] = n * sm[192 + t]; }
                else { rta[u] = y * sm[64 + t]; kda[u] = rta[u]; } }
#pragma unroll
            for (int jj = 0; jj < 4; ++jj) { rtw[jj][i2] = pk2(rta[0][jj], rta[1][jj]); kdw[jj][i2] = pk2(kda[0][jj], kda[1][jj]); }
        }
        const int colb = (part == 1 ? 128 : 0) + 4 * cq;
#pragma unroll
        for (int jj = 0; jj < 4; ++jj) { bf16* d = RT + (colb + jj) * 72 + t0;
            *(u32x4*)(d) = (u32x4){rtw[jj][0], rtw[jj][1], rtw[jj][2], rtw[jj][3]}; *(u32x4*)(d + 8) = (u32x4){rtw[jj][4], rtw[jj][5], rtw[jj][6], rtw[jj][7]};
            if (part == 1) { bf16* ko = (bf16*)(dni + DNI_KDT) + (4 * cq + jj) * 64 + t0;
                *(u32x4*)(ko) = (u32x4){kdw[jj][0], kdw[jj][1], kdw[jj][2], kdw[jj][3]}; *(u32x4*)(ko + 8) = (u32x4){kdw[jj][4], kdw[jj][5], kdw[jj][6], kdw[jj][7]}; } }
    }
    __syncthreads();
    { const int kind = wid >> 2, ti = (wid >> 1) & 1, tj = wid & 1, r = lane & 31, hh = lane >> 5;
      const bf16* Aop = KB + (32 * ti + r) * 136 + 8 * hh; const bf16* Bop = (kind ? QB : KB) + (32 * tj + r) * 136 + 8 * hh;
      f32x16 acc;
#pragma unroll
      for (int i = 0; i < 16; ++i) acc[i] = 0.f;
#pragma unroll
      for (int ks = 0; ks < 8; ++ks) { const bf16x8 a = *(const bf16x8*)(Aop + 16 * ks), bq = *(const bf16x8*)(Bop + 16 * ks); acc = MFMA32(a, bq, acc); }
      const int t = 32 * tj + r; const float Gt = sm[t], bet = sm[64 + t];
#pragma unroll
      for (int g4 = 0; g4 < 4; ++g4) { const int i0 = 32 * ti + 8 * g4 + 4 * hh; float o[4];
#pragma unroll
          for (int e = 0; e < 4; ++e) { const int i = i0 + e; const float dec = __expf(Gt - sm[i]); const float v = acc[4 * g4 + e] * dec;
              o[e] = kind ? (t >= i ? v : 0.f) : (t > i ? bet * v : 0.f); }
          if (kind == 0) { const bool diag = (i0 >> 4) == (t >> 4);
              u32x2 w; w.x = diag ? 0u : pk2(-o[0], -o[1]); w.y = diag ? 0u : pk2(-o[2], -o[3]); *(u32x2*)(AB + t * 72 + i0) = w;
              if (diag) *(f32x4*)(AD + ((t >> 4) * 16 + (t & 15)) * 20 + (i0 & 15)) = (f32x4){o[0], o[1], o[2], o[3]}; }
          else { u32x2 w; w.x = pk2(o[0], o[1]); w.y = pk2(o[2], o[3]); *(u32x2*)((bf16*)(dni + DNI_P) + t * 64 + i0) = w; } } }
    __syncthreads();
    if (wid == 0) { const int blk = lane >> 4, j = lane & 15; float x[16];
#pragma unroll
        for (int t = 0; t < 16; ++t) x[t] = 0.f;
#pragma unroll
        for (int t = 0; t < 16; ++t) { float s = (t == j) ? 1.0f : 0.f;
#pragma unroll
            for (int s4 = 0; s4 < (t + 3) / 4; ++s4) { const f32x4 a = *(const f32x4*)(AD + (blk * 16 + t) * 20 + 4 * s4);
                s -= a.x * x[4 * s4]; s -= a.y * x[4 * s4 + 1]; s -= a.z * x[4 * s4 + 2]; s -= a.w * x[4 * s4 + 3]; }
            x[t] = s; }
#pragma unroll
        for (int t = 0; t < 16; ++t) { TD[(blk * 16 + t) * 32 + j] = (bf16)f2bf(x[t] - ((t == j) ? 1.0f : 0.f)); TD[(blk * 16 + t) * 32 + 16 + j] = (bf16)0; } }
    __syncthreads();
    { const int cl = lane & 15, kq = lane >> 4, c0 = 32 * wid;
#pragma unroll
      for (int i = 0; i < 4; ++i) {
          f32x4 acc[2];
#pragma unroll
          for (int nf = 0; nf < 2; ++nf) acc[nf] = ld4bf(RT + (c0 + 16 * nf + cl) * 72 + 16 * i + 4 * kq);
          if (i >= 1) {
#pragma unroll
              for (int ks = 0; ks < (i == 3 ? 2 : 1); ++ks) { const bf16x8 a = *(const bf16x8*)(AB + (16 * i + cl) * 72 + 32 * ks + 8 * kq);
#pragma unroll
                  for (int nf = 0; nf < 2; ++nf) { const bf16x8 bb = *(const bf16x8*)(RT + (c0 + 16 * nf + cl) * 72 + 32 * ks + 8 * kq); acc[nf] = MFMA16(a, bb, acc[nf]); } } }
#pragma unroll
          for (int nf = 0; nf < 2; ++nf) { u32x2 w; w.x = pk2(acc[nf].x, acc[nf].y); w.y = pk2(acc[nf].z, acc[nf].w); *(u32x2*)(RT + (c0 + 16 * nf + cl) * 72 + 16 * i + 4 * kq) = w; }
          asm volatile("" ::: "memory");
          const bf16x8 a2 = *(const bf16x8*)(TD + (i * 16 + cl) * 32 + 8 * kq);
#pragma unroll
          for (int nf = 0; nf < 2; ++nf) { bf16x8 b2 = *(const bf16x8*)(RT + (c0 + 16 * nf + cl) * 72 + 16 * i + 8 * (kq & 1));
              if (kq >= 2) b2 = (bf16x8){0, 0, 0, 0, 0, 0, 0, 0};
              acc[nf] = MFMA16(a2, b2, acc[nf]);
              u32x2 w; w.x = pk2(acc[nf].x, acc[nf].y); w.y = pk2(acc[nf].z, acc[nf].w); *(u32x2*)(RT + (c0 + 16 * nf + cl) * 72 + 16 * i + 4 * kq) = w;
              if (wid >= 4) { const int d = c0 - 128 + 16 * nf + cl; bf16* wp = WS + (16 * i + 4 * kq) * 136 + d;
                  wp[0] = (bf16)(w.x & 0xffffu); wp[136] = (bf16)(w.x >> 16); wp[272] = (bf16)(w.y & 0xffffu); wp[408] = (bf16)(w.y >> 16); } }
          asm volatile("" ::: "memory");
      } }
    __syncthreads();
#pragma unroll
    for (int k = 0; k < 2; ++k) { const int p = tid + 512 * k;
        *(u32x4*)(dni + DNI_UVT + 16 * p) = *(const u32x4*)((const unsigned char*)RT + (p >> 3) * 144 + (p & 7) * 16);
        *(u32x4*)(dni + DNI_W + 16 * p) = *(const u32x4*)((const unsigned char*)WS + (p >> 4) * 272 + (p & 15) * 16); }
    __syncthreads();
}

constexpr int L1_XL = 0, L1_WT = 33792, L1_LA = 33792, L1_LB = 70656, L1_XCH = 107520;
DI void m1_lru_item(const Ctx& C, int l, int b, int c) {
    const int tid = C.tid, lane = C.lane, wid = C.wave, r = lane & 31, hh = lane >> 5;
    bf16* XL = (bf16*)(C.lds + L1_XL); bf16* WT = (bf16*)(C.lds + L1_WT); bf16* LA = (bf16*)(C.lds + L1_LA); bf16* LB = (bf16*)(C.lds + L1_LB); float* xch = (float*)(C.lds + L1_XCH);
    const bf16* PB = (const bf16*)(C.ws + WS_PB);
    const int L = (c == 0) ? 16 : 64, row0 = chunk_row0(b, c);
    {
      u32x4 wv[8];
#pragma unroll
      for (int k = 0; k < 8; ++k) wv[k] = *(const u32x4*)(C.ws + WS_LWT + (size_t)l * 65536 + (size_t)(tid + 512 * k) * 16);
      const int cq = tid & 63, tq = tid >> 6, col = 4 * cq, t0 = 8 * tq;
      const float* cw = inp(I_LCW) + (size_t)l * 4 * 256 + col;
      const f32x4 w0 = *(const f32x4*)(cw), w1 = *(const f32x4*)(cw + 256), w2 = *(const f32x4*)(cw + 512), w3 = *(const f32x4*)(cw + 768), bias = *(const f32x4*)(inp(I_LCB) + l * 256 + col);
      f32x4 x0 = (f32x4){0.f, 0.f, 0.f, 0.f}, x1 = x0, x2 = x0;
      if (t0 < L) {
          if (t0 == 0) { const int r3 = halo_row(b, c, 3); if (r3 >= 0) { x0 = ld4bf(PB + (size_t)r3 * PB_LD + 512 + col); x1 = ld4bf(PB + (size_t)(r3 + 1) * PB_LD + 512 + col); x2 = ld4bf(PB + (size_t)(r3 + 2) * PB_LD + 512 + col); } }
          else { x0 = ld4bf(PB + (size_t)(row0 + t0 - 3) * PB_LD + 512 + col); x1 = ld4bf(PB + (size_t)(row0 + t0 - 2) * PB_LD + 512 + col); x2 = ld4bf(PB + (size_t)(row0 + t0 - 1) * PB_LD + 512 + col); }
      }
#pragma unroll
      for (int i = 0; i < 8; ++i) { const int t = t0 + i; f32x4 y = (f32x4){0.f, 0.f, 0.f, 0.f};
          if (t < L) { const f32x4 x3 = ld4bf(PB + (size_t)(row0 + t) * PB_LD + 512 + col); y = w0 * x0 + w1 * x1 + w2 * x2 + w3 * x3 + bias;
              if (c == NCHUNK - 1 && t >= 61) *(f32x4*)(C.out + O_LRUCP + ((size_t)(l * NB + b) * 3 + (t - 61)) * 256 + col) = x3;
              x0 = x1; x1 = x2; x2 = x3; }
          u32x2 w; w.x = pk2(y.x, y.y); w.y = pk2(y.z, y.w); *(u32x2*)(XL + t * 264 + col) = w; }
#pragma unroll
      for (int k = 0; k < 8; ++k) { const int p = tid + 512 * k; *(u32x4*)((unsigned char*)WT + (p >> 3) * 144 + (p & 7) * 16) = wv[k]; } }
    __syncthreads();
    const int n = wid >> 1, eh = wid & 1, e = n * 64 + 32 * eh + r;
    f32x16 pa[2], px[2];
#pragma unroll
    for (int th = 0; th < 2; ++th)
#pragma unroll
        for (int i = 0; i < 16; ++i) { pa[th][i] = 0.f; px[th][i] = 0.f; }
#pragma unroll
    for (int ks = 0; ks < 4; ++ks) {
        const bf16x8 ba_ = *(const bf16x8*)(WT + ((0 * 4 + n) * 64 + 32 * eh + r) * 72 + 16 * ks + 8 * hh), bx_ = *(const bf16x8*)(WT + ((1 * 4 + n) * 64 + 32 * eh + r) * 72 + 16 * ks + 8 * hh);
#pragma unroll
        for (int th = 0; th < 2; ++th) { const bf16x8 a = *(const bf16x8*)(XL + (32 * th + r) * 264 + n * 64 + 16 * ks + 8 * hh); pa[th] = MFMA32(a, ba_, pa[th]); px[th] = MFMA32(a, bx_, px[th]); } }
    __syncthreads();
    { const float ba = inp(I_LBA)[l * 256 + e], bx = inp(I_LBX)[l * 256 + e], sp = softplus(-inp(I_LLAM)[l * 256 + e]);
#pragma unroll
      for (int th = 0; th < 2; ++th)
#pragma unroll
          for (int g4 = 0; g4 < 4; ++g4) { float la4[4], bm4[4];
#pragma unroll
              for (int k = 0; k < 4; ++k) { const int t = 32 * th + 8 * g4 + 4 * hh + k; const float xv = bf1(XL[t * 264 + e]);
                  const float rg = sigm(pa[th][4 * g4 + k] + ba), ig = sigm(px[th][4 * g4 + k] + bx), la = -8.0f * rg * sp;
                  la4[k] = (t < L) ? la : 0.f; bm4[k] = (t < L) ? sqrtf(fmaxf(1.0f - __expf(2.0f * la), 0.f)) * (ig * xv) : 0.f; }
              u32x2 w; w.x = pk2(la4[0], la4[1]); w.y = pk2(la4[2], la4[3]); *(u32x2*)(LA + e * 72 + 32 * th + 8 * g4 + 4 * hh) = w;
              w.x = pk2(bm4[0], bm4[1]); w.y = pk2(bm4[2], bm4[3]); *(u32x2*)(LB + e * 72 + 32 * th + 8 * g4 + 4 * hh) = w; } }
    __syncthreads();
    { const int ec = tid & 255, th = tid >> 8; float ar[32], ai[32];
#pragma unroll
      for (int i = 0; i < 4; ++i) { const u32x4 la = *(const u32x4*)(LA + ec * 72 + 32 * th + 8 * i), lb = *(const u32x4*)(LB + ec * 72 + 32 * th + 8 * i);
          const unsigned lw[4] = {la.x, la.y, la.z, la.w}, bw[4] = {lb.x, lb.y, lb.z, lb.w};
#pragma unroll
          for (int k = 0; k < 4; ++k) { ar[8 * i + 2 * k] = __expf(bflo(lw[k])); ar[8 * i + 2 * k + 1] = __expf(bfhi(lw[k])); ai[8 * i + 2 * k] = bflo(bw[k]); ai[8 * i + 2 * k + 1] = bfhi(bw[k]); } }
      { float hl = 0.f, ac = 1.f;
#pragma unroll
        for (int t = 0; t < 32; ++t) { hl = ar[t] * hl + ai[t]; ac *= ar[t]; ai[t] = hl; ar[t] = ac; } }
      if (th == 0) { xch[2 * ec] = ai[31]; xch[2 * ec + 1] = ar[31]; }
      __syncthreads();
      if (th == 1) { const float h0 = xch[2 * ec], a0 = xch[2 * ec + 1];
#pragma unroll
        for (int t = 0; t < 32; ++t) { ai[t] = ar[t] * h0 + ai[t]; ar[t] = ar[t] * a0; }
        ((float*)(C.ws + WS_CA))[(size_t)(b * NCHUNK + c) * 256 + ec] = ar[31]; ((float*)(C.ws + WS_CB))[(size_t)(b * NCHUNK + c) * 256 + ec] = ai[31]; }
      bf16* AC = (bf16*)(C.ws + WS_LA); bf16* HL = (bf16*)(C.ws + WS_LB);
#pragma unroll
      for (int t = 0; t < 32; ++t) { const int tt = 32 * th + t;
          if (tt < L) { AC[(size_t)(row0 + tt) * 256 + ec] = (bf16)f2bf(ar[t]); HL[(size_t)(row0 + tt) * 256 + ec] = (bf16)f2bf(ai[t]); } } }
    __syncthreads();
}
DI void m1_phase(const Ctx& C0, int l) {
    constexpr int NDN = NB * NCHUNK * 4, NLRU = NB * NCHUNK;
#ifndef M1_SUB
#define M1_SUB 3
#endif
    for (int it = C0.bid; it < NDN + NLRU; it += C0.G) {
        const Ctx C = fresh(C0);
#ifndef M1_DUP
#define M1_DUP 0
#endif
        if (it < NDN) { if (M1_SUB & 1) { const int h = it & 3, bc = it >> 2; for (int rep = 0; rep < ((M1_DUP & 1) ? 2 : 1); ++rep) { const Ctx Cr = fresh(C0); m1_dn_item(Cr, l, bc / NCHUNK, bc % NCHUNK, h); } } }
        else if (M1_SUB & 2) { const int bc = it - NDN; for (int rep = 0; rep < ((M1_DUP & 2) ? 2 : 1); ++rep) { const Ctx Cr = fresh(C0); m1_lru_item(Cr, l, bc / NCHUNK, bc % NCHUNK); } }
    }
}
constexpr int M2_WL = 0, M2_QL = 17408, M2_PL = 34816, M2_KL = 44032, M2_UT = 62464, M2_ST = 80896, M2_OS = 115712;
DI void m2_dn(const Ctx& C, int l, int b, int h) {
    const int tid = C.tid, lane = C.lane, wid = C.wave, tm = wid >> 2, tn = wid & 3, r = lane & 31, hh = lane >> 5;
    bf16* WL = (bf16*)(C.lds + M2_WL); bf16* QL = (bf16*)(C.lds + M2_QL); bf16* PL = (bf16*)(C.lds + M2_PL); bf16* KL = (bf16*)(C.lds + M2_KL);
    bf16* UT = (bf16*)(C.lds + M2_UT); bf16* ST = (bf16*)(C.lds + M2_ST); float* OS = (float*)(C.lds + M2_OS);
    const bf16* PB = (const bf16*)(C.ws + WS_PB); bf16* O = (bf16*)(C.ws + WS_O); const float* GCA = (const float*)(C.ws + WS_GCA);
    f32x16 S0, S1;
#pragma unroll
    for (int i = 0; i < 16; ++i) { S0[i] = 0.f; S1[i] = 0.f; }
    for (int i = tid; i < 128 * 136 / 2; i += NTHREADS) ((unsigned*)ST)[i] = 0u;
    u32x4 pre[7];
    const unsigned char* dni0 = C.ws + WS_DNI + (size_t)((b * NCHUNK) * 4 + h) * DNI_ITEM;
#define M2_LOAD(dn) do { \
        pre[0] = *(const u32x4*)((dn) + DNI_W + 16 * tid); pre[1] = *(const u32x4*)((dn) + DNI_W + 16 * (tid + 512)); \
        pre[2] = *(const u32x4*)((dn) + DNI_QG + 16 * tid); pre[3] = *(const u32x4*)((dn) + DNI_QG + 16 * (tid + 512)); \
        pre[4] = *(const u32x4*)((dn) + DNI_P + 16 * tid); \
        pre[5] = *(const u32x4*)((dn) + DNI_KDT + 16 * tid); pre[6] = *(const u32x4*)((dn) + DNI_KDT + 16 * (tid + 512)); } while (0)
#define M2_STORE() do { \
        { const int p = tid; *(u32x4*)((unsigned char*)WL + (p >> 4) * 272 + (p & 15) * 16) = pre[0]; *(u32x4*)((unsigned char*)QL + (p >> 4) * 272 + (p & 15) * 16) = pre[2]; \
          *(u32x4*)((unsigned char*)PL + (p >> 3) * 144 + (p & 7) * 16) = pre[4]; *(u32x4*)((unsigned char*)KL + (p >> 3) * 144 + (p & 7) * 16) = pre[5]; } \
        { const int p = tid + 512; *(u32x4*)((unsigned char*)WL + (p >> 4) * 272 + (p & 15) * 16) = pre[1]; *(u32x4*)((unsigned char*)QL + (p >> 4) * 272 + (p & 15) * 16) = pre[3]; \
          *(u32x4*)((unsigned char*)KL + (p >> 3) * 144 + (p & 7) * 16) = pre[6]; } } while (0)
    M2_LOAD(dni0);
    M2_STORE();
    const int nt_ = tid >> 3, nsg = tid & 7;
    u32x2 uv[4], uvn[4]; u32x4 zz[2], zzn[2]; float egc, egcn;
#define M2_LOAD2(cc, UV, ZZ, EG) do { const unsigned char* dn_ = C.ws + WS_DNI + (size_t)((b * NCHUNK + (cc)) * 4 + h) * DNI_ITEM; \
        const bf16* uvt_ = (const bf16*)(dn_ + DNI_UVT) + (32 * tn + r) * 64 + 32 * tm + 4 * hh; \
        _Pragma("unroll") for (int g4 = 0; g4 < 4; ++g4) UV[g4] = *(const u32x2*)(uvt_ + 8 * g4); \
        EG = GCA[(b * NCHUNK + (cc)) * 4 + h]; \
        const int vr_ = ((cc) > 0 || nt_ < 16) ? chunk_row0(b, (cc)) + nt_ : chunk_row0(b, (cc)); \
        const bf16* zp_ = PB + (size_t)vr_ * PB_LD + h * 128 + 16 * nsg; ZZ[0] = *(const u32x4*)(zp_); ZZ[1] = *(const u32x4*)(zp_ + 8); } while (0)
    M2_LOAD2(0, uv, zz, egc);
    asm volatile("" :: "v"(uv[0]), "v"(uv[1]), "v"(uv[2]), "v"(uv[3]), "v"(zz[0]), "v"(zz[1]), "v"(egc));
    __syncthreads();
    u32x4 zzp[2] = {zz[0], zz[1]};
#define M2_NORM(cc) do { const int t = tid >> 3, sg = tid & 7; f32x4 v[4]; float s = 0.f; \
        _Pragma("unroll") for (int i = 0; i < 4; ++i) { v[i] = *(const f32x4*)(OS + t * 132 + 16 * sg + 4 * i); s += (v[i].x * v[i].x + v[i].y * v[i].y) + (v[i].z * v[i].z + v[i].w * v[i].w); } \
        s += xshfl(s, lane ^ 1); s += xshfl(s, lane ^ 2); s += xshfl(s, lane ^ 4); \
        const float rs = __builtin_amdgcn_rsqf(s * (1.0f / 128.0f) + EPS); \
        if ((cc) > 0 || t < 16) { const int row = chunk_row0(b, (cc)) + t; unsigned w[8]; \
            const unsigned zw[8] = {zzp[0].x, zzp[0].y, zzp[0].z, zzp[0].w, zzp[1].x, zzp[1].y, zzp[1].z, zzp[1].w}; \
            _Pragma("unroll") for (int i = 0; i < 4; ++i) { const f32x4 z = (f32x4){bflo(zw[2 * i]), bfhi(zw[2 * i]), bflo(zw[2 * i + 1]), bfhi(zw[2 * i + 1])};     \
                w[2 * i] = pk2(v[i].x * rs * z.x, v[i].y * rs * z.y); w[2 * i + 1] = pk2(v[i].z * rs * z.z, v[i].w * rs * z.w); } \
            bf16* op = O + (size_t)row * DM + h * 128 + 16 * sg; \
            *(u32x4*)(op) = (u32x4){w[0], w[1], w[2], w[3]}; *(u32x4*)(op + 8) = (u32x4){w[4], w[5], w[6], w[7]}; } } while (0)
    for (int c = 0; c < NCHUNK; ++c) {
        const int item = (b * NCHUNK + c) * 4 + h;
        const unsigned char* dni = C.ws + WS_DNI + (size_t)item * DNI_ITEM;
        if (c + 1 < NCHUNK) { M2_LOAD(dni + 4 * DNI_ITEM); M2_LOAD2(c + 1, uvn, zzn, egcn); }
        f32x16 ws, qs;
#pragma unroll
        for (int i = 0; i < 16; ++i) { ws[i] = 0.f; qs[i] = 0.f; }
#pragma unroll
        for (int ks = 0; ks < 4; ++ks) {
            const bf16x8 bfr = *(const bf16x8*)(ST + (32 * tn + r) * 136 + 16 * ks + 8 * hh);
            const bf16x8 aw = *(const bf16x8*)(WL + (32 * tm + r) * 136 + 16 * ks + 8 * hh), aq = *(const bf16x8*)(QL + (32 * tm + r) * 136 + 16 * ks + 8 * hh);
            ws = MFMA32(aw, bfr, ws); qs = MFMA32(aq, bfr, qs); }
        if (c > 0) M2_NORM(c - 1);
#pragma unroll
        for (int ks = 4; ks < 8; ++ks) {
            const bf16x8 bfr = *(const bf16x8*)(ST + (32 * tn + r) * 136 + 16 * ks + 8 * hh);
            const bf16x8 aw = *(const bf16x8*)(WL + (32 * tm + r) * 136 + 16 * ks + 8 * hh), aq = *(const bf16x8*)(QL + (32 * tm + r) * 136 + 16 * ks + 8 * hh);
            ws = MFMA32(aw, bfr, ws); qs = MFMA32(aq, bfr, qs); }
        {
#pragma unroll
          for (int g4 = 0; g4 < 4; ++g4) { const f32x4 uf = (f32x4){bflo(uv[g4].x), bfhi(uv[g4].x), bflo(uv[g4].y), bfhi(uv[g4].y)};
              u32x2 w; w.x = pk2(uf.x - ws[4 * g4], uf.y - ws[4 * g4 + 1]); w.y = pk2(uf.z - ws[4 * g4 + 2], uf.w - ws[4 * g4 + 3]);
              *(u32x2*)(UT + (32 * tn + r) * 72 + 32 * tm + 8 * g4 + 4 * hh) = w; } }
        __syncthreads();
        { S0 = S0 * egc; S1 = S1 * egc;
#pragma unroll
          for (int ks = 0; ks < 4; ++ks) {
              const bf16x8 bfr = *(const bf16x8*)(UT + (32 * tn + r) * 72 + 16 * ks + 8 * hh);
              const bf16x8 ap = *(const bf16x8*)(PL + (32 * tm + r) * 72 + 16 * ks + 8 * hh);
              const bf16x8 a0 = *(const bf16x8*)(KL + (64 * tm + r) * 72 + 16 * ks + 8 * hh), a1 = *(const bf16x8*)(KL + (64 * tm + 32 + r) * 72 + 16 * ks + 8 * hh);
              qs = MFMA32(ap, bfr, qs); S0 = MFMA32(a0, bfr, S0); S1 = MFMA32(a1, bfr, S1); } }
        __syncthreads();
#pragma unroll
        for (int g4 = 0; g4 < 4; ++g4) {
            u32x2 w; w.x = pk2(S0[4 * g4], S0[4 * g4 + 1]); w.y = pk2(S0[4 * g4 + 2], S0[4 * g4 + 3]); *(u32x2*)(ST + (32 * tn + r) * 136 + 64 * tm + 8 * g4 + 4 * hh) = w;
            w.x = pk2(S1[4 * g4], S1[4 * g4 + 1]); w.y = pk2(S1[4 * g4 + 2], S1[4 * g4 + 3]); *(u32x2*)(ST + (32 * tn + r) * 136 + 64 * tm + 32 + 8 * g4 + 4 * hh) = w; }
#pragma unroll
        for (int i = 0; i < 16; ++i) OS[(32 * tm + crow(i, hh)) * 132 + 32 * tn + r] = qs[i];
        zzp[0] = zz[0]; zzp[1] = zz[1];
        if (c + 1 < NCHUNK) { M2_STORE();
#pragma unroll
            for (int g4 = 0; g4 < 4; ++g4) uv[g4] = uvn[g4];
            zz[0] = zzn[0]; zz[1] = zzn[1]; egc = egcn; }
        __syncthreads();
    }
    M2_NORM(NCHUNK - 1);
#undef M2_NORM
#undef M2_LOAD
#undef M2_LOAD2
#undef M2_STORE
    { float* so = C.out + O_DNP + ((size_t)((l * NB + b) * 4 + h)) * 16384;
#pragma unroll
      for (int i = 0; i < 16; ++i) { so[(size_t)(64 * tm + crow(i, hh)) * 128 + 32 * tn + r] = S0[i]; so[(size_t)(64 * tm + 32 + crow(i, hh)) * 128 + 32 * tn + r] = S1[i]; } }
}

constexpr int R_QL = 0, R_QG = 9216, R_KL = 18432, R_KDT = 27648, R_VT = 36864, R_ST = 46080, R_PL = 55296, R_OS = 64512, R_GL = 81920;
DI void m2_ret(const Ctx& C, int l, int b, int h) {
    const int tid = C.tid, lane = C.lane, wid = C.wave, r = lane & 31, hh = lane >> 5;
    bf16* QL = (bf16*)(C.lds + R_QL); bf16* QG = (bf16*)(C.lds + R_QG); bf16* KL = (bf16*)(C.lds + R_KL); bf16* KDT = (bf16*)(C.lds + R_KDT); bf16* VT = (bf16*)(C.lds + R_VT);
    bf16* ST = (bf16*)(C.lds + R_ST); bf16* PL = (bf16*)(C.lds + R_PL); float* OS = (float*)(C.lds + R_OS); bf16* GL = (bf16*)(C.lds + R_GL);
    const bf16* PB = (const bf16*)(C.ws + WS_PB); bf16* O = (bf16*)(C.ws + WS_O); const float* rope = (const float*)(C.ws + WS_ROPE);
    const float lg = (h == 0) ? -0.0317486983145803f : (h == 1) ? -0.015748356968139168f : (h == 2) ? -0.007843177461025893f : -0.003913899321136329f;
    f32x16 acc;
#pragma unroll
    for (int i = 0; i < 16; ++i) acc[i] = 0.f;
    for (int i = tid; i < 64 * 72 / 2; i += NTHREADS) ((unsigned*)ST)[i] = 0u;
    __syncthreads();
    u32x2 rq1, rq2, rk1, rk2; u32x4 rv, rg; f32x4 rc0, rc1;
    u32x2 nq1, nq2, nk1, nk2; u32x4 nv, ng; f32x4 nc0, nc1;
#define R_LOAD(cc, Q1, Q2, K1, K2, VV, GV, C0_, C1_) do { const int t_ = tid >> 3, j_ = tid & 7; const int L_ = ((cc) == 0) ? 16 : 64; \
        const bf16* pr_ = PB + (size_t)(chunk_row0(b, (cc)) + (t_ < L_ ? t_ : 0)) * PB_LD; \
        Q1 = *(const u32x2*)(pr_ + 1024 + 64 * h + 4 * j_); Q2 = *(const u32x2*)(pr_ + 1024 + 64 * h + 32 + 4 * j_); K1 = *(const u32x2*)(pr_ + 1280 + 64 * h + 4 * j_); K2 = *(const u32x2*)(pr_ + 1280 + 64 * h + 32 + 4 * j_); \
        VV = *(const u32x4*)(pr_ + 1536 + 64 * h + 8 * j_); GV = *(const u32x4*)(pr_ + 1792 + 64 * h + 8 * j_); \
        const float* rp_ = rope + ((size_t)((((cc) == 0) ? 0 : 16 + 64 * ((cc) - 1)) + t_) * 32 + 4 * j_) * 2; C0_ = *(const f32x4*)(rp_); C1_ = *(const f32x4*)(rp_ + 4); } while (0)
    R_LOAD(0, rq1, rq2, rk1, rk2, rv, rg, rc0, rc1);
    asm volatile("" :: "v"(rq1), "v"(rq2), "v"(rk1), "v"(rk2), "v"(rv), "v"(rg), "v"(rc0), "v"(rc1));
    for (int c = 0; c < NCHUNK; ++c) {
        const int L = (c == 0) ? 16 : 64, row0 = chunk_row0(b, c);
        if (c + 1 < NCHUNK) R_LOAD(c + 1, nq1, nq2, nk1, nk2, nv, ng, nc0, nc1);
        { const int t = tid >> 3, j = tid & 7;
          f32x4 q1 = (f32x4){0.f, 0.f, 0.f, 0.f}, q2 = q1, k1 = q1, k2 = q1; u32x4 vv = (u32x4){0u, 0u, 0u, 0u}, gv = vv;
          if (t < L) { q1 = (f32x4){bflo(rq1.x), bfhi(rq1.x), bflo(rq1.y), bfhi(rq1.y)}; q2 = (f32x4){bflo(rq2.x), bfhi(rq2.x), bflo(rq2.y), bfhi(rq2.y)};
              k1 = (f32x4){bflo(rk1.x), bfhi(rk1.x), bflo(rk1.y), bfhi(rk1.y)}; k2 = (f32x4){bflo(rk2.x), bfhi(rk2.x), bflo(rk2.y), bfhi(rk2.y)}; vv = rv; gv = rg; }
          const f32x4 cs0 = rc0, cs1 = rc1;
          const float cc[4] = {cs0.x, cs0.z, cs1.x, cs1.z}, sn[4] = {cs0.y, cs0.w, cs1.y, cs1.w};
          const float dq = __expf(lg * (float)(t + 1)), dk = (t < L) ? 0.125f * __expf(lg * (float)(L - 1 - t)) : 0.f;
          float qa[4], qb[4], ka[4], kb[4];
#pragma unroll
          for (int e = 0; e < 4; ++e) { qa[e] = q1[e] * cc[e] - q2[e] * sn[e]; qb[e] = q1[e] * sn[e] + q2[e] * cc[e]; ka[e] = k1[e] * cc[e] - k2[e] * sn[e]; kb[e] = k1[e] * sn[e] + k2[e] * cc[e]; }
          u32x2 w;
          w.x = pk2(qa[0], qa[1]); w.y = pk2(qa[2], qa[3]); *(u32x2*)(QL + t * 72 + 4 * j) = w; w.x = pk2(qb[0], qb[1]); w.y = pk2(qb[2], qb[3]); *(u32x2*)(QL + t * 72 + 32 + 4 * j) = w;
          w.x = pk2(qa[0] * dq, qa[1] * dq); w.y = pk2(qa[2] * dq, qa[3] * dq); *(u32x2*)(QG + t * 72 + 4 * j) = w; w.x = pk2(qb[0] * dq, qb[1] * dq); w.y = pk2(qb[2] * dq, qb[3] * dq); *(u32x2*)(QG + t * 72 + 32 + 4 * j) = w;
          w.x = pk2(ka[0] * 0.125f, ka[1] * 0.125f); w.y = pk2(ka[2] * 0.125f, ka[3] * 0.125f); *(u32x2*)(KL + t * 72 + 4 * j) = w;
          w.x = pk2(kb[0] * 0.125f, kb[1] * 0.125f); w.y = pk2(kb[2] * 0.125f, kb[3] * 0.125f); *(u32x2*)(KL + t * 72 + 32 + 4 * j) = w;
#pragma unroll
          for (int e = 0; e < 4; ++e) { KDT[(4 * j + e) * 72 + t] = (bf16)f2bf(ka[e] * dk); KDT[(32 + 4 * j + e) * 72 + t] = (bf16)f2bf(kb[e] * dk); }
          const unsigned vw[4] = {vv.x, vv.y, vv.z, vv.w};
#pragma unroll
          for (int e = 0; e < 4; ++e) { VT[(8 * j + 2 * e) * 72 + t] = (bf16)(vw[e] & 0xffffu); VT[(8 * j + 2 * e + 1) * 72 + t] = (bf16)(vw[e] >> 16); }
          *(u32x4*)(GL + t * 72 + 8 * j) = gv; }
        __syncthreads();
        if (wid < 4) { const int ti = wid >> 1, tj = wid & 1; f32x16 p;
#pragma unroll
            for (int i = 0; i < 16; ++i) p[i] = 0.f;
#pragma unroll
            for (int ks = 0; ks < 4; ++ks) { const bf16x8 a = *(const bf16x8*)(KL + (32 * ti + r) * 72 + 16 * ks + 8 * hh), bq = *(const bf16x8*)(QL + (32 * tj + r) * 72 + 16 * ks + 8 * hh); p = MFMA32(a, bq, p); }
            const int t = 32 * tj + r;
#pragma unroll
            for (int g4 = 0; g4 < 4; ++g4) { const int i0 = 32 * ti + 8 * g4 + 4 * hh; float o[4];
#pragma unroll
                for (int e = 0; e < 4; ++e) { const int i = i0 + e; o[e] = (t >= i) ? p[4 * g4 + e] * __expf(lg * (float)(t - i)) : 0.f; }
                u32x2 w; w.x = pk2(o[0], o[1]); w.y = pk2(o[2], o[3]); *(u32x2*)(PL + t * 72 + i0) = w; }
        } else { const int tm = (wid >> 1) & 1, en = wid & 1;
#pragma unroll
            for (int i = 0; i < 16; ++i) acc[i] = 0.f;
#pragma unroll
            for (int ks = 0; ks < 4; ++ks) { const bf16x8 a = *(const bf16x8*)(QG + (32 * tm + r) * 72 + 16 * ks + 8 * hh), bs = *(const bf16x8*)(ST + (32 * en + r) * 72 + 16 * ks + 8 * hh); acc = MFMA32(a, bs, acc); }
        }
        __syncthreads();
        if (wid < 4) { const int dm = wid >> 1, en = wid & 1; acc = acc * __expf(lg * (float)L);
#pragma unroll
            for (int ks = 0; ks < 4; ++ks) { const bf16x8 a = *(const bf16x8*)(KDT + (32 * dm + r) * 72 + 16 * ks + 8 * hh), bv = *(const bf16x8*)(VT + (32 * en + r) * 72 + 16 * ks + 8 * hh); acc = MFMA32(a, bv, acc); }
        } else { const int tm = (wid >> 1) & 1, en = wid & 1;
#pragma unroll
            for (int ks = 0; ks < 4; ++ks) { const bf16x8 a = *(const bf16x8*)(PL + (32 * tm + r) * 72 + 16 * ks + 8 * hh), bv = *(const bf16x8*)(VT + (32 * en + r) * 72 + 16 * ks + 8 * hh); acc = MFMA32(a, bv, acc); }
        }
        __syncthreads();
        if (wid < 4) { const int dm = wid >> 1, en = wid & 1;
#pragma unroll
            for (int g4 = 0; g4 < 4; ++g4) { u32x2 w; w.x = pk2(acc[4 * g4], acc[4 * g4 + 1]); w.y = pk2(acc[4 * g4 + 2], acc[4 * g4 + 3]); *(u32x2*)(ST + (32 * en + r) * 72 + 32 * dm + 8 * g4 + 4 * hh) = w; }
        } else { const int tm = (wid >> 1) & 1, en = wid & 1;
#pragma unroll
            for (int i = 0; i < 16; ++i) OS[(32 * tm + crow(i, hh)) * 68 + 32 * en + r] = acc[i];
        }
        __syncthreads();
        { const int t = tid >> 3, sg = tid & 7; const f32x4 v0 = *(const f32x4*)(OS + t * 68 + 8 * sg), v1 = *(const f32x4*)(OS + t * 68 + 8 * sg + 4);
          float s = (v0.x + v0.y) + (v0.z + v0.w) + (v1.x + v1.y) + (v1.z + v1.w);
          s += xshfl(s, lane ^ 1); s += xshfl(s, lane ^ 2); s += xshfl(s, lane ^ 4);
          const float mu = s * (1.0f / 64.0f);
          const f32x4 d0 = v0 - mu, d1 = v1 - mu; float q = (d0.x * d0.x + d0.y * d0.y) + (d0.z * d0.z + d0.w * d0.w) + (d1.x * d1.x + d1.y * d1.y) + (d1.z * d1.z + d1.w * d1.w);
          q += xshfl(q, lane ^ 1); q += xshfl(q, lane ^ 2); q += xshfl(q, lane ^ 4);
          const float rs = __builtin_amdgcn_rsqf(q * (1.0f / 64.0f) + EPS);
          if (t < L) { const u32x4 gv = *(const u32x4*)(GL + t * 72 + 8 * sg); u32x4 w;
              w.x = pk2(d0.x * rs * silu(bflo(gv.x)), d0.y * rs * silu(bfhi(gv.x))); w.y = pk2(d0.z * rs * silu(bflo(gv.y)), d0.w * rs * silu(bfhi(gv.y)));
              w.z = pk2(d1.x * rs * silu(bflo(gv.z)), d1.y * rs * silu(bfhi(gv.z))); w.w = pk2(d1.z * rs * silu(bflo(gv.w)), d1.w * rs * silu(bfhi(gv.w)));
              *(u32x4*)(O + (size_t)(row0 + t) * DM + 768 + 64 * h + 8 * sg) = w; } }
        if (c + 1 < NCHUNK) { rq1 = nq1; rq2 = nq2; rk1 = nk1; rk2 = nk2; rv = nv; rg = ng; rc0 = nc0; rc1 = nc1; }
        __syncthreads();
    }
#undef R_LOAD
    if (wid < 4) { const int dm = wid >> 1, en = wid & 1; float* so = C.out + O_RETP + ((size_t)((l * NB + b) * 4 + h)) * 4096;
#pragma unroll
        for (int i = 0; i < 16; ++i) so[(size_t)(32 * dm + crow(i, hh)) * 64 + 32 * en + r] = acc[i]; }
}

DI void m2_lru_item(const Ctx& C, int l, int b, int c) {
    const int e = C.tid & 255, th = C.tid >> 8;
    const bf16* AC = (const bf16*)(C.ws + WS_LA); const bf16* HL = (const bf16*)(C.ws + WS_LB); const bf16* PB = (const bf16*)(C.ws + WS_PB); bf16* O = (bf16*)(C.ws + WS_O);
    const float* CA = (const float*)(C.ws + WS_CA) + (size_t)(b * NCHUNK) * 256 + e; const float* CB = (const float*)(C.ws + WS_CB) + (size_t)(b * NCHUNK) * 256 + e;
    float hin = 0.f;
#pragma unroll 8
    for (int cc = 0; cc < c; ++cc) hin = CA[cc * 256] * hin + CB[cc * 256];
    const int L = (c == 0) ? 16 : 64, row0 = chunk_row0(b, c);
#pragma unroll 8
    for (int t = 0; t < 32; ++t) { const int tt = 32 * th + t;
        if (tt < L) { const size_t row = (size_t)(row0 + tt);
            const float hv = bf1(AC[row * 256 + e]) * hin + bf1(HL[row * 256 + e]);
            O[row * DM + 512 + e] = (bf16)f2bf(hv * gelu_tanh(bf1(PB[row * PB_LD + 768 + e]))); } }
    if (c == NCHUNK - 1 && th == 1) C.out[O_LRUP + (size_t)(l * NB + b) * 256 + e] = CA[c * 256] * hin + CB[c * 256];
}
DI void ms_dn(const Ctx& C, int l, int s, int h) {
    const int tid = C.tid, lane = C.lane, wid = C.wave, row = SROW0 + s;
    float* sh = (float*)C.lds; float* scal = sh + 384; float* Ush = sh + 400; float* osh = sh + 528; float* red = sh + 1024;
    const bf16* PA = (const bf16*)(C.ws + WS_PA); const bf16* PB = (const bf16*)(C.ws + WS_PB); bf16* O = (bf16*)(C.ws + WS_O);
    const int e4 = tid & 31, dg = tid >> 5;
    const float* S0p = inp(I_SDN) + ((size_t)((l * NSAMP + s) * 4 + h) * 128) * 128;
    f32x4 sv[8];
#pragma unroll
    for (int i = 0; i < 8; ++i) sv[i] = *(const f32x4*)(S0p + (size_t)(8 * dg + i) * 128 + 4 * e4);
    const int part = tid >> 7, d_ = tid & 127, col = (part < 3 ? part : 0) * 512 + h * 128 + d_;
    const float* buf = inp(I_SDNC) + ((size_t)(l * NSAMP + s) * 3) * 1536 + col; const float* cw = inp(I_DNCW) + (size_t)l * 4 * 1536 + col;
    const float x0 = buf[0], x1 = buf[1536], x2 = buf[3072], x3 = bf1(PA[(size_t)row * PA_LD + col]), c0 = cw[0], c1 = cw[1536], c2 = cw[3072], c3 = cw[4608];
    const float a_ = bf1(PA[(size_t)row * PA_LD + 1536 + h]), b_ = bf1(PA[(size_t)row * PA_LD + 1540 + h]), alog = inp(I_ALOG)[l * 4 + h], dtb = inp(I_DTB)[l * 4 + h];
    const float z0 = bf1(PB[(size_t)row * PB_LD + h * 128 + lane]), z1 = bf1(PB[(size_t)row * PB_LD + h * 128 + 64 + lane]), nw0 = inp(I_DNNW)[l * 128 + lane], nw1 = inp(I_DNNW)[l * 128 + 64 + lane];
    if (tid < 384) { sh[part * 128 + d_] = silu(c0 * x0 + c1 * x1 + c2 * x2 + c3 * x3);
        float* co = C.out + O_DNCS + ((size_t)(l * NSAMP + s) * 3) * 1536 + col; co[0] = x1; co[1536] = x2; co[3072] = x3; }
    __syncthreads();
    if (wid < 2) { const float v0 = sh[wid * 128 + lane], v1 = sh[wid * 128 + 64 + lane]; const float ss = wave_sum(v0 * v0 + v1 * v1, lane);
        const float sc = __builtin_amdgcn_rsqf(ss + EPS) * (wid == 0 ? 0.08838834764831845f : 1.0f); sh[wid * 128 + lane] = v0 * sc; sh[wid * 128 + 64 + lane] = v1 * sc; }
    __syncthreads();
    if (wid == 0) { const float qk = wave_sum(sh[lane] * sh[128 + lane] + sh[64 + lane] * sh[192 + lane], lane);
        if (lane == 0) { const float g = -__expf(alog) * softplus(a_ + dtb); scal[0] = qk; scal[1] = __expf(g); scal[2] = sigm(b_); } }
    f32x4 kS = (f32x4){0.f, 0.f, 0.f, 0.f}, qS = kS;
#pragma unroll
    for (int i = 0; i < 8; ++i) { const int d = 8 * dg + i; kS = kS + sv[i] * sh[128 + d]; qS = qS + sv[i] * sh[d]; }
    *(f32x4*)(red + dg * 256 + 4 * e4) = kS; *(f32x4*)(red + dg * 256 + 128 + 4 * e4) = qS;
    __syncthreads();
    if (tid < 128) { float ks = 0.f, qs = 0.f;
#pragma unroll
        for (int g = 0; g < 16; ++g) { ks += red[g * 256 + tid]; qs += red[g * 256 + 128 + tid]; }
        const float eG = scal[1], U = scal[2] * (sh[256 + tid] - eG * ks); Ush[tid] = U; osh[tid] = eG * qs + scal[0] * U; }
    __syncthreads();
    { const f32x4 U4 = *(const f32x4*)(Ush + 4 * e4); const float eG = scal[1];
      float* So = C.out + O_DNS + ((size_t)((l * NSAMP + s) * 4 + h) * 128) * 128;
#pragma unroll
      for (int i = 0; i < 8; ++i) { const int d = 8 * dg + i; *(f32x4*)(So + (size_t)d * 128 + 4 * e4) = sv[i] * eG + U4 * sh[128 + d]; } }
    if (wid == 0) { const float o0 = osh[lane], o1 = osh[lane + 64]; const float ss = wave_sum(o0 * o0 + o1 * o1, lane); const float rs = __builtin_amdgcn_rsqf(ss * (1.0f / 128.0f) + EPS);
        bf16* op = O + (size_t)row * DM + h * 128;
        op[lane] = (bf16)f2bf(o0 * rs * nw0 * silu(z0)); op[lane + 64] = (bf16)f2bf(o1 * rs * nw1 * silu(z1)); }
    __syncthreads();
}
DI void ms_ret(const Ctx& C, int l, int s, int h) {
    const int tid = C.tid, lane = C.lane, wid = C.wave, row = SROW0 + s;
    float* sh = (float*)C.lds; float* osh = sh + 256; float* red = sh + 1024;
    const bf16* PB = (const bf16*)(C.ws + WS_PB); bf16* O = (bf16*)(C.ws + WS_O); const float* rope = (const float*)(C.ws + WS_ROPE) + (size_t)2064 * 32 * 2;
    const float gam = 1.0f - exp2f(-5.0f - (float)h);
    const bf16* pr = PB + (size_t)row * PB_LD;
    const int e4 = tid & 15, dg = tid >> 4;
    const float* S0p = inp(I_SRET) + ((size_t)((l * NSAMP + s) * 4 + h) * 64) * 64;
    f32x4 sv[2];
#pragma unroll
    for (int i = 0; i < 2; ++i) sv[i] = *(const f32x4*)(S0p + (size_t)(2 * dg + i) * 64 + 4 * e4);
    const int i_ = tid & 31;
    const float q1 = bf1(pr[1024 + 64 * h + i_]), q2 = bf1(pr[1024 + 64 * h + 32 + i_]), k1 = bf1(pr[1280 + 64 * h + i_]), k2 = bf1(pr[1280 + 64 * h + 32 + i_]), cr = rope[2 * i_], sr = rope[2 * i_ + 1];
    const float vv = bf1(pr[1536 + 64 * h + lane]), gg = bf1(pr[1792 + 64 * h + lane]);
    if (tid < 32) { sh[i_] = q1 * cr - q2 * sr; sh[32 + i_] = q1 * sr + q2 * cr; sh[64 + i_] = 0.125f * (k1 * cr - k2 * sr); sh[96 + i_] = 0.125f * (k1 * sr + k2 * cr); }
    else if (tid >= 64 && tid < 128) sh[128 + lane] = vv;
    __syncthreads();
    if (wid == 0) { const float qk = wave_sum(sh[lane] * sh[64 + lane], lane); if (lane == 0) sh[192] = qk; }
    f32x4 qS = (f32x4){0.f, 0.f, 0.f, 0.f};
#pragma unroll
    for (int i = 0; i < 2; ++i) { const int d = 2 * dg + i; qS = qS + sv[i] * sh[d]; }
    *(f32x4*)(red + dg * 64 + 4 * e4) = qS;
    __syncthreads();
    if (tid < 64) { float qs = 0.f;
#pragma unroll
        for (int g = 0; g < 32; ++g) qs += red[g * 64 + tid];
        osh[tid] = gam * qs + sh[192] * sh[128 + tid]; }
    { const f32x4 v4 = *(const f32x4*)(sh + 128 + 4 * e4); float* So = C.out + O_RETS + ((size_t)((l * NSAMP + s) * 4 + h) * 64) * 64;
#pragma unroll
      for (int i = 0; i < 2; ++i) { const int d = 2 * dg + i; *(f32x4*)(So + (size_t)d * 64 + 4 * e4) = sv[i] * gam + v4 * sh[64 + d]; } }
    __syncthreads();
    if (wid == 0) { const float o = osh[lane]; const float mu = wave_sum(o, lane) * (1.0f / 64.0f); const float d = o - mu; const float var = wave_sum(d * d, lane) * (1.0f / 64.0f);
        O[(size_t)row * DM + 768 + 64 * h + lane] = (bf16)f2bf(d * __builtin_amdgcn_rsqf(var + EPS) * silu(gg)); }
    __syncthreads();
}
DI void ms_lru(const Ctx& C, int l, int s) {
    const int tid = C.tid, row = SROW0 + s; float* sh = (float*)C.lds;
    const bf16* PB = (const bf16*)(C.ws + WS_PB); bf16* O = (bf16*)(C.ws + WS_O);
    const int e = tid & 255, n = e >> 6, ee = e & 63;
    u32x4 wa8[8], wx8[8];
    { const unsigned char* wp = C.ws + WS_LWT + (size_t)l * 65536 + (size_t)((n * 64 + ee) * 64) * 2;
#pragma unroll
      for (int i = 0; i < 8; ++i) { wa8[i] = *(const u32x4*)(wp + 16 * i); wx8[i] = *(const u32x4*)(wp + 32768 + 16 * i); } }
    const float* buf = inp(I_SLRUC) + ((size_t)(l * NSAMP + s) * 3) * 256 + e; const float* cw = inp(I_LCW) + (size_t)l * 4 * 256 + e;
    const float x0 = buf[0], x1 = buf[256], x2 = buf[512], x3 = bf1(PB[(size_t)row * PB_LD + 512 + e]);
    const float xl = cw[0] * x0 + cw[256] * x1 + cw[512] * x2 + cw[768] * x3 + inp(I_LCB)[l * 256 + e];
    const float ba = inp(I_LBA)[l * 256 + e], bx = inp(I_LBX)[l * 256 + e], lam = inp(I_LLAM)[l * 256 + e], h0 = inp(I_SLRU)[(size_t)(l * NSAMP + s) * 256 + e], yv = bf1(PB[(size_t)row * PB_LD + 768 + e]);
    if (tid < 256) { sh[e] = xl; float* co = C.out + O_LRUCS + ((size_t)(l * NSAMP + s) * 3) * 256 + e; co[0] = x1; co[256] = x2; co[512] = x3; }
    __syncthreads();
    if (tid < 256) { float ar = 0.f, ai = 0.f;
#pragma unroll
        for (int i = 0; i < 8; ++i) { const unsigned aw[4] = {wa8[i].x, wa8[i].y, wa8[i].z, wa8[i].w}, xw[4] = {wx8[i].x, wx8[i].y, wx8[i].z, wx8[i].w};
#pragma unroll
            for (int k = 0; k < 4; ++k) { const float xa = sh[n * 64 + 8 * i + 2 * k], xb = sh[n * 64 + 8 * i + 2 * k + 1];
                ar += xa * bflo(aw[k]) + xb * bfhi(aw[k]); ai += xa * bflo(xw[k]) + xb * bfhi(xw[k]); } }
        const float rg = sigm(ar + ba), ig = sigm(ai + bx), la = -8.0f * rg * softplus(-lam);
        const float a = __expf(la), bm = sqrtf(fmaxf(1.0f - __expf(2.0f * la), 0.f)) * (ig * xl);
        const float hn = a * h0 + bm;
        C.out[O_LRUS + (size_t)(l * NSAMP + s) * 256 + e] = hn;
        O[(size_t)row * DM + 512 + e] = (bf16)f2bf(hn * gelu_tanh(yv)); }
    __syncthreads();
}
DI void m2_phase(const Ctx& C0, int l) {
    const int bid = C0.bid;
#ifndef M2_SUB
#define M2_SUB 0xf
#endif
#ifndef M2_DUP
#define M2_DUP 0
#endif
    if (bid < 32) { if (M2_SUB & 1) { for (int rep = 0; rep < ((M2_DUP & 1) ? 2 : 1); ++rep) { const Ctx Cr = fresh(C0); m2_dn(Cr, l, bid >> 2, bid & 3); __syncthreads(); } } return; }
    if (bid < 64) { if (M2_SUB & 2) { for (int rep = 0; rep < ((M2_DUP & 2) ? 2 : 1); ++rep) { const Ctx Cr = fresh(C0); m2_ret(Cr, l, (bid - 32) >> 2, (bid - 32) & 3); __syncthreads(); } } }
    else if (M2_SUB & 8) { const int nb = C0.G - 64;
        for (int rep = 0; rep < ((M2_DUP & 8) ? 2 : 1); ++rep)
        for (int it = bid - 64; it < NB * NCHUNK + NSAMP * 9; it += nb) { const Ctx C = fresh(C0);
            if (it < NB * NCHUNK) { m2_lru_item(C, l, it / NCHUNK, it % NCHUNK); }
            else { const int s = (it - NB * NCHUNK) / 9, k = (it - NB * NCHUNK) % 9;
                if (k < 4) ms_dn(C, l, s, k); else if (k < 8) ms_ret(C, l, s, k - 4); else ms_lru(C, l, s); } } }
    { const Ctx C = fresh(C0); __syncthreads();
      const int gw = (bid - 32) * NWAVES + C.wave, nw = (C0.G - 32) * NWAVES;
      convert_set(C, l, 1, gw, nw);
      if (l + 1 < 2) convert_set(C, l + 1, 0, gw, nw); }
}
constexpr int N_PHASES = 17;
#ifndef PH_MASK
#define PH_MASK 0x3ff
#endif
#define PH_EN(k) ((PH_MASK >> (k)) & 1)
#ifndef MK_PER_PHASE
#define MK_PER_PHASE 0
#endif
__global__ void __launch_bounds__(NTHREADS, 2) hybrid_fwd(Args args) {
    extern __shared__ __attribute__((aligned(16))) unsigned char lds[];
    Ctx C0;
    C0.out = args.out; C0.ws = args.ws; C0.lds = lds;
    C0.tid = threadIdx.x; C0.lane = C0.tid & 63; C0.wave = __builtin_amdgcn_readfirstlane(C0.tid >> 6); C0.G = gridDim.x; C0.bid = blockIdx.x;
    const int wave0 = C0.wave;
    volatile LAS unsigned* MISC = (volatile LAS unsigned*)((LAS unsigned char*)lds + MISC_OFF);
    if (C0.tid < 64) MISC[C0.tid] = 0u;
    __syncthreads();
    XcdBarrier bar; bar.bar = (unsigned*)(C0.ws + WS_CTL) + CW_BAR; bar.x = 0; bar.st = nullptr;
    const int lo = args.ph_lo, hi = args.ph_hi;
    if (hi - lo > 1) bar = xcd_barrier_post((unsigned*)(C0.ws + WS_CTL) + CW_BAR, MISC + 8);
    LAS unsigned char* ldsl = (LAS unsigned char*)lds;
    if (lo == 0) {
        if (PH_EN(9)) { const Ctx C = fresh(C0); p0_rows(C); convert_lru_weights(C); convert_set(C, 0, 0, C.bid * NWAVES + C.wave, C.G * NWAVES); }
        if (1 < hi) { XcdBarrier b2 = bar; asm volatile("" : "+s"(b2.bar), "+s"(b2.x)); int t0 = C0.tid; asm volatile("" : "+v"(t0)); xcd_barrier(b2, t0); }
    }
#define GRID_BAR_IN() do { XcdBarrier b4 = bar; asm volatile("" : "+s"(b4.bar), "+s"(b4.x)); xcd_barrier(b4, C.tid); } while (0)
    for (int ph = (lo == 0 ? 1 : lo); ph < hi; ++ph) {
#ifndef DUP_MASK
#define DUP_MASK 0
#endif
        const int nrep = ((DUP_MASK >> ((ph - 1) % 8)) & 1) ? 2 : 1;
        for (int rep = 0; rep < nrep; ++rep) {
        Ctx C = C0;
        { int ln = (int)__builtin_amdgcn_mbcnt_hi(~0u, __builtin_amdgcn_mbcnt_lo(~0u, 0u)); int wv = wave0; asm volatile("" : "+v"(ln), "+s"(wv)); C.lane = ln; C.wave = wv; C.tid = wv * 64 + ln; }
        { unsigned long long w = (unsigned long long)C0.ws, o = (unsigned long long)C0.out; asm volatile("" : "+s"(w), "+s"(o));
          C.ws = (unsigned char*)(GAS unsigned char*)w; C.out = (float*)(GAS float*)o; }
        { int bb = C0.bid, gg = C0.G; asm volatile("" : "+s"(bb), "+s"(gg)); C.bid = bb; C.G = gg; }
        unsigned long long* SS = (unsigned long long*)(C.ws + WS_SS);
        bf16* XB = (bf16*)(C.ws + WS_XB); bf16* H = (bf16*)(C.ws + WS_H); bf16* PA = (bf16*)(C.ws + WS_PA); bf16* PB = (bf16*)(C.ws + WS_PB); bf16* O = (bf16*)(C.ws + WS_O);
        float* XE = (float*)(C.ws + WS_XE); unsigned char* wt = C.ws + WS_WT;
            if (rep) { XcdBarrier b3 = bar; asm volatile("" : "+s"(b3.bar), "+s"(b3.x)); xcd_barrier(b3, C.tid); }
            const int l = (ph - 1) / 8, k = (ph - 1) % 8;
            unsigned long long* ss_in1 = SS + (size_t)(3 * l) * NROWS;
            if (k == 0 && PH_EN(0)) {
                pg8::Gemm g{XB, (const bf16*)(wt + WT_F1I), NROWS, 2 * DFF, DM, nullptr, 0}; pg8::StaticOrder S; S.init(NROWS, 2 * DFF, C.G, C.bid);
                pg8::EpiSwiglu E{H, DFF, ss_in1};
                pg8::gemm_phase<pg8::EpiSwiglu, pg8::StaticOrder, true, true>(ldsl, g, S, E, C.tid);
            } else if (k == 1 && PH_EN(1)) {
                pg8::Gemm g{H, (const bf16*)(wt + WT_F1O), NROWS, DM, DFF, (float*)(C.ws + WS_SLAB), DFF / 256}; pg8::SplitOrder S; S.init(DFF, C.G, C.bid);
                pg8::EpiResid E{l == 0 ? inp(I_XP) : C.out + O_YP, C.out + O_YP, XE, XB, ss_in1 + NROWS, 0.5f};
                pg8::gemm_phase<pg8::EpiResid, pg8::SplitOrder, true, true>(ldsl, g, S, E, C.tid);
                GRID_BAR_IN(); fix_rows(C, g.nparts, E.scale, E.ssn);
            } else if (k == 2 && PH_EN(2)) {
                pg8::Gemm g{XB, (const bf16*)(wt + WT_WIN), NROWS, DIN_PAD, DM, nullptr, 0}; pg8::StaticOrder S; S.init(NROWS, DIN_PAD, C.G, C.bid);
                pg8::EpiProj E{PA, PB, ss_in1 + NROWS};
                pg8::gemm_phase<pg8::EpiProj, pg8::StaticOrder, true, true>(ldsl, g, S, E, C.tid);
            } else if (k == 3 && PH_EN(3)) { m1_phase(C, l);
            } else if (k == 4 && PH_EN(4)) { m2_phase(C, l);
            } else if (k == 5 && PH_EN(5)) {
                pg8::Gemm g{O, (const bf16*)(wt + WT_WOUT), NROWS, DM, DM, (float*)(C.ws + WS_SLAB), DM / 256}; pg8::SplitOrder S; S.init(DM, C.G, C.bid);
                pg8::EpiResid E{C.out + O_YP, C.out + O_YP, XE, XB, ss_in1 + 2 * NROWS, 1.0f};
                pg8::gemm_phase<pg8::EpiResid, pg8::SplitOrder, true, true>(ldsl, g, S, E, C.tid);
                GRID_BAR_IN(); fix_rows(C, g.nparts, E.scale, E.ssn);
            } else if (k == 6 && PH_EN(6)) {
                pg8::Gemm g{XB, (const bf16*)(wt + WT_F2I), NROWS, 2 * DFF, DM, nullptr, 0}; pg8::StaticOrder S; S.init(NROWS, 2 * DFF, C.G, C.bid);
                pg8::EpiSwiglu E{H, DFF, ss_in1 + 2 * NROWS};
                pg8::gemm_phase<pg8::EpiSwiglu, pg8::StaticOrder, true, true>(ldsl, g, S, E, C.tid);
            } else if (k == 7 && PH_EN(7)) {
                pg8::Gemm g{H, (const bf16*)(wt + WT_F2O), NROWS, DM, DFF, (float*)(C.ws + WS_SLAB), DFF / 256}; pg8::SplitOrder S; S.init(DFF, C.G, C.bid);
                pg8::EpiResid E{C.out + O_YP, C.out + O_YP, XE, XB, ss_in1 + 3 * NROWS, 0.5f};
                pg8::gemm_phase<pg8::EpiResid, pg8::SplitOrder, true, true>(ldsl, g, S, E, C.tid);
                GRID_BAR_IN(); if (l == 0) fix_rows(C, g.nparts, E.scale, E.ssn); else final_fix_norm(C, g.nparts, E.scale);
            }
        }
        if (ph + 1 < hi) { XcdBarrier b2 = bar; asm volatile("" : "+s"(b2.bar), "+s"(b2.x)); int ln = (int)__builtin_amdgcn_mbcnt_hi(~0u, __builtin_amdgcn_mbcnt_lo(~0u, 0u)); int wv = wave0; asm volatile("" : "+v"(ln), "+s"(wv)); xcd_barrier(b2, wv * 64 + ln); }
    }
}

extern "C" void kernel_launch(void* const* d_in, const int* in_sizes, int n_in, void* d_out, int out_size, void* d_ws, size_t ws_size, hipStream_t stream) {
    static int grid = 0;
    if (grid == 0) {
        if (n_in != 29 || out_size != (int)O_END || ws_size < WS_END) { fprintf(stderr, "kernel_launch: unexpected shapes: n_in %d out %d ws %zu (need %zu)\n", n_in, out_size, ws_size, (size_t)WS_END); grid = -1; return; }
        int dev = 0, cus = 0, per_cu = 0;
        if (hipGetDevice(&dev) != hipSuccess || hipDeviceGetAttribute(&cus, hipDeviceAttributeMultiprocessorCount, dev) != hipSuccess) { grid = -1; return; }
        if (hipFuncSetAttribute((const void*)hybrid_fwd, hipFuncAttributeMaxDynamicSharedMemorySize, LDS_BYTES) != hipSuccess) { fprintf(stderr, "kernel_launch: hipFuncSetAttribute failed\n"); grid = -1; return; }
        if (hipOccupancyMaxActiveBlocksPerMultiprocessor(&per_cu, (const void*)hybrid_fwd, NTHREADS, LDS_BYTES) != hipSuccess || per_cu < 1) { fprintf(stderr, "kernel_launch: occupancy query says %d blocks per CU\n", per_cu); grid = -1; return; }
        (void)hipGetLastError();
        grid = cus;
        if (grid < 128) { fprintf(stderr, "kernel_launch: %d CUs: too few for this kernel's phase-role split\n", grid); grid = -1; return; }
    }
    if (grid < 0) return;
    if (hipMemsetAsync((char*)d_ws + WS_CTL, 0, CTL_ZERO_BYTES, stream) != hipSuccess) return;
    Args a{};
    for (int i = 0; i < 29; ++i) a.in[i] = (const float*)d_in[i];
    a.out = (float*)d_out; a.ws = (unsigned char*)d_ws;
#if MK_PER_PHASE
    for (int ph = 0; ph < N_PHASES; ++ph) { a.ph_lo = ph; a.ph_hi = ph + 1; hipLaunchKernelGGL(hybrid_fwd, dim3(grid), dim3(NTHREADS), LDS_BYTES, stream, a); }
#else
    a.ph_lo = 0; a.ph_hi = N_PHASES; hipLaunchKernelGGL(hybrid_fwd, dim3(grid), dim3(NTHREADS), LDS_BYTES, stream, a);
#endif
}
```

```cpp
#include <hip/hip_runtime.h>
#include <cstdio>
#include <cstdint>
namespace pg8 {
#define PG8_LAS __attribute__((address_space(3)))
typedef unsigned short bf16_t;
typedef short bf16x8 __attribute__((ext_vector_type(8)));
typedef float f32x4 __attribute__((ext_vector_type(4)));
typedef unsigned u32x4 __attribute__((ext_vector_type(4)));
constexpr int BM = 256, BK = 64, HALF = 128, HTB = HALF * BK * 2  , STAGE_BYTES = 8 * HTB, NXCD = 8, WGM = 8;

__host__ __device__ __forceinline__ int lds_byte(int r, int c) { const int st = (r >> 4) * 2 + (c >> 5), rr = r & 15, cc = c & 31, ob = rr * 64 + cc * 2; return st * 1024 + (ob ^ (((ob >> 9) & 1) << 5)); }
__host__ __device__ __forceinline__ void stage_rc(int b, int& R, int& C) { const int st = b / 1024, sb = b % 1024, swz = sb ^ (((sb >> 9) & 1) << 5); R = (st >> 1) * 16 + swz / 64; C = (st & 1) * 32 + (swz % 64) / 2; }
__host__ __device__ __forceinline__ int perm32(int rho) { const int n = rho >> 4, i = rho & 15; return 8 * (i >> 2) + 4 * n + (i & 3); }

struct Unit { int pm, pn, kt0, nkt, part; };
struct Gemm { const bf16_t* A; const bf16_t* Bt; int M, N, K; float* slab; int nparts; };

struct StaticOrder {
    int nM, nN, nwg, G, c;
    __host__ __device__ void init(int M, int N, int G_, int c_) { nM = M / BM; nN = N / BM; nwg = nM * nN; G = G_; c = c_; }
    __host__ __device__ bool next(int i, Unit& u) const {
        const long L = (long)i * G + c; if (L >= nwg) { u.pm = 0; u.pn = 0; u.kt0 = 0; u.nkt = 0; u.part = -1; return false; }
        int wgid = (int)L; { const int q = nwg / NXCD, r = nwg % NXCD, xcd = wgid % NXCD, off = wgid / NXCD; wgid = (xcd < r ? xcd * (q + 1) : r * (q + 1) + (xcd - r) * q) + off; }
        const int nig = WGM * nN, gid = wgid / nig, fm = gid * WGM, gsz = (nM - fm) < WGM ? (nM - fm) : WGM;
        u.pm = fm + ((wgid % nig) % gsz); u.pn = (wgid % nig) / gsz; u.kt0 = 0; u.nkt = 0; u.part = -1; return true;
    }
    __device__ __forceinline__ void a_ready(const Unit&) const {}
    __device__ __forceinline__ void done(const Unit&) const {}
};

__device__ __forceinline__ unsigned cvt_pk_bf16(float lo, float hi) { unsigned r; asm volatile("v_cvt_pk_bf16_f32 %0, %1, %2" : "=v"(r) : "v"(lo), "v"(hi)); return r; }
struct SplitOrder {
    StaticOrder so; int nparts;
    __host__ __device__ void init(int K, int G_, int c_) { so.init(64 * BM, 1024, G_, c_); nparts = K / BK / 4; }
    __host__ __device__ bool next(int i, Unit& u) const {
        Unit f; const bool full = so.next(i, f);
        const int L = i * so.G + so.c - so.nwg; const bool part = (L >= 0) && (L < 4 * nparts);
        const int q = part ? L / nparts : 0, p = part ? L % nparts : 0;
        Unit r; r.pm = full ? f.pm : 64; r.pn = full ? f.pn : q; r.kt0 = full ? 0 : 4 * p; r.nkt = full ? 0 : 4; r.part = full ? -1 : p;
        u = r; return full || part;
    }
    __device__ __forceinline__ void a_ready(const Unit&) const {}
    __device__ __forceinline__ void done(const Unit&) const {}
};
__device__ __forceinline__ void slab_dump(const f32x4 (&acc)[2][2][4][2], const Unit& u, float* slab, int nparts, int wr, int wc, int fr, int fq) {
    float* base = slab + (size_t)(u.pn * nparts + u.part) * 65536 + (size_t)(wr * 64 + fr) * 256 + wc * 32 + 8 * fq;
#pragma unroll
    for (int ai = 0; ai < 2; ++ai)
#pragma unroll
        for (int m = 0; m < 4; ++m)
#pragma unroll
            for (int bj = 0; bj < 2; ++bj) { float* p = base + (size_t)(ai * HALF + m * 16) * 256 + bj * HALF; *(f32x4*)p = acc[ai][bj][m][0]; *(f32x4*)(p + 4) = acc[ai][bj][m][1]; }
}
typedef unsigned u32x2 __attribute__((ext_vector_type(2)));
__device__ __forceinline__ float fast_sigmoid(float x) { return __builtin_amdgcn_rcpf(1.0f + __expf(-x)); }
__device__ __forceinline__ float fast_silu(float x) { return x * fast_sigmoid(x); }
constexpr int NP_ROWS = 16384;

struct EpiSwiglu {
    static constexpr bool PERM = true, AFTER_DRAIN = false;
    bf16_t* H; int ldh; const unsigned long long* ss;
    __device__ __forceinline__ void operator()(const f32x4 (&acc)[2][2][4][2], const Unit& u, int wr, int wc, int fr, int fq) const {
        const int row0 = u.pm * BM + wr * 64 + fr, col0 = u.pn * 128 + wc * 32 + 8 * fq;
        unsigned long long sv[8];
#pragma unroll
        for (int i = 0; i < 8; ++i) sv[i] = ss[row0 + (i >> 2) * HALF + (i & 3) * 16];
        float rsv[8];
#pragma unroll
        for (int i = 0; i < 8; ++i) rsv[i] = __builtin_amdgcn_rsqf((float)sv[i] * (1.0f / (1024.0f * 1048576.0f)) + 1e-6f);
#pragma unroll
        for (int ai = 0; ai < 2; ++ai)
#pragma unroll
            for (int m = 0; m < 4; ++m) {
                const int row = row0 + ai * HALF + m * 16;
                const float rs = rsv[ai * 4 + m];
                float hv[8];
#pragma unroll
                for (int n = 0; n < 2; ++n)
#pragma unroll
                    for (int e = 0; e < 4; ++e) { const float g = acc[ai][0][m][n][e] * rs, up = acc[ai][1][m][n][e] * rs; hv[4 * n + e] = fast_silu(g) * up; }
                u32x4 w; w.x = cvt_pk_bf16(hv[0], hv[1]); w.y = cvt_pk_bf16(hv[2], hv[3]); w.z = cvt_pk_bf16(hv[4], hv[5]); w.w = cvt_pk_bf16(hv[6], hv[7]);
                *(u32x4*)(H + (size_t)row * ldh + col0) = w;
            }
    }
};
struct EpiProj {
    static constexpr bool PERM = true, AFTER_DRAIN = false;
    bf16_t* PA; bf16_t* PB; const unsigned long long* ss;
    __device__ __forceinline__ void operator()(const f32x4 (&acc)[2][2][4][2], const Unit& u, int wr, int wc, int fr, int fq) const {
        const int row0 = u.pm * BM + wr * 64 + fr;
        bf16_t* base; int ld, colt;
        if (u.pn < 7) { base = PA; ld = 1792; colt = u.pn * 256; } else { base = PB; ld = 2048; colt = (u.pn - 7) * 256; }
        const int col0 = colt + wc * 32 + 8 * fq;
        unsigned long long sv[8];
#pragma unroll
        for (int i = 0; i < 8; ++i) sv[i] = ss[row0 + (i >> 2) * HALF + (i & 3) * 16];
        float rsv[8];
#pragma unroll
        for (int i = 0; i < 8; ++i) rsv[i] = __builtin_amdgcn_rsqf((float)sv[i] * (1.0f / (1024.0f * 1048576.0f)) + 1e-6f);
#pragma unroll
        for (int ai = 0; ai < 2; ++ai)
#pragma unroll
            for (int m = 0; m < 4; ++m) {
                const int row = row0 + ai * HALF + m * 16;
                const float rs = rsv[ai * 4 + m];
                bf16_t* rowp = base + (size_t)row * ld + col0;
#pragma unroll
                for (int bj = 0; bj < 2; ++bj) { const f32x4 v0 = acc[ai][bj][m][0] * rs, v1 = acc[ai][bj][m][1] * rs;
                    u32x4 w; w.x = cvt_pk_bf16(v0[0], v0[1]); w.y = cvt_pk_bf16(v0[2], v0[3]); w.z = cvt_pk_bf16(v1[0], v1[1]); w.w = cvt_pk_bf16(v1[2], v1[3]);
                    *(u32x4*)(rowp + bj * HALF) = w; }
            }
    }
};
struct EpiResid {
    static constexpr bool PERM = true, AFTER_DRAIN = false;
    const float* xin_lo; float* xout_lo; float* xe; bf16_t* xb; unsigned long long* ssn; float scale;
    __device__ __forceinline__ void operator()(const f32x4 (&acc)[2][2][4][2], const Unit& u, int wr, int wc, int fr, int fq) const {
        const int row0 = u.pm * BM + wr * 64 + fr, col0 = u.pn * BM + wc * 32 + 8 * fq;
        const bool lo = (u.pm * BM) < NP_ROWS;
#pragma unroll
        for (int ah = 0; ah < 4; ++ah) { const int ai = ah >> 1, mh = (ah & 1) * 2;
            f32x4 xo[2][2][2];
#pragma unroll
            for (int mm = 0; mm < 2; ++mm) { const int row = row0 + ai * HALF + (mh + mm) * 16;
                const float* xi = lo ? xin_lo + (size_t)row * 1024 : xe + (size_t)(row - NP_ROWS) * 1024;
#pragma unroll
                for (int bj = 0; bj < 2; ++bj) { xo[mm][bj][0] = *(const f32x4*)(xi + col0 + bj * HALF); xo[mm][bj][1] = *(const f32x4*)(xi + col0 + bj * HALF + 4); } }
#pragma unroll
            for (int mm = 0; mm < 2; ++mm) { const int m = mh + mm;
                const int row = row0 + ai * HALF + m * 16;
                float* xop = lo ? xout_lo + (size_t)row * 1024 : xe + (size_t)(row - NP_ROWS) * 1024;
                float sq = 0.f;
#pragma unroll
                for (int bj = 0; bj < 2; ++bj) { const int c = col0 + bj * HALF;
                    const f32x4 a0 = xo[mm][bj][0] + acc[ai][bj][m][0] * scale, a1 = xo[mm][bj][1] + acc[ai][bj][m][1] * scale;
                    *(f32x4*)(xop + c) = a0; *(f32x4*)(xop + c + 4) = a1;
                    u32x4 w; w.x = cvt_pk_bf16(a0[0], a0[1]); w.y = cvt_pk_bf16(a0[2], a0[3]); w.z = cvt_pk_bf16(a1[0], a1[1]); w.w = cvt_pk_bf16(a1[2], a1[3]);
                    *(u32x4*)(xb + (size_t)row * 1024 + c) = w;
                    sq += (a0[0] * a0[0] + a0[1] * a0[1]) + (a0[2] * a0[2] + a0[3] * a0[3]) + (a1[0] * a1[0] + a1[1] * a1[1]) + (a1[2] * a1[2] + a1[3] * a1[3]); }
                sq += __builtin_bit_cast(float, __builtin_amdgcn_ds_bpermute((fr + 16 * (fq ^ 1)) << 2, __builtin_bit_cast(int, sq))); sq += __builtin_bit_cast(float, __builtin_amdgcn_ds_bpermute((fr + 16 * (fq ^ 2)) << 2, __builtin_bit_cast(int, sq)));
                if (fq == 0) atomicAdd(ssn + row, (unsigned long long)(sq * 1048576.0f + 0.5f));
            }
        }
    }
};
template <class Epi, class Sched, bool ALIGN_EPI = false, bool SP2 = false>
__device__ __forceinline__ void gemm_phase(PG8_LAS unsigned char* lds, const Gemm g, const Sched& S, const Epi& E, const int tid_in) {
    int tid_ = tid_in; asm volatile("" : "+v"(tid_));
    const int tid = tid_, wid = __builtin_amdgcn_readfirstlane(tid >> 6), lane = tid & 63, wr = wid >> 2, wc = wid & 3, fr = lane & 15, fq = lane >> 4;
    const int K = g.K, nt = K / BK;
    unsigned voffA[2], voffB[2];
#pragma unroll
    for (int i = 0; i < 2; ++i) { int R, C; stage_rc(tid * 16 + i * 8192, R, C); const int Rb = Epi::PERM ? ((R & ~31) + perm32(R & 31)) : R;
        voffA[i] = (unsigned)(R * K + C) * 2u; voffB[i] = (unsigned)(Rb * K + C) * 2u; }
    const size_t kstep = (size_t)(BK * 2);
    const size_t hstep = (size_t)HALF * K * 2;
    const size_t tstep = 2 * hstep;
    const unsigned ldsw = (unsigned)wid * 1024u;
    const int aoff = lds_byte(wr * 64 + fr, fq * 8), boff = lds_byte(wc * 32 + fr, fq * 8);
#define PG8_SA(b, h) (((b) * 2 + (h)) * HTB)
#define PG8_SB(b, h) ((4 + (b) * 2 + (h)) * HTB)
#define PG8_STAGE(bufoff, gbase, voff) do { _Pragma("unroll") for (int _i = 0; _i < 2; ++_i) \
        __builtin_amdgcn_global_load_lds((const unsigned*)((const char*)(gbase) + (voff)[_i]), (PG8_LAS unsigned*)(lds + (bufoff) + ldsw + _i * 8192), 16, 0, 0); } while (0)
#define PG8_LDA(dst, b, h) do { _Pragma("unroll") for (int m = 0; m < 4; ++m) _Pragma("unroll") for (int k = 0; k < 2; ++k) dst[m][k] = *(const PG8_LAS bf16x8*)(lds + PG8_SA(b, h) + aoff + m * 2048 + k * 1024); } while (0)
#define PG8_LDB(dst, b, h) do { _Pragma("unroll") for (int n = 0; n < 2; ++n) _Pragma("unroll") for (int k = 0; k < 2; ++k) dst[n][k] = *(const PG8_LAS bf16x8*)(lds + PG8_SB(b, h) + boff + n * 2048 + k * 1024); } while (0)
#define PG8_MMA(ai, bj, At, Bt) do { __builtin_amdgcn_s_setprio(1); _Pragma("unroll") for (int m = 0; m < 4; ++m) _Pragma("unroll") for (int n = 0; n < 2; ++n) _Pragma("unroll") for (int k = 0; k < 2; ++k) \
        acc[ai][bj][m][n] = __builtin_amdgcn_mfma_f32_16x16x32_bf16(Bt[n][k], At[m][k], acc[ai][bj][m][n], 0, 0, 0); __builtin_amdgcn_s_setprio(0); } while (0)
#define PG8_WAIT_V(n) asm volatile("s_waitcnt vmcnt(" #n ")" ::: "memory")
#define PG8_WAIT_L(n) asm volatile("s_waitcnt lgkmcnt(" #n ")" ::: "memory")
#define PG8_BAR __builtin_amdgcn_s_barrier()
#define PG8_SCHED __builtin_amdgcn_sched_barrier(0)
    Unit cur, nxt; int ui = 0;
    if (!S.next(0, cur)) return;
    f32x4 acc[2][2][4][2];
#pragma unroll
    for (int a = 0; a < 2; ++a)
#pragma unroll
        for (int b = 0; b < 2; ++b)
#pragma unroll
            for (int m = 0; m < 4; ++m)
#pragma unroll
                for (int n = 0; n < 2; ++n) acc[a][b][m][n] = (f32x4){0.f, 0.f, 0.f, 0.f};
    bf16x8 At[4][2], B0[2][2], B1[2][2];
    int cnt = cur.nkt > 0 ? cur.nkt : nt;
    const char* cA = (const char*)g.A + (size_t)cur.pm * tstep + (size_t)cur.kt0 * kstep; const char* cB = (const char*)g.Bt + (size_t)cur.pn * tstep + (size_t)cur.kt0 * kstep;
    S.a_ready(cur);
    if constexpr (SP2) {
        PG8_STAGE(PG8_SB(0, 0), cB, voffB); PG8_STAGE(PG8_SB(0, 1), cB + hstep, voffB); PG8_STAGE(PG8_SA(0, 0), cA, voffA); PG8_STAGE(PG8_SA(0, 1), cA + hstep, voffA);
        if (wr == 1) PG8_BAR;
        PG8_WAIT_V(2); PG8_BAR;
        PG8_STAGE(PG8_SB(1, 0), cB + kstep, voffB); PG8_STAGE(PG8_SA(1, 0), cA + kstep, voffA); PG8_STAGE(PG8_SB(1, 1), cB + hstep + kstep, voffB);
        PG8_WAIT_V(6); PG8_BAR;
    } else {
        PG8_STAGE(PG8_SB(0, 0), cB, voffB); PG8_STAGE(PG8_SA(0, 0), cA, voffA); PG8_STAGE(PG8_SB(0, 1), cB + hstep, voffB); PG8_STAGE(PG8_SA(0, 1), cA + hstep, voffA);
        if (wr == 1) PG8_BAR;
        PG8_WAIT_V(4); PG8_BAR;
        PG8_STAGE(PG8_SB(1, 0), cB + kstep, voffB); PG8_STAGE(PG8_SA(1, 0), cA + kstep, voffA); PG8_STAGE(PG8_SB(1, 1), cB + hstep + kstep, voffB);
        PG8_WAIT_V(6); PG8_BAR;
    }
    for (;;) {
        const bool has_next = S.next(ui + 1, nxt);
        const char* nA = has_next ? (const char*)g.A + (size_t)nxt.pm * tstep + (size_t)nxt.kt0 * kstep : cA; const char* nB = has_next ? (const char*)g.Bt + (size_t)nxt.pn * tstep + (size_t)nxt.kt0 * kstep : cB;
        for (int t = 0; t < cnt; t += 2) {
            const bool last = (t == cnt - 2);
            const char* a1 = cA + (size_t)(t + 1) * kstep;
            const char* a2 = last ? nA : cA + (size_t)(t + 2) * kstep; const char* b2 = last ? nB : cB + (size_t)(t + 2) * kstep;
            const char* a3 = a2 + kstep; const char* b3 = b2 + kstep;
            if (last && has_next) S.a_ready(nxt);
            if constexpr (SP2) {
            PG8_LDB(B0, 0, 0); PG8_LDB(B1, 0, 1); PG8_SCHED; PG8_LDA(At, 0, 0); PG8_STAGE(PG8_SA(1, 1), a1 + hstep, voffA);
            PG8_WAIT_V(8); PG8_WAIT_L(0); PG8_BAR; PG8_MMA(0, 0, At, B0); PG8_MMA(0, 1, At, B1); PG8_BAR; PG8_SCHED;
            PG8_LDA(At, 0, 1); PG8_STAGE(PG8_SB(0, 0), b2, voffB); PG8_STAGE(PG8_SB(0, 1), b2 + hstep, voffB); PG8_STAGE(PG8_SA(0, 0), a2, voffA);
            PG8_WAIT_V(8); PG8_WAIT_L(0); PG8_BAR; PG8_MMA(1, 0, At, B0); PG8_MMA(1, 1, At, B1); PG8_BAR; PG8_SCHED;
            PG8_LDB(B0, 1, 0); PG8_LDB(B1, 1, 1); PG8_SCHED; PG8_LDA(At, 1, 0); PG8_STAGE(PG8_SA(0, 1), a2 + hstep, voffA);
            PG8_WAIT_V(8); PG8_WAIT_L(0); PG8_BAR; PG8_MMA(0, 0, At, B0); PG8_MMA(0, 1, At, B1); PG8_BAR; PG8_SCHED;
            PG8_LDA(At, 1, 1); PG8_STAGE(PG8_SB(1, 0), b3, voffB); PG8_STAGE(PG8_SB(1, 1), b3 + hstep, voffB); PG8_STAGE(PG8_SA(1, 0), a3, voffA);
            PG8_WAIT_V(8); PG8_WAIT_L(0); PG8_BAR; PG8_MMA(1, 0, At, B0); PG8_MMA(1, 1, At, B1); PG8_BAR; PG8_SCHED;
            } else {
            PG8_LDB(B0, 0, 0); PG8_SCHED; PG8_LDA(At, 0, 0); PG8_STAGE(PG8_SA(1, 1), a1 + hstep, voffA);
            PG8_WAIT_L(8); PG8_BAR; PG8_WAIT_L(0); PG8_MMA(0, 0, At, B0); PG8_BAR; PG8_SCHED;
            PG8_LDB(B1, 0, 1); PG8_STAGE(PG8_SB(0, 0), b2, voffB);
            PG8_BAR; PG8_WAIT_L(0); PG8_MMA(0, 1, At, B1); PG8_BAR;
            PG8_LDA(At, 0, 1); PG8_STAGE(PG8_SA(0, 0), a2, voffA);
            PG8_BAR; PG8_WAIT_L(0); PG8_MMA(1, 0, At, B0); PG8_BAR; PG8_SCHED;
            PG8_STAGE(PG8_SB(0, 1), b2 + hstep, voffB);
            PG8_WAIT_V(6); PG8_BAR; PG8_MMA(1, 1, At, B1); PG8_BAR;
            PG8_LDB(B0, 1, 0); PG8_SCHED; PG8_LDA(At, 1, 0); PG8_STAGE(PG8_SA(0, 1), a2 + hstep, voffA);
            PG8_WAIT_L(8); PG8_BAR; PG8_WAIT_L(0); PG8_MMA(0, 0, At, B0); PG8_BAR; PG8_SCHED;
            PG8_LDB(B1, 1, 1); PG8_STAGE(PG8_SB(1, 0), b3, voffB);
            PG8_BAR; PG8_WAIT_L(0); PG8_MMA(0, 1, At, B1); PG8_BAR;
            PG8_LDA(At, 1, 1); PG8_STAGE(PG8_SA(1, 0), a3, voffA);
            PG8_BAR; PG8_WAIT_L(0); PG8_MMA(1, 0, At, B0); PG8_BAR; PG8_SCHED;
            PG8_STAGE(PG8_SB(1, 1), b3 + hstep, voffB);
            PG8_WAIT_V(6); PG8_BAR; PG8_MMA(1, 1, At, B1); PG8_BAR;
            }
        }
        if constexpr (ALIGN_EPI) { if (wr == 0) PG8_BAR; }
        if constexpr (!Epi::AFTER_DRAIN) { if (cur.part >= 0) slab_dump(acc, cur, g.slab, g.nparts, wr, wc, fr, fq); else E(acc, cur, wr, wc, fr, fq); S.done(cur); }
        if (!has_next) break;
#pragma unroll
        for (int a = 0; a < 2; ++a)
#pragma unroll
            for (int b = 0; b < 2; ++b)
#pragma unroll
                for (int m = 0; m < 4; ++m)
#pragma unroll
                    for (int n = 0; n < 2; ++n) acc[a][b][m][n] = (f32x4){0.f, 0.f, 0.f, 0.f};
        cur = nxt; cA = nA; cB = nB; ++ui; cnt = cur.nkt > 0 ? cur.nkt : nt;
        if constexpr (ALIGN_EPI) { if (wr == 1) PG8_BAR; }
    }
    PG8_WAIT_V(0);
    if constexpr (!ALIGN_EPI) { if (wr == 0) PG8_BAR; }
    PG8_BAR;
    if constexpr (Epi::AFTER_DRAIN) { E.fused(acc, cur, wr, wc, fr, fq, lds, wid, lane); S.done(cur); }
#undef PG8_SA
#undef PG8_SB
#undef PG8_STAGE
#undef PG8_LDA
#undef PG8_LDB
#undef PG8_MMA
#undef PG8_WAIT_V
#undef PG8_WAIT_L
#undef PG8_BAR
#undef PG8_SCHED
}
}

constexpr int DM = 1024, NROWS = 16640, NPROMPT = 16384, NMETAROWS = 128, SROW0 = 16512;
constexpr int DFF = 2816, NCHUNK = 33, NB = 8, NSAMP = 128;
constexpr int PA_LD = 1792, PB_LD = 2048, DIN_PAD = 3840;
constexpr float EPS = 1e-6f;
constexpr size_t MiB = 1u << 20;
constexpr size_t WS_CTL = 0, WS_SS = 1 * MiB, CTL_ZERO_BYTES = 2 * MiB;
constexpr size_t WS_ROPE = 2 * MiB;
constexpr size_t WS_XE = 3 * MiB;
constexpr size_t WS_LWT = 6 * MiB;
constexpr size_t WS_GCA = 4 * MiB, WS_CA = 4 * MiB + 65536, WS_CB = WS_CA + 524288;
constexpr size_t WS_WT = 8 * MiB;
constexpr size_t WT_F1I = 0, WT_F1O = 11534336, WT_WIN = 17301504, WT_WOUT = 25165824, WT_F2I = 27262976, WT_F2O = 38797312, WT_END = 44564480;
constexpr size_t WS_XB = 52 * MiB;
constexpr size_t WS_R = 86 * MiB;
constexpr size_t WS_H = WS_R, WS_PA = WS_R, WS_O = WS_R, WS_PB = 144 * MiB, WS_DNI = 210 * MiB, WS_LA = 285 * MiB, WS_LB = 294 * MiB, WS_END = 303 * MiB;
static_assert(WS_SS + (size_t)7 * NROWS * 8 <= CTL_ZERO_BYTES, "ss arrays inside the memset");
static_assert(WS_WT + WT_END <= WS_XB && WS_XB + (size_t)NROWS * DM * 2 <= WS_R && WS_H + (size_t)NROWS * DFF * 2 <= WS_END, "ws map");
static_assert(WS_PA + (size_t)NROWS * PA_LD * 2 <= WS_PB && WS_PB + (size_t)NROWS * PB_LD * 2 <= WS_DNI, "ws map 2");
constexpr size_t WS_SLAB = WS_DNI;
constexpr int DNI_ITEM = 73728;
constexpr int DNI_W = 0, DNI_QG = 16384, DNI_KDT = 32768, DNI_UVT = 49152, DNI_P = 65536;
static_assert(WS_DNI + (size_t)1056 * DNI_ITEM <= WS_LA && WS_LA + (size_t)NROWS * 256 * 2 <= WS_LB && WS_LB + (size_t)NROWS * 256 * 2 <= WS_END, "ws map 3");
constexpr int CW_BAR = 4096;
constexpr size_t O_YP = 0, O_YS = 16777216, O_DNP = O_YS + 131072, O_DNCP = O_DNP + 1048576, O_LRUP = O_DNCP + 73728, O_LRUCP = O_LRUP + 4096, O_RETP = O_LRUCP + 12288,
                 O_DNS = O_RETP + 262144, O_DNCS = O_DNS + 16777216, O_LRUS = O_DNCS + 1179648, O_LRUCS = O_LRUS + 65536, O_RETS = O_LRUCS + 196608, O_END = O_RETS + 4194304;
constexpr int LDS_BYTES = 155648, MISC_OFF = LDS_BYTES - 256;
constexpr int NWAVES = 8, NTHREADS = 512;

#define GAS __attribute__((address_space(1)))
#define LAS __attribute__((address_space(3)))
typedef unsigned short bf16;
typedef float f32x4 __attribute__((ext_vector_type(4)));
typedef float f32x16 __attribute__((ext_vector_type(16)));
typedef short bf16x8 __attribute__((ext_vector_type(8)));
typedef unsigned u32x4 __attribute__((ext_vector_type(4)));
typedef unsigned u32x2 __attribute__((ext_vector_type(2)));
#define DI __device__ __forceinline__
DI unsigned f2bf(float f) { return (unsigned)__builtin_bit_cast(unsigned short, (__bf16)f); }
typedef __bf16 hwbf16x2 __attribute__((ext_vector_type(2)));
typedef float f32x2 __attribute__((ext_vector_type(2)));
DI unsigned pk2(float lo, float hi) { const f32x2 v = {lo, hi}; return __builtin_bit_cast(unsigned, __builtin_convertvector(v, hwbf16x2)); }
DI float bflo(unsigned w) { return __builtin_bit_cast(float, w << 16); }
DI float bfhi(unsigned w) { return __builtin_bit_cast(float, w & 0xffff0000u); }
DI f32x4 ld4bf(const bf16* p) { const u32x2 v = *(const u32x2*)p; return (f32x4){bflo(v.x), bfhi(v.x), bflo(v.y), bfhi(v.y)}; }
DI float bf1(bf16 b) { return __builtin_bit_cast(float, (unsigned)b << 16); }
DI float sigm(float x) { return __builtin_amdgcn_rcpf(1.0f + __expf(-x)); }
DI float silu(float x) { return x * sigm(x); }
DI float softplus(float x) { return x > 20.f ? x : log1pf(__expf(x)); }
DI float gelu_tanh(float y) { const float u = 0.7978845608028654f * (y + 0.044715f * y * y * y); const float t = 1.0f - 2.0f * __builtin_amdgcn_rcpf(__expf(2.0f * u) + 1.0f); return 0.5f * y * (1.0f + t); }
DI float xshfl(float v, int src) { return __builtin_bit_cast(float, __builtin_amdgcn_ds_bpermute(src << 2, __builtin_bit_cast(int, v))); }
DI float wave_sum(float v, int lane) {
#pragma unroll
    for (int o = 1; o < 64; o <<= 1) v += xshfl(v, lane ^ o);
    return v;
}
#define MFMA32(a, b, c) __builtin_amdgcn_mfma_f32_32x32x16_bf16((a), (b), (c), 0, 0, 0)
DI int crow(int reg, int hh) { return (reg & 3) + 8 * (reg >> 2) + 4 * hh; }

typedef GAS unsigned gu32;
#define RLX_AGENT __ATOMIC_RELAXED, __HIP_MEMORY_SCOPE_AGENT
#define XB_TMO      128
#define XB_XCNT(j)  (256  + 64 * (j))
#define XB_XSUB(j)  (1280 + 64 * (j))
#define XB_XGEN(j)  (2304 + 64 * (j))
#define XB_TOP      3328
#define XB_TOPGEN   3392
#define XCD_BAR_WORDS 3456
#define XB_SPIN_CAP (1u << 18)

__device__ __forceinline__ unsigned xb_ld(unsigned* p)              { return __hip_atomic_load(p, __ATOMIC_RELAXED, __HIP_MEMORY_SCOPE_AGENT); }
__device__ __forceinline__ unsigned xb_add(unsigned* p, unsigned v) { return __hip_atomic_fetch_add(p, v, __ATOMIC_RELAXED, __HIP_MEMORY_SCOPE_AGENT); }
__device__ __forceinline__ unsigned xb_xcc_id() { return (unsigned)__builtin_amdgcn_s_getreg((3 << 11) | 20) & 0xFu; }
#define XB_SPIN(cond, bar) do { unsigned _sp = 0; while (cond) { __builtin_amdgcn_s_sleep(1); \
    if ((++_sp & 255u) == 0u) { if (xb_ld(&(bar)[XB_TMO])) break; if (_sp > XB_SPIN_CAP) { atomicAdd(&(bar)[XB_TMO], 1u); break; } } } } while (0)

struct XcdBarrier {
    unsigned* bar; unsigned x;
    volatile LAS unsigned* st;
};

__device__ __forceinline__ XcdBarrier xcd_barrier_post(unsigned* bar, volatile LAS unsigned* st) {
    XcdBarrier b; b.bar = bar; b.x = xb_xcc_id(); b.st = st;
    if (threadIdx.x == 0) (void)xb_add(&bar[XB_XCNT(b.x)], 1u);
    return b;
}
__device__ __forceinline__ void xcd_barrier_complete(unsigned* bar, unsigned x, unsigned& nloc, unsigned& nx) {
    const unsigned G = gridDim.x * gridDim.y * gridDim.z;
    unsigned sum, cnt, mine, sp = 0u;
    for (;;) {
        sum = 0u; cnt = 0u; mine = 0u;
#pragma unroll
        for (unsigned j = 0; j < 16; ++j) { const unsigned c = xb_ld(&bar[XB_XCNT(j)]); sum += c; cnt += (c > 0u) ? 1u : 0u; mine = (j == x) ? c : mine; }
        if (sum == G) break;
        __builtin_amdgcn_s_sleep(1);
        if ((++sp & 255u) == 0u) { if (xb_ld(&bar[XB_TMO])) break; if (sp > XB_SPIN_CAP) { atomicAdd(&bar[XB_TMO], 1u); break; } }
    }
    nloc = mine > 0u ? mine : 1u; nx = cnt > 0u ? cnt : 1u;
}

__device__ __forceinline__ void xcd_barrier(const XcdBarrier& b, const int tid) {
    asm volatile("s_waitcnt vmcnt(0)" ::: "memory");
    __syncthreads();
    if (tid == 0) {
        unsigned* bar = b.bar;
        __builtin_amdgcn_s_waitcnt(0);
        unsigned nloc = b.st[0], nx = b.st[1];
        if (nloc == 0u) { xcd_barrier_complete(bar, b.x, nloc, nx); b.st[0] = nloc; b.st[1] = nx; }
        const unsigned old = xb_add(&bar[XB_XSUB(b.x)], 1u);
        const unsigned gen = old / nloc;
        if (old + 1u == (gen + 1u) * nloc) {
            __builtin_amdgcn_fence(__ATOMIC_RELEASE, "agent");
            asm volatile("s_waitcnt vmcnt(0)" ::: "memory");
            const unsigned og = xb_add(&bar[XB_TOP], 1u);
            const unsigned tg = og / nx;
            if (og + 1u == (tg + 1u) * nx) xb_add(&bar[XB_TOPGEN], 1u);
            else XB_SPIN(xb_ld(&bar[XB_TOPGEN]) == tg, bar);
            __builtin_amdgcn_fence(__ATOMIC_ACQUIRE, "agent");
            xb_add(&bar[XB_XGEN(b.x)], 1u);
            asm volatile("s_waitcnt vmcnt(0)" ::: "memory");
        } else {
            XB_SPIN(xb_ld(&bar[XB_XGEN(b.x)]) == gen, bar);
            __builtin_amdgcn_fence(__ATOMIC_ACQUIRE, "agent");
            asm volatile("s_waitcnt vmcnt(0)" ::: "memory");
        }
    }
    __syncthreads();
}

struct Args { const float* in[29]; float* out; unsigned char* ws; int ph_lo, ph_hi; };
typedef const float* const __attribute__((address_space(4))) * kargp_t;
DI const float* inp(int i) { kargp_t p = (kargp_t)__builtin_amdgcn_kernarg_segment_ptr(); asm volatile("" : "+s"(p)); return (const float*)(const GAS float*)(unsigned long long)p[i]; }
struct Ctx {
    float* out; unsigned char* ws;
    unsigned char* lds;
    int tid, lane, wave, G, bid;
};
DI Ctx fresh(const Ctx& C0) { Ctx C = C0; int t = C0.tid; asm volatile("" : "+v"(t)); C.tid = t; C.lane = t & 63; C.wave = __builtin_amdgcn_readfirstlane(t >> 6); return C; }
enum { I_XP = 0, I_XS, I_SDN, I_SDNC, I_SLRU, I_SLRUC, I_SRET, I_META, I_NF1, I_WF1I, I_WF1O, I_NMIX, I_WIN, I_DNCW, I_ALOG, I_DTB, I_DNNW, I_LCW, I_LCB, I_LWA, I_LBA, I_LWX, I_LBX, I_LLAM,
       I_WOUT, I_NF2, I_WF2I, I_WF2O, I_NFIN };

template <int MODE> DI int colmap(int n) {
    if (MODE == 0) return n;
    if (MODE == 1) { const int pn = n >> 8, bj = (n >> 7) & 1, j = n & 127; return bj * DFF + 128 * pn + j; }
    return n < 1544 ? n : (n < 1792 ? -1 : n - 248);
}
template <int MODE> DI void convert_item(const float* W, int K, int Nsrc, int Ndst, const float* scale, bf16* WT, float* scr, int item, int lane) {
    const int nblk = Ndst / 32, kb = item / nblk, nb = item % nblk, k0 = 64 * kb, n0 = 32 * nb;
    const int sc = colmap<MODE>(n0 + (lane & 31));
    float wv[32];
#pragma unroll
    for (int i = 0; i < 32; ++i) { const int kk = 2 * i + (lane >> 5); wv[i] = (sc >= 0) ? W[(size_t)(k0 + kk) * Nsrc + sc] : 0.f; }
#pragma unroll
    for (int i = 0; i < 32; ++i) { const int kk = 2 * i + (lane >> 5); float v = wv[i]; if (scale) v *= scale[k0 + kk]; scr[kk * 33 + (lane & 31)] = v; }
    asm volatile("s_waitcnt lgkmcnt(0)" ::: "memory");
    const int c = lane & 7;
#pragma unroll
    for (int j = 0; j < 4; ++j) { const int n = (lane >> 3) + 8 * j; const float* s = scr + (8 * c) * 33 + n;
        u32x4 o; o.x = pk2(s[0 * 33], s[1 * 33]); o.y = pk2(s[2 * 33], s[3 * 33]); o.z = pk2(s[4 * 33], s[5 * 33]); o.w = pk2(s[6 * 33], s[7 * 33]);
        *(u32x4*)(WT + (size_t)(n0 + n) * K + k0 + 8 * c) = o; }
    asm volatile("s_waitcnt lgkmcnt(0)" ::: "memory");
}
DI void convert_set(const Ctx& C, int l, int set, int gw, int nwaves) {
    float* scr = (float*)(C.lds + C.wave * 16384);
    constexpr int I1 = 16 * 176, I2 = 44 * 32, I3 = 16 * 120, I4 = 16 * 32;
    unsigned char* wt = C.ws + WS_WT;
    if (set == 0 || set == 2 || set == 3) {
        const int lo_ = (set == 3) ? I1 : 0, hi_ = (set == 2) ? I1 : I1 + I2 + I3;
        for (int it = lo_ + gw; it < hi_; it += nwaves) { int r = it;
            if (r < I1) { convert_item<1>(inp(I_WF1I) + (size_t)l * DM * 2 * DFF, DM, 2 * DFF, 2 * DFF, inp(I_NF1) + l * DM, (bf16*)(wt + WT_F1I), scr, r, C.lane); continue; } r -= I1;
            if (r < I2) { convert_item<0>(inp(I_WF1O) + (size_t)l * DFF * DM, DFF, DM, DM, nullptr, (bf16*)(wt + WT_F1O), scr, r, C.lane); continue; } r -= I2;
            convert_item<2>(inp(I_WIN) + (size_t)l * DM * 3592, DM, 3592, DIN_PAD, inp(I_NMIX) + l * DM, (bf16*)(wt + WT_WIN), scr, r, C.lane); }
    } else {
        for (int it = gw; it < I1 + I2 + I4; it += nwaves) { int r = it;
            if (r < I1) { convert_item<1>(inp(I_WF2I) + (size_t)l * DM * 2 * DFF, DM, 2 * DFF, 2 * DFF, inp(I_NF2) + l * DM, (bf16*)(wt + WT_F2I), scr, r, C.lane); continue; } r -= I1;
            if (r < I2) { convert_item<0>(inp(I_WF2O) + (size_t)l * DFF * DM, DFF, DM, DM, nullptr, (bf16*)(wt + WT_F2O), scr, r, C.lane); continue; } r -= I2;
            convert_item<0>(inp(I_WOUT) + (size_t)l * DM * DM, DM, DM, DM, nullptr, (bf16*)(wt + WT_WOUT), scr, r, C.lane); }
    }
}
DI void convert_lru_weights(const Ctx& C) {
    const int g = C.bid * NTHREADS + C.tid;
    if (g < 2 * 2 * 4 * 64 * 64) { const int l = g >> 15, mat = (g >> 14) & 1, n = (g >> 12) & 3, e = (g >> 6) & 63, d = g & 63;
        const float v = inp(mat ? I_LWX : I_LWA)[(size_t)((l * 4 + n) * 64 + d) * 64 + e]; ((bf16*)(C.ws + WS_LWT))[g] = (bf16)f2bf(v); }
}
DI void sincos_d(double ang, double& s, double& c) {
    const double TWO_PI = 6.283185307179586476925286766559, HALF_PI = 1.5707963267948966192313216916398;
    double n = __builtin_rint(ang / TWO_PI); double r = ang - n * TWO_PI;
    double k = __builtin_rint(r / HALF_PI); double y = r - k * HALF_PI;
    const double y2 = y * y;
    double sp = 1.0 / 1307674368000.0; sp = sp * y2 - 1.0 / 6227020800.0; sp = sp * y2 + 1.0 / 39916800.0; sp = sp * y2 - 1.0 / 362880.0; sp = sp * y2 + 1.0 / 5040.0; sp = sp * y2 - 1.0 / 120.0; sp = sp * y2 + 1.0 / 6.0;
    const double sy = y - y * y2 * sp;
    double cp = 1.0 / 20922789888000.0; cp = cp * y2 - 1.0 / 87178291200.0; cp = cp * y2 + 1.0 / 479001600.0; cp = cp * y2 - 1.0 / 3628800.0; cp = cp * y2 + 1.0 / 40320.0; cp = cp * y2 - 1.0 / 720.0; cp = cp * y2 + 1.0 / 24.0;
    const double cy = 1.0 - 0.5 * y2 + y2 * y2 * cp;
    const int q = ((int)k) & 3;
    s = (q == 0) ? sy : (q == 1) ? cy : (q == 2) ? -sy : -cy;
    c = (q == 0) ? cy : (q == 1) ? -sy : (q == 2) ? -cy : sy;
}
DI void p0_rows(const Ctx& C) {
    const int gw = C.bid * NWAVES + C.wave, NGW = C.G * NWAVES;
    unsigned long long* ss0 = (unsigned long long*)(C.ws + WS_SS); bf16* XB = (bf16*)(C.ws + WS_XB); float* XE = (float*)(C.ws + WS_XE);
    for (int row = gw; row < NROWS; row += NGW) {
        const float* src = row < NPROMPT ? inp(I_XP) + (size_t)row * DM : (row < SROW0 ? inp(I_META) + (size_t)((row - NPROMPT) & 15) * DM : inp(I_XS) + (size_t)(row - SROW0) * DM);
        f32x4 v[4]; float s = 0.f;
#pragma unroll
        for (int j = 0; j < 4; ++j) { v[j] = *(const f32x4*)(src + 4 * C.lane + 256 * j); s += (v[j].x * v[j].x + v[j].y * v[j].y) + (v[j].z * v[j].z + v[j].w * v[j].w); }
        s = wave_sum(s, C.lane);
        if (C.lane == 0) ss0[row] = (unsigned long long)(s * 1048576.0f + 0.5f);
#pragma unroll
        for (int j = 0; j < 4; ++j) { u32x2 w; w.x = pk2(v[j].x, v[j].y); w.y = pk2(v[j].z, v[j].w); *(u32x2*)(XB + (size_t)row * DM + 4 * C.lane + 256 * j) = w;
            if (row >= NPROMPT) *(f32x4*)(XE + (size_t)(row - NPROMPT) * DM + 4 * C.lane + 256 * j) = v[j]; }
    }
    float* rope = (float*)(C.ws + WS_ROPE);
    for (int e = C.bid * NTHREADS + C.tid; e < 2065 * 32; e += C.G * NTHREADS) {
        const int p = e >> 5, i = e & 31; double inv = 1.0; for (int k = 0; k < i; ++k) inv *= 0.7498942093324558;
        const double pos = (p == 2064) ? 16384.0 : (double)p; double s, c; sincos_d(pos * inv, s, c);
        rope[2 * e] = (float)c; rope[2 * e + 1] = (float)s;
    }
}
DI void final_norm(const Ctx& C) {
    const int gw = C.bid * NWAVES + C.wave, NGW = C.G * NWAVES;
    const unsigned long long* ss = (const unsigned long long*)(C.ws + WS_SS) + 6 * NROWS; const float* XE = (const float*)(C.ws + WS_XE); const float* nw = inp(I_NFIN);
    f32x4 w[4];
#pragma unroll
    for (int j = 0; j < 4; ++j) w[j] = *(const f32x4*)(nw + 4 * C.lane + 256 * j);
    for (int it = gw; it < NPROMPT + NSAMP; it += NGW) {
        const int row = it < NPROMPT ? it : SROW0 + (it - NPROMPT);
        const float* src = it < NPROMPT ? C.out + O_YP + (size_t)row * DM : XE + (size_t)(row - NPROMPT) * DM;
        float* dst = it < NPROMPT ? C.out + O_YP + (size_t)row * DM : C.out + O_YS + (size_t)(it - NPROMPT) * DM;
        const float rs = 1.0f / sqrtf((float)ss[row] * (1.0f / (1024.0f * 1048576.0f)) + EPS);
#pragma unroll
        for (int j = 0; j < 4; ++j) { const f32x4 v = *(const f32x4*)(src + 4 * C.lane + 256 * j); *(f32x4*)(dst + 4 * C.lane + 256 * j) = v * rs * w[j]; }
    }
}

DI void fix_rows(const Ctx& C, int nparts, float scale, unsigned long long* ssn) {
    const int gw = C.bid * NWAVES + C.wave, NGW = C.G * NWAVES;
    const float* slab = (const float*)(C.ws + WS_SLAB); float* XE = (float*)(C.ws + WS_XE); bf16* XB = (bf16*)(C.ws + WS_XB);
    for (int job = gw; job < 256 * 4; job += NGW) {
        const int r = job >> 2, pn = job & 3;
        const float* sp = slab + (size_t)(pn * nparts) * 65536 + (size_t)r * 256 + 4 * C.lane;
        f32x4 a = (f32x4){0.f, 0.f, 0.f, 0.f};
        for (int p = 0; p < nparts; ++p) a = a + *(const f32x4*)(sp + (size_t)p * 65536);
        float* xp = XE + (size_t)r * DM + 256 * pn + 4 * C.lane;
        const f32x4 x = *(const f32x4*)xp + a * scale;
        *(f32x4*)xp = x;
        u32x2 w; w.x = pk2(x.x, x.y); w.y = pk2(x.z, x.w); *(u32x2*)(XB + (size_t)(NPROMPT + r) * DM + 256 * pn + 4 * C.lane) = w;
        const float sq = wave_sum((x.x * x.x + x.y * x.y) + (x.z * x.z + x.w * x.w), C.lane);
        if (C.lane == 0) atomicAdd(ssn + NPROMPT + r, (unsigned long long)(sq * 1048576.0f + 0.5f));
    }
}

DI void final_fix_norm(const Ctx& C, int nparts, float scale) {
    const int gw = C.bid * NWAVES + C.wave, NGW = C.G * NWAVES;
    const unsigned long long* ss = (const unsigned long long*)(C.ws + WS_SS) + 6 * NROWS; const float* nw = inp(I_NFIN);
    const float* slab = (const float*)(C.ws + WS_SLAB); const float* XE = (const float*)(C.ws + WS_XE); const bf16* XB = (const bf16*)(C.ws + WS_XB);
    f32x4 w[4];
#pragma unroll
    for (int j = 0; j < 4; ++j) w[j] = *(const f32x4*)(nw + 4 * C.lane + 256 * j);
    for (int it = gw; it < NPROMPT + NSAMP; it += NGW) {
        if (it < NSAMP) {
            const int r = 128 + it; f32x4 x[4]; float sq = 0.f;
#pragma unroll
            for (int pn = 0; pn < 4; ++pn) { const float* sp = slab + (size_t)(pn * nparts) * 65536 + (size_t)r * 256 + 4 * C.lane; f32x4 a = (f32x4){0.f, 0.f, 0.f, 0.f};
                for (int p = 0; p < nparts; ++p) a = a + *(const f32x4*)(sp + (size_t)p * 65536);
                x[pn] = *(const f32x4*)(XE + (size_t)r * DM + 256 * pn + 4 * C.lane) + a * scale; sq += (x[pn].x * x[pn].x + x[pn].y * x[pn].y) + (x[pn].z * x[pn].z + x[pn].w * x[pn].w); }
            const float rs = 1.0f / sqrtf(wave_sum(sq, C.lane) * (1.0f / 1024.0f) + EPS);
#pragma unroll
            for (int pn = 0; pn < 4; ++pn) *(f32x4*)(C.out + O_YS + (size_t)it * DM + 256 * pn + 4 * C.lane) = x[pn] * rs * w[pn];
        } else { const int row = it - NSAMP;
            const float rs = 1.0f / sqrtf((float)ss[row] * (1.0f / (1024.0f * 1048576.0f)) + EPS);
#pragma unroll
            for (int j = 0; j < 4; ++j) { const f32x4 v = ld4bf(XB + (size_t)row * DM + 4 * C.lane + 256 * j); *(f32x4*)(C.out + O_YP + (size_t)row * DM + 4 * C.lane + 256 * j) = v * rs * w[j]; } }
    }
}
DI int chunk_row0(int b, int c) { return c == 0 ? NPROMPT + 16 * b : b * 2048 + 64 * (c - 1); }
DI int halo_row(int b, int c, int back) { return c == 0 ? -1 : (c == 1 ? NPROMPT + 16 * b + 16 - back : b * 2048 + 64 * (c - 1) - back); }

constexpr int N1_R = 0, N1_QB = 52736, N1_KB = 70144, N1_RT = 87552, N1_SM = 124416, N1_CW = 126464, N1_AB = 0, N1_AD = 9216, N1_TD = 14336, N1_WS = 18432;
#define MFMA16(a, b, c) __builtin_amdgcn_mfma_f32_16x16x32_bf16((a), (b), (c), 0, 0, 0)
DI void m1_dn_item(const Ctx& C, int l, int b, int c, int h) {
    const int tid = C.tid, lane = C.lane, wid = C.wave;
    bf16* R = (bf16*)(C.lds + N1_R); bf16* QB = (bf16*)(C.lds + N1_QB); bf16* KB = (bf16*)(C.lds + N1_KB); bf16* RT = (bf16*)(C.lds + N1_RT);
    float* sm = (float*)(C.lds + N1_SM); float* CW = (float*)(C.lds + N1_CW);
    bf16* AB = (bf16*)(C.lds + N1_AB); float* AD = (float*)(C.lds + N1_AD); bf16* TD = (bf16*)(C.lds + N1_TD); bf16* WS = (bf16*)(C.lds + N1_WS);
    const bf16* PA = (const bf16*)(C.ws + WS_PA);
    const int L = (c == 0) ? 16 : 64, row0 = chunk_row0(b, c), item = (b * NCHUNK + c) * 4 + h;
    unsigned char* dni = C.ws + WS_DNI + (size_t)item * DNI_ITEM;
    { u32x4 rv[7];
#pragma unroll
      for (int k = 0; k < 7; ++k) { const int p = tid + 512 * k; rv[k] = (u32x4){0u, 0u, 0u, 0u};
          if (p < 67 * 48) { const int ri = p / 48, pc = p % 48, t = ri - 3; int row = -1;
              if (t < 0) row = halo_row(b, c, -t); else if (t < L) row = row0 + t;
              if (row >= 0) rv[k] = *(const u32x4*)(PA + (size_t)row * PA_LD + (pc >> 4) * 512 + h * 128 + 8 * (pc & 15)); } }
      f32x4 cwv = (f32x4){0.f, 0.f, 0.f, 0.f};
      if (tid < 384) { const int tap = tid / 96, q4 = tid % 96; cwv = *(const f32x4*)(inp(I_DNCW) + (size_t)l * 4 * 1536 + tap * 1536 + (q4 >> 5) * 512 + h * 128 + 4 * (q4 & 31)); }
      if (wid == 7) {
          const int t = lane; float g = 0.f, be = 0.f;
          if (t < L) { const bf16* pr = PA + (size_t)(row0 + t) * PA_LD + 1536 + h; const float a = bf1(pr[0]), bb = bf1(pr[4]);
              g = -__expf(inp(I_ALOG)[l * 4 + h]) * softplus(a + inp(I_DTB)[l * 4 + h]); be = sigm(bb); }
          float G = g;
#pragma unroll
          for (int o = 1; o < 64; o <<= 1) { const float v = xshfl(G, (lane - o) & 63); if (lane >= o) G += v; }
          const float GC = xshfl(G, 63);
          sm[t] = G; sm[64 + t] = be; sm[128 + t] = __expf(G); sm[192 + t] = __expf(GC - G);
          if (lane == 0) ((float*)(C.ws + WS_GCA))[item] = __expf(GC);
      }
#pragma unroll
      for (int k = 0; k < 7; ++k) { const int p = tid + 512 * k; if (p < 67 * 48) *(u32x4*)((unsigned char*)R + (p / 48) * 784 + (p % 48) * 16) = rv[k]; }
      if (tid < 384) { const int tap = tid / 96, q4 = tid % 96; *(f32x4*)(CW + tap * 384 + 4 * q4) = cwv; } }
    __syncthreads();
    { const int t = tid >> 3, cg = tid & 7; const bool live = t < L;
#pragma unroll
      for (int part = 0; part < 2; ++part) {
          float y[16];
#pragma unroll
          for (int j = 0; j < 16; ++j) y[j] = 0.f;
          u32x4 x3[2] = {(u32x4){0u, 0u, 0u, 0u}, (u32x4){0u, 0u, 0u, 0u}};
#pragma unroll
          for (int tap = 0; tap < 4; ++tap)
#pragma unroll
              for (int hf = 0; hf < 2; ++hf) { const u32x4 xv = *(const u32x4*)(R + (t + tap) * 392 + part * 128 + 16 * cg + 8 * hf); if (tap == 3) x3[hf] = xv;
                  const f32x4 w0 = *(const f32x4*)(CW + tap * 384 + part * 128 + 16 * cg + 8 * hf), w1 = *(const f32x4*)(CW + tap * 384 + part * 128 + 16 * cg + 8 * hf + 4);
                  y[8 * hf + 0] += w0.x * bflo(xv.x); y[8 * hf + 1] += w0.y * bfhi(xv.x); y[8 * hf + 2] += w0.z * bflo(xv.y); y[8 * hf + 3] += w0.w * bfhi(xv.y);
                  y[8 * hf + 4] += w1.x * bflo(xv.z); y[8 * hf + 5] += w1.y * bfhi(xv.z); y[8 * hf + 6] += w1.z * bflo(xv.w); y[8 * hf + 7] += w1.w * bfhi(xv.w); }
          float ss = 0.f;
#pragma unroll
          for (int j = 0; j < 16; ++j) { y[j] = live ? silu(y[j]) : 0.f; ss += y[j] * y[j]; }
          ss += xshfl(ss, lane ^ 1); ss += xshfl(ss, lane ^ 2); ss += xshfl(ss, lane ^ 4);
          const float sc = __builtin_amdgcn_rsqf(ss + EPS) * (part == 0 ? 0.08838834764831845f : 1.0f);
          bf16* dst = (part == 0 ? QB : KB) + t * 136 + 16 * cg;
          *(u32x4*)(dst) = (u32x4){pk2(y[0] * sc, y[1] * sc), pk2(y[2] * sc, y[3] * sc), pk2(y[4] * sc, y[5] * sc), pk2(y[6] * sc, y[7] * sc)};
          *(u32x4*)(dst + 8) = (u32x4){pk2(y[8] * sc, y[9] * sc), pk2(y[10] * sc, y[11] * sc), pk2(y[12] * sc, y[13] * sc), pk2(y[14] * sc, y[15] * sc)};
          if (part == 0) { const float sq = sc * sm[128 + t]; bf16* qo = (bf16*)(dni + DNI_QG) + t * 128 + 16 * cg;
              *(u32x4*)(qo) = (u32x4){pk2(y[0] * sq, y[1] * sq), pk2(y[2] * sq, y[3] * sq), pk2(y[4] * sq, y[5] * sq), pk2(y[6] * sq, y[7] * sq)};
              *(u32x4*)(qo + 8) = (u32x4){pk2(y[8] * sq, y[9] * sq), pk2(y[10] * sq, y[11] * sq), pk2(y[12] * sq, y[13] * sq), pk2(y[14] * sq, y[15] * sq)}; }
          else if (cg == 0) sm[256 + t] = sc;
          if (c == NCHUNK - 1 && t >= 61) { float* co = C.out + O_DNCP + ((size_t)(l * NB + b) * 3 + (t - 61)) * 1536 + part * 512 + h * 128 + 16 * cg;
#pragma unroll
              for (int hf = 0; hf < 2; ++hf) { *(f32x4*)(co + 8 * hf) = (f32x4){bflo(x3[hf].x), bfhi(x3[hf].x), bflo(x3[hf].y), bfhi(x3[hf].y)}; *(f32x4*)(co + 8 * hf + 4) = (f32x4){bflo(x3[hf].z), bfhi(x3[hf].z), bflo(x3[hf].w), bfhi(x3[hf].w)}; } }
      } }
    { const int t = tid >> 3, cg = tid & 7;
      if (t < L) { bf16* zp = (bf16*)(C.ws + WS_PB) + (size_t)(row0 + t) * PB_LD + h * 128 + 16 * cg; const float* nw = inp(I_DNNW) + l * 128 + 16 * cg;
          const u32x4 z0 = *(const u32x4*)(zp), z1 = *(const u32x4*)(zp + 8); const unsigned zw[8] = {z0.x, z0.y, z0.z, z0.w, z1.x, z1.y, z1.z, z1.w}; unsigned gw[8];
#pragma unroll
          for (int i = 0; i < 4; ++i) { const f32x4 g = *(const f32x4*)(nw + 4 * i);
              gw[2 * i] = pk2(g.x * silu(bflo(zw[2 * i])), g.y * silu(bfhi(zw[2 * i]))); gw[2 * i + 1] = pk2(g.z * silu(bflo(zw[2 * i + 1])), g.w * silu(bfhi(zw[2 * i + 1]))); }
          *(u32x4*)(zp) = (u32x4){gw[0], gw[1], gw[2], gw[3]}; *(u32x4*)(zp + 8) = (u32x4){gw[4], gw[5], gw[6], gw[7]}; } }
    __syncthreads();
    if (wid < 4) {
        const int part = 1 + (tid >> 7), rr = tid & 127, cq = rr & 31, tq = rr >> 5, t0 = 16 * tq;
        const float* cw = inp(I_DNCW) + (size_t)l * 4 * 1536 + part * 512 + h * 128 + 4 * cq;
        const f32x4 w0 = *(const f32x4*)(cw), w1 = *(const f32x4*)(cw + 1536), w2 = *(const f32x4*)(cw + 2 * 1536), w3 = *(const f32x4*)(cw + 3 * 1536);
        const bf16* rp = R + part * 128 + 4 * cq;
        f32x4 x0 = ld4bf(rp + (t0 + 0) * 392), x1 = ld4bf(rp + (t0 + 1) * 392), x2 = ld4bf(rp + (t0 + 2) * 392);
        unsigned rtw[4][8], kdw[4][8];
#pragma unroll
        for (int i2 = 0; i2 < 8; ++i2) {
            f32x4 rta[2], kda[2];
#pragma unroll
            for (int u = 0; u < 2; ++u) { const int t = t0 + 2 * i2 + u; const f32x4 x3 = ld4bf(rp + (t + 3) * 392);
                f32x4 y = w0 * x0 + w1 * x1 + w2 * x2 + w3 * x3; x0 = x1; x1 = x2; x2 = x3;
                y = (t < L) ? (f32x4){silu(y.x), silu(y.y), silu(y.z), silu(y.w)} : (f32x4){0.f, 0.f, 0.f, 0.f};
                if (c == NCHUNK - 1 && part == 2 && t >= 61) *(f32x4*)(C.out + O_DNCP + ((size_t)(l * NB + b) * 3 + (t - 61)) * 1536 + 1024 + h * 128 + 4 * cq) = x3;
                if (part == 1) { const f32x4 n = y * sm[256 + t]; rta[u] = n * (sm[64 + t] * sm[128 + t]); kda[u] = n * sm[192 + t]; }
                else { rta[u] = y * sm[64 + t]; kda[u] = rta[u]; } }
#pragma unroll
            for (int jj = 0; jj < 4; ++jj) { rtw[jj][i2] = pk2(rta[0][jj], rta[1][jj]); kdw[jj][i2] = pk2(kda[0][jj], kda[1][jj]); }
        }
        const int colb = (part == 1 ? 128 : 0) + 4 * cq;
#pragma unroll
        for (int jj = 0; jj < 4; ++jj) { bf16* d = RT + (colb + jj) * 72 + t0;
            *(u32x4*)(d) = (u32x4){rtw[jj][0], rtw[jj][1], rtw[jj][2], rtw[jj][3]}; *(u32x4*)(d + 8) = (u32x4){rtw[jj][4], rtw[jj][5], rtw[jj][6], rtw[jj][7]};
            if (part == 1) { bf16* ko = (bf16*)(dni + DNI_KDT) + (4 * cq + jj) * 64 + t0;
                *(u32x4*)(ko) = (u32x4){kdw[jj][0], kdw[jj][1], kdw[jj][2], kdw[jj][3]}; *(u32x4*)(ko + 8) = (u32x4){kdw[jj][4], kdw[jj][5], kdw[jj][6], kdw[jj][7]}; } }
    }
    __syncthreads();
    { const int kind = wid >> 2, ti = (wid >> 1) & 1, tj = wid & 1, r = lane & 31, hh = lane >> 5;
      const bf16* Aop = KB + (32 * ti + r) * 136 + 8 * hh; const bf16* Bop = (kind ? QB : KB) + (32 * tj + r) * 136 + 8 * hh;
      f32x16 acc;
#pragma unroll
      for (int i = 0; i < 16; ++i) acc[i] = 0.f;
#pragma unroll
      for (int ks = 0; ks < 8; ++ks) { const bf16x8 a = *(const bf16x8*)(Aop + 16 * ks), bq = *(const bf16x8*)(Bop + 16 * ks); acc = MFMA32(a, bq, acc); }
      const int t = 32 * tj + r; const float Gt = sm[t], bet = sm[64 + t];
#pragma unroll
      for (int g4 = 0; g4 < 4; ++g4) { const int i0 = 32 * ti + 8 * g4 + 4 * hh; float o[4];
#pragma unroll
          for (int e = 0; e < 4; ++e) { const int i = i0 + e; const float dec = __expf(Gt - sm[i]); const float v = acc[4 * g4 + e] * dec;
              o[e] = kind ? (t >= i ? v : 0.f) : (t > i ? bet * v : 0.f); }
          if (kind == 0) { const bool diag = (i0 >> 4) == (t >> 4);
              u32x2 w; w.x = diag ? 0u : pk2(-o[0], -o[1]); w.y = diag ? 0u : pk2(-o[2], -o[3]); *(u32x2*)(AB + t * 72 + i0) = w;
              if (diag) *(f32x4*)(AD + ((t >> 4) * 16 + (t & 15)) * 20 + (i0 & 15)) = (f32x4){o[0], o[1], o[2], o[3]}; }
          else { u32x2 w; w.x = pk2(o[0], o[1]); w.y = pk2(o[2], o[3]); *(u32x2*)((bf16*)(dni + DNI_P) + t * 64 + i0) = w; } } }
    __syncthreads();
    if (wid == 0) { const int blk = lane >> 4, j = lane & 15; float x[16];
#pragma unroll
        for (int t = 0; t < 16; ++t) x[t] = 0.f;
#pragma unroll
        for (int t = 0; t < 16; ++t) { float s = (t == j) ? 1.0f : 0.f;
#pragma unroll
            for (int s4 = 0; s4 < (t + 3) / 4; ++s4) { const f32x4 a = *(const f32x4*)(AD + (blk * 16 + t) * 20 + 4 * s4);
                s -= a.x * x[4 * s4]; s -= a.y * x[4 * s4 + 1]; s -= a.z * x[4 * s4 + 2]; s -= a.w * x[4 * s4 + 3]; }
            x[t] = s; }
#pragma unroll
        for (int t = 0; t < 16; ++t) { TD[(blk * 16 + t) * 32 + j] = (bf16)f2bf(x[t] - ((t == j) ? 1.0f : 0.f)); TD[(blk * 16 + t) * 32 + 16 + j] = (bf16)0; } }
    __syncthreads();
    { const int cl = lane & 15, kq = lane >> 4, c0 = 32 * wid;
#pragma unroll
      for (int i = 0; i < 4; ++i) {
          f32x4 acc[2];
#pragma unroll
          for (int nf = 0; nf < 2; ++nf) acc[nf] = ld4bf(RT + (c0 + 16 * nf + cl) * 72 + 16 * i + 4 * kq);
          if (i >= 1) {
#pragma unroll
              for (int ks = 0; ks < (i == 3 ? 2 : 1); ++ks) { const bf16x8 a = *(const bf16x8*)(AB + (16 * i + cl) * 72 + 32 * ks + 8 * kq);
#pragma unroll
                  for (int nf = 0; nf < 2; ++nf) { const bf16x8 bb = *(const bf16x8*)(RT + (c0 + 16 * nf + cl) * 72 + 32 * ks + 8 * kq); acc[nf] = MFMA16(a, bb, acc[nf]); } } }
#pragma unroll
          for (int nf = 0; nf < 2; ++nf) { u32x2 w; w.x = pk2(acc[nf].x, acc[nf].y); w.y = pk2(acc[nf].z, acc[nf].w); *(u32x2*)(RT + (c0 + 16 * nf + cl) * 72 + 16 * i + 4 * kq) = w; }
          asm volatile("" ::: "memory");
          const bf16x8 a2 = *(const bf16x8*)(TD + (i * 16 + cl) * 32 + 8 * kq);
#pragma unroll
          for (int nf = 0; nf < 2; ++nf) { bf16x8 b2 = *(const bf16x8*)(RT + (c0 + 16 * nf + cl) * 72 + 16 * i + 8 * (kq & 1));
              if (kq >= 2) b2 = (bf16x8){0, 0, 0, 0, 0, 0, 0, 0};
              acc[nf] = MFMA16(a2, b2, acc[nf]);
              u32x2 w; w.x = pk2(acc[nf].x, acc[nf].y); w.y = pk2(acc[nf].z, acc[nf].w); *(u32x2*)(RT + (c0 + 16 * nf + cl) * 72 + 16 * i + 4 * kq) = w;
              if (wid >= 4) { const int d = c0 - 128 + 16 * nf + cl; bf16* wp = WS + (16 * i + 4 * kq) * 136 + d;
                  wp[0] = (bf16)(w.x & 0xffffu); wp[136] = (bf16)(w.x >> 16); wp[272] = (bf16)(w.y & 0xffffu); wp[408] = (bf16)(w.y >> 16); } }
          asm volatile("" ::: "memory");
      } }
    __syncthreads();
#pragma unroll
    for (int k = 0; k < 2; ++k) { const int p = tid + 512 * k;
        *(u32x4*)(dni + DNI_UVT + 16 * p) = *(const u32x4*)((const unsigned char*)RT + (p >> 3) * 144 + (p & 7) * 16);
        *(u32x4*)(dni + DNI_W + 16 * p) = *(const u32x4*)((const unsigned char*)WS + (p >> 4) * 272 + (p & 15) * 16); }
    __syncthreads();
}

constexpr int L1_XL = 0, L1_WT = 33792, L1_LA = 33792, L1_LB = 70656, L1_XCH = 107520;
DI void m1_lru_item(const Ctx& C, int l, int b, int c) {
    const int tid = C.tid, lane = C.lane, wid = C.wave, r = lane & 31, hh = lane >> 5;
    bf16* XL = (bf16*)(C.lds + L1_XL); bf16* WT = (bf16*)(C.lds + L1_WT); bf16* LA = (bf16*)(C.lds + L1_LA); bf16* LB = (bf16*)(C.lds + L1_LB); float* xch = (float*)(C.lds + L1_XCH);
    const bf16* PB = (const bf16*)(C.ws + WS_PB);
    const int L = (c == 0) ? 16 : 64, row0 = chunk_row0(b, c);
    {
      u32x4 wv[8];
#pragma unroll
      for (int k = 0; k < 8; ++k) wv[k] = *(const u32x4*)(C.ws + WS_LWT + (size_t)l * 65536 + (size_t)(tid + 512 * k) * 16);
      const int cq = tid & 63, tq = tid >> 6, col = 4 * cq, t0 = 8 * tq;
      const float* cw = inp(I_LCW) + (size_t)l * 4 * 256 + col;
      const f32x4 w0 = *(const f32x4*)(cw), w1 = *(const f32x4*)(cw + 256), w2 = *(const f32x4*)(cw + 512), w3 = *(const f32x4*)(cw + 768), bias = *(const f32x4*)(inp(I_LCB) + l * 256 + col);
      f32x4 x0 = (f32x4){0.f, 0.f, 0.f, 0.f}, x1 = x0, x2 = x0;
      if (t0 < L) {
          if (t0 == 0) { const int r3 = halo_row(b, c, 3); if (r3 >= 0) { x0 = ld4bf(PB + (size_t)r3 * PB_LD + 512 + col); x1 = ld4bf(PB + (size_t)(r3 + 1) * PB_LD + 512 + col); x2 = ld4bf(PB + (size_t)(r3 + 2) * PB_LD + 512 + col); } }
          else { x0 = ld4bf(PB + (size_t)(row0 + t0 - 3) * PB_LD + 512 + col); x1 = ld4bf(PB + (size_t)(row0 + t0 - 2) * PB_LD + 512 + col); x2 = ld4bf(PB + (size_t)(row0 + t0 - 1) * PB_LD + 512 + col); }
      }
#pragma unroll
      for (int i = 0; i < 8; ++i) { const int t = t0 + i; f32x4 y = (f32x4){0.f, 0.f, 0.f, 0.f};
          if (t < L) { const f32x4 x3 = ld4bf(PB + (size_t)(row0 + t) * PB_LD + 512 + col); y = w0 * x0 + w1 * x1 + w2 * x2 + w3 * x3 + bias;
              if (c == NCHUNK - 1 && t >= 61) *(f32x4*)(C.out + O_LRUCP + ((size_t)(l * NB + b) * 3 + (t - 61)) * 256 + col) = x3;
              x0 = x1; x1 = x2; x2 = x3; }
          u32x2 w; w.x = pk2(y.x, y.y); w.y = pk2(y.z, y.w); *(u32x2*)(XL + t * 264 + col) = w; }
#pragma unroll
      for (int k = 0; k < 8; ++k) { const int p = tid + 512 * k; *(u32x4*)((unsigned char*)WT + (p >> 3) * 144 + (p & 7) * 16) = wv[k]; } }
    __syncthreads();
    const int n = wid >> 1, eh = wid & 1, e = n * 64 + 32 * eh + r;
    f32x16 pa[2], px[2];
#pragma unroll
    for (int th = 0; th < 2; ++th)
#pragma unroll
        for (int i = 0; i < 16; ++i) { pa[th][i] = 0.f; px[th][i] = 0.f; }
#pragma unroll
    for (int ks = 0; ks < 4; ++ks) {
        const bf16x8 ba_ = *(const bf16x8*)(WT + ((0 * 4 + n) * 64 + 32 * eh + r) * 72 + 16 * ks + 8 * hh), bx_ = *(const bf16x8*)(WT + ((1 * 4 + n) * 64 + 32 * eh + r) * 72 + 16 * ks + 8 * hh);
#pragma unroll
        for (int th = 0; th < 2; ++th) { const bf16x8 a = *(const bf16x8*)(XL + (32 * th + r) * 264 + n * 64 + 16 * ks + 8 * hh); pa[th] = MFMA32(a, ba_, pa[th]); px[th] = MFMA32(a, bx_, px[th]); } }
    __syncthreads();
    { const float ba = inp(I_LBA)[l * 256 + e], bx = inp(I_LBX)[l * 256 + e], sp = softplus(-inp(I_LLAM)[l * 256 + e]);
#pragma unroll
      for (int th = 0; th < 2; ++th)
#pragma unroll
          for (int g4 = 0; g4 < 4; ++g4) { float la4[4], bm4[4];
#pragma unroll
              for (int k = 0; k < 4; ++k) { const int t = 32 * th + 8 * g4 + 4 * hh + k; const float xv = bf1(XL[t * 264 + e]);
                  const float rg = sigm(pa[th][4 * g4 + k] + ba), ig = sigm(px[th][4 * g4 + k] + bx), la = -8.0f * rg * sp;
                  la4[k] = (t < L) ? la : 0.f; bm4[k] = (t < L) ? sqrtf(fmaxf(1.0f - __expf(2.0f * la), 0.f)) * (ig * xv) : 0.f; }
              u32x2 w; w.x = pk2(la4[0], la4[1]); w.y = pk2(la4[2], la4[3]); *(u32x2*)(LA + e * 72 + 32 * th + 8 * g4 + 4 * hh) = w;
              w.x = pk2(bm4[0], bm4[1]); w.y = pk2(bm4[2], bm4[3]); *(u32x2*)(LB + e * 72 + 32 * th + 8 * g4 + 4 * hh) = w; } }
    __syncthreads();
    { const int ec = tid & 255, th = tid >> 8; float ar[32], ai[32];
#pragma unroll
      for (int i = 0; i < 4; ++i) { const u32x4 la = *(const u32x4*)(LA + ec * 72 + 32 * th + 8 * i), lb = *(const u32x4*)(LB + ec * 72 + 32 * th + 8 * i);
          const unsigned lw[4] = {la.x, la.y, la.z, la.w}, bw[4] = {lb.x, lb.y, lb.z, lb.w};
#pragma unroll
          for (int k = 0; k < 4; ++k) { ar[8 * i + 2 * k] = __expf(bflo(lw[k])); ar[8 * i + 2 * k + 1] = __expf(bfhi(lw[k])); ai[8 * i + 2 * k] = bflo(bw[k]); ai[8 * i + 2 * k + 1] = bfhi(bw[k]); } }
      { float hl = 0.f, ac = 1.f;
#pragma unroll
        for (int t = 0; t < 32; ++t) { hl = ar[t] * hl + ai[t]; ac *= ar[t]; ai[t] = hl; ar[t] = ac; } }
      if (th == 0) { xch[2 * ec] = ai[31]; xch[2 * ec + 1] = ar[31]; }
      __syncthreads();
      if (th == 1) { const float h0 = xch[2 * ec], a0 = xch[2 * ec + 1];
#pragma unroll
        for (int t = 0; t < 32; ++t) { ai[t] = ar[t] * h0 + ai[t]; ar[t] = ar[t] * a0; }
        ((float*)(C.ws + WS_CA))[(size_t)(b * NCHUNK + c) * 256 + ec] = ar[31]; ((float*)(C.ws + WS_CB))[(size_t)(b * NCHUNK + c) * 256 + ec] = ai[31]; }
      bf16* AC = (bf16*)(C.ws + WS_LA); bf16* HL = (bf16*)(C.ws + WS_LB);
#pragma unroll
      for (int t = 0; t < 32; ++t) { const int tt = 32 * th + t;
          if (tt < L) { AC[(size_t)(row0 + tt) * 256 + ec] = (bf16)f2bf(ar[t]); HL[(size_t)(row0 + tt) * 256 + ec] = (bf16)f2bf(ai[t]); } } }
    __syncthreads();
}
DI void m1_phase(const Ctx& C0, int l) {
    constexpr int NDN = NB * NCHUNK * 4, NLRU = NB * NCHUNK;
#ifndef M1_SUB
#define M1_SUB 3
#endif
    for (int it = C0.bid; it < NDN + NLRU; it += C0.G) {
        const Ctx C = fresh(C0);
#ifndef M1_DUP
#define M1_DUP 0
#endif
        if (it < NDN) { if (M1_SUB & 1) { const int h = it & 3, bc = it >> 2; for (int rep = 0; rep < ((M1_DUP & 1) ? 2 : 1); ++rep) { const Ctx Cr = fresh(C0); m1_dn_item(Cr, l, bc / NCHUNK, bc % NCHUNK, h); } } }
        else if (M1_SUB & 2) { const int bc = it - NDN; for (int rep = 0; rep < ((M1_DUP & 2) ? 2 : 1); ++rep) { const Ctx Cr = fresh(C0); m1_lru_item(Cr, l, bc / NCHUNK, bc % NCHUNK); } }
    }
}
constexpr int M2_WL = 0, M2_QL = 17408, M2_PL = 34816, M2_KL = 44032, M2_UT = 62464, M2_ST = 80896, M2_OS = 115712;
DI void m2_dn(const Ctx& C, int l, int b, int h) {
    const int tid = C.tid, lane = C.lane, wid = C.wave, tm = wid >> 2, tn = wid & 3, r = lane & 31, hh = lane >> 5;
    bf16* WL = (bf16*)(C.lds + M2_WL); bf16* QL = (bf16*)(C.lds + M2_QL); bf16* PL = (bf16*)(C.lds + M2_PL); bf16* KL = (bf16*)(C.lds + M2_KL);
    bf16* UT = (bf16*)(C.lds + M2_UT); bf16* ST = (bf16*)(C.lds + M2_ST); float* OS = (float*)(C.lds + M2_OS);
    const bf16* PB = (const bf16*)(C.ws + WS_PB); bf16* O = (bf16*)(C.ws + WS_O); const float* GCA = (const float*)(C.ws + WS_GCA);
    f32x16 S0, S1;
#pragma unroll
    for (int i = 0; i < 16; ++i) { S0[i] = 0.f; S1[i] = 0.f; }
    for (int i = tid; i < 128 * 136 / 2; i += NTHREADS) ((unsigned*)ST)[i] = 0u;
    u32x4 pre[7];
    const unsigned char* dni0 = C.ws + WS_DNI + (size_t)((b * NCHUNK) * 4 + h) * DNI_ITEM;
#define M2_LOAD(dn) do { \
        pre[0] = *(const u32x4*)((dn) + DNI_W + 16 * tid); pre[1] = *(const u32x4*)((dn) + DNI_W + 16 * (tid + 512)); \
        pre[2] = *(const u32x4*)((dn) + DNI_QG + 16 * tid); pre[3] = *(const u32x4*)((dn) + DNI_QG + 16 * (tid + 512)); \
        pre[4] = *(const u32x4*)((dn) + DNI_P + 16 * tid); \
        pre[5] = *(const u32x4*)((dn) + DNI_KDT + 16 * tid); pre[6] = *(const u32x4*)((dn) + DNI_KDT + 16 * (tid + 512)); } while (0)
#define M2_STORE() do { \
        { const int p = tid; *(u32x4*)((unsigned char*)WL + (p >> 4) * 272 + (p & 15) * 16) = pre[0]; *(u32x4*)((unsigned char*)QL + (p >> 4) * 272 + (p & 15) * 16) = pre[2]; \
          *(u32x4*)((unsigned char*)PL + (p >> 3) * 144 + (p & 7) * 16) = pre[4]; *(u32x4*)((unsigned char*)KL + (p >> 3) * 144 + (p & 7) * 16) = pre[5]; } \
        { const int p = tid + 512; *(u32x4*)((unsigned char*)WL + (p >> 4) * 272 + (p & 15) * 16) = pre[1]; *(u32x4*)((unsigned char*)QL + (p >> 4) * 272 + (p & 15) * 16) = pre[3]; \
          *(u32x4*)((unsigned char*)KL + (p >> 3) * 144 + (p & 7) * 16) = pre[6]; } } while (0)
    M2_LOAD(dni0);
    M2_STORE();
    const int nt_ = tid >> 3, nsg = tid & 7;
    u32x2 uv[4], uvn[4]; u32x4 zz[2], zzn[2]; float egc, egcn;
#define M2_LOAD2(cc, UV, ZZ, EG) do { const unsigned char* dn_ = C.ws + WS_DNI + (size_t)((b * NCHUNK + (cc)) * 4 + h) * DNI_ITEM; \
        const bf16* uvt_ = (const bf16*)(dn_ + DNI_UVT) + (32 * tn + r) * 64 + 32 * tm + 4 * hh; \
        _Pragma("unroll") for (int g4 = 0; g4 < 4; ++g4) UV[g4] = *(const u32x2*)(uvt_ + 8 * g4); \
        EG = GCA[(b * NCHUNK + (cc)) * 4 + h]; \
        const int vr_ = ((cc) > 0 || nt_ < 16) ? chunk_row0(b, (cc)) + nt_ : chunk_row0(b, (cc)); \
        const bf16* zp_ = PB + (size_t)vr_ * PB_LD + h * 128 + 16 * nsg; ZZ[0] = *(const u32x4*)(zp_); ZZ[1] = *(const u32x4*)(zp_ + 8); } while (0)
    M2_LOAD2(0, uv, zz, egc);
    asm volatile("" :: "v"(uv[0]), "v"(uv[1]), "v"(uv[2]), "v"(uv[3]), "v"(zz[0]), "v"(zz[1]), "v"(egc));
    __syncthreads();
    u32x4 zzp[2] = {zz[0], zz[1]};
#define M2_NORM(cc) do { const int t = tid >> 3, sg = tid & 7; f32x4 v[4]; float s = 0.f; \
        _Pragma("unroll") for (int i = 0; i < 4; ++i) { v[i] = *(const f32x4*)(OS + t * 132 + 16 * sg + 4 * i); s += (v[i].x * v[i].x + v[i].y * v[i].y) + (v[i].z * v[i].z + v[i].w * v[i].w); } \
        s += xshfl(s, lane ^ 1); s += xshfl(s, lane ^ 2); s += xshfl(s, lane ^ 4); \
        const float rs = __builtin_amdgcn_rsqf(s * (1.0f / 128.0f) + EPS); \
        if ((cc) > 0 || t < 16) { const int row = chunk_row0(b, (cc)) + t; unsigned w[8]; \
            const unsigned zw[8] = {zzp[0].x, zzp[0].y, zzp[0].z, zzp[0].w, zzp[1].x, zzp[1].y, zzp[1].z, zzp[1].w}; \
            _Pragma("unroll") for (int i = 0; i < 4; ++i) { const f32x4 z = (f32x4){bflo(zw[2 * i]), bfhi(zw[2 * i]), bflo(zw[2 * i + 1]), bfhi(zw[2 * i + 1])};     \
                w[2 * i] = pk2(v[i].x * rs * z.x, v[i].y * rs * z.y); w[2 * i + 1] = pk2(v[i].z * rs * z.z, v[i].w * rs * z.w); } \
            bf16* op = O + (size_t)row * DM + h * 128 + 16 * sg; \
            *(u32x4*)(op) = (u32x4){w[0], w[1], w[2], w[3]}; *(u32x4*)(op + 8) = (u32x4){w[4], w[5], w[6], w[7]}; } } while (0)
    for (int c = 0; c < NCHUNK; ++c) {
        const int item = (b * NCHUNK + c) * 4 + h;
        const unsigned char* dni = C.ws + WS_DNI + (size_t)item * DNI_ITEM;
        if (c + 1 < NCHUNK) { M2_LOAD(dni + 4 * DNI_ITEM); M2_LOAD2(c + 1, uvn, zzn, egcn); }
        f32x16 ws, qs;
#pragma unroll
        for (int i = 0; i < 16; ++i) { ws[i] = 0.f; qs[i] = 0.f; }
#pragma unroll
        for (int ks = 0; ks < 4; ++ks) {
            const bf16x8 bfr = *(const bf16x8*)(ST + (32 * tn + r) * 136 + 16 * ks + 8 * hh);
            const bf16x8 aw = *(const bf16x8*)(WL + (32 * tm + r) * 136 + 16 * ks + 8 * hh), aq = *(const bf16x8*)(QL + (32 * tm + r) * 136 + 16 * ks + 8 * hh);
            ws = MFMA32(aw, bfr, ws); qs = MFMA32(aq, bfr, qs); }
        if (c > 0) M2_NORM(c - 1);
#pragma unroll
        for (int ks = 4; ks < 8; ++ks) {
            const bf16x8 bfr = *(const bf16x8*)(ST + (32 * tn + r) * 136 + 16 * ks + 8 * hh);
            const bf16x8 aw = *(const bf16x8*)(WL + (32 * tm + r) * 136 + 16 * ks + 8 * hh), aq = *(const bf16x8*)(QL + (32 * tm + r) * 136 + 16 * ks + 8 * hh);
            ws = MFMA32(aw, bfr, ws); qs = MFMA32(aq, bfr, qs); }
        {
#pragma unroll
          for (int g4 = 0; g4 < 4; ++g4) { const f32x4 uf = (f32x4){bflo(uv[g4].x), bfhi(uv[g4].x), bflo(uv[g4].y), bfhi(uv[g4].y)};
              u32x2 w; w.x = pk2(uf.x - ws[4 * g4], uf.y - ws[4 * g4 + 1]); w.y = pk2(uf.z - ws[4 * g4 + 2], uf.w - ws[4 * g4 + 3]);
              *(u32x2*)(UT + (32 * tn + r) * 72 + 32 * tm + 8 * g4 + 4 * hh) = w; } }
        __syncthreads();
        { S0 = S0 * egc; S1 = S1 * egc;
#pragma unroll
          for (int ks = 0; ks < 4; ++ks) {
              const bf16x8 bfr = *(const bf16x8*)(UT + (32 * tn + r) * 72 + 16 * ks + 8 * hh);
              const bf16x8 ap = *(const bf16x8*)(PL + (32 * tm + r) * 72 + 16 * ks + 8 * hh);
              const bf16x8 a0 = *(const bf16x8*)(KL + (64 * tm + r) * 72 + 16 * ks + 8 * hh), a1 = *(const bf16x8*)(KL + (64 * tm + 32 + r) * 72 + 16 * ks + 8 * hh);
              qs = MFMA32(ap, bfr, qs); S0 = MFMA32(a0, bfr, S0); S1 = MFMA32(a1, bfr, S1); } }
        __syncthreads();
#pragma unroll
        for (int g4 = 0; g4 < 4; ++g4) {
            u32x2 w; w.x = pk2(S0[4 * g4], S0[4 * g4 + 1]); w.y = pk2(S0[4 * g4 + 2], S0[4 * g4 + 3]); *(u32x2*)(ST + (32 * tn + r) * 136 + 64 * tm + 8 * g4 + 4 * hh) = w;
            w.x = pk2(S1[4 * g4], S1[4 * g4 + 1]); w.y = pk2(S1[4 * g4 + 2], S1[4 * g4 + 3]); *(u32x2*)(ST + (32 * tn + r) * 136 + 64 * tm + 32 + 8 * g4 + 4 * hh) = w; }
#pragma unroll
        for (int i = 0; i < 16; ++i) OS[(32 * tm + crow(i, hh)) * 132 + 32 * tn + r] = qs[i];
        zzp[0] = zz[0]; zzp[1] = zz[1];
        if (c + 1 < NCHUNK) { M2_STORE();
#pragma unroll
            for (int g4 = 0; g4 < 4; ++g4) uv[g4] = uvn[g4];
            zz[0] = zzn[0]; zz[1] = zzn[1]; egc = egcn; }
        __syncthreads();
    }
    M2_NORM(NCHUNK - 1);
#undef M2_NORM
#undef M2_LOAD
#undef M2_LOAD2
#undef M2_STORE
    { float* so = C.out + O_DNP + ((size_t)((l * NB + b) * 4 + h)) * 16384;
#pragma unroll
      for (int i = 0; i < 16; ++i) { so[(size_t)(64 * tm + crow(i, hh)) * 128 + 32 * tn + r] = S0[i]; so[(size_t)(64 * tm + 32 + crow(i, hh)) * 128 + 32 * tn + r] = S1[i]; } }
}

constexpr int R_QL = 0, R_QG = 9216, R_KL = 18432, R_KDT = 27648, R_VT = 36864, R_ST = 46080, R_PL = 55296, R_OS = 64512, R_GL = 81920;
DI void m2_ret(const Ctx& C, int l, int b, int h) {
    const int tid = C.tid, lane = C.lane, wid = C.wave, r = lane & 31, hh = lane >> 5;
    bf16* QL = (bf16*)(C.lds + R_QL); bf16* QG = (bf16*)(C.lds + R_QG); bf16* KL = (bf16*)(C.lds + R_KL); bf16* KDT = (bf16*)(C.lds + R_KDT); bf16* VT = (bf16*)(C.lds + R_VT);
    bf16* ST = (bf16*)(C.lds + R_ST); bf16* PL = (bf16*)(C.lds + R_PL); float* OS = (float*)(C.lds + R_OS); bf16* GL = (bf16*)(C.lds + R_GL);
    const bf16* PB = (const bf16*)(C.ws + WS_PB); bf16* O = (bf16*)(C.ws + WS_O); const float* rope = (const float*)(C.ws + WS_ROPE);
    const float lg = (h == 0) ? -0.0317486983145803f : (h == 1) ? -0.015748356968139168f : (h == 2) ? -0.007843177461025893f : -0.003913899321136329f;
    f32x16 acc;
#pragma unroll
    for (int i = 0; i < 16; ++i) acc[i] = 0.f;
    for (int i = tid; i < 64 * 72 / 2; i += NTHREADS) ((unsigned*)ST)[i] = 0u;
    __syncthreads();
    u32x2 rq1, rq2, rk1, rk2; u32x4 rv, rg; f32x4 rc0, rc1;
    u32x2 nq1, nq2, nk1, nk2; u32x4 nv, ng; f32x4 nc0, nc1;
#define R_LOAD(cc, Q1, Q2, K1, K2, VV, GV, C0_, C1_) do { const int t_ = tid >> 3, j_ = tid & 7; const int L_ = ((cc) == 0) ? 16 : 64; \
        const bf16* pr_ = PB + (size_t)(chunk_row0(b, (cc)) + (t_ < L_ ? t_ : 0)) * PB_LD; \
        Q1 = *(const u32x2*)(pr_ + 1024 + 64 * h + 4 * j_); Q2 = *(const u32x2*)(pr_ + 1024 + 64 * h + 32 + 4 * j_); K1 = *(const u32x2*)(pr_ + 1280 + 64 * h + 4 * j_); K2 = *(const u32x2*)(pr_ + 1280 + 64 * h + 32 + 4 * j_); \
        VV = *(const u32x4*)(pr_ + 1536 + 64 * h + 8 * j_); GV = *(const u32x4*)(pr_ + 1792 + 64 * h + 8 * j_); \
        const float* rp_ = rope + ((size_t)((((cc) == 0) ? 0 : 16 + 64 * ((cc) - 1)) + t_) * 32 + 4 * j_) * 2; C0_ = *(const f32x4*)(rp_); C1_ = *(const f32x4*)(rp_ + 4); } while (0)
    R_LOAD(0, rq1, rq2, rk1, rk2, rv, rg, rc0, rc1);
    asm volatile("" :: "v"(rq1), "v"(rq2), "v"(rk1), "v"(rk2), "v"(rv), "v"(rg), "v"(rc0), "v"(rc1));
    for (int c = 0; c < NCHUNK; ++c) {
        const int L = (c == 0) ? 16 : 64, row0 = chunk_row0(b, c);
        if (c + 1 < NCHUNK) R_LOAD(c + 1, nq1, nq2, nk1, nk2, nv, ng, nc0, nc1);
        { const int t = tid >> 3, j = tid & 7;
          f32x4 q1 = (f32x4){0.f, 0.f, 0.f, 0.f}, q2 = q1, k1 = q1, k2 = q1; u32x4 vv = (u32x4){0u, 0u, 0u, 0u}, gv = vv;
          if (t < L) { q1 = (f32x4){bflo(rq1.x), bfhi(rq1.x), bflo(rq1.y), bfhi(rq1.y)}; q2 = (f32x4){bflo(rq2.x), bfhi(rq2.x), bflo(rq2.y), bfhi(rq2.y)};
              k1 = (f32x4){bflo(rk1.x), bfhi(rk1.x), bflo(rk1.y), bfhi(rk1.y)}; k2 = (f32x4){bflo(rk2.x), bfhi(rk2.x), bflo(rk2.y), bfhi(rk2.y)}; vv = rv; gv = rg; }
          const f32x4 cs0 = rc0, cs1 = rc1;
          const float cc[4] = {cs0.x, cs0.z, cs1.x, cs1.z}, sn[4] = {cs0.y, cs0.w, cs1.y, cs1.w};
          const float dq = __expf(lg * (float)(t + 1)), dk = (t < L) ? 0.125f * __expf(lg * (float)(L - 1 - t)) : 0.f;
          float qa[4], qb[4], ka[4], kb[4];
#pragma unroll
          for (int e = 0; e < 4; ++e) { qa[e] = q1[e] * cc[e] - q2[e] * sn[e]; qb[e] = q1[e] * sn[e] + q2[e] * cc[e]; ka[e] = k1[e] * cc[e] - k2[e] * sn[e]; kb[e] = k1[e] * sn[e] + k2[e] * cc[e]; }
          u32x2 w;
          w.x = pk2(qa[0], qa[1]); w.y = pk2(qa[2], qa[3]); *(u32x2*)(QL + t * 72 + 4 * j) = w; w.x = pk2(qb[0], qb[1]); w.y = pk2(qb[2], qb[3]); *(u32x2*)(QL + t * 72 + 32 + 4 * j) = w;
          w.x = pk2(qa[0] * dq, qa[1] * dq); w.y = pk2(qa[2] * dq, qa[3] * dq); *(u32x2*)(QG + t * 72 + 4 * j) = w; w.x = pk2(qb[0] * dq, qb[1] * dq); w.y = pk2(qb[2] * dq, qb[3] * dq); *(u32x2*)(QG + t * 72 + 32 + 4 * j) = w;
          w.x = pk2(ka[0] * 0.125f, ka[1] * 0.125f); w.y = pk2(ka[2] * 0.125f, ka[3] * 0.125f); *(u32x2*)(KL + t * 72 + 4 * j) = w;
          w.x = pk2(kb[0] * 0.125f, kb[1] * 0.125f); w.y = pk2(kb[2] * 0.125f, kb[3] * 0.125f); *(u32x2*)(KL + t * 72 + 32 + 4 * j) = w;
#pragma unroll
          for (int e = 0; e < 4; ++e) { KDT[(4 * j + e) * 72 + t] = (bf16)f2bf(ka[e] * dk); KDT[(32 + 4 * j + e) * 72 + t] = (bf16)f2bf(kb[e] * dk); }
          const unsigned vw[4] = {vv.x, vv.y, vv.z, vv.w};
#pragma unroll
          for (int e = 0; e < 4; ++e) { VT[(8 * j + 2 * e) * 72 + t] = (bf16)(vw[e] & 0xffffu); VT[(8 * j + 2 * e + 1) * 72 + t] = (bf16)(vw[e] >> 16); }
          *(u32x4*)(GL + t * 72 + 8 * j) = gv; }
        __syncthreads();
        if (wid < 4) { const int ti = wid >> 1, tj = wid & 1; f32x16 p;
#pragma unroll
            for (int i = 0; i < 16; ++i) p[i] = 0.f;
#pragma unroll
            for (int ks = 0; ks < 4; ++ks) { const bf16x8 a = *(const bf16x8*)(KL + (32 * ti + r) * 72 + 16 * ks + 8 * hh), bq = *(const bf16x8*)(QL + (32 * tj + r) * 72 + 16 * ks + 8 * hh); p = MFMA32(a, bq, p); }
            const int t = 32 * tj + r;
#pragma unroll
            for (int g4 = 0; g4 < 4; ++g4) { const int i0 = 32 * ti + 8 * g4 + 4 * hh; float o[4];
#pragma unroll
                for (int e = 0; e < 4; ++e) { const int i = i0 + e; o[e] = (t >= i) ? p[4 * g4 + e] * __expf(lg * (float)(t - i)) : 0.f; }
                u32x2 w; w.x = pk2(o[0], o[1]); w.y = pk2(o[2], o[3]); *(u32x2*)(PL + t * 72 + i0) = w; }
        } else { const int tm = (wid >> 1) & 1, en = wid & 1;
#pragma unroll
            for (int i = 0; i < 16; ++i) acc[i] = 0.f;
#pragma unroll
            for (int ks = 0; ks < 4; ++ks) { const bf16x8 a = *(const bf16x8*)(QG + (32 * tm + r) * 72 + 16 * ks + 8 * hh), bs = *(const bf16x8*)(ST + (32 * en + r) * 72 + 16 * ks + 8 * hh); acc = MFMA32(a, bs, acc); }
        }
        __syncthreads();
        if (wid < 4) { const int dm = wid >> 1, en = wid & 1; acc = acc * __expf(lg * (float)L);
#pragma unroll
            for (int ks = 0; ks < 4; ++ks) { const bf16x8 a = *(const bf16x8*)(KDT + (32 * dm + r) * 72 + 16 * ks + 8 * hh), bv = *(const bf16x8*)(VT + (32 * en + r) * 72 + 16 * ks + 8 * hh); acc = MFMA32(a, bv, acc); }
        } else { const int tm = (wid >> 1) & 1, en = wid & 1;
#pragma unroll
            for (int ks = 0; ks < 4; ++ks) { const bf16x8 a = *(const bf16x8*)(PL + (32 * tm + r) * 72 + 16 * ks + 8 * hh), bv = *(const bf16x8*)(VT + (32 * en + r) * 72 + 16 * ks + 8 * hh); acc = MFMA32(a, bv, acc); }
        }
        __syncthreads();
        if (wid < 4) { const int dm = wid >> 1, en = wid & 1;
#pragma unroll
            for (int g4 = 0; g4 < 4; ++g4) { u32x2 w; w.x = pk2(acc[4 * g4], acc[4 * g4 + 1]); w.y = pk2(acc[4 * g4 + 2], acc[4 * g4 + 3]); *(u32x2*)(ST + (32 * en + r) * 72 + 32 * dm + 8 * g4 + 4 * hh) = w; }
        } else { const int tm = (wid >> 1) & 1, en = wid & 1;
#pragma unroll
            for (int i = 0; i < 16; ++i) OS[(32 * tm + crow(i, hh)) * 68 + 32 * en + r] = acc[i];
        }
        __syncthreads();
        { const int t = tid >> 3, sg = tid & 7; const f32x4 v0 = *(const f32x4*)(OS + t * 68 + 8 * sg), v1 = *(const f32x4*)(OS + t * 68 + 8 * sg + 4);
          float s = (v0.x + v0.y) + (v0.z + v0.w) + (v1.x + v1.y) + (v1.z + v1.w);
          s += xshfl(s, lane ^ 1); s += xshfl(s, lane ^ 2); s += xshfl(s, lane ^ 4);
          const float mu = s * (1.0f / 64.0f);
          const f32x4 d0 = v0 - mu, d1 = v1 - mu; float q = (d0.x * d0.x + d0.y * d0.y) + (d0.z * d0.z + d0.w * d0.w) + (d1.x * d1.x + d1.y * d1.y) + (d1.z * d1.z + d1.w * d1.w);
          q += xshfl(q, lane ^ 1); q += xshfl(q, lane ^ 2); q += xshfl(q, lane ^ 4);
          const float rs = __builtin_amdgcn_rsqf(q * (1.0f / 64.0f) + EPS);
          if (t < L) { const u32x4 gv = *(const u32x4*)(GL + t * 72 + 8 * sg); u32x4 w;
              w.x = pk2(d0.x * rs * silu(bflo(gv.x)), d0.y * rs * silu(bfhi(gv.x))); w.y = pk2(d0.z * rs * silu(bflo(gv.y)), d0.w * rs * silu(bfhi(gv.y)));
              w.z = pk2(d1.x * rs * silu(bflo(gv.z)), d1.y * rs * silu(bfhi(gv.z))); w.w = pk2(d1.z * rs * silu(bflo(gv.w)), d1.w * rs * silu(bfhi(gv.w)));
              *(u32x4*)(O + (size_t)(row0 + t) * DM + 768 + 64 * h + 8 * sg) = w; } }
        if (c + 1 < NCHUNK) { rq1 = nq1; rq2 = nq2; rk1 = nk1; rk2 = nk2; rv = nv; rg = ng; rc0 = nc0; rc1 = nc1; }
        __syncthreads();
    }
#undef R_LOAD
    if (wid < 4) { const int dm = wid >> 1, en = wid & 1; float* so = C.out + O_RETP + ((size_t)((l * NB + b) * 4 + h)) * 4096;
#pragma unroll
        for (int i = 0; i < 16; ++i) so[(size_t)(32 * dm + crow(i, hh)) * 64 + 32 * en + r] = acc[i]; }
}

DI void m2_lru_item(const Ctx& C, int l, int b, int c) {
    const int e = C.tid & 255, th = C.tid >> 8;
    const bf16* AC = (const bf16*)(C.ws + WS_LA); const bf16* HL = (const bf16*)(C.ws + WS_LB); const bf16* PB = (const bf16*)(C.ws + WS_PB); bf16* O = (bf16*)(C.ws + WS_O);
    const float* CA = (const float*)(C.ws + WS_CA) + (size_t)(b * NCHUNK) * 256 + e; const float* CB = (const float*)(C.ws + WS_CB) + (size_t)(b * NCHUNK) * 256 + e;
    float hin = 0.f;
#pragma unroll 8
    for (int cc = 0; cc < c; ++cc) hin = CA[cc * 256] * hin + CB[cc * 256];
    const int L = (c == 0) ? 16 : 64, row0 = chunk_row0(b, c);
#pragma unroll 8
    for (int t = 0; t < 32; ++t) { const int tt = 32 * th + t;
        if (tt < L) { const size_t row = (size_t)(row0 + tt);
            const float hv = bf1(AC[row * 256 + e]) * hin + bf1(HL[row * 256 + e]);
            O[row * DM + 512 + e] = (bf16)f2bf(hv * gelu_tanh(bf1(PB[row * PB_LD + 768 + e]))); } }
    if (c == NCHUNK - 1 && th == 1) C.out[O_LRUP + (size_t)(l * NB + b) * 256 + e] = CA[c * 256] * hin + CB[c * 256];
}
DI void ms_dn(const Ctx& C, int l, int s, int h) {
    const int tid = C.tid, lane = C.lane, wid = C.wave, row = SROW0 + s;
    float* sh = (float*)C.lds; float* scal = sh + 384; float* Ush = sh + 400; float* osh = sh + 528; float* red = sh + 1024;
    const bf16* PA = (const bf16*)(C.ws + WS_PA); const bf16* PB = (const bf16*)(C.ws + WS_PB); bf16* O = (bf16*)(C.ws + WS_O);
    const int e4 = tid & 31, dg = tid >> 5;
    const float* S0p = inp(I_SDN) + ((size_t)((l * NSAMP + s) * 4 + h) * 128) * 128;
    f32x4 sv[8];
#pragma unroll
    for (int i = 0; i < 8; ++i) sv[i] = *(const f32x4*)(S0p + (size_t)(8 * dg + i) * 128 + 4 * e4);
    const int part = tid >> 7, d_ = tid & 127, col = (part < 3 ? part : 0) * 512 + h * 128 + d_;
    const float* buf = inp(I_SDNC) + ((size_t)(l * NSAMP + s) * 3) * 1536 + col; const float* cw = inp(I_DNCW) + (size_t)l * 4 * 1536 + col;
    const float x0 = buf[0], x1 = buf[1536], x2 = buf[3072], x3 = bf1(PA[(size_t)row * PA_LD + col]), c0 = cw[0], c1 = cw[1536], c2 = cw[3072], c3 = cw[4608];
    const float a_ = bf1(PA[(size_t)row * PA_LD + 1536 + h]), b_ = bf1(PA[(size_t)row * PA_LD + 1540 + h]), alog = inp(I_ALOG)[l * 4 + h], dtb = inp(I_DTB)[l * 4 + h];
    const float z0 = bf1(PB[(size_t)row * PB_LD + h * 128 + lane]), z1 = bf1(PB[(size_t)row * PB_LD + h * 128 + 64 + lane]), nw0 = inp(I_DNNW)[l * 128 + lane], nw1 = inp(I_DNNW)[l * 128 + 64 + lane];
    if (tid < 384) { sh[part * 128 + d_] = silu(c0 * x0 + c1 * x1 + c2 * x2 + c3 * x3);
        float* co = C.out + O_DNCS + ((size_t)(l * NSAMP + s) * 3) * 1536 + col; co[0] = x1; co[1536] = x2; co[3072] = x3; }
    __syncthreads();
    if (wid < 2) { const float v0 = sh[wid * 128 + lane], v1 = sh[wid * 128 + 64 + lane]; const float ss = wave_sum(v0 * v0 + v1 * v1, lane);
        const float sc = __builtin_amdgcn_rsqf(ss + EPS) * (wid == 0 ? 0.08838834764831845f : 1.0f); sh[wid * 128 + lane] = v0 * sc; sh[wid * 128 + 64 + lane] = v1 * sc; }
    __syncthreads();
    if (wid == 0) { const float qk = wave_sum(sh[lane] * sh[128 + lane] + sh[64 + lane] * sh[192 + lane], lane);
        if (lane == 0) { const float g = -__expf(alog) * softplus(a_ + dtb); scal[0] = qk; scal[1] = __expf(g); scal[2] = sigm(b_); } }
    f32x4 kS = (f32x4){0.f, 0.f, 0.f, 0.f}, qS = kS;
#pragma unroll
    for (int i = 0; i < 8; ++i) { const int d = 8 * dg + i; kS = kS + sv[i] * sh[128 + d]; qS = qS + sv[i] * sh[d]; }
    *(f32x4*)(red + dg * 256 + 4 * e4) = kS; *(f32x4*)(red + dg * 256 + 128 + 4 * e4) = qS;
    __syncthreads();
    if (tid < 128) { float ks = 0.f, qs = 0.f;
#pragma unroll
        for (int g = 0; g < 16; ++g) { ks += red[g * 256 + tid]; qs += red[g * 256 + 128 + tid]; }
        const float eG = scal[1], U = scal[2] * (sh[256 + tid] - eG * ks); Ush[tid] = U; osh[tid] = eG * qs + scal[0] * U; }
    __syncthreads();
    { const f32x4 U4 = *(const f32x4*)(Ush + 4 * e4); const float eG = scal[1];
      float* So = C.out + O_DNS + ((size_t)((l * NSAMP + s) * 4 + h) * 128) * 128;
#pragma unroll
      for (int i = 0; i < 8; ++i) { const int d = 8 * dg + i; *(f32x4*)(So + (size_t)d * 128 + 4 * e4) = sv[i] * eG + U4 * sh[128 + d]; } }
    if (wid == 0) { const float o0 = osh[lane], o1 = osh[lane + 64]; const float ss = wave_sum(o0 * o0 + o1 * o1, lane); const float rs = __builtin_amdgcn_rsqf(ss * (1.0f / 128.0f) + EPS);
        bf16* op = O + (size_t)row * DM + h * 128;
        op[lane] = (bf16)f2bf(o0 * rs * nw0 * silu(z0)); op[lane + 64] = (bf16)f2bf(o1 * rs * nw1 * silu(z1)); }
    __syncthreads();
}
DI void ms_ret(const Ctx& C, int l, int s, int h) {
    const int tid = C.tid, lane = C.lane, wid = C.wave, row = SROW0 + s;
    float* sh = (float*)C.lds; float* osh = sh + 256; float* red = sh + 1024;
    const bf16* PB = (const bf16*)(C.ws + WS_PB); bf16* O = (bf16*)(C.ws + WS_O); const float* rope = (const float*)(C.ws + WS_ROPE) + (size_t)2064 * 32 * 2;
    const float gam = 1.0f - exp2f(-5.0f - (float)h);
    const bf16* pr = PB + (size_t)row * PB_LD;
    const int e4 = tid & 15, dg = tid >> 4;
    const float* S0p = inp(I_SRET) + ((size_t)((l * NSAMP + s) * 4 + h) * 64) * 64;
    f32x4 sv[2];
#pragma unroll
    for (int i = 0; i < 2; ++i) sv[i] = *(const f32x4*)(S0p + (size_t)(2 * dg + i) * 64 + 4 * e4);
    const int i_ = tid & 31;
    const float q1 = bf1(pr[1024 + 64 * h + i_]), q2 = bf1(pr[1024 + 64 * h + 32 + i_]), k1 = bf1(pr[1280 + 64 * h + i_]), k2 = bf1(pr[1280 + 64 * h + 32 + i_]), cr = rope[2 * i_], sr = rope[2 * i_ + 1];
    const float vv = bf1(pr[1536 + 64 * h + lane]), gg = bf1(pr[1792 + 64 * h + lane]);
    if (tid < 32) { sh[i_] = q1 * cr - q2 * sr; sh[32 + i_] = q1 * sr + q2 * cr; sh[64 + i_] = 0.125f * (k1 * cr - k2 * sr); sh[96 + i_] = 0.125f * (k1 * sr + k2 * cr); }
    else if (tid >= 64 && tid < 128) sh[128 + lane] = vv;
    __syncthreads();
    if (wid == 0) { const float qk = wave_sum(sh[lane] * sh[64 + lane], lane); if (lane == 0) sh[192] = qk; }
    f32x4 qS = (f32x4){0.f, 0.f, 0.f, 0.f};
#pragma unroll
    for (int i = 0; i < 2; ++i) { const int d = 2 * dg + i; qS = qS + sv[i] * sh[d]; }
    *(f32x4*)(red + dg * 64 + 4 * e4) = qS;
    __syncthreads();
    if (tid < 64) { float qs = 0.f;
#pragma unroll
        for (int g = 0; g < 32; ++g) qs += red[g * 64 + tid];
        osh[tid] = gam * qs + sh[192] * sh[128 + tid]; }
    { const f32x4 v4 = *(const f32x4*)(sh + 128 + 4 * e4); float* So = C.out + O_RETS + ((size_t)((l * NSAMP + s) * 4 + h) * 64) * 64;
#pragma unroll
      for (int i = 0; i < 2; ++i) { const int d = 2 * dg + i; *(f32x4*)(So + (size_t)d * 64 + 4 * e4) = sv[i] * gam + v4 * sh[64 + d]; } }
    __syncthreads();
    if (wid == 0) { const float o = osh[lane]; const float mu = wave_sum(o, lane) * (1.0f / 64.0f); const float d = o - mu; const float var = wave_sum(d * d, lane) * (1.0f / 64.0f);
        O[(size_t)row * DM + 768 + 64 * h + lane] = (bf16)f2bf(d * __builtin_amdgcn_rsqf(var + EPS) * silu(gg)); }
    __syncthreads();
}
DI void ms_lru(const Ctx& C, int l, int s) {
    const int tid = C.tid, row = SROW0 + s; float* sh = (float*)C.lds;
    const bf16* PB = (const bf16*)(C.ws + WS_PB); bf16* O = (bf16*)(C.ws + WS_O);
    const int e = tid & 255, n = e >> 6, ee = e & 63;
    u32x4 wa8[8], wx8[8];
    { const unsigned char* wp = C.ws + WS_LWT + (size_t)l * 65536 + (size_t)((n * 64 + ee) * 64) * 2;
#pragma unroll
      for (int i = 0; i < 8; ++i) { wa8[i] = *(const u32x4*)(wp + 16 * i); wx8[i] = *(const u32x4*)(wp + 32768 + 16 * i); } }
    const float* buf = inp(I_SLRUC) + ((size_t)(l * NSAMP + s) * 3) * 256 + e; const float* cw = inp(I_LCW) + (size_t)l * 4 * 256 + e;
    const float x0 = buf[0], x1 = buf[256], x2 = buf[512], x3 = bf1(PB[(size_t)row * PB_LD + 512 + e]);
    const float xl = cw[0] * x0 + cw[256] * x1 + cw[512] * x2 + cw[768] * x3 + inp(I_LCB)[l * 256 + e];
    const float ba = inp(I_LBA)[l * 256 + e], bx = inp(I_LBX)[l * 256 + e], lam = inp(I_LLAM)[l * 256 + e], h0 = inp(I_SLRU)[(size_t)(l * NSAMP + s) * 256 + e], yv = bf1(PB[(size_t)row * PB_LD + 768 + e]);
    if (tid < 256) { sh[e] = xl; float* co = C.out + O_LRUCS + ((size_t)(l * NSAMP + s) * 3) * 256 + e; co[0] = x1; co[256] = x2; co[512] = x3; }
    __syncthreads();
    if (tid < 256) { float ar = 0.f, ai = 0.f;
#pragma unroll
        for (int i = 0; i < 8; ++i) { const unsigned aw[4] = {wa8[i].x, wa8[i].y, wa8[i].z, wa8[i].w}, xw[4] = {wx8[i].x, wx8[i].y, wx8[i].z, wx8[i].w};
#pragma unroll
            for (int k = 0; k < 4; ++k) { const float xa = sh[n * 64 + 8 * i + 2 * k], xb = sh[n * 64 + 8 * i + 2 * k + 1];
                ar += xa * bflo(aw[k]) + xb * bfhi(aw[k]); ai += xa * bflo(xw[k]) + xb * bfhi(xw[k]); } }
        const float rg = sigm(ar + ba), ig = sigm(ai + bx), la = -8.0f * rg * softplus(-lam);
        const float a = __expf(la), bm = sqrtf(fmaxf(1.0f - __expf(2.0f * la), 0.f)) * (ig * xl);
        const float hn = a * h0 + bm;
        C.out[O_LRUS + (size_t)(l * NSAMP + s) * 256 + e] = hn;
        O[(size_t)row * DM + 512 + e] = (bf16)f2bf(hn * gelu_tanh(yv)); }
    __syncthreads();
}
DI void m2_phase(const Ctx& C0, int l) {
    const int bid = C0.bid;
#ifndef M2_SUB
#define M2_SUB 0xf
#endif
#ifndef M2_DUP
#define M2_DUP 0
#endif
    if (bid < 32) { if (M2_SUB & 1) { for (int rep = 0; rep < ((M2_DUP & 1) ? 2 : 1); ++rep) { const Ctx Cr = fresh(C0); m2_dn(Cr, l, bid >> 2, bid & 3); __syncthreads(); } } return; }
    if (bid < 64) { if (M2_SUB & 2) { for (int rep = 0; rep < ((M2_DUP & 2) ? 2 : 1); ++rep) { const Ctx Cr = fresh(C0); m2_ret(Cr, l, (bid - 32) >> 2, (bid - 32) & 3); __syncthreads(); } } }
    else if (M2_SUB & 8) { const int nb = C0.G - 64;
        for (int rep = 0; rep < ((M2_DUP & 8) ? 2 : 1); ++rep)
        for (int it = bid - 64; it < NB * NCHUNK + NSAMP * 9; it += nb) { const Ctx C = fresh(C0);
            if (it < NB * NCHUNK) { m2_lru_item(C, l, it / NCHUNK, it % NCHUNK); }
            else { const int s = (it - NB * NCHUNK) / 9, k = (it - NB * NCHUNK) % 9;
                if (k < 4) ms_dn(C, l, s, k); else if (k < 8) ms_ret(C, l, s, k - 4); else ms_lru(C, l, s); } } }
    { const Ctx C = fresh(C0); __syncthreads();
      const int gw = (bid - 32) * NWAVES + C.wave, nw = (C0.G - 32) * NWAVES;
      convert_set(C, l, 1, gw, nw);
      if (l + 1 < 2) convert_set(C, l + 1, 0, gw, nw); }
}
constexpr int N_PHASES = 17;
#ifndef PH_MASK
#define PH_MASK 0x3ff
#endif
#define PH_EN(k) ((PH_MASK >> (k)) & 1)
#ifndef MK_PER_PHASE
#define MK_PER_PHASE 0
#endif
__global__ void __launch_bounds__(NTHREADS, 2) hybrid_fwd(Args args) {
    extern __shared__ __attribute__((aligned(16))) unsigned char lds[];
    Ctx C0;
    C0.out = args.out; C0.ws = args.ws; C0.lds = lds;
    C0.tid = threadIdx.x; C0.lane = C0.tid & 63; C0.wave = __builtin_amdgcn_readfirstlane(C0.tid >> 6); C0.G = gridDim.x; C0.bid = blockIdx.x;
    const int wave0 = C0.wave;
    volatile LAS unsigned* MISC = (volatile LAS unsigned*)((LAS unsigned char*)lds + MISC_OFF);
    if (C0.tid < 64) MISC[C0.tid] = 0u;
    __syncthreads();
    XcdBarrier bar; bar.bar = (unsigned*)(C0.ws + WS_CTL) + CW_BAR; bar.x = 0; bar.st = nullptr;
    const int lo = args.ph_lo, hi = args.ph_hi;
    if (hi - lo > 1) bar = xcd_barrier_post((unsigned*)(C0.ws + WS_CTL) + CW_BAR, MISC + 8);
    LAS unsigned char* ldsl = (LAS unsigned char*)lds;
    if (lo == 0) {
        if (PH_EN(9)) { const Ctx C = fresh(C0); p0_rows(C); convert_lru_weights(C); convert_set(C, 0, 0, C.bid * NWAVES + C.wave, C.G * NWAVES); }
        if (1 < hi) { XcdBarrier b2 = bar; asm volatile("" : "+s"(b2.bar), "+s"(b2.x)); int t0 = C0.tid; asm volatile("" : "+v"(t0)); xcd_barrier(b2, t0); }
    }
#define GRID_BAR_IN() do { XcdBarrier b4 = bar; asm volatile("" : "+s"(b4.bar), "+s"(b4.x)); xcd_barrier(b4, C.tid); } while (0)
    for (int ph = (lo == 0 ? 1 : lo); ph < hi; ++ph) {
#ifndef DUP_MASK
#define DUP_MASK 0
#endif
        const int nrep = ((DUP_MASK >> ((ph - 1) % 8)) & 1) ? 2 : 1;
        for (int rep = 0; rep < nrep; ++rep) {
        Ctx C = C0;
        { int ln = (int)__builtin_amdgcn_mbcnt_hi(~0u, __builtin_amdgcn_mbcnt_lo(~0u, 0u)); int wv = wave0; asm volatile("" : "+v"(ln), "+s"(wv)); C.lane = ln; C.wave = wv; C.tid = wv * 64 + ln; }
        { unsigned long long w = (unsigned long long)C0.ws, o = (unsigned long long)C0.out; asm volatile("" : "+s"(w), "+s"(o));
          C.ws = (unsigned char*)(GAS unsigned char*)w; C.out = (float*)(GAS float*)o; }
        { int bb = C0.bid, gg = C0.G; asm volatile("" : "+s"(bb), "+s"(gg)); C.bid = bb; C.G = gg; }
        unsigned long long* SS = (unsigned long long*)(C.ws + WS_SS);
        bf16* XB = (bf16*)(C.ws + WS_XB); bf16* H = (bf16*)(C.ws + WS_H); bf16* PA = (bf16*)(C.ws + WS_PA); bf16* PB = (bf16*)(C.ws + WS_PB); bf16* O = (bf16*)(C.ws + WS_O);
        float* XE = (float*)(C.ws + WS_XE); unsigned char* wt = C.ws + WS_WT;
            if (rep) { XcdBarrier b3 = bar; asm volatile("" : "+s"(b3.bar), "+s"(b3.x)); xcd_barrier(b3, C.tid); }
            const int l = (ph - 1) / 8, k = (ph - 1) % 8;
            unsigned long long* ss_in1 = SS + (size_t)(3 * l) * NROWS;
            if (k == 0 && PH_EN(0)) {
                pg8::Gemm g{XB, (const bf16*)(wt + WT_F1I), NROWS, 2 * DFF, DM, nullptr, 0}; pg8::StaticOrder S; S.init(NROWS, 2 * DFF, C.G, C.bid);
                pg8::EpiSwiglu E{H, DFF, ss_in1};
                pg8::gemm_phase<pg8::EpiSwiglu, pg8::StaticOrder, true, true>(ldsl, g, S, E, C.tid);
            } else if (k == 1 && PH_EN(1)) {
                pg8::Gemm g{H, (const bf16*)(wt + WT_F1O), NROWS, DM, DFF, (float*)(C.ws + WS_SLAB), DFF / 256}; pg8::SplitOrder S; S.init(DFF, C.G, C.bid);
                pg8::EpiResid E{l == 0 ? inp(I_XP) : C.out + O_YP, C.out + O_YP, XE, XB, ss_in1 + NROWS, 0.5f};
                pg8::gemm_phase<pg8::EpiResid, pg8::SplitOrder, true, true>(ldsl, g, S, E, C.tid);
                GRID_BAR_IN(); fix_rows(C, g.nparts, E.scale, E.ssn);
            } else if (k == 2 && PH_EN(2)) {
                pg8::Gemm g{XB, (const bf16*)(wt + WT_WIN), NROWS, DIN_PAD, DM, nullptr, 0}; pg8::StaticOrder S; S.init(NROWS, DIN_PAD, C.G, C.bid);
                pg8::EpiProj E{PA, PB, ss_in1 + NROWS};
                pg8::gemm_phase<pg8::EpiProj, pg8::StaticOrder, true, true>(ldsl, g, S, E, C.tid);
            } else if (k == 3 && PH_EN(3)) { m1_phase(C, l);
            } else if (k == 4 && PH_EN(4)) { m2_phase(C, l);
            } else if (k == 5 && PH_EN(5)) {
                pg8::Gemm g{O, (const bf16*)(wt + WT_WOUT), NROWS, DM, DM, (float*)(C.ws + WS_SLAB), DM / 256}; pg8::SplitOrder S; S.init(DM, C.G, C.bid);
                pg8::EpiResid E{C.out + O_YP, C.out + O_YP, XE, XB, ss_in1 + 2 * NROWS, 1.0f};
                pg8::gemm_phase<pg8::EpiResid, pg8::SplitOrder, true, true>(ldsl, g, S, E, C.tid);
                GRID_BAR_IN(); fix_rows(C, g.nparts, E.scale, E.ssn);
            } else if (k == 6 && PH_EN(6)) {
                pg8::Gemm g{XB, (const bf16*)(wt + WT_F2I), NROWS, 2 * DFF, DM, nullptr, 0}; pg8::StaticOrder S; S.init(NROWS, 2 * DFF, C.G, C.bid);
                pg8::EpiSwiglu E{H, DFF, ss_in1 + 2 * NROWS};
                pg8::gemm_phase<pg8::EpiSwiglu, pg8::StaticOrder, true, true>(ldsl, g, S, E, C.tid);
            } else if (k == 7 && PH_EN(7)) {
                pg8::Gemm g{H, (const bf16*)(wt + WT_F2O), NROWS, DM, DFF, (float*)(C.ws + WS_SLAB), DFF / 256}; pg8::SplitOrder S; S.init(DFF, C.G, C.bid);
                pg8::EpiResid E{C.out + O_YP, C.out + O_YP, XE, XB, ss_in1 + 3 * NROWS, 0.5f};
                pg8::gemm_phase<pg8::EpiResid, pg8::SplitOrder, true, true>(ldsl, g, S, E, C.tid);
                GRID_BAR_IN(); if (l == 0) fix_rows(C, g.nparts, E.scale, E.ssn); else final_fix_norm(C, g.nparts, E.scale);
            }
        }
        if (ph + 1 < hi) { XcdBarrier b2 = bar; asm volatile("" : "+s"(b2.bar), "+s"(b2.x)); int ln = (int)__builtin_amdgcn_mbcnt_hi(~0u, __builtin_amdgcn_mbcnt_lo(~0u, 0u)); int wv = wave0; asm volatile("" : "+v"(ln), "+s"(wv)); xcd_barrier(b2, wv * 64 + ln); }
    }
}

extern "C" void kernel_launch(void* const* d_in, const int* in_sizes, int n_in, void* d_out, int out_size, void* d_ws, size_t ws_size, hipStream_t stream) {
    static int grid = 0;
    if (grid == 0) {
        if (n_in != 29 || out_size != (int)O_END || ws_size < WS_END) { fprintf(stderr, "kernel_launch: unexpected shapes: n_in %d out %d ws %zu (need %zu)\n", n_in, out_size, ws_size, (size_t)WS_END); grid = -1; return; }
        int dev = 0, cus = 0, per_cu = 0;
        if (hipGetDevice(&dev) != hipSuccess || hipDeviceGetAttribute(&cus, hipDeviceAttributeMultiprocessorCount, dev) != hipSuccess) { grid = -1; return; }
        if (hipFuncSetAttribute((const void*)hybrid_fwd, hipFuncAttributeMaxDynamicSharedMemorySize, LDS_BYTES) != hipSuccess) { fprintf(stderr, "kernel_launch: hipFuncSetAttribute failed\n"); grid = -1; return; }
        if (hipOccupancyMaxActiveBlocksPerMultiprocessor(&per_cu, (const void*)hybrid_fwd, NTHREADS, LDS_BYTES) != hipSuccess || per_cu < 1) { fprintf(stderr, "kernel_launch: occupancy query says %d blocks per CU\n", per_cu); grid = -1; return; }
        (void)hipGetLastError();
        grid = cus;
        if (grid < 128) { fprintf(stderr, "kernel_launch: %d CUs: too few for this kernel's phase-role split\n", grid); grid = -1; return; }
    }
    if (grid < 0) return;
    if (hipMemsetAsync((char*)d_ws + WS_CTL, 0, CTL_ZERO_BYTES, stream) != hipSuccess) return;
    Args a{};
    for (int i = 0; i < 29; ++i) a.in[i] = (const float*)d_in[i];
    a.out = (float*)d_out; a.ws = (unsigned char*)d_ws;
#if MK_PER_PHASE
    for (int ph = 0; ph < N_PHASES; ++ph) { a.ph_lo = ph; a.ph_hi = ph + 1; hipLaunchKernelGGL(hybrid_fwd, dim3(grid), dim3(NTHREADS), LDS_BYTES, stream, a); }
#else
    a.ph_lo = 0; a.ph_hi = N_PHASES; hipLaunchKernelGGL(hybrid_fwd, dim3(grid), dim3(NTHREADS), LDS_BYTES, stream, a);
#endif
}
```

```cpp
#include <hip/hip_runtime.h>
#include <cstdio>
#include <cstdint>
namespace pg8 {
#define PG8_LAS __attribute__((address_space(3)))
typedef unsigned short bf16_t;
typedef short bf16x8 __attribute__((ext_vector_type(8)));
typedef float f32x4 __attribute__((ext_vector_type(4)));
typedef unsigned u32x4 __attribute__((ext_vector_type(4)));
constexpr int BM = 256, BK = 64, HALF = 128, HTB = HALF * BK * 2  , STAGE_BYTES = 8 * HTB, NXCD = 8, WGM = 8;

__host__ __device__ __forceinline__ int lds_byte(int r, int c) { const int st = (r >> 4) * 2 + (c >> 5), rr = r & 15, cc = c & 31, ob = rr * 64 + cc * 2; return st * 1024 + (ob ^ (((ob >> 9) & 1) << 5)); }
__host__ __device__ __forceinline__ void stage_rc(int b, int& R, int& C) { const int st = b / 1024, sb = b % 1024, swz = sb ^ (((sb >> 9) & 1) << 5); R = (st >> 1) * 16 + swz / 64; C = (st & 1) * 32 + (swz % 64) / 2; }
__host__ __device__ __forceinline__ int perm32(int rho) { const int n = rho >> 4, i = rho & 15; return 8 * (i >> 2) + 4 * n + (i & 3); }

struct Unit { int pm, pn, kt0, nkt, part; };
struct Gemm { const bf16_t* A; const bf16_t* Bt; int M, N, K; float* slab; int nparts; };

struct StaticOrder {
    int nM, nN, nwg, G, c;
    __host__ __device__ void init(int M, int N, int G_, int c_) { nM = M / BM; nN = N / BM; nwg = nM * nN; G = G_; c = c_; }
    __host__ __device__ bool next(int i, Unit& u) const {
        const long L = (long)i * G + c; if (L >= nwg) { u.pm = 0; u.pn = 0; u.kt0 = 0; u.nkt = 0; u.part = -1; return false; }
        int wgid = (int)L; { const int q = nwg / NXCD, r = nwg % NXCD, xcd = wgid % NXCD, off = wgid / NXCD; wgid = (xcd < r ? xcd * (q + 1) : r * (q + 1) + (xcd - r) * q) + off; }
        const int nig = WGM * nN, gid = wgid / nig, fm = gid * WGM, gsz = (nM - fm) < WGM ? (nM - fm) : WGM;
        u.pm = fm + ((wgid % nig) % gsz); u.pn = (wgid % nig) / gsz; u.kt0 = 0; u.nkt = 0; u.part = -1; return true;
    }
    __device__ __forceinline__ void a_ready(const Unit&) const {}
    __device__ __forceinline__ void done(const Unit&) const {}
};

__device__ __forceinline__ unsigned cvt_pk_bf16(float lo, float hi) { unsigned r; asm volatile("v_cvt_pk_bf16_f32 %0, %1, %2" : "=v"(r) : "v"(lo), "v"(hi)); return r; }
struct SplitOrder {
    StaticOrder so; int nparts;
    __host__ __device__ void init(int K, int G_, int c_) { so.init(64 * BM, 1024, G_, c_); nparts = K / BK / 4; }
    __host__ __device__ bool next(int i, Unit& u) const {
        Unit f; const bool full = so.next(i, f);
        const int L = i * so.G + so.c - so.nwg; const bool part = (L >= 0) && (L < 4 * nparts);
        const int q = part ? L / nparts : 0, p = part ? L % nparts : 0;
        Unit r; r.pm = full ? f.pm : 64; r.pn = full ? f.pn : q; r.kt0 = full ? 0 : 4 * p; r.nkt = full ? 0 : 4; r.part = full ? -1 : p;
        u = r; return full || part;
    }
    __device__ __forceinline__ void a_ready(const Unit&) const {}
    __device__ __forceinline__ void done(const Unit&) const {}
};
__device__ __forceinline__ void slab_dump(const f32x4 (&acc)[2][2][4][2], const Unit& u, float* slab, int nparts, int wr, int wc, int fr, int fq) {
    float* base = slab + (size_t)(u.pn * nparts + u.part) * 65536 + (size_t)(wr * 64 + fr) * 256 + wc * 32 + 8 * fq;
#pragma unroll
    for (int ai = 0; ai < 2; ++ai)
#pragma unroll
        for (int m = 0; m < 4; ++m)
#pragma unroll
            for (int bj = 0; bj < 2; ++bj) { float* p = base + (size_t)(ai * HALF + m * 16) * 256 + bj * HALF; *(f32x4*)p = acc[ai][bj][m][0]; *(f32x4*)(p + 4) = acc[ai][bj][m][1]; }
}
typedef unsigned u32x2 __attribute__((ext_vector_type(2)));
__device__ __forceinline__ float fast_sigmoid(float x) { return __builtin_amdgcn_rcpf(1.0f + __expf(-x)); }
__device__ __forceinline__ float fast_silu(float x) { return x * fast_sigmoid(x); }
constexpr int NP_ROWS = 16384;

struct EpiSwiglu {
    static constexpr bool PERM = true, AFTER_DRAIN = false;
    bf16_t* H; int ldh; const unsigned long long* ss;
    __device__ __forceinline__ void operator()(const f32x4 (&acc)[2][2][4][2], const Unit& u, int wr, int wc, int fr, int fq) const {
        const int row0 = u.pm * BM + wr * 64 + fr, col0 = u.pn * 128 + wc * 32 + 8 * fq;
        unsigned long long sv[8];
#pragma unroll
        for (int i = 0; i < 8; ++i) sv[i] = ss[row0 + (i >> 2) * HALF + (i & 3) * 16];
        float rsv[8];
#pragma unroll
        for (int i = 0; i < 8; ++i) rsv[i] = __builtin_amdgcn_rsqf((float)sv[i] * (1.0f / (1024.0f * 1048576.0f)) + 1e-6f);
#pragma unroll
        for (int ai = 0; ai < 2; ++ai)
#pragma unroll
            for (int m = 0; m < 4; ++m) {
                const int row = row0 + ai * HALF + m * 16;
                const float rs = rsv[ai * 4 + m];
                float hv[8];
#pragma unroll
                for (int n = 0; n < 2; ++n)
#pragma unroll
                    for (int e = 0; e < 4; ++e) { const float g = acc[ai][0][m][n][e] * rs, up = acc[ai][1][m][n][e] * rs; hv[4 * n + e] = fast_silu(g) * up; }
                u32x4 w; w.x = cvt_pk_bf16(hv[0], hv[1]); w.y = cvt_pk_bf16(hv[2], hv[3]); w.z = cvt_pk_bf16(hv[4], hv[5]); w.w = cvt_pk_bf16(hv[6], hv[7]);
                *(u32x4*)(H + (size_t)row * ldh + col0) = w;
            }
    }
};
struct EpiProj {
    static constexpr bool PERM = true, AFTER_DRAIN = false;
    bf16_t* PA; bf16_t* PB; const unsigned long long* ss;
    __device__ __forceinline__ void operator()(const f32x4 (&acc)[2][2][4][2], const Unit& u, int wr, int wc, int fr, int fq) const {
        const int row0 = u.pm * BM + wr * 64 + fr;
        bf16_t* base; int ld, colt;
        if (u.pn < 7) { base = PA; ld = 1792; colt = u.pn * 256; } else { base = PB; ld = 2048; colt = (u.pn - 7) * 256; }
        const int col0 = colt + wc * 32 + 8 * fq;
        unsigned long long sv[8];
#pragma unroll
        for (int i = 0; i < 8; ++i) sv[i] = ss[row0 + (i >> 2) * HALF + (i & 3) * 16];
        float rsv[8];
#pragma unroll
        for (int i = 0; i < 8; ++i) rsv[i] = __builtin_amdgcn_rsqf((float)sv[i] * (1.0f / (1024.0f * 1048576.0f)) + 1e-6f);
#pragma unroll
        for (int ai = 0; ai < 2; ++ai)
#pragma unroll
            for (int m = 0; m < 4; ++m) {
                const int row = row0 + ai * HALF + m * 16;
                const float rs = rsv[ai * 4 + m];
                bf16_t* rowp = base + (size_t)row * ld + col0;
#pragma unroll
                for (int bj = 0; bj < 2; ++bj) { const f32x4 v0 = acc[ai][bj][m][0] * rs, v1 = acc[ai][bj][m][1] * rs;
                    u32x4 w; w.x = cvt_pk_bf16(v0[0], v0[1]); w.y = cvt_pk_bf16(v0[2], v0[3]); w.z = cvt_pk_bf16(v1[0], v1[1]); w.w = cvt_pk_bf16(v1[2], v1[3]);
                    *(u32x4*)(rowp + bj * HALF) = w; }
            }
    }
};
struct EpiResid {
    static constexpr bool PERM = true, AFTER_DRAIN = false;
    const float* xin_lo; float* xout_lo; float* xe; bf16_t* xb; unsigned long long* ssn; float scale;
    __device__ __forceinline__ void operator()(const f32x4 (&acc)[2][2][4][2], const Unit& u, int wr, int wc, int fr, int fq) const {
        const int row0 = u.pm * BM + wr * 64 + fr, col0 = u.pn * BM + wc * 32 + 8 * fq;
        const bool lo = (u.pm * BM) < NP_ROWS;
#pragma unroll
        for (int ah = 0; ah < 4; ++ah) { const int ai = ah >> 1, mh = (ah & 1) * 2;
            f32x4 xo[2][2][2];
#pragma unroll
            for (int mm = 0; mm < 2; ++mm) { const int row = row0 + ai * HALF + (mh + mm) * 16;
                const float* xi = lo ? xin_lo + (size_t)row * 1024 : xe + (size_t)(row - NP_ROWS) * 1024;
#pragma unroll
                for (int bj = 0; bj < 2; ++bj) { xo[mm][bj][0] = *(const f32x4*)(xi + col0 + bj * HALF); xo[mm][bj][1] = *(const f32x4*)(xi + col0 + bj * HALF + 4); } }
#pragma unroll
            for (int mm = 0; mm < 2; ++mm) { const int m = mh + mm;
                const int row = row0 + ai * HALF + m * 16;
                float* xop = lo ? xout_lo + (size_t)row * 1024 : xe + (size_t)(row - NP_ROWS) * 1024;
                float sq = 0.f;
#pragma unroll
                for (int bj = 0; bj < 2; ++bj) { const int c = col0 + bj * HALF;
                    const f32x4 a0 = xo[mm][bj][0] + acc[ai][bj][m][0] * scale, a1 = xo[mm][bj][1] + acc[ai][bj][m][1] * scale;
                    *(f32x4*)(xop + c) = a0; *(f32x4*)(xop + c + 4) = a1;
                    u32x4 w; w.x = cvt_pk_bf16(a0[0], a0[1]); w.y = cvt_pk_bf16(a0[2], a0[3]); w.z = cvt_pk_bf16(a1[0], a1[1]); w.w = cvt_pk_bf16(a1[2], a1[3]);
                    *(u32x4*)(xb + (size_t)row * 1024 + c) = w;
                    sq += (a0[0] * a0[0] + a0[1] * a0[1]) + (a0[2] * a0[2] + a0[3] * a0[3]) + (a1[0] * a1[0] + a1[1] * a1[1]) + (a1[2] * a1[2] + a1[3] * a1[3]); }
                sq += __builtin_bit_cast(float, __builtin_amdgcn_ds_bpermute((fr + 16 * (fq ^ 1)) << 2, __builtin_bit_cast(int, sq))); sq += __builtin_bit_cast(float, __builtin_amdgcn_ds_bpermute((fr + 16 * (fq ^ 2)) << 2, __builtin_bit_cast(int, sq)));
                if (fq == 0) atomicAdd(ssn + row, (unsigned long long)(sq * 1048576.0f + 0.5f));
            }
        }
    }
};
template <class Epi, class Sched, bool ALIGN_EPI = false, bool SP2 = false>
__device__ __forceinline__ void gemm_phase(PG8_LAS unsigned char* lds, const Gemm g, const Sched& S, const Epi& E, const int tid_in) {
    int tid_ = tid_in; asm volatile("" : "+v"(tid_));
    const int tid = tid_, wid = __builtin_amdgcn_readfirstlane(tid >> 6), lane = tid & 63, wr = wid >> 2, wc = wid & 3, fr = lane & 15, fq = lane >> 4;
    const int K = g.K, nt = K / BK;
    unsigned voffA[2], voffB[2];
#pragma unroll
    for (int i = 0; i < 2; ++i) { int R, C; stage_rc(tid * 16 + i * 8192, R, C); const int Rb = Epi::PERM ? ((R & ~31) + perm32(R & 31)) : R;
        voffA[i] = (unsigned)(R * K + C) * 2u; voffB[i] = (unsigned)(Rb * K + C) * 2u; }
    const size_t kstep = (size_t)(BK * 2);
    const size_t hstep = (size_t)HALF * K * 2;
    const size_t tstep = 2 * hstep;
    const unsigned ldsw = (unsigned)wid * 1024u;
    const int aoff = lds_byte(wr * 64 + fr, fq * 8), boff = lds_byte(wc * 32 + fr, fq * 8);
#define PG8_SA(b, h) (((b) * 2 + (h)) * HTB)
#define PG8_SB(b, h) ((4 + (b) * 2 + (h)) * HTB)
#define PG8_STAGE(bufoff, gbase, voff) do { _Pragma("unroll") for (int _i = 0; _i < 2; ++_i) \
        __builtin_amdgcn_global_load_lds((const unsigned*)((const char*)(gbase) + (voff)[_i]), (PG8_LAS unsigned*)(lds + (bufoff) + ldsw + _i * 8192), 16, 0, 0); } while (0)
#define PG8_LDA(dst, b, h) do { _Pragma("unroll") for (int m = 0; m < 4; ++m) _Pragma("unroll") for (int k = 0; k < 2; ++k) dst[m][k] = *(const PG8_LAS bf16x8*)(lds + PG8_SA(b, h) + aoff + m * 2048 + k * 1024); } while (0)
#define PG8_LDB(dst, b, h) do { _Pragma("unroll") for (int n = 0; n < 2; ++n) _Pragma("unroll") for (int k = 0; k < 2; ++k) dst[n][k] = *(const PG8_LAS bf16x8*)(lds + PG8_SB(b, h) + boff + n * 2048 + k * 1024); } while (0)
#define PG8_MMA(ai, bj, At, Bt) do { __builtin_amdgcn_s_setprio(1); _Pragma("unroll") for (int m = 0; m < 4; ++m) _Pragma("unroll") for (int n = 0; n < 2; ++n) _Pragma("unroll") for (int k = 0; k < 2; ++k) \
        acc[ai][bj][m][n] = __builtin_amdgcn_mfma_f32_16x16x32_bf16(Bt[n][k], At[m][k], acc[ai][bj][m][n], 0, 0, 0); __builtin_amdgcn_s_setprio(0); } while (0)
#define PG8_WAIT_V(n) asm volatile("s_waitcnt vmcnt(" #n ")" ::: "memory")
#define PG8_WAIT_L(n) asm volatile("s_waitcnt lgkmcnt(" #n ")" ::: "memory")
#define PG8_BAR __builtin_amdgcn_s_barrier()
#define PG8_SCHED __builtin_amdgcn_sched_barrier(0)
    Unit cur, nxt; int ui = 0;
    if (!S.next(0, cur)) return;
    f32x4 acc[2][2][4][2];
#pragma unroll
    for (int a = 0; a < 2; ++a)
#pragma unroll
        for (int b = 0; b < 2; ++b)
#pragma unroll
            for (int m = 0; m < 4; ++m)
#pragma unroll
                for (int n = 0; n < 2; ++n) acc[a][b][m][n] = (f32x4){0.f, 0.f, 0.f, 0.f};
    bf16x8 At[4][2], B0[2][2], B1[2][2];
    int cnt = cur.nkt > 0 ? cur.nkt : nt;
    const char* cA = (const char*)g.A + (size_t)cur.pm * tstep + (size_t)cur.kt0 * kstep; const char* cB = (const char*)g.Bt + (size_t)cur.pn * tstep + (size_t)cur.kt0 * kstep;
    S.a_ready(cur);
    if constexpr (SP2) {
        PG8_STAGE(PG8_SB(0, 0), cB, voffB); PG8_STAGE(PG8_SB(0, 1), cB + hstep, voffB); PG8_STAGE(PG8_SA(0, 0), cA, voffA); PG8_STAGE(PG8_SA(0, 1), cA + hstep, voffA);
        if (wr == 1) PG8_BAR;
        PG8_WAIT_V(2); PG8_BAR;
        PG8_STAGE(PG8_SB(1, 0), cB + kstep, voffB); PG8_STAGE(PG8_SA(1, 0), cA + kstep, voffA); PG8_STAGE(PG8_SB(1, 1), cB + hstep + kstep, voffB);
        PG8_WAIT_V(6); PG8_BAR;
    } else {
        PG8_STAGE(PG8_SB(0, 0), cB, voffB); PG8_STAGE(PG8_SA(0, 0), cA, voffA); PG8_STAGE(PG8_SB(0, 1), cB + hstep, voffB); PG8_STAGE(PG8_SA(0, 1), cA + hstep, voffA);
        if (wr == 1) PG8_BAR;
        PG8_WAIT_V(4); PG8_BAR;
        PG8_STAGE(PG8_SB(1, 0), cB + kstep, voffB); PG8_STAGE(PG8_SA(1, 0), cA + kstep, voffA); PG8_STAGE(PG8_SB(1, 1), cB + hstep + kstep, voffB);
        PG8_WAIT_V(6); PG8_BAR;
    }
    for (;;) {
        const bool has_next = S.next(ui + 1, nxt);
        const char* nA = has_next ? (const char*)g.A + (size_t)nxt.pm * tstep + (size_t)nxt.kt0 * kstep : cA; const char* nB = has_next ? (const char*)g.Bt + (size_t)nxt.pn * tstep + (size_t)nxt.kt0 * kstep : cB;
        for (int t = 0; t < cnt; t += 2) {
            const bool last = (t == cnt - 2);
            const char* a1 = cA + (size_t)(t + 1) * kstep;
            const char* a2 = last ? nA : cA + (size_t)(t + 2) * kstep; const char* b2 = last ? nB : cB + (size_t)(t + 2) * kstep;
            const char* a3 = a2 + kstep; const char* b3 = b2 + kstep;
            if (last && has_next) S.a_ready(nxt);
            if constexpr (SP2) {
            PG8_LDB(B0, 0, 0); PG8_LDB(B1, 0, 1); PG8_SCHED; PG8_LDA(At, 0, 0); PG8_STAGE(PG8_SA(1, 1), a1 + hstep, voffA);
            PG8_WAIT_V(8); PG8_WAIT_L(0); PG8_BAR; PG8_MMA(0, 0, At, B0); PG8_MMA(0, 1, At, B1); PG8_BAR; PG8_SCHED;
            PG8_LDA(At, 0, 1); PG8_STAGE(PG8_SB(0, 0), b2, voffB); PG8_STAGE(PG8_SB(0, 1), b2 + hstep, voffB); PG8_STAGE(PG8_SA(0, 0), a2, voffA);
            PG8_WAIT_V(8); PG8_WAIT_L(0); PG8_BAR; PG8_MMA(1, 0, At, B0); PG8_MMA(1, 1, At, B1); PG8_BAR; PG8_SCHED;
            PG8_LDB(B0, 1, 0); PG8_LDB(B1, 1, 1); PG8_SCHED; PG8_LDA(At, 1, 0); PG8_STAGE(PG8_SA(0, 1), a2 + hstep, voffA);
            PG8_WAIT_V(8); PG8_WAIT_L(0); PG8_BAR; PG8_MMA(0, 0, At, B0); PG8_MMA(0, 1, At, B1); PG8_BAR; PG8_SCHED;
            PG8_LDA(At, 1, 1); PG8_STAGE(PG8_SB(1, 0), b3, voffB); PG8_STAGE(PG8_SB(1, 1), b3 + hstep, voffB); PG8_STAGE(PG8_SA(1, 0), a3, voffA);
            PG8_WAIT_V(8); PG8_WAIT_L(0); PG8_BAR; PG8_MMA(1, 0, At, B0); PG8_MMA(1, 1, At, B1); PG8_BAR; PG8_SCHED;
            } else {
            PG8_LDB(B0, 0, 0); PG8_SCHED; PG8_LDA(At, 0, 0); PG8_STAGE(PG8_SA(1, 1), a1 + hstep, voffA);
            PG8_WAIT_L(8); PG8_BAR; PG8_WAIT_L(0); PG8_MMA(0, 0, At, B0); PG8_BAR; PG8_SCHED;
            PG8_LDB(B1, 0, 1); PG8_STAGE(PG8_SB(0, 0), b2, voffB);
            PG8_BAR; PG8_WAIT_L(0); PG8_MMA(0, 1, At, B1); PG8_BAR;
            PG8_LDA(At, 0, 1); PG8_STAGE(PG8_SA(0, 0), a2, voffA);
            PG8_BAR; PG8_WAIT_L(0); PG8_MMA(1, 0, At, B0); PG8_BAR; PG8_SCHED;
            PG8_STAGE(PG8_SB(0, 1), b2 + hstep, voffB);
            PG8_WAIT_V(6); PG8_BAR; PG8_MMA(1, 1, At, B1); PG8_BAR;
            PG8_LDB(B0, 1, 0); PG8_SCHED; PG8_LDA(At, 1, 0); PG8_STAGE(PG8_SA(0, 1), a2 + hstep, voffA);
            PG8_WAIT_L(8); PG8_BAR; PG8_WAIT_L(0); PG8_MMA(0, 0, At, B0); PG8_BAR; PG8_SCHED;
            PG8_LDB(B1, 1, 1); PG8_STAGE(PG8_SB(1, 0), b3, voffB);
            PG8_BAR; PG8_WAIT_L(0); PG8_MMA(0, 1, At, B1); PG8_BAR;
            PG8_LDA(At, 1, 1); PG8_STAGE(PG8_SA(1, 0), a3, voffA);
            PG8_BAR; PG8_WAIT_L(0); PG8_MMA(1, 0, At, B0); PG8_BAR; PG8_SCHED;
            PG8_STAGE(PG8_SB(1, 1), b3 + hstep, voffB);
            PG8_WAIT_V(6); PG8_BAR; PG8_MMA(1, 1, At, B1); PG8_BAR;
            }
        }
        if constexpr (ALIGN_EPI) { if (wr == 0) PG8_BAR; }
        if constexpr (!Epi::AFTER_DRAIN) { if (cur.part >= 0) slab_dump(acc, cur, g.slab, g.nparts, wr, wc, fr, fq); else E(acc, cur, wr, wc, fr, fq); S.done(cur); }
        if (!has_next) break;
#pragma unroll
        for (int a = 0; a < 2; ++a)
#pragma unroll
            for (int b = 0; b < 2; ++b)
#pragma unroll
                for (int m = 0; m < 4; ++m)
#pragma unroll
                    for (int n = 0; n < 2; ++n) acc[a][b][m][n] = (f32x4){0.f, 0.f, 0.f, 0.f};
        cur = nxt; cA = nA; cB = nB; ++ui; cnt = cur.nkt > 0 ? cur.nkt : nt;
        if constexpr (ALIGN_EPI) { if (wr == 1) PG8_BAR; }
    }
    PG8_WAIT_V(0);
    if constexpr (!ALIGN_EPI) { if (wr == 0) PG8_BAR; }
    PG8_BAR;
    if constexpr (Epi::AFTER_DRAIN) { E.fused(acc, cur, wr, wc, fr, fq, lds, wid, lane); S.done(cur); }
#undef PG8_SA
#undef PG8_SB
#undef PG8_STAGE
#undef PG8_LDA
#undef PG8_LDB
#undef PG8_MMA
#undef PG8_WAIT_V
#undef PG8_WAIT_L
#undef PG8_BAR
#undef PG8_SCHED
}
}

constexpr int DM = 1024, NROWS = 16640, NPROMPT = 16384, NMETAROWS = 128, SROW0 = 16512;
constexpr int DFF = 2816, NCHUNK = 33, NB = 8, NSAMP = 128;
constexpr int PA_LD = 1792, PB_LD = 2048, DIN_PAD = 3840;
constexpr float EPS = 1e-6f;
constexpr size_t MiB = 1u << 20;
constexpr size_t WS_CTL = 0, WS_SS = 1 * MiB, CTL_ZERO_BYTES = 2 * MiB;
constexpr size_t WS_ROPE = 2 * MiB;
constexpr size_t WS_XE = 3 * MiB;
constexpr size_t WS_LWT = 6 * MiB;
constexpr size_t WS_GCA = 4 * MiB, WS_CA = 4 * MiB + 65536, WS_CB = WS_CA + 524288;
constexpr size_t WS_WT = 8 * MiB;
constexpr size_t WT_F1I = 0, WT_F1O = 11534336, WT_WIN = 17301504, WT_WOUT = 25165824, WT_F2I = 27262976, WT_F2O = 38797312, WT_END = 44564480;
constexpr size_t WS_XB = 52 * MiB;
constexpr size_t WS_R = 86 * MiB;
constexpr size_t WS_H = WS_R, WS_PA = WS_R, WS_O = WS_R, WS_PB = 144 * MiB, WS_DNI = 210 * MiB, WS_LA = 285 * MiB, WS_LB = 294 * MiB, WS_END = 303 * MiB;
static_assert(WS_SS + (size_t)7 * NROWS * 8 <= CTL_ZERO_BYTES, "ss arrays inside the memset");
static_assert(WS_WT + WT_END <= WS_XB && WS_XB + (size_t)NROWS * DM * 2 <= WS_R && WS_H + (size_t)NROWS * DFF * 2 <= WS_END, "ws map");
static_assert(WS_PA + (size_t)NROWS * PA_LD * 2 <= WS_PB && WS_PB + (size_t)NROWS * PB_LD * 2 <= WS_DNI, "ws map 2");
constexpr size_t WS_SLAB = WS_DNI;
constexpr int DNI_ITEM = 73728;
constexpr int DNI_W = 0, DNI_QG = 16384, DNI_KDT = 32768, DNI_UVT = 49152, DNI_P = 65536;
static_assert(WS_DNI + (size_t)1056 * DNI_ITEM <= WS_LA && WS_LA + (size_t)NROWS * 256 * 2 <= WS_LB && WS_LB + (size_t)NROWS * 256 * 2 <= WS_END, "ws map 3");
constexpr int CW_BAR = 4096;
constexpr size_t O_YP = 0, O_YS = 16777216, O_DNP = O_YS + 131072, O_DNCP = O_DNP + 1048576, O_LRUP = O_DNCP + 73728, O_LRUCP = O_LRUP + 4096, O_RETP = O_LRUCP + 12288,
                 O_DNS = O_RETP + 262144, O_DNCS = O_DNS + 16777216, O_LRUS = O_DNCS + 1179648, O_LRUCS = O_LRUS + 65536, O_RETS = O_LRUCS + 196608, O_END = O_RETS + 4194304;
constexpr int LDS_BYTES = 155648, MISC_OFF = LDS_BYTES - 256;
constexpr int NWAVES = 8, NTHREADS = 512;

#define GAS __attribute__((address_space(1)))
#define LAS __attribute__((address_space(3)))
typedef unsigned short bf16;
typedef float f32x4 __attribute__((ext_vector_type(4)));
typedef float f32x16 __attribute__((ext_vector_type(16)));
typedef short bf16x8 __attribute__((ext_vector_type(8)));
typedef unsigned u32x4 __attribute__((ext_vector_type(4)));
typedef unsigned u32x2 __attribute__((ext_vector_type(2)));
#define DI __device__ __forceinline__
DI unsigned f2bf(float f) { return (unsigned)__builtin_bit_cast(unsigned short, (__bf16)f); }
typedef __bf16 hwbf16x2 __attribute__((ext_vector_type(2)));
typedef float f32x2 __attribute__((ext_vector_type(2)));
DI unsigned pk2(float lo, float hi) { const f32x2 v = {lo, hi}; return __builtin_bit_cast(unsigned, __builtin_convertvector(v, hwbf16x2)); }
DI float bflo(unsigned w) { return __builtin_bit_cast(float, w << 16); }
DI float bfhi(unsigned w) { return __builtin_bit_cast(float, w & 0xffff0000u); }
DI f32x4 ld4bf(const bf16* p) { const u32x2 v = *(const u32x2*)p; return (f32x4){bflo(v.x), bfhi(v.x), bflo(v.y), bfhi(v.y)}; }
DI float bf1(bf16 b) { return __builtin_bit_cast(float, (unsigned)b << 16); }
DI float sigm(float x) { return __builtin_amdgcn_rcpf(1.0f + __expf(-x)); }
DI float silu(float x) { return x * sigm(x); }
DI float softplus(float x) { return x > 20.f ? x : log1pf(__expf(x)); }
DI float gelu_tanh(float y) { const float u = 0.7978845608028654f * (y + 0.044715f * y * y * y); const float t = 1.0f - 2.0f * __builtin_amdgcn_rcpf(__expf(2.0f * u) + 1.0f); return 0.5f * y * (1.0f + t); }
DI float xshfl(float v, int src) { return __builtin_bit_cast(float, __builtin_amdgcn_ds_bpermute(src << 2, __builtin_bit_cast(int, v))); }
DI float wave_sum(float v, int lane) {
#pragma unroll
    for (int o = 1; o < 64; o <<= 1) v += xshfl(v, lane ^ o);
    return v;
}
#define MFMA32(a, b, c) __builtin_amdgcn_mfma_f32_32x32x16_bf16((a), (b), (c), 0, 0, 0)
DI int crow(int reg, int hh) { return (reg & 3) + 8 * (reg >> 2) + 4 * hh; }

typedef GAS unsigned gu32;
#define RLX_AGENT __ATOMIC_RELAXED, __HIP_MEMORY_SCOPE_AGENT
#define XB_TMO      128
#define XB_XCNT(j)  (256  + 64 * (j))
#define XB_XSUB(j)  (1280 + 64 * (j))
#define XB_XGEN(j)  (2304 + 64 * (j))
#define XB_TOP      3328
#define XB_TOPGEN   3392
#define XCD_BAR_WORDS 3456
#define XB_SPIN_CAP (1u << 18)

__device__ __forceinline__ unsigned xb_ld(unsigned* p)              { return __hip_atomic_load(p, __ATOMIC_RELAXED, __HIP_MEMORY_SCOPE_AGENT); }
__device__ __forceinline__ unsigned xb_add(unsigned* p, unsigned v) { return __hip_atomic_fetch_add(p, v, __ATOMIC_RELAXED, __HIP_MEMORY_SCOPE_AGENT); }
__device__ __forceinline__ unsigned xb_xcc_id() { return (unsigned)__builtin_amdgcn_s_getreg((3 << 11) | 20) & 0xFu; }
#define XB_SPIN(cond, bar) do { unsigned _sp = 0; while (cond) { __builtin_amdgcn_s_sleep(1); \
    if ((++_sp & 255u) == 0u) { if (xb_ld(&(bar)[XB_TMO])) break; if (_sp > XB_SPIN_CAP) { atomicAdd(&(bar)[XB_TMO], 1u); break; } } } } while (0)

struct XcdBarrier {
    unsigned* bar; unsigned x;
    volatile LAS unsigned* st;
};

__device__ __forceinline__ XcdBarrier xcd_barrier_post(unsigned* bar, volatile LAS unsigned* st) {
    XcdBarrier b; b.bar = bar; b.x = xb_xcc_id(); b.st = st;
    if (threadIdx.x == 0) (void)xb_add(&bar[XB_XCNT(b.x)], 1u);
    return b;
}
__device__ __forceinline__ void xcd_barrier_complete(unsigned* bar, unsigned x, unsigned& nloc, unsigned& nx) {
    const unsigned G = gridDim.x * gridDim.y * gridDim.z;
    unsigned sum, cnt, mine, sp = 0u;
    for (;;) {
        sum = 0u; cnt = 0u; mine = 0u;
#pragma unroll
        for (unsigned j = 0; j < 16; ++j) { const unsigned c = xb_ld(&bar[XB_XCNT(j)]); sum += c; cnt += (c > 0u) ? 1u : 0u; mine = (j == x) ? c : mine; }
        if (sum == G) break;
        __builtin_amdgcn_s_sleep(1);
        if ((++sp & 255u) == 0u) { if (xb_ld(&bar[XB_TMO])) break; if (sp > XB_SPIN_CAP) { atomicAdd(&bar[XB_TMO], 1u); break; } }
    }
    nloc = mine > 0u ? mine : 1u; nx = cnt > 0u ? cnt : 1u;
}

__device__ __forceinline__ void xcd_barrier(const XcdBarrier& b, const int tid) {
    asm volatile("s_waitcnt vmcnt(0)" ::: "memory");
    __syncthreads();
    if (tid == 0) {
        unsigned* bar = b.bar;
        __builtin_amdgcn_s_waitcnt(0);
        unsigned nloc = b.st[0], nx = b.st[1];
        if (nloc == 0u) { xcd_barrier_complete(bar, b.x, nloc, nx); b.st[0] = nloc; b.st[1] = nx; }
        const unsigned old = xb_add(&bar[XB_XSUB(b.x)], 1u);
        const unsigned gen = old / nloc;
        if (old + 1u == (gen + 1u) * nloc) {
            __builtin_amdgcn_fence(__ATOMIC_RELEASE, "agent");
            asm volatile("s_waitcnt vmcnt(0)" ::: "memory");
            const unsigned og = xb_add(&bar[XB_TOP], 1u);
            const unsigned tg = og / nx;
            if (og + 1u == (tg + 1u) * nx) xb_add(&bar[XB_TOPGEN], 1u);
            else XB_SPIN(xb_ld(&bar[XB_TOPGEN]) == tg, bar);
            __builtin_amdgcn_fence(__ATOMIC_ACQUIRE, "agent");
            xb_add(&bar[XB_XGEN(b.x)], 1u);
            asm volatile("s_waitcnt vmcnt(0)" ::: "memory");
        } else {
            XB_SPIN(xb_ld(&bar[XB_XGEN(b.x)]) == gen, bar);
            __builtin_amdgcn_fence(__ATOMIC_ACQUIRE, "agent");
            asm volatile("s_waitcnt vmcnt(0)" ::: "memory");
        }
    }
    __syncthreads();
}

struct Args { const float* in[29]; float* out; unsigned char* ws; int ph_lo, ph_hi; };
typedef const float* const __attribute__((address_space(4))) * kargp_t;
DI const float* inp(int i) { kargp_t p = (kargp_t)__builtin_amdgcn_kernarg_segment_ptr(); asm volatile("" : "+s"(p)); return (const float*)(const GAS float*)(unsigned long long)p[i]; }
struct Ctx {
    float* out; unsigned char* ws;
    unsigned char* lds;
    int tid, lane, wave, G, bid;
};
DI Ctx fresh(const Ctx& C0) { Ctx C = C0; int t = C0.tid; asm volatile("" : "+v"(t)); C.tid = t; C.lane = t & 63; C.wave = __builtin_amdgcn_readfirstlane(t >> 6); return C; }
enum { I_XP = 0, I_XS, I_SDN, I_SDNC, I_SLRU, I_SLRUC, I_SRET, I_META, I_NF1, I_WF1I, I_WF1O, I_NMIX, I_WIN, I_DNCW, I_ALOG, I_DTB, I_DNNW, I_LCW, I_LCB, I_LWA, I_LBA, I_LWX, I_LBX, I_LLAM,
       I_WOUT, I_NF2, I_WF2I, I_WF2O, I_NFIN };

template <int MODE> DI int colmap(int n) {
    if (MODE == 0) return n;
    if (MODE == 1) { const int pn = n >> 8, bj = (n >> 7) & 1, j = n & 127; return bj * DFF + 128 * pn + j; }
    return n < 1544 ? n : (n < 1792 ? -1 : n - 248);
}
template <int MODE> DI void convert_item(const float* W, int K, int Nsrc, int Ndst, const float* scale, bf16* WT, float* scr, int item, int lane) {
    const int nblk = Ndst / 32, kb = item / nblk, nb = item % nblk, k0 = 64 * kb, n0 = 32 * nb;
    const int sc = colmap<MODE>(n0 + (lane & 31));
    float wv[32];
#pragma unroll
    for (int i = 0; i < 32; ++i) { const int kk = 2 * i + (lane >> 5); wv[i] = (sc >= 0) ? W[(size_t)(k0 + kk) * Nsrc + sc] : 0.f; }
#pragma unroll
    for (int i = 0; i < 32; ++i) { const int kk = 2 * i + (lane >> 5); float v = wv[i]; if (scale) v *= scale[k0 + kk]; scr[kk * 33 + (lane & 31)] = v; }
    asm volatile("s_waitcnt lgkmcnt(0)" ::: "memory");
    const int c = lane & 7;
#pragma unroll
    for (int j = 0; j < 4; ++j) { const int n = (lane >> 3) + 8 * j; const float* s = scr + (8 * c) * 33 + n;
        u32x4 o; o.x = pk2(s[0 * 33], s[1 * 33]); o.y = pk2(s[2 * 33], s[3 * 33]); o.z = pk2(s[4 * 33], s[5 * 33]); o.w = pk2(s[6 * 33], s[7 * 33]);
        *(u32x4*)(WT + (size_t)(n0 + n) * K + k0 + 8 * c) = o; }
    asm volatile("s_waitcnt lgkmcnt(0)" ::: "memory");
}
DI void convert_set(const Ctx& C, int l, int set, int gw, int nwaves) {
    float* scr = (float*)(C.lds + C.wave * 16384);
    constexpr int I1 = 16 * 176, I2 = 44 * 32, I3 = 16 * 120, I4 = 16 * 32;
    unsigned char* wt = C.ws + WS_WT;
    if (set == 0 || set == 2 || set == 3) {
        const int lo_ = (set == 3) ? I1 : 0, hi_ = (set == 2) ? I1 : I1 + I2 + I3;
        for (int it = lo_ + gw; it < hi_; it += nwaves) { int r = it;
            if (r < I1) { convert_item<1>(inp(I_WF1I) + (size_t)l * DM * 2 * DFF, DM, 2 * DFF, 2 * DFF, inp(I_NF1) + l * DM, (bf16*)(wt + WT_F1I), scr, r, C.lane); continue; } r -= I1;
            if (r < I2) { convert_item<0>(inp(I_WF1O) + (size_t)l * DFF * DM, DFF, DM, DM, nullptr, (bf16*)(wt + WT_F1O), scr, r, C.lane); continue; } r -= I2;
            convert_item<2>(inp(I_WIN) + (size_t)l * DM * 3592, DM, 3592, DIN_PAD, inp(I_NMIX) + l * DM, (bf16*)(wt + WT_WIN), scr, r, C.lane); }
    } else {
        for (int it = gw; it < I1 + I2 + I4; it += nwaves) { int r = it;
            if (r < I1) { convert_item<1>(inp(I_WF2I) + (size_t)l * DM * 2 * DFF, DM, 2 * DFF, 2 * DFF, inp(I_NF2) + l * DM, (bf16*)(wt + WT_F2I), scr, r, C.lane); continue; } r -= I1;
            if (r < I2) { convert_item<0>(inp(I_WF2O) + (size_t)l * DFF * DM, DFF, DM, DM, nullptr, (bf16*)(wt + WT_F2O), scr, r, C.lane); continue; } r -= I2;
            convert_item<0>(inp(I_WOUT) + (size_t)l * DM * DM, DM, DM, DM, nullptr, (bf16*)(wt + WT_WOUT), scr, r, C.lane); }
    }
}
DI void convert_lru_weights(const Ctx& C) {
    const int g = C.bid * NTHREADS + C.tid;
    if (g < 2 * 2 * 4 * 64 * 64) { const int l = g >> 15, mat = (g >> 14) & 1, n = (g >> 12) & 3, e = (g >> 6) & 63, d = g & 63;
        const float v = inp(mat ? I_LWX : I_LWA)[(size_t)((l * 4 + n) * 64 + d) * 64 + e]; ((bf16*)(C.ws + WS_LWT))[g] = (bf16)f2bf(v); }
}
DI void sincos_d(double ang, double& s, double& c) {
    const double TWO_PI = 6.283185307179586476925286766559, HALF_PI = 1.5707963267948966192313216916398;
    double n = __builtin_rint(ang / TWO_PI); double r = ang - n * TWO_PI;
    double k = __builtin_rint(r / HALF_PI); double y = r - k * HALF_PI;
    const double y2 = y * y;
    double sp = 1.0 / 1307674368000.0; sp = sp * y2 - 1.0 / 6227020800.0; sp = sp * y2 + 1.0 / 39916800.0; sp = sp * y2 - 1.0 / 362880.0; sp = sp * y2 + 1.0 / 5040.0; sp = sp * y2 - 1.0 / 120.0; sp = sp * y2 + 1.0 / 6.0;
    const double sy = y - y * y2 * sp;
    double cp = 1.0 / 20922789888000.0; cp = cp * y2 - 1.0 / 87178291200.0; cp = cp * y2 + 1.0 / 479001600.0; cp = cp * y2 - 1.0 / 3628800.0; cp = cp * y2 + 1.0 / 40320.0; cp = cp * y2 - 1.0 / 720.0; cp = cp * y2 + 1.0 / 24.0;
    const double cy = 1.0 - 0.5 * y2 + y2 * y2 * cp;
    const int q = ((int)k) & 3;
    s = (q == 0) ? sy : (q == 1) ? cy : (q == 2) ? -sy : -cy;
    c = (q == 0) ? cy : (q == 1) ? -sy : (q == 2) ? -cy : sy;
}
DI const float* p0_row_src(int row) { return row < NPROMPT ? inp(I_XP) + (size_t)row * DM : (row < SROW0 ? inp(I_META) + (size_t)((row - NPROMPT) & 15) * DM : inp(I_XS) + (size_t)(row - SROW0) * DM); }
DI void p0_rows(const Ctx& C) {
    const int gw = C.bid * NWAVES + C.wave, NGW = C.G * NWAVES;
    unsigned long long* ss0 = (unsigned long long*)(C.ws + WS_SS); bf16* XB = (bf16*)(C.ws + WS_XB); float* XE = (float*)(C.ws + WS_XE);
    f32x4 v[4], vn[4];
    if (gw < NROWS) { const float* src = p0_row_src(gw);
#pragma unroll
        for (int j = 0; j < 4; ++j) v[j] = *(const f32x4*)(src + 4 * C.lane + 256 * j); }
    for (int row = gw; row < NROWS; row += NGW) {
        const bool more = row + NGW < NROWS;
        if (more) { const float* src = p0_row_src(row + NGW);
#pragma unroll
            for (int j = 0; j < 4; ++j) vn[j] = *(const f32x4*)(src + 4 * C.lane + 256 * j); }
        float s = 0.f;
#pragma unroll
        for (int j = 0; j < 4; ++j) s += (v[j].x * v[j].x + v[j].y * v[j].y) + (v[j].z * v[j].z + v[j].w * v[j].w);
        s = wave_sum(s, C.lane);
        if (C.lane == 0) ss0[row] = (unsigned long long)(s * 1048576.0f + 0.5f);
#pragma unroll
        for (int j = 0; j < 4; ++j) { u32x2 w; w.x = pk2(v[j].x, v[j].y); w.y = pk2(v[j].z, v[j].w); *(u32x2*)(XB + (size_t)row * DM + 4 * C.lane + 256 * j) = w;
            if (row >= NPROMPT) *(f32x4*)(XE + (size_t)(row - NPROMPT) * DM + 4 * C.lane + 256 * j) = v[j]; }
        if (more) {
#pragma unroll
            for (int j = 0; j < 4; ++j) v[j] = vn[j]; }
    }
    float* rope = (float*)(C.ws + WS_ROPE);
    for (int e = C.bid * NTHREADS + C.tid; e < 2065 * 32; e += C.G * NTHREADS) {
        const int p = e >> 5, i = e & 31; double inv = 1.0; for (int k = 0; k < i; ++k) inv *= 0.7498942093324558;
        const double pos = (p == 2064) ? 16384.0 : (double)p; double s, c; sincos_d(pos * inv, s, c);
        rope[2 * e] = (float)c; rope[2 * e + 1] = (float)s;
    }
}
DI void final_norm(const Ctx& C) {
    const int gw = C.bid * NWAVES + C.wave, NGW = C.G * NWAVES;
    const unsigned long long* ss = (const unsigned long long*)(C.ws + WS_SS) + 6 * NROWS; const float* XE = (const float*)(C.ws + WS_XE); const float* nw = inp(I_NFIN);
    f32x4 w[4];
#pragma unroll
    for (int j = 0; j < 4; ++j) w[j] = *(const f32x4*)(nw + 4 * C.lane + 256 * j);
    for (int it = gw; it < NPROMPT + NSAMP; it += NGW) {
        const int row = it < NPROMPT ? it : SROW0 + (it - NPROMPT);
        const float* src = it < NPROMPT ? C.out + O_YP + (size_t)row * DM : XE + (size_t)(row - NPROMPT) * DM;
        float* dst = it < NPROMPT ? C.out + O_YP + (size_t)row * DM : C.out + O_YS + (size_t)(it - NPROMPT) * DM;
        const float rs = 1.0f / sqrtf((float)ss[row] * (1.0f / (1024.0f * 1048576.0f)) + EPS);
#pragma unroll
        for (int j = 0; j < 4; ++j) { const f32x4 v = *(const f32x4*)(src + 4 * C.lane + 256 * j); *(f32x4*)(dst + 4 * C.lane + 256 * j) = v * rs * w[j]; }
    }
}

DI void fix_rows(const Ctx& C, int nparts, float scale, unsigned long long* ssn) {
    const int gw = C.bid * NWAVES + C.wave, NGW = C.G * NWAVES;
    const float* slab = (const float*)(C.ws + WS_SLAB); float* XE = (float*)(C.ws + WS_XE); bf16* XB = (bf16*)(C.ws + WS_XB);
    for (int job = gw; job < 256 * 4; job += NGW) {
        const int r = job >> 2, pn = job & 3;
        const float* sp = slab + (size_t)(pn * nparts) * 65536 + (size_t)r * 256 + 4 * C.lane;
        f32x4 a = (f32x4){0.f, 0.f, 0.f, 0.f};
        for (int p = 0; p < nparts; ++p) a = a + *(const f32x4*)(sp + (size_t)p * 65536);
        float* xp = XE + (size_t)r * DM + 256 * pn + 4 * C.lane;
        const f32x4 x = *(const f32x4*)xp + a * scale;
        *(f32x4*)xp = x;
        u32x2 w; w.x = pk2(x.x, x.y); w.y = pk2(x.z, x.w); *(u32x2*)(XB + (size_t)(NPROMPT + r) * DM + 256 * pn + 4 * C.lane) = w;
        const float sq = wave_sum((x.x * x.x + x.y * x.y) + (x.z * x.z + x.w * x.w), C.lane);
        if (C.lane == 0) atomicAdd(ssn + NPROMPT + r, (unsigned long long)(sq * 1048576.0f + 0.5f));
    }
}

DI void final_fix_norm(const Ctx& C, int nparts, float scale) {
    const int gw = C.bid * NWAVES + C.wave, NGW = C.G * NWAVES;
    const unsigned long long* ss = (const unsigned long long*)(C.ws + WS_SS) + 6 * NROWS; const float* nw = inp(I_NFIN);
    const float* slab = (const float*)(C.ws + WS_SLAB); const float* XE = (const float*)(C.ws + WS_XE); const bf16* XB = (const bf16*)(C.ws + WS_XB);
    f32x4 w[4];
#pragma unroll
    for (int j = 0; j < 4; ++j) w[j] = *(const f32x4*)(nw + 4 * C.lane + 256 * j);
    if (gw < NSAMP) {
        const int it = gw, r = 128 + it; f32x4 x[4]; float sq = 0.f;
#pragma unroll
        for (int pn = 0; pn < 4; ++pn) { const float* sp = slab + (size_t)(pn * nparts) * 65536 + (size_t)r * 256 + 4 * C.lane; f32x4 a = (f32x4){0.f, 0.f, 0.f, 0.f};
            for (int p = 0; p < nparts; ++p) a = a + *(const f32x4*)(sp + (size_t)p * 65536);
            x[pn] = *(const f32x4*)(XE + (size_t)r * DM + 256 * pn + 4 * C.lane) + a * scale; sq += (x[pn].x * x[pn].x + x[pn].y * x[pn].y) + (x[pn].z * x[pn].z + x[pn].w * x[pn].w); }
        const float rs = 1.0f / sqrtf(wave_sum(sq, C.lane) * (1.0f / 1024.0f) + EPS);
#pragma unroll
        for (int pn = 0; pn < 4; ++pn) *(f32x4*)(C.out + O_YS + (size_t)it * DM + 256 * pn + 4 * C.lane) = x[pn] * rs * w[pn];
    }
    u32x2 v[2][4], vn[2][4]; unsigned long long sv[2], svn[2];
#define FN_LOAD(V, SV, base) do { _Pragma("unroll") for (int q = 0; q < 2; ++q) { const int row_ = (base) + q * NGW; if (row_ < NPROMPT) { SV[q] = ss[row_]; \
        _Pragma("unroll") for (int j = 0; j < 4; ++j) V[q][j] = *(const u32x2*)(XB + (size_t)row_ * DM + 4 * C.lane + 256 * j); } } } while (0)
    FN_LOAD(v, sv, gw);
    for (int row = gw; row < NPROMPT; row += 2 * NGW) {
        if (row + 2 * NGW < NPROMPT) FN_LOAD(vn, svn, row + 2 * NGW);
#pragma unroll
        for (int q = 0; q < 2; ++q) { const int rw = row + q * NGW;
            if (rw < NPROMPT) { const float rs = 1.0f / sqrtf((float)sv[q] * (1.0f / (1024.0f * 1048576.0f)) + EPS);
#pragma unroll
                for (int j = 0; j < 4; ++j) { const f32x4 x = (f32x4){bflo(v[q][j].x), bfhi(v[q][j].x), bflo(v[q][j].y), bfhi(v[q][j].y)}; *(f32x4*)(C.out + O_YP + (size_t)rw * DM + 4 * C.lane + 256 * j) = x * rs * w[j]; } } }
#pragma unroll
        for (int q = 0; q < 2; ++q) { sv[q] = svn[q];
#pragma unroll
            for (int j = 0; j < 4; ++j) v[q][j] = vn[q][j]; }
    }
#undef FN_LOAD
}
DI int chunk_row0(int b, int c) { return c == 0 ? NPROMPT + 16 * b : b * 2048 + 64 * (c - 1); }
DI int halo_row(int b, int c, int back) { return c == 0 ? -1 : (c == 1 ? NPROMPT + 16 * b + 16 - back : b * 2048 + 64 * (c - 1) - back); }

constexpr int N1_R = 0, N1_QB = 52736, N1_KB = 70144, N1_RT = 87552, N1_SM = 124416, N1_CW = 126464, N1_AB = 0, N1_AD = 9216, N1_TD = 14336, N1_WS = 18432;
#define MFMA16(a, b, c) __builtin_amdgcn_mfma_f32_16x16x32_bf16((a), (b), (c), 0, 0, 0)
DI void m1_dn_item(const Ctx& C, int l, int b, int c, int h) {
    const int tid = C.tid, lane = C.lane, wid = C.wave;
    bf16* R = (bf16*)(C.lds + N1_R); bf16* QB = (bf16*)(C.lds + N1_QB); bf16* KB = (bf16*)(C.lds + N1_KB); bf16* RT = (bf16*)(C.lds + N1_RT);
    float* sm = (float*)(C.lds + N1_SM); float* CW = (float*)(C.lds + N1_CW);
    bf16* AB = (bf16*)(C.lds + N1_AB); float* AD = (float*)(C.lds + N1_AD); bf16* TD = (bf16*)(C.lds + N1_TD); bf16* WS = (bf16*)(C.lds + N1_WS);
    const bf16* PA = (const bf16*)(C.ws + WS_PA);
    const int L = (c == 0) ? 16 : 64, row0 = chunk_row0(b, c), item = (b * NCHUNK + c) * 4 + h;
    unsigned char* dni = C.ws + WS_DNI + (size_t)item * DNI_ITEM;
    { u32x4 rv[7];
#pragma unroll
      for (int k = 0; k < 7; ++k) { const int p = tid + 512 * k; rv[k] = (u32x4){0u, 0u, 0u, 0u};
          if (p < 67 * 48) { const int ri = p / 48, pc = p % 48, t = ri - 3; int row = -1;
              if (t < 0) row = halo_row(b, c, -t); else if (t < L) row = row0 + t;
              if (row >= 0) rv[k] = *(const u32x4*)(PA + (size_t)row * PA_LD + (pc >> 4) * 512 + h * 128 + 8 * (pc & 15)); } }
      f32x4 cwv = (f32x4){0.f, 0.f, 0.f, 0.f};
      if (tid < 384) { const int tap = tid / 96, q4 = tid % 96; cwv = *(const f32x4*)(inp(I_DNCW) + (size_t)l * 4 * 1536 + tap * 1536 + (q4 >> 5) * 512 + h * 128 + 4 * (q4 & 31)); }
      if (wid == 7) {
          const int t = lane; float g = 0.f, be = 0.f;
          if (t < L) { const bf16* pr = PA + (size_t)(row0 + t) * PA_LD + 1536 + h; const float a = bf1(pr[0]), bb = bf1(pr[4]);
              g = -__expf(inp(I_ALOG)[l * 4 + h]) * softplus(a + inp(I_DTB)[l * 4 + h]); be = sigm(bb); }
          float G = g;
#pragma unroll
          for (int o = 1; o < 64; o <<= 1) { const float v = xshfl(G, (lane - o) & 63); if (lane >= o) G += v; }
          const float GC = xshfl(G, 63);
          sm[t] = G; sm[64 + t] = be; sm[128 + t] = __expf(G); sm[192 + t] = __expf(GC - G);
          if (lane == 0) ((float*)(C.ws + WS_GCA))[item] = __expf(GC);
      }
#pragma unroll
      for (int k = 0; k < 7; ++k) { const int p = tid + 512 * k; if (p < 67 * 48) *(u32x4*)((unsigned char*)R + (p / 48) * 784 + (p % 48) * 16) = rv[k]; }
      if (tid < 384) { const int tap = tid / 96, q4 = tid % 96; *(f32x4*)(CW + tap * 384 + 4 * q4) = cwv; } }
    __syncthreads();
    { const int t = tid >> 3, cg = tid & 7; const bool live = t < L;
#pragma unroll
      for (int part = 0; part < 2; ++part) {
          float y[16];
#pragma unroll
          for (int j = 0; j < 16; ++j) y[j] = 0.f;
          u32x4 x3[2] = {(u32x4){0u, 0u, 0u, 0u}, (u32x4){0u, 0u, 0u, 0u}};
#pragma unroll
          for (int tap = 0; tap < 4; ++tap)
#pragma unroll
              for (int hf = 0; hf < 2; ++hf) { const u32x4 xv = *(const u32x4*)(R + (t + tap) * 392 + part * 128 + 16 * cg + 8 * hf); if (tap == 3) x3[hf] = xv;
                  const f32x4 w0 = *(const f32x4*)(CW + tap * 384 + part * 128 + 16 * cg + 8 * hf), w1 = *(const f32x4*)(CW + tap * 384 + part * 128 + 16 * cg + 8 * hf + 4);
                  y[8 * hf + 0] += w0.x * bflo(xv.x); y[8 * hf + 1] += w0.y * bfhi(xv.x); y[8 * hf + 2] += w0.z * bflo(xv.y); y[8 * hf + 3] += w0.w * bfhi(xv.y);
                  y[8 * hf + 4] += w1.x * bflo(xv.z); y[8 * hf + 5] += w1.y * bfhi(xv.z); y[8 * hf + 6] += w1.z * bflo(xv.w); y[8 * hf + 7] += w1.w * bfhi(xv.w); }
          float ss = 0.f;
#pragma unroll
          for (int j = 0; j < 16; ++j) { y[j] = live ? silu(y[j]) : 0.f; ss += y[j] * y[j]; }
          ss += xshfl(ss, lane ^ 1); ss += xshfl(ss, lane ^ 2); ss += xshfl(ss, lane ^ 4);
          const float sc = __builtin_amdgcn_rsqf(ss + EPS) * (part == 0 ? 0.08838834764831845f : 1.0f);
          bf16* dst = (part == 0 ? QB : KB) + t * 136 + 16 * cg;
          *(u32x4*)(dst) = (u32x4){pk2(y[0] * sc, y[1] * sc), pk2(y[2] * sc, y[3] * sc), pk2(y[4] * sc, y[5] * sc), pk2(y[6] * sc, y[7] * sc)};
          *(u32x4*)(dst + 8) = (u32x4){pk2(y[8] * sc, y[9] * sc), pk2(y[10] * sc, y[11] * sc), pk2(y[12] * sc, y[13] * sc), pk2(y[14] * sc, y[15] * sc)};
          if (part == 0) { const float sq = sc * sm[128 + t]; bf16* qo = (bf16*)(dni + DNI_QG) + t * 128 + 16 * cg;
              *(u32x4*)(qo) = (u32x4){pk2(y[0] * sq, y[1] * sq), pk2(y[2] * sq, y[3] * sq), pk2(y[4] * sq, y[5] * sq), pk2(y[6] * sq, y[7] * sq)};
              *(u32x4*)(qo + 8) = (u32x4){pk2(y[8] * sq, y[9] * sq), pk2(y[10] * sq, y[11] * sq), pk2(y[12] * sq, y[13] * sq), pk2(y[14] * sq, y[15] * sq)}; }
          else if (cg == 0) sm[256 + t] = sc;
          if (c == NCHUNK - 1 && t >= 61) { float* co = C.out + O_DNCP + ((size_t)(l * NB + b) * 3 + (t - 61)) * 1536 + part * 512 + h * 128 + 16 * cg;
#pragma unroll
              for (int hf = 0; hf < 2; ++hf) { *(f32x4*)(co + 8 * hf) = (f32x4){bflo(x3[hf].x), bfhi(x3[hf].x), bflo(x3[hf].y), bfhi(x3[hf].y)}; *(f32x4*)(co + 8 * hf + 4) = (f32x4){bflo(x3[hf].z), bfhi(x3[hf].z), bflo(x3[hf].w), bfhi(x3[hf].w)}; } }
      } }
    { const int t = tid >> 3, cg = tid & 7;
      if (t < L) { bf16* zp = (bf16*)(C.ws + WS_PB) + (size_t)(row0 + t) * PB_LD + h * 128 + 16 * cg; const float* nw = inp(I_DNNW) + l * 128 + 16 * cg;
          const u32x4 z0 = *(const u32x4*)(zp), z1 = *(const u32x4*)(zp + 8); const unsigned zw[8] = {z0.x, z0.y, z0.z, z0.w, z1.x, z1.y, z1.z, z1.w}; unsigned gw[8];
#pragma unroll
          for (int i = 0; i < 4; ++i) { const f32x4 g = *(const f32x4*)(nw + 4 * i);
              gw[2 * i] = pk2(g.x * silu(bflo(zw[2 * i])), g.y * silu(bfhi(zw[2 * i]))); gw[2 * i + 1] = pk2(g.z * silu(bflo(zw[2 * i + 1])), g.w * silu(bfhi(zw[2 * i + 1]))); }
          *(u32x4*)(zp) = (u32x4){gw[0], gw[1], gw[2], gw[3]}; *(u32x4*)(zp + 8) = (u32x4){gw[4], gw[5], gw[6], gw[7]}; } }
    __syncthreads();
    if (wid < 4) {
        const int part = 1 + (tid >> 7), rr = tid & 127, cq = rr & 31, tq = rr >> 5, t0 = 16 * tq;
        const float* cw = inp(I_DNCW) + (size_t)l * 4 * 1536 + part * 512 + h * 128 + 4 * cq;
        const f32x4 w0 = *(const f32x4*)(cw), w1 = *(const f32x4*)(cw + 1536), w2 = *(const f32x4*)(cw + 2 * 1536), w3 = *(const f32x4*)(cw + 3 * 1536);
        const bf16* rp = R + part * 128 + 4 * cq;
        f32x4 x0 = ld4bf(rp + (t0 + 0) * 392), x1 = ld4bf(rp + (t0 + 1) * 392), x2 = ld4bf(rp + (t0 + 2) * 392);
        unsigned rtw[4][8], kdw[4][8];
#pragma unroll
        for (int i2 = 0; i2 < 8; ++i2) {
            f32x4 rta[2], kda[2];
#pragma unroll
            for (int u = 0; u < 2; ++u) { const int t = t0 + 2 * i2 + u; const f32x4 x3 = ld4bf(rp + (t + 3) * 392);
                f32x4 y = w0 * x0 + w1 * x1 + w2 * x2 + w3 * x3; x0 = x1; x1 = x2; x2 = x3;
                y = (t < L) ? (f32x4){silu(y.x), silu(y.y), silu(y.z), silu(y.w)} : (f32x4){0.f, 0.f, 0.f, 0.f};
                if (c == NCHUNK - 1 && part == 2 && t >= 61) *(f32x4*)(C.out + O_DNCP + ((size_t)(l * NB + b) * 3 + (t - 61)) * 1536 + 1024 + h * 128 + 4 * cq) = x3;
                if (part == 1) { const f32x4 n = y * sm[256 + t]; rta[u] = n * (sm[64 + t] * sm[128 + t]); kda[u] = n * sm[192 + t]; }
                else { rta[u] = y * sm[64 + t]; kda[u] = rta[u]; } }
#pragma unroll
            for (int jj = 0; jj < 4; ++jj) { rtw[jj][i2] = pk2(rta[0][jj], rta[1][jj]); kdw[jj][i2] = pk2(kda[0][jj], kda[1][jj]); }
        }
        const int colb = (part == 1 ? 128 : 0) + 4 * cq;
#pragma unroll
        for (int jj = 0; jj < 4; ++jj) { bf16* d = RT + (colb + jj) * 72 + t0;
            *(u32x4*)(d) = (u32x4){rtw[jj][0], rtw[jj][1], rtw[jj][2], rtw[jj][3]}; *(u32x4*)(d + 8) = (u32x4){rtw[jj][4], rtw[jj][5], rtw[jj][6], rtw[jj][7]};
            if (part == 1) { bf16* ko = (bf16*)(dni + DNI_KDT) + (4 * cq + jj) * 64 + t0;
                *(u32x4*)(ko) = (u32x4){kdw[jj][0], kdw[jj][1], kdw[jj][2], kdw[jj][3]}; *(u32x4*)(ko + 8) = (u32x4){kdw[jj][4], kdw[jj][5], kdw[jj][6], kdw[jj][7]}; } }
    }
    __syncthreads();
    { const int kind = wid >> 2, ti = (wid >> 1) & 1, tj = wid & 1, r = lane & 31, hh = lane >> 5;
      const bf16* Aop = KB + (32 * ti + r) * 136 + 8 * hh; const bf16* Bop = (kind ? QB : KB) + (32 * tj + r) * 136 + 8 * hh;
      f32x16 acc;
#pragma unroll
      for (int i = 0; i < 16; ++i) acc[i] = 0.f;
#pragma unroll
      for (int ks = 0; ks < 8; ++ks) { const bf16x8 a = *(const bf16x8*)(Aop + 16 * ks), bq = *(const bf16x8*)(Bop + 16 * ks); acc = MFMA32(a, bq, acc); }
      const int t = 32 * tj + r; const float Gt = sm[t], bet = sm[64 + t];
#pragma unroll
      for (int g4 = 0; g4 < 4; ++g4) { const int i0 = 32 * ti + 8 * g4 + 4 * hh; float o[4];
#pragma unroll
          for (int e = 0; e < 4; ++e) { const int i = i0 + e; const float dec = __expf(Gt - sm[i]); const float v = acc[4 * g4 + e] * dec;
              o[e] = kind ? (t >= i ? v : 0.f) : (t > i ? bet * v : 0.f); }
          if (kind == 0) { const bool diag = (i0 >> 4) == (t >> 4);
              u32x2 w; w.x = diag ? 0u : pk2(-o[0], -o[1]); w.y = diag ? 0u : pk2(-o[2], -o[3]); *(u32x2*)(AB + t * 72 + i0) = w;
              if (diag) *(f32x4*)(AD + ((t >> 4) * 16 + (t & 15)) * 20 + (i0 & 15)) = (f32x4){o[0], o[1], o[2], o[3]}; }
          else { u32x2 w; w.x = pk2(o[0], o[1]); w.y = pk2(o[2], o[3]); *(u32x2*)((bf16*)(dni + DNI_P) + t * 64 + i0) = w; } } }
    __syncthreads();
    if (wid == 0) { const int blk = lane >> 4, j = lane & 15; float x[16];
#pragma unroll
        for (int t = 0; t < 16; ++t) x[t] = 0.f;
#pragma unroll
        for (int t = 0; t < 16; ++t) { float s = (t == j) ? 1.0f : 0.f;
#pragma unroll
            for (int s4 = 0; s4 < (t + 3) / 4; ++s4) { const f32x4 a = *(const f32x4*)(AD + (blk * 16 + t) * 20 + 4 * s4);
                s -= a.x * x[4 * s4]; s -= a.y * x[4 * s4 + 1]; s -= a.z * x[4 * s4 + 2]; s -= a.w * x[4 * s4 + 3]; }
            x[t] = s; }
#pragma unroll
        for (int t = 0; t < 16; ++t) { TD[(blk * 16 + t) * 32 + j] = (bf16)f2bf(x[t] - ((t == j) ? 1.0f : 0.f)); TD[(blk * 16 + t) * 32 + 16 + j] = (bf16)0; } }
    __syncthreads();
    { const int cl = lane & 15, kq = lane >> 4, c0 = 32 * wid;
#pragma unroll
      for (int i = 0; i < 4; ++i) {
          f32x4 acc[2];
#pragma unroll
          for (int nf = 0; nf < 2; ++nf) acc[nf] = ld4bf(RT + (c0 + 16 * nf + cl) * 72 + 16 * i + 4 * kq);
          if (i >= 1) {
#pragma unroll
              for (int ks = 0; ks < (i == 3 ? 2 : 1); ++ks) { const bf16x8 a = *(const bf16x8*)(AB + (16 * i + cl) * 72 + 32 * ks + 8 * kq);
#pragma unroll
                  for (int nf = 0; nf < 2; ++nf) { const bf16x8 bb = *(const bf16x8*)(RT + (c0 + 16 * nf + cl) * 72 + 32 * ks + 8 * kq); acc[nf] = MFMA16(a, bb, acc[nf]); } } }
#pragma unroll
          for (int nf = 0; nf < 2; ++nf) { u32x2 w; w.x = pk2(acc[nf].x, acc[nf].y); w.y = pk2(acc[nf].z, acc[nf].w); *(u32x2*)(RT + (c0 + 16 * nf + cl) * 72 + 16 * i + 4 * kq) = w; }
          asm volatile("" ::: "memory");
          const bf16x8 a2 = *(const bf16x8*)(TD + (i * 16 + cl) * 32 + 8 * kq);
#pragma unroll
          for (int nf = 0; nf < 2; ++nf) { bf16x8 b2 = *(const bf16x8*)(RT + (c0 + 16 * nf + cl) * 72 + 16 * i + 8 * (kq & 1));
              if (kq >= 2) b2 = (bf16x8){0, 0, 0, 0, 0, 0, 0, 0};
              acc[nf] = MFMA16(a2, b2, acc[nf]);
              u32x2 w; w.x = pk2(acc[nf].x, acc[nf].y); w.y = pk2(acc[nf].z, acc[nf].w); *(u32x2*)(RT + (c0 + 16 * nf + cl) * 72 + 16 * i + 4 * kq) = w;
              if (wid >= 4) { const int d = c0 - 128 + 16 * nf + cl; bf16* wp = WS + (16 * i + 4 * kq) * 136 + d;
                  wp[0] = (bf16)(w.x & 0xffffu); wp[136] = (bf16)(w.x >> 16); wp[272] = (bf16)(w.y & 0xffffu); wp[408] = (bf16)(w.y >> 16); } }
          asm volatile("" ::: "memory");
      } }
    __syncthreads();
#pragma unroll
    for (int k = 0; k < 2; ++k) { const int p = tid + 512 * k;
        *(u32x4*)(dni + DNI_UVT + 16 * p) = *(const u32x4*)((const unsigned char*)RT + (p >> 3) * 144 + (p & 7) * 16);
        *(u32x4*)(dni + DNI_W + 16 * p) = *(const u32x4*)((const unsigned char*)WS + (p >> 4) * 272 + (p & 15) * 16); }
    __syncthreads();
}

constexpr int L1_XL = 0, L1_WT = 33792, L1_LA = 33792, L1_LB = 70656, L1_XCH = 107520;
DI void m1_lru_item(const Ctx& C, int l, int b, int c) {
    const int tid = C.tid, lane = C.lane, wid = C.wave, r = lane & 31, hh = lane >> 5;
    bf16* XL = (bf16*)(C.lds + L1_XL); bf16* WT = (bf16*)(C.lds + L1_WT); bf16* LA = (bf16*)(C.lds + L1_LA); bf16* LB = (bf16*)(C.lds + L1_LB); float* xch = (float*)(C.lds + L1_XCH);
    const bf16* PB = (const bf16*)(C.ws + WS_PB);
    const int L = (c == 0) ? 16 : 64, row0 = chunk_row0(b, c);
    {
      u32x4 wv[8];
#pragma unroll
      for (int k = 0; k < 8; ++k) wv[k] = *(const u32x4*)(C.ws + WS_LWT + (size_t)l * 65536 + (size_t)(tid + 512 * k) * 16);
      const int cq = tid & 63, tq = tid >> 6, col = 4 * cq, t0 = 8 * tq;
      const float* cw = inp(I_LCW) + (size_t)l * 4 * 256 + col;
      const f32x4 w0 = *(const f32x4*)(cw), w1 = *(const f32x4*)(cw + 256), w2 = *(const f32x4*)(cw + 512), w3 = *(const f32x4*)(cw + 768), bias = *(const f32x4*)(inp(I_LCB) + l * 256 + col);
      f32x4 x0 = (f32x4){0.f, 0.f, 0.f, 0.f}, x1 = x0, x2 = x0;
      if (t0 < L) {
          if (t0 == 0) { const int r3 = halo_row(b, c, 3); if (r3 >= 0) { x0 = ld4bf(PB + (size_t)r3 * PB_LD + 512 + col); x1 = ld4bf(PB + (size_t)(r3 + 1) * PB_LD + 512 + col); x2 = ld4bf(PB + (size_t)(r3 + 2) * PB_LD + 512 + col); } }
          else { x0 = ld4bf(PB + (size_t)(row0 + t0 - 3) * PB_LD + 512 + col); x1 = ld4bf(PB + (size_t)(row0 + t0 - 2) * PB_LD + 512 + col); x2 = ld4bf(PB + (size_t)(row0 + t0 - 1) * PB_LD + 512 + col); }
      }
#pragma unroll
      for (int i = 0; i < 8; ++i) { const int t = t0 + i; f32x4 y = (f32x4){0.f, 0.f, 0.f, 0.f};
          if (t < L) { const f32x4 x3 = ld4bf(PB + (size_t)(row0 + t) * PB_LD + 512 + col); y = w0 * x0 + w1 * x1 + w2 * x2 + w3 * x3 + bias;
              if (c == NCHUNK - 1 && t >= 61) *(f32x4*)(C.out + O_LRUCP + ((size_t)(l * NB + b) * 3 + (t - 61)) * 256 + col) = x3;
              x0 = x1; x1 = x2; x2 = x3; }
          u32x2 w; w.x = pk2(y.x, y.y); w.y = pk2(y.z, y.w); *(u32x2*)(XL + t * 264 + col) = w; }
#pragma unroll
      for (int k = 0; k < 8; ++k) { const int p = tid + 512 * k; *(u32x4*)((unsigned char*)WT + (p >> 3) * 144 + (p & 7) * 16) = wv[k]; } }
    __syncthreads();
    const int n = wid >> 1, eh = wid & 1, e = n * 64 + 32 * eh + r;
    f32x16 pa[2], px[2];
#pragma unroll
    for (int th = 0; th < 2; ++th)
#pragma unroll
        for (int i = 0; i < 16; ++i) { pa[th][i] = 0.f; px[th][i] = 0.f; }
#pragma unroll
    for (int ks = 0; ks < 4; ++ks) {
        const bf16x8 ba_ = *(const bf16x8*)(WT + ((0 * 4 + n) * 64 + 32 * eh + r) * 72 + 16 * ks + 8 * hh), bx_ = *(const bf16x8*)(WT + ((1 * 4 + n) * 64 + 32 * eh + r) * 72 + 16 * ks + 8 * hh);
#pragma unroll
        for (int th = 0; th < 2; ++th) { const bf16x8 a = *(const bf16x8*)(XL + (32 * th + r) * 264 + n * 64 + 16 * ks + 8 * hh); pa[th] = MFMA32(a, ba_, pa[th]); px[th] = MFMA32(a, bx_, px[th]); } }
    __syncthreads();
    { const float ba = inp(I_LBA)[l * 256 + e], bx = inp(I_LBX)[l * 256 + e], sp = softplus(-inp(I_LLAM)[l * 256 + e]);
#pragma unroll
      for (int th = 0; th < 2; ++th)
#pragma unroll
          for (int g4 = 0; g4 < 4; ++g4) { float la4[4], bm4[4];
#pragma unroll
              for (int k = 0; k < 4; ++k) { const int t = 32 * th + 8 * g4 + 4 * hh + k; const float xv = bf1(XL[t * 264 + e]);
                  const float rg = sigm(pa[th][4 * g4 + k] + ba), ig = sigm(px[th][4 * g4 + k] + bx), la = -8.0f * rg * sp;
                  la4[k] = (t < L) ? la : 0.f; bm4[k] = (t < L) ? sqrtf(fmaxf(1.0f - __expf(2.0f * la), 0.f)) * (ig * xv) : 0.f; }
              u32x2 w; w.x = pk2(la4[0], la4[1]); w.y = pk2(la4[2], la4[3]); *(u32x2*)(LA + e * 72 + 32 * th + 8 * g4 + 4 * hh) = w;
              w.x = pk2(bm4[0], bm4[1]); w.y = pk2(bm4[2], bm4[3]); *(u32x2*)(LB + e * 72 + 32 * th + 8 * g4 + 4 * hh) = w; } }
    __syncthreads();
    { const int ec = tid & 255, th = tid >> 8; float ar[32], ai[32];
#pragma unroll
      for (int i = 0; i < 4; ++i) { const u32x4 la = *(const u32x4*)(LA + ec * 72 + 32 * th + 8 * i), lb = *(const u32x4*)(LB + ec * 72 + 32 * th + 8 * i);
          const unsigned lw[4] = {la.x, la.y, la.z, la.w}, bw[4] = {lb.x, lb.y, lb.z, lb.w};
#pragma unroll
          for (int k = 0; k < 4; ++k) { ar[8 * i + 2 * k] = __expf(bflo(lw[k])); ar[8 * i + 2 * k + 1] = __expf(bfhi(lw[k])); ai[8 * i + 2 * k] = bflo(bw[k]); ai[8 * i + 2 * k + 1] = bfhi(bw[k]); } }
      { float hl = 0.f, ac = 1.f;
#pragma unroll
        for (int t = 0; t < 32; ++t) { hl = ar[t] * hl + ai[t]; ac *= ar[t]; ai[t] = hl; ar[t] = ac; } }
      if (th == 0) { xch[2 * ec] = ai[31]; xch[2 * ec + 1] = ar[31]; }
      __syncthreads();
      if (th == 1) { const float h0 = xch[2 * ec], a0 = xch[2 * ec + 1];
#pragma unroll
        for (int t = 0; t < 32; ++t) { ai[t] = ar[t] * h0 + ai[t]; ar[t] = ar[t] * a0; }
        ((float*)(C.ws + WS_CA))[(size_t)(b * NCHUNK + c) * 256 + ec] = ar[31]; ((float*)(C.ws + WS_CB))[(size_t)(b * NCHUNK + c) * 256 + ec] = ai[31]; }
      bf16* AC = (bf16*)(C.ws + WS_LA); bf16* HL = (bf16*)(C.ws + WS_LB);
#pragma unroll
      for (int t = 0; t < 32; ++t) { const int tt = 32 * th + t;
          if (tt < L) { AC[(size_t)(row0 + tt) * 256 + ec] = (bf16)f2bf(ar[t]); HL[(size_t)(row0 + tt) * 256 + ec] = (bf16)f2bf(ai[t]); } } }
    __syncthreads();
}
DI void m1_phase(const Ctx& C0, int l) {
    constexpr int NDN = NB * NCHUNK * 4, NLRU = NB * NCHUNK;
#ifndef M1_SUB
#define M1_SUB 3
#endif
    for (int it = C0.bid; it < NDN + NLRU; it += C0.G) {
        const Ctx C = fresh(C0);
#ifndef M1_DUP
#define M1_DUP 0
#endif
        if (it < NDN) { if (M1_SUB & 1) { const int h = it & 3, bc = it >> 2; for (int rep = 0; rep < ((M1_DUP & 1) ? 2 : 1); ++rep) { const Ctx Cr = fresh(C0); m1_dn_item(Cr, l, bc / NCHUNK, bc % NCHUNK, h); } } }
        else if (M1_SUB & 2) { const int bc = it - NDN; for (int rep = 0; rep < ((M1_DUP & 2) ? 2 : 1); ++rep) { const Ctx Cr = fresh(C0); m1_lru_item(Cr, l, bc / NCHUNK, bc % NCHUNK); } }
    }
}
constexpr int M2_WL = 0, M2_QL = 17408, M2_PL = 34816, M2_KL = 44032, M2_UT = 62464, M2_ST = 80896, M2_OS = 115712;
DI void m2_dn(const Ctx& C, int l, int b, int h) {
    const int tid = C.tid, lane = C.lane, wid = C.wave, tm = wid >> 2, tn = wid & 3, r = lane & 31, hh = lane >> 5;
    bf16* WL = (bf16*)(C.lds + M2_WL); bf16* QL = (bf16*)(C.lds + M2_QL); bf16* PL = (bf16*)(C.lds + M2_PL); bf16* KL = (bf16*)(C.lds + M2_KL);
    bf16* UT = (bf16*)(C.lds + M2_UT); bf16* ST = (bf16*)(C.lds + M2_ST); float* OS = (float*)(C.lds + M2_OS);
    const bf16* PB = (const bf16*)(C.ws + WS_PB); bf16* O = (bf16*)(C.ws + WS_O); const float* GCA = (const float*)(C.ws + WS_GCA);
    f32x16 S0, S1;
#pragma unroll
    for (int i = 0; i < 16; ++i) { S0[i] = 0.f; S1[i] = 0.f; }
    for (int i = tid; i < 128 * 136 / 2; i += NTHREADS) ((unsigned*)ST)[i] = 0u;
    u32x4 pre[7];
    const unsigned char* dni0 = C.ws + WS_DNI + (size_t)((b * NCHUNK) * 4 + h) * DNI_ITEM;
#define M2_LOAD(dn) do { \
        pre[0] = *(const u32x4*)((dn) + DNI_W + 16 * tid); pre[1] = *(const u32x4*)((dn) + DNI_W + 16 * (tid + 512)); \
        pre[2] = *(const u32x4*)((dn) + DNI_QG + 16 * tid); pre[3] = *(const u32x4*)((dn) + DNI_QG + 16 * (tid + 512)); \
        pre[4] = *(const u32x4*)((dn) + DNI_P + 16 * tid); \
        pre[5] = *(const u32x4*)((dn) + DNI_KDT + 16 * tid); pre[6] = *(const u32x4*)((dn) + DNI_KDT + 16 * (tid + 512)); } while (0)
#define M2_STORE() do { \
        { const int p = tid; *(u32x4*)((unsigned char*)WL + (p >> 4) * 272 + (p & 15) * 16) = pre[0]; *(u32x4*)((unsigned char*)QL + (p >> 4) * 272 + (p & 15) * 16) = pre[2]; \
          *(u32x4*)((unsigned char*)PL + (p >> 3) * 144 + (p & 7) * 16) = pre[4]; *(u32x4*)((unsigned char*)KL + (p >> 3) * 144 + (p & 7) * 16) = pre[5]; } \
        { const int p = tid + 512; *(u32x4*)((unsigned char*)WL + (p >> 4) * 272 + (p & 15) * 16) = pre[1]; *(u32x4*)((unsigned char*)QL + (p >> 4) * 272 + (p & 15) * 16) = pre[3]; \
          *(u32x4*)((unsigned char*)KL + (p >> 3) * 144 + (p & 7) * 16) = pre[6]; } } while (0)
    M2_LOAD(dni0);
    M2_STORE();
    const int nt_ = tid >> 3, nsg = tid & 7;
    u32x2 uv[4], uvn[4]; u32x4 zz[2], zzn[2]; float egc, egcn;
#define M2_LOAD2(cc, UV, ZZ, EG) do { const unsigned char* dn_ = C.ws + WS_DNI + (size_t)((b * NCHUNK + (cc)) * 4 + h) * DNI_ITEM; \
        const bf16* uvt_ = (const bf16*)(dn_ + DNI_UVT) + (32 * tn + r) * 64 + 32 * tm + 4 * hh; \
        _Pragma("unroll") for (int g4 = 0; g4 < 4; ++g4) UV[g4] = *(const u32x2*)(uvt_ + 8 * g4); \
        EG = GCA[(b * NCHUNK + (cc)) * 4 + h]; \
        const int vr_ = ((cc) > 0 || nt_ < 16) ? chunk_row0(b, (cc)) + nt_ : chunk_row0(b, (cc)); \
        const bf16* zp_ = PB + (size_t)vr_ * PB_LD + h * 128 + 16 * nsg; ZZ[0] = *(const u32x4*)(zp_); ZZ[1] = *(const u32x4*)(zp_ + 8); } while (0)
    M2_LOAD2(0, uv, zz, egc);
    asm volatile("" :: "v"(uv[0]), "v"(uv[1]), "v"(uv[2]), "v"(uv[3]), "v"(zz[0]), "v"(zz[1]), "v"(egc));
    __syncthreads();
    u32x4 zzp[2] = {zz[0], zz[1]};
#define M2_NORM(cc) do { const int t = tid >> 3, sg = tid & 7; f32x4 v[4]; float s = 0.f; \
        _Pragma("unroll") for (int i = 0; i < 4; ++i) { v[i] = *(const f32x4*)(OS + t * 132 + 16 * sg + 4 * i); s += (v[i].x * v[i].x + v[i].y * v[i].y) + (v[i].z * v[i].z + v[i].w * v[i].w); } \
        s += xshfl(s, lane ^ 1); s += xshfl(s, lane ^ 2); s += xshfl(s, lane ^ 4); \
        const float rs = __builtin_amdgcn_rsqf(s * (1.0f / 128.0f) + EPS); \
        if ((cc) > 0 || t < 16) { const int row = chunk_row0(b, (cc)) + t; unsigned w[8]; \
            const unsigned zw[8] = {zzp[0].x, zzp[0].y, zzp[0].z, zzp[0].w, zzp[1].x, zzp[1].y, zzp[1].z, zzp[1].w}; \
            _Pragma("unroll") for (int i = 0; i < 4; ++i) { const f32x4 z = (f32x4){bflo(zw[2 * i]), bfhi(zw[2 * i]), bflo(zw[2 * i + 1]), bfhi(zw[2 * i + 1])};     \
                w[2 * i] = pk2(v[i].x * rs * z.x, v[i].y * rs * z.y); w[2 * i + 1] = pk2(v[i].z * rs * z.z, v[i].w * rs * z.w); } \
            bf16* op = O + (size_t)row * DM + h * 128 + 16 * sg; \
            *(u32x4*)(op) = (u32x4){w[0], w[1], w[2], w[3]}; *(u32x4*)(op + 8) = (u32x4){w[4], w[5], w[6], w[7]}; } } while (0)
    for (int c = 0; c < NCHUNK; ++c) {
        const int item = (b * NCHUNK + c) * 4 + h;
        const unsigned char* dni = C.ws + WS_DNI + (size_t)item * DNI_ITEM;
        if (c + 1 < NCHUNK) { M2_LOAD(dni + 4 * DNI_ITEM); M2_LOAD2(c + 1, uvn, zzn, egcn); }
        f32x16 ws, qs;
#pragma unroll
        for (int i = 0; i < 16; ++i) { ws[i] = 0.f; qs[i] = 0.f; }
#pragma unroll
        for (int ks = 0; ks < 4; ++ks) {
            const bf16x8 bfr = *(const bf16x8*)(ST + (32 * tn + r) * 136 + 16 * ks + 8 * hh);
            const bf16x8 aw = *(const bf16x8*)(WL + (32 * tm + r) * 136 + 16 * ks + 8 * hh), aq = *(const bf16x8*)(QL + (32 * tm + r) * 136 + 16 * ks + 8 * hh);
            ws = MFMA32(aw, bfr, ws); qs = MFMA32(aq, bfr, qs); }
        if (c > 0) M2_NORM(c - 1);
#pragma unroll
        for (int ks = 4; ks < 8; ++ks) {
            const bf16x8 bfr = *(const bf16x8*)(ST + (32 * tn + r) * 136 + 16 * ks + 8 * hh);
            const bf16x8 aw = *(const bf16x8*)(WL + (32 * tm + r) * 136 + 16 * ks + 8 * hh), aq = *(const bf16x8*)(QL + (32 * tm + r) * 136 + 16 * ks + 8 * hh);
            ws = MFMA32(aw, bfr, ws); qs = MFMA32(aq, bfr, qs); }
        {
#pragma unroll
          for (int g4 = 0; g4 < 4; ++g4) { const f32x4 uf = (f32x4){bflo(uv[g4].x), bfhi(uv[g4].x), bflo(uv[g4].y), bfhi(uv[g4].y)};
              u32x2 w; w.x = pk2(uf.x - ws[4 * g4], uf.y - ws[4 * g4 + 1]); w.y = pk2(uf.z - ws[4 * g4 + 2], uf.w - ws[4 * g4 + 3]);
              *(u32x2*)(UT + (32 * tn + r) * 72 + 32 * tm + 8 * g4 + 4 * hh) = w; } }
        __syncthreads();
        { S0 = S0 * egc; S1 = S1 * egc;
#pragma unroll
          for (int ks = 0; ks < 4; ++ks) {
              const bf16x8 bfr = *(const bf16x8*)(UT + (32 * tn + r) * 72 + 16 * ks + 8 * hh);
              const bf16x8 ap = *(const bf16x8*)(PL + (32 * tm + r) * 72 + 16 * ks + 8 * hh);
              const bf16x8 a0 = *(const bf16x8*)(KL + (64 * tm + r) * 72 + 16 * ks + 8 * hh), a1 = *(const bf16x8*)(KL + (64 * tm + 32 + r) * 72 + 16 * ks + 8 * hh);
              qs = MFMA32(ap, bfr, qs); S0 = MFMA32(a0, bfr, S0); S1 = MFMA32(a1, bfr, S1); } }
        __syncthreads();
#pragma unroll
        for (int g4 = 0; g4 < 4; ++g4) {
            u32x2 w; w.x = pk2(S0[4 * g4], S0[4 * g4 + 1]); w.y = pk2(S0[4 * g4 + 2], S0[4 * g4 + 3]); *(u32x2*)(ST + (32 * tn + r) * 136 + 64 * tm + 8 * g4 + 4 * hh) = w;
            w.x = pk2(S1[4 * g4], S1[4 * g4 + 1]); w.y = pk2(S1[4 * g4 + 2], S1[4 * g4 + 3]); *(u32x2*)(ST + (32 * tn + r) * 136 + 64 * tm + 32 + 8 * g4 + 4 * hh) = w; }
#pragma unroll
        for (int i = 0; i < 16; ++i) OS[(32 * tm + crow(i, hh)) * 132 + 32 * tn + r] = qs[i];
        zzp[0] = zz[0]; zzp[1] = zz[1];
        if (c + 1 < NCHUNK) { M2_STORE();
#pragma unroll
            for (int g4 = 0; g4 < 4; ++g4) uv[g4] = uvn[g4];
            zz[0] = zzn[0]; zz[1] = zzn[1]; egc = egcn; }
        __syncthreads();
    }
    M2_NORM(NCHUNK - 1);
#undef M2_NORM
#undef M2_LOAD
#undef M2_LOAD2
#undef M2_STORE
    { float* so = C.out + O_DNP + ((size_t)((l * NB + b) * 4 + h)) * 16384;
#pragma unroll
      for (int i = 0; i < 16; ++i) { so[(size_t)(64 * tm + crow(i, hh)) * 128 + 32 * tn + r] = S0[i]; so[(size_t)(64 * tm + 32 + crow(i, hh)) * 128 + 32 * tn + r] = S1[i]; } }
}

constexpr int R_QL = 0, R_QG = 9216, R_KL = 18432, R_KDT = 27648, R_VT = 36864, R_ST = 46080, R_PL = 55296, R_OS = 64512, R_GL = 81920;
DI void m2_ret(const Ctx& C, int l, int b, int h) {
    const int tid = C.tid, lane = C.lane, wid = C.wave, r = lane & 31, hh = lane >> 5;
    bf16* QL = (bf16*)(C.lds + R_QL); bf16* QG = (bf16*)(C.lds + R_QG); bf16* KL = (bf16*)(C.lds + R_KL); bf16* KDT = (bf16*)(C.lds + R_KDT); bf16* VT = (bf16*)(C.lds + R_VT);
    bf16* ST = (bf16*)(C.lds + R_ST); bf16* PL = (bf16*)(C.lds + R_PL); float* OS = (float*)(C.lds + R_OS); bf16* GL = (bf16*)(C.lds + R_GL);
    const bf16* PB = (const bf16*)(C.ws + WS_PB); bf16* O = (bf16*)(C.ws + WS_O); const float* rope = (const float*)(C.ws + WS_ROPE);
    const float lg = (h == 0) ? -0.0317486983145803f : (h == 1) ? -0.015748356968139168f : (h == 2) ? -0.007843177461025893f : -0.003913899321136329f;
    f32x16 acc;
#pragma unroll
    for (int i = 0; i < 16; ++i) acc[i] = 0.f;
    for (int i = tid; i < 64 * 72 / 2; i += NTHREADS) ((unsigned*)ST)[i] = 0u;
    __syncthreads();
    u32x2 rq1, rq2, rk1, rk2; u32x4 rv, rg; f32x4 rc0, rc1;
    u32x2 nq1, nq2, nk1, nk2; u32x4 nv, ng; f32x4 nc0, nc1;
#define R_LOAD(cc, Q1, Q2, K1, K2, VV, GV, C0_, C1_) do { const int t_ = tid >> 3, j_ = tid & 7; const int L_ = ((cc) == 0) ? 16 : 64; \
        const bf16* pr_ = PB + (size_t)(chunk_row0(b, (cc)) + (t_ < L_ ? t_ : 0)) * PB_LD; \
        Q1 = *(const u32x2*)(pr_ + 1024 + 64 * h + 4 * j_); Q2 = *(const u32x2*)(pr_ + 1024 + 64 * h + 32 + 4 * j_); K1 = *(const u32x2*)(pr_ + 1280 + 64 * h + 4 * j_); K2 = *(const u32x2*)(pr_ + 1280 + 64 * h + 32 + 4 * j_); \
        VV = *(const u32x4*)(pr_ + 1536 + 64 * h + 8 * j_); GV = *(const u32x4*)(pr_ + 1792 + 64 * h + 8 * j_); \
        const float* rp_ = rope + ((size_t)((((cc) == 0) ? 0 : 16 + 64 * ((cc) - 1)) + t_) * 32 + 4 * j_) * 2; C0_ = *(const f32x4*)(rp_); C1_ = *(const f32x4*)(rp_ + 4); } while (0)
    R_LOAD(0, rq1, rq2, rk1, rk2, rv, rg, rc0, rc1);
    asm volatile("" :: "v"(rq1), "v"(rq2), "v"(rk1), "v"(rk2), "v"(rv), "v"(rg), "v"(rc0), "v"(rc1));
    for (int c = 0; c < NCHUNK; ++c) {
        const int L = (c == 0) ? 16 : 64, row0 = chunk_row0(b, c);
        if (c + 1 < NCHUNK) R_LOAD(c + 1, nq1, nq2, nk1, nk2, nv, ng, nc0, nc1);
        { const int t = tid >> 3, j = tid & 7;
          f32x4 q1 = (f32x4){0.f, 0.f, 0.f, 0.f}, q2 = q1, k1 = q1, k2 = q1; u32x4 vv = (u32x4){0u, 0u, 0u, 0u}, gv = vv;
          if (t < L) { q1 = (f32x4){bflo(rq1.x), bfhi(rq1.x), bflo(rq1.y), bfhi(rq1.y)}; q2 = (f32x4){bflo(rq2.x), bfhi(rq2.x), bflo(rq2.y), bfhi(rq2.y)};
              k1 = (f32x4){bflo(rk1.x), bfhi(rk1.x), bflo(rk1.y), bfhi(rk1.y)}; k2 = (f32x4){bflo(rk2.x), bfhi(rk2.x), bflo(rk2.y), bfhi(rk2.y)}; vv = rv; gv = rg; }
          const f32x4 cs0 = rc0, cs1 = rc1;
          const float cc[4] = {cs0.x, cs0.z, cs1.x, cs1.z}, sn[4] = {cs0.y, cs0.w, cs1.y, cs1.w};
          const float dq = __expf(lg * (float)(t + 1)), dk = (t < L) ? 0.125f * __expf(lg * (float)(L - 1 - t)) : 0.f;
          float qa[4], qb[4], ka[4], kb[4];
#pragma unroll
          for (int e = 0; e < 4; ++e) { qa[e] = q1[e] * cc[e] - q2[e] * sn[e]; qb[e] = q1[e] * sn[e] + q2[e] * cc[e]; ka[e] = k1[e] * cc[e] - k2[e] * sn[e]; kb[e] = k1[e] * sn[e] + k2[e] * cc[e]; }
          u32x2 w;
          w.x = pk2(qa[0], qa[1]); w.y = pk2(qa[2], qa[3]); *(u32x2*)(QL + t * 72 + 4 * j) = w; w.x = pk2(qb[0], qb[1]); w.y = pk2(qb[2], qb[3]); *(u32x2*)(QL + t * 72 + 32 + 4 * j) = w;
          w.x = pk2(qa[0] * dq, qa[1] * dq); w.y = pk2(qa[2] * dq, qa[3] * dq); *(u32x2*)(QG + t * 72 + 4 * j) = w; w.x = pk2(qb[0] * dq, qb[1] * dq); w.y = pk2(qb[2] * dq, qb[3] * dq); *(u32x2*)(QG + t * 72 + 32 + 4 * j) = w;
          w.x = pk2(ka[0] * 0.125f, ka[1] * 0.125f); w.y = pk2(ka[2] * 0.125f, ka[3] * 0.125f); *(u32x2*)(KL + t * 72 + 4 * j) = w;
          w.x = pk2(kb[0] * 0.125f, kb[1] * 0.125f); w.y = pk2(kb[2] * 0.125f, kb[3] * 0.125f); *(u32x2*)(KL + t * 72 + 32 + 4 * j) = w;
#pragma unroll
          for (int e = 0; e < 4; ++e) { KDT[(4 * j + e) * 72 + t] = (bf16)f2bf(ka[e] * dk); KDT[(32 + 4 * j + e) * 72 + t] = (bf16)f2bf(kb[e] * dk); }
          const unsigned vw[4] = {vv.x, vv.y, vv.z, vv.w};
#pragma unroll
          for (int e = 0; e < 4; ++e) { VT[(8 * j + 2 * e) * 72 + t] = (bf16)(vw[e] & 0xffffu); VT[(8 * j + 2 * e + 1) * 72 + t] = (bf16)(vw[e] >> 16); }
          *(u32x4*)(GL + t * 72 + 8 * j) = gv; }
        __syncthreads();
        if (wid < 4) { const int ti = wid >> 1, tj = wid & 1; f32x16 p;
#pragma unroll
            for (int i = 0; i < 16; ++i) p[i] = 0.f;
#pragma unroll
            for (int ks = 0; ks < 4; ++ks) { const bf16x8 a = *(const bf16x8*)(KL + (32 * ti + r) * 72 + 16 * ks + 8 * hh), bq = *(const bf16x8*)(QL + (32 * tj + r) * 72 + 16 * ks + 8 * hh); p = MFMA32(a, bq, p); }
            const int t = 32 * tj + r;
#pragma unroll
            for (int g4 = 0; g4 < 4; ++g4) { const int i0 = 32 * ti + 8 * g4 + 4 * hh; float o[4];
#pragma unroll
                for (int e = 0; e < 4; ++e) { const int i = i0 + e; o[e] = (t >= i) ? p[4 * g4 + e] * __expf(lg * (float)(t - i)) : 0.f; }
                u32x2 w; w.x = pk2(o[0], o[1]); w.y = pk2(o[2], o[3]); *(u32x2*)(PL + t * 72 + i0) = w; }
        } else { const int tm = (wid >> 1) & 1, en = wid & 1;
#pragma unroll
            for (int i = 0; i < 16; ++i) acc[i] = 0.f;
#pragma unroll
            for (int ks = 0; ks < 4; ++ks) { const bf16x8 a = *(const bf16x8*)(QG + (32 * tm + r) * 72 + 16 * ks + 8 * hh), bs = *(const bf16x8*)(ST + (32 * en + r) * 72 + 16 * ks + 8 * hh); acc = MFMA32(a, bs, acc); }
        }
        __syncthreads();
        if (wid < 4) { const int dm = wid >> 1, en = wid & 1; acc = acc * __expf(lg * (float)L);
#pragma unroll
            for (int ks = 0; ks < 4; ++ks) { const bf16x8 a = *(const bf16x8*)(KDT + (32 * dm + r) * 72 + 16 * ks + 8 * hh), bv = *(const bf16x8*)(VT + (32 * en + r) * 72 + 16 * ks + 8 * hh); acc = MFMA32(a, bv, acc); }
        } else { const int tm = (wid >> 1) & 1, en = wid & 1;
#pragma unroll
            for (int ks = 0; ks < 4; ++ks) { const bf16x8 a = *(const bf16x8*)(PL + (32 * tm + r) * 72 + 16 * ks + 8 * hh), bv = *(const bf16x8*)(VT + (32 * en + r) * 72 + 16 * ks + 8 * hh); acc = MFMA32(a, bv, acc); }
        }
        __syncthreads();
        if (wid < 4) { const int dm = wid >> 1, en = wid & 1;
#pragma unroll
            for (int g4 = 0; g4 < 4; ++g4) { u32x2 w; w.x = pk2(acc[4 * g4], acc[4 * g4 + 1]); w.y = pk2(acc[4 * g4 + 2], acc[4 * g4 + 3]); *(u32x2*)(ST + (32 * en + r) * 72 + 32 * dm + 8 * g4 + 4 * hh) = w; }
        } else { const int tm = (wid >> 1) & 1, en = wid & 1;
#pragma unroll
            for (int i = 0; i < 16; ++i) OS[(32 * tm + crow(i, hh)) * 68 + 32 * en + r] = acc[i];
        }
        __syncthreads();
        { const int t = tid >> 3, sg = tid & 7; const f32x4 v0 = *(const f32x4*)(OS + t * 68 + 8 * sg), v1 = *(const f32x4*)(OS + t * 68 + 8 * sg + 4);
          float s = (v0.x + v0.y) + (v0.z + v0.w) + (v1.x + v1.y) + (v1.z + v1.w);
          s += xshfl(s, lane ^ 1); s += xshfl(s, lane ^ 2); s += xshfl(s, lane ^ 4);
          const float mu = s * (1.0f / 64.0f);
          const f32x4 d0 = v0 - mu, d1 = v1 - mu; float q = (d0.x * d0.x + d0.y * d0.y) + (d0.z * d0.z + d0.w * d0.w) + (d1.x * d1.x + d1.y * d1.y) + (d1.z * d1.z + d1.w * d1.w);
          q += xshfl(q, lane ^ 1); q += xshfl(q, lane ^ 2); q += xshfl(q, lane ^ 4);
          const float rs = __builtin_amdgcn_rsqf(q * (1.0f / 64.0f) + EPS);
          if (t < L) { const u32x4 gv = *(const u32x4*)(GL + t * 72 + 8 * sg); u32x4 w;
              w.x = pk2(d0.x * rs * silu(bflo(gv.x)), d0.y * rs * silu(bfhi(gv.x))); w.y = pk2(d0.z * rs * silu(bflo(gv.y)), d0.w * rs * silu(bfhi(gv.y)));
              w.z = pk2(d1.x * rs * silu(bflo(gv.z)), d1.y * rs * silu(bfhi(gv.z))); w.w = pk2(d1.z * rs * silu(bflo(gv.w)), d1.w * rs * silu(bfhi(gv.w)));
              *(u32x4*)(O + (size_t)(row0 + t) * DM + 768 + 64 * h + 8 * sg) = w; } }
        if (c + 1 < NCHUNK) { rq1 = nq1; rq2 = nq2; rk1 = nk1; rk2 = nk2; rv = nv; rg = ng; rc0 = nc0; rc1 = nc1; }
        __syncthreads();
    }
#undef R_LOAD
    if (wid < 4) { const int dm = wid >> 1, en = wid & 1; float* so = C.out + O_RETP + ((size_t)((l * NB + b) * 4 + h)) * 4096;
#pragma unroll
        for (int i = 0; i < 16; ++i) so[(size_t)(32 * dm + crow(i, hh)) * 64 + 32 * en + r] = acc[i]; }
}

DI void m2_lru_item(const Ctx& C, int l, int b, int c) {
    const int e = C.tid & 255, th = C.tid >> 8;
    const bf16* AC = (const bf16*)(C.ws + WS_LA); const bf16* HL = (const bf16*)(C.ws + WS_LB); const bf16* PB = (const bf16*)(C.ws + WS_PB); bf16* O = (bf16*)(C.ws + WS_O);
    const float* CA = (const float*)(C.ws + WS_CA) + (size_t)(b * NCHUNK) * 256 + e; const float* CB = (const float*)(C.ws + WS_CB) + (size_t)(b * NCHUNK) * 256 + e;
    float hin = 0.f;
#pragma unroll 8
    for (int cc = 0; cc < c; ++cc) hin = CA[cc * 256] * hin + CB[cc * 256];
    const int L = (c == 0) ? 16 : 64, row0 = chunk_row0(b, c);
#pragma unroll 8
    for (int t = 0; t < 32; ++t) { const int tt = 32 * th + t;
        if (tt < L) { const size_t row = (size_t)(row0 + tt);
            const float hv = bf1(AC[row * 256 + e]) * hin + bf1(HL[row * 256 + e]);
            O[row * DM + 512 + e] = (bf16)f2bf(hv * gelu_tanh(bf1(PB[row * PB_LD + 768 + e]))); } }
    if (c == NCHUNK - 1 && th == 1) C.out[O_LRUP + (size_t)(l * NB + b) * 256 + e] = CA[c * 256] * hin + CB[c * 256];
}
DI void ms_dn(const Ctx& C, int l, int s, int h) {
    const int tid = C.tid, lane = C.lane, wid = C.wave, row = SROW0 + s;
    float* sh = (float*)C.lds; float* scal = sh + 384; float* Ush = sh + 400; float* osh = sh + 528; float* red = sh + 1024;
    const bf16* PA = (const bf16*)(C.ws + WS_PA); const bf16* PB = (const bf16*)(C.ws + WS_PB); bf16* O = (bf16*)(C.ws + WS_O);
    const int e4 = tid & 31, dg = tid >> 5;
    const float* S0p = inp(I_SDN) + ((size_t)((l * NSAMP + s) * 4 + h) * 128) * 128;
    f32x4 sv[8];
#pragma unroll
    for (int i = 0; i < 8; ++i) sv[i] = *(const f32x4*)(S0p + (size_t)(8 * dg + i) * 128 + 4 * e4);
    const int part = tid >> 7, d_ = tid & 127, col = (part < 3 ? part : 0) * 512 + h * 128 + d_;
    const float* buf = inp(I_SDNC) + ((size_t)(l * NSAMP + s) * 3) * 1536 + col; const float* cw = inp(I_DNCW) + (size_t)l * 4 * 1536 + col;
    const float x0 = buf[0], x1 = buf[1536], x2 = buf[3072], x3 = bf1(PA[(size_t)row * PA_LD + col]), c0 = cw[0], c1 = cw[1536], c2 = cw[3072], c3 = cw[4608];
    const float a_ = bf1(PA[(size_t)row * PA_LD + 1536 + h]), b_ = bf1(PA[(size_t)row * PA_LD + 1540 + h]), alog = inp(I_ALOG)[l * 4 + h], dtb = inp(I_DTB)[l * 4 + h];
    const float z0 = bf1(PB[(size_t)row * PB_LD + h * 128 + lane]), z1 = bf1(PB[(size_t)row * PB_LD + h * 128 + 64 + lane]), nw0 = inp(I_DNNW)[l * 128 + lane], nw1 = inp(I_DNNW)[l * 128 + 64 + lane];
    if (tid < 384) { sh[part * 128 + d_] = silu(c0 * x0 + c1 * x1 + c2 * x2 + c3 * x3);
        float* co = C.out + O_DNCS + ((size_t)(l * NSAMP + s) * 3) * 1536 + col; co[0] = x1; co[1536] = x2; co[3072] = x3; }
    __syncthreads();
    if (wid < 2) { const float v0 = sh[wid * 128 + lane], v1 = sh[wid * 128 + 64 + lane]; const float ss = wave_sum(v0 * v0 + v1 * v1, lane);
        const float sc = __builtin_amdgcn_rsqf(ss + EPS) * (wid == 0 ? 0.08838834764831845f : 1.0f); sh[wid * 128 + lane] = v0 * sc; sh[wid * 128 + 64 + lane] = v1 * sc; }
    __syncthreads();
    if (wid == 0) { const float qk = wave_sum(sh[lane] * sh[128 + lane] + sh[64 + lane] * sh[192 + lane], lane);
        if (lane == 0) { const float g = -__expf(alog) * softplus(a_ + dtb); scal[0] = qk; scal[1] = __expf(g); scal[2] = sigm(b_); } }
    f32x4 kS = (f32x4){0.f, 0.f, 0.f, 0.f}, qS = kS;
#pragma unroll
    for (int i = 0; i < 8; ++i) { const int d = 8 * dg + i; kS = kS + sv[i] * sh[128 + d]; qS = qS + sv[i] * sh[d]; }
    *(f32x4*)(red + dg * 256 + 4 * e4) = kS; *(f32x4*)(red + dg * 256 + 128 + 4 * e4) = qS;
    __syncthreads();
    if (tid < 128) { float ks = 0.f, qs = 0.f;
#pragma unroll
        for (int g = 0; g < 16; ++g) { ks += red[g * 256 + tid]; qs += red[g * 256 + 128 + tid]; }
        const float eG = scal[1], U = scal[2] * (sh[256 + tid] - eG * ks); Ush[tid] = U; osh[tid] = eG * qs + scal[0] * U; }
    __syncthreads();
    { const f32x4 U4 = *(const f32x4*)(Ush + 4 * e4); const float eG = scal[1];
      float* So = C.out + O_DNS + ((size_t)((l * NSAMP + s) * 4 + h) * 128) * 128;
#pragma unroll
      for (int i = 0; i < 8; ++i) { const int d = 8 * dg + i; *(f32x4*)(So + (size_t)d * 128 + 4 * e4) = sv[i] * eG + U4 * sh[128 + d]; } }
    if (wid == 0) { const float o0 = osh[lane], o1 = osh[lane + 64]; const float ss = wave_sum(o0 * o0 + o1 * o1, lane); const float rs = __builtin_amdgcn_rsqf(ss * (1.0f / 128.0f) + EPS);
        bf16* op = O + (size_t)row * DM + h * 128;
        op[lane] = (bf16)f2bf(o0 * rs * nw0 * silu(z0)); op[lane + 64] = (bf16)f2bf(o1 * rs * nw1 * silu(z1)); }
    __syncthreads();
}
DI void ms_ret(const Ctx& C, int l, int s, int h) {
    const int tid = C.tid, lane = C.lane, wid = C.wave, row = SROW0 + s;
    float* sh = (float*)C.lds; float* osh = sh + 256; float* red = sh + 1024;
    const bf16* PB = (const bf16*)(C.ws + WS_PB); bf16* O = (bf16*)(C.ws + WS_O); const float* rope = (const float*)(C.ws + WS_ROPE) + (size_t)2064 * 32 * 2;
    const float gam = 1.0f - exp2f(-5.0f - (float)h);
    const bf16* pr = PB + (size_t)row * PB_LD;
    const int e4 = tid & 15, dg = tid >> 4;
    const float* S0p = inp(I_SRET) + ((size_t)((l * NSAMP + s) * 4 + h) * 64) * 64;
    f32x4 sv[2];
#pragma unroll
    for (int i = 0; i < 2; ++i) sv[i] = *(const f32x4*)(S0p + (size_t)(2 * dg + i) * 64 + 4 * e4);
    const int i_ = tid & 31;
    const float q1 = bf1(pr[1024 + 64 * h + i_]), q2 = bf1(pr[1024 + 64 * h + 32 + i_]), k1 = bf1(pr[1280 + 64 * h + i_]), k2 = bf1(pr[1280 + 64 * h + 32 + i_]), cr = rope[2 * i_], sr = rope[2 * i_ + 1];
    const float vv = bf1(pr[1536 + 64 * h + lane]), gg = bf1(pr[1792 + 64 * h + lane]);
    if (tid < 32) { sh[i_] = q1 * cr - q2 * sr; sh[32 + i_] = q1 * sr + q2 * cr; sh[64 + i_] = 0.125f * (k1 * cr - k2 * sr); sh[96 + i_] = 0.125f * (k1 * sr + k2 * cr); }
    else if (tid >= 64 && tid < 128) sh[128 + lane] = vv;
    __syncthreads();
    if (wid == 0) { const float qk = wave_sum(sh[lane] * sh[64 + lane], lane); if (lane == 0) sh[192] = qk; }
    f32x4 qS = (f32x4){0.f, 0.f, 0.f, 0.f};
#pragma unroll
    for (int i = 0; i < 2; ++i) { const int d = 2 * dg + i; qS = qS + sv[i] * sh[d]; }
    *(f32x4*)(red + dg * 64 + 4 * e4) = qS;
    __syncthreads();
    if (tid < 64) { float qs = 0.f;
#pragma unroll
        for (int g = 0; g < 32; ++g) qs += red[g * 64 + tid];
        osh[tid] = gam * qs + sh[192] * sh[128 + tid]; }
    { const f32x4 v4 = *(const f32x4*)(sh + 128 + 4 * e4); float* So = C.out + O_RETS + ((size_t)((l * NSAMP + s) * 4 + h) * 64) * 64;
#pragma unroll
      for (int i = 0; i < 2; ++i) { const int d = 2 * dg + i; *(f32x4*)(So + (size_t)d * 64 + 4 * e4) = sv[i] * gam + v4 * sh[64 + d]; } }
    __syncthreads();
    if (wid == 0) { const float o = osh[lane]; const float mu = wave_sum(o, lane) * (1.0f / 64.0f); const float d = o - mu; const float var = wave_sum(d * d, lane) * (1.0f / 64.0f);
        O[(size_t)row * DM + 768 + 64 * h + lane] = (bf16)f2bf(d * __builtin_amdgcn_rsqf(var + EPS) * silu(gg)); }
    __syncthreads();
}
DI void ms_lru(const Ctx& C, int l, int s) {
    const int tid = C.tid, row = SROW0 + s; float* sh = (float*)C.lds;
    const bf16* PB = (const bf16*)(C.ws + WS_PB); bf16* O = (bf16*)(C.ws + WS_O);
    const int e = tid & 255, n = e >> 6, ee = e & 63;
    u32x4 wa8[8], wx8[8];
    { const unsigned char* wp = C.ws + WS_LWT + (size_t)l * 65536 + (size_t)((n * 64 + ee) * 64) * 2;
#pragma unroll
      for (int i = 0; i < 8; ++i) { wa8[i] = *(const u32x4*)(wp + 16 * i); wx8[i] = *(const u32x4*)(wp + 32768 + 16 * i); } }
    const float* buf = inp(I_SLRUC) + ((size_t)(l * NSAMP + s) * 3) * 256 + e; const float* cw = inp(I_LCW) + (size_t)l * 4 * 256 + e;
    const float x0 = buf[0], x1 = buf[256], x2 = buf[512], x3 = bf1(PB[(size_t)row * PB_LD + 512 + e]);
    const float xl = cw[0] * x0 + cw[256] * x1 + cw[512] * x2 + cw[768] * x3 + inp(I_LCB)[l * 256 + e];
    const float ba = inp(I_LBA)[l * 256 + e], bx = inp(I_LBX)[l * 256 + e], lam = inp(I_LLAM)[l * 256 + e], h0 = inp(I_SLRU)[(size_t)(l * NSAMP + s) * 256 + e], yv = bf1(PB[(size_t)row * PB_LD + 768 + e]);
    if (tid < 256) { sh[e] = xl; float* co = C.out + O_LRUCS + ((size_t)(l * NSAMP + s) * 3) * 256 + e; co[0] = x1; co[256] = x2; co[512] = x3; }
    __syncthreads();
    if (tid < 256) { float ar = 0.f, ai = 0.f;
#pragma unroll
        for (int i = 0; i < 8; ++i) { const unsigned aw[4] = {wa8[i].x, wa8[i].y, wa8[i].z, wa8[i].w}, xw[4] = {wx8[i].x, wx8[i].y, wx8[i].z, wx8[i].w};
#pragma unroll
            for (int k = 0; k < 4; ++k) { const float xa = sh[n * 64 + 8 * i + 2 * k], xb = sh[n * 64 + 8 * i + 2 * k + 1];
                ar += xa * bflo(aw[k]) + xb * bfhi(aw[k]); ai += xa * bflo(xw[k]) + xb * bfhi(xw[k]); } }
        const float rg = sigm(ar + ba), ig = sigm(ai + bx), la = -8.0f * rg * softplus(-lam);
        const float a = __expf(la), bm = sqrtf(fmaxf(1.0f - __expf(2.0f * la), 0.f)) * (ig * xl);
        const float hn = a * h0 + bm;
        C.out[O_LRUS + (size_t)(l * NSAMP + s) * 256 + e] = hn;
        O[(size_t)row * DM + 512 + e] = (bf16)f2bf(hn * gelu_tanh(yv)); }
    __syncthreads();
}
DI void m2_phase(const Ctx& C0, int l) {
    const int bid = C0.bid;
#ifndef M2_SUB
#define M2_SUB 0xf
#endif
#ifndef M2_DUP
#define M2_DUP 0
#endif
    if (bid < 32) { if (M2_SUB & 1) { for (int rep = 0; rep < ((M2_DUP & 1) ? 2 : 1); ++rep) { const Ctx Cr = fresh(C0); m2_dn(Cr, l, bid >> 2, bid & 3); __syncthreads(); } } return; }
    if (bid < 64) { if (M2_SUB & 2) { for (int rep = 0; rep < ((M2_DUP & 2) ? 2 : 1); ++rep) { const Ctx Cr = fresh(C0); m2_ret(Cr, l, (bid - 32) >> 2, (bid - 32) & 3); __syncthreads(); } } }
    else if (M2_SUB & 8) { const int nb = C0.G - 64;
        for (int rep = 0; rep < ((M2_DUP & 8) ? 2 : 1); ++rep)
        for (int it = bid - 64; it < NB * NCHUNK + NSAMP * 9; it += nb) { const Ctx C = fresh(C0);
            if (it < NB * NCHUNK) { m2_lru_item(C, l, it / NCHUNK, it % NCHUNK); }
            else { const int s = (it - NB * NCHUNK) / 9, k = (it - NB * NCHUNK) % 9;
                if (k < 4) ms_dn(C, l, s, k); else if (k < 8) ms_ret(C, l, s, k - 4); else ms_lru(C, l, s); } } }
    { const Ctx C = fresh(C0); __syncthreads();
      const int gw = (bid - 32) * NWAVES + C.wave, nw = (C0.G - 32) * NWAVES;
      convert_set(C, l, 1, gw, nw);
      if (l + 1 < 2) convert_set(C, l + 1, 0, gw, nw); }
}
constexpr int N_PHASES = 17;
#ifndef PH_MASK
#define PH_MASK 0x3ff
#endif
#define PH_EN(k) ((PH_MASK >> (k)) & 1)
#ifndef MK_PER_PHASE
#define MK_PER_PHASE 0
#endif
__global__ void __launch_bounds__(NTHREADS, 2) hybrid_fwd(Args args) {
    extern __shared__ __attribute__((aligned(16))) unsigned char lds[];
    Ctx C0;
    C0.out = args.out; C0.ws = args.ws; C0.lds = lds;
    C0.tid = threadIdx.x; C0.lane = C0.tid & 63; C0.wave = __builtin_amdgcn_readfirstlane(C0.tid >> 6); C0.G = gridDim.x; C0.bid = blockIdx.x;
    const int wave0 = C0.wave;
    volatile LAS unsigned* MISC = (volatile LAS unsigned*)((LAS unsigned char*)lds + MISC_OFF);
    if (C0.tid < 64) MISC[C0.tid] = 0u;
    __syncthreads();
    XcdBarrier bar; bar.bar = (unsigned*)(C0.ws + WS_CTL) + CW_BAR; bar.x = 0; bar.st = nullptr;
    const int lo = args.ph_lo, hi = args.ph_hi;
    if (hi - lo > 1) bar = xcd_barrier_post((unsigned*)(C0.ws + WS_CTL) + CW_BAR, MISC + 8);
    LAS unsigned char* ldsl = (LAS unsigned char*)lds;
    if (lo == 0) {
        if (PH_EN(9)) { const Ctx C = fresh(C0); p0_rows(C); convert_lru_weights(C); convert_set(C, 0, 0, C.bid * NWAVES + C.wave, C.G * NWAVES); }
        if (1 < hi) { XcdBarrier b2 = bar; asm volatile("" : "+s"(b2.bar), "+s"(b2.x)); int t0 = C0.tid; asm volatile("" : "+v"(t0)); xcd_barrier(b2, t0); }
    }
#define GRID_BAR_IN() do { XcdBarrier b4 = bar; asm volatile("" : "+s"(b4.bar), "+s"(b4.x)); xcd_barrier(b4, C.tid); } while (0)
    for (int ph = (lo == 0 ? 1 : lo); ph < hi; ++ph) {
#ifndef DUP_MASK
#define DUP_MASK 0
#endif
        const int nrep = ((DUP_MASK >> ((ph - 1) % 8)) & 1) ? 2 : 1;
        for (int rep = 0; rep < nrep; ++rep) {
        Ctx C = C0;
        { int ln = (int)__builtin_amdgcn_mbcnt_hi(~0u, __builtin_amdgcn_mbcnt_lo(~0u, 0u)); int wv = wave0; asm volatile("" : "+v"(ln), "+s"(wv)); C.lane = ln; C.wave = wv; C.tid = wv * 64 + ln; }
        { unsigned long long w = (unsigned long long)C0.ws, o = (unsigned long long)C0.out; asm volatile("" : "+s"(w), "+s"(o));
          C.ws = (unsigned char*)(GAS unsigned char*)w; C.out = (float*)(GAS float*)o; }
        { int bb = C0.bid, gg = C0.G; asm volatile("" : "+s"(bb), "+s"(gg)); C.bid = bb; C.G = gg; }
        unsigned long long* SS = (unsigned long long*)(C.ws + WS_SS);
        bf16* XB = (bf16*)(C.ws + WS_XB); bf16* H = (bf16*)(C.ws + WS_H); bf16* PA = (bf16*)(C.ws + WS_PA); bf16* PB = (bf16*)(C.ws + WS_PB); bf16* O = (bf16*)(C.ws + WS_O);
        float* XE = (float*)(C.ws + WS_XE); unsigned char* wt = C.ws + WS_WT;
            if (rep) { XcdBarrier b3 = bar; asm volatile("" : "+s"(b3.bar), "+s"(b3.x)); xcd_barrier(b3, C.tid); }
            const int l = (ph - 1) / 8, k = (ph - 1) % 8;
            unsigned long long* ss_in1 = SS + (size_t)(3 * l) * NROWS;
            if (k == 0 && PH_EN(0)) {
                pg8::Gemm g{XB, (const bf16*)(wt + WT_F1I), NROWS, 2 * DFF, DM, nullptr, 0}; pg8::StaticOrder S; S.init(NROWS, 2 * DFF, C.G, C.bid);
                pg8::EpiSwiglu E{H, DFF, ss_in1};
                pg8::gemm_phase<pg8::EpiSwiglu, pg8::StaticOrder, true, true>(ldsl, g, S, E, C.tid);
            } else if (k == 1 && PH_EN(1)) {
                pg8::Gemm g{H, (const bf16*)(wt + WT_F1O), NROWS, DM, DFF, (float*)(C.ws + WS_SLAB), DFF / 256}; pg8::SplitOrder S; S.init(DFF, C.G, C.bid);
                pg8::EpiResid E{l == 0 ? inp(I_XP) : C.out + O_YP, C.out + O_YP, XE, XB, ss_in1 + NROWS, 0.5f};
                pg8::gemm_phase<pg8::EpiResid, pg8::SplitOrder, true, true>(ldsl, g, S, E, C.tid);
                GRID_BAR_IN(); fix_rows(C, g.nparts, E.scale, E.ssn);
            } else if (k == 2 && PH_EN(2)) {
                pg8::Gemm g{XB, (const bf16*)(wt + WT_WIN), NROWS, DIN_PAD, DM, nullptr, 0}; pg8::StaticOrder S; S.init(NROWS, DIN_PAD, C.G, C.bid);
                pg8::EpiProj E{PA, PB, ss_in1 + NROWS};
                pg8::gemm_phase<pg8::EpiProj, pg8::StaticOrder, true, true>(ldsl, g, S, E, C.tid);
            } else if (k == 3 && PH_EN(3)) { m1_phase(C, l);
            } else if (k == 4 && PH_EN(4)) { m2_phase(C, l);
            } else if (k == 5 && PH_EN(5)) {
                pg8::Gemm g{O, (const bf16*)(wt + WT_WOUT), NROWS, DM, DM, (float*)(C.ws + WS_SLAB), DM / 256}; pg8::SplitOrder S; S.init(DM, C.G, C.bid);
                pg8::EpiResid E{C.out + O_YP, C.out + O_YP, XE, XB, ss_in1 + 2 * NROWS, 1.0f};
                pg8::gemm_phase<pg8::EpiResid, pg8::SplitOrder, true, true>(ldsl, g, S, E, C.tid);
                GRID_BAR_IN(); fix_rows(C, g.nparts, E.scale, E.ssn);
            } else if (k == 6 && PH_EN(6)) {
                pg8::Gemm g{XB, (const bf16*)(wt + WT_F2I), NROWS, 2 * DFF, DM, nullptr, 0}; pg8::StaticOrder S; S.init(NROWS, 2 * DFF, C.G, C.bid);
                pg8::EpiSwiglu E{H, DFF, ss_in1 + 2 * NROWS};
                pg8::gemm_phase<pg8::EpiSwiglu, pg8::StaticOrder, true, true>(ldsl, g, S, E, C.tid);
            } else if (k == 7 && PH_EN(7)) {
                pg8::Gemm g{H, (const bf16*)(wt + WT_F2O), NROWS, DM, DFF, (float*)(C.ws + WS_SLAB), DFF / 256}; pg8::SplitOrder S; S.init(DFF, C.G, C.bid);
                pg8::EpiResid E{C.out + O_YP, C.out + O_YP, XE, XB, ss_in1 + 3 * NROWS, 0.5f};
                pg8::gemm_phase<pg8::EpiResid, pg8::SplitOrder, true, true>(ldsl, g, S, E, C.tid);
                GRID_BAR_IN(); if (l == 0) fix_rows(C, g.nparts, E.scale, E.ssn); else final_fix_norm(C, g.nparts, E.scale);
            }
        }
        if (ph + 1 < hi) { XcdBarrier b2 = bar; asm volatile("" : "+s"(b2.bar), "+s"(b2.x)); int ln = (int)__builtin_amdgcn_mbcnt_hi(~0u, __builtin_amdgcn_mbcnt_lo(~0u, 0u)); int wv = wave0; asm volatile("" : "+v"(ln), "+s"(wv)); xcd_barrier(b2, wv * 64 + ln); }
    }
}

extern "C" void kernel_launch(void* const* d_in, const int* in_sizes, int n_in, void* d_out, int out_size, void* d_ws, size_t ws_size, hipStream_t stream) {
    static int grid = 0;
    if (grid == 0) {
        if (n_in != 29 || out_size != (int)O_END || ws_size < WS_END) { fprintf(stderr, "kernel_launch: unexpected shapes: n_in %d out %d ws %zu (need %zu)\n", n_in, out_size, ws_size, (size_t)WS_END); grid = -1; return; }
        int dev = 0, cus = 0, per_cu = 0;
        if (hipGetDevice(&dev) != hipSuccess || hipDeviceGetAttribute(&cus, hipDeviceAttributeMultiprocessorCount, dev) != hipSuccess) { grid = -1; return; }
        if (hipFuncSetAttribute((const void*)hybrid_fwd, hipFuncAttributeMaxDynamicSharedMemorySize, LDS_BYTES) != hipSuccess) { fprintf(stderr, "kernel_launch: hipFuncSetAttribute failed\n"); grid = -1; return; }
        if (hipOccupancyMaxActiveBlocksPerMultiprocessor(&per_cu, (const void*)hybrid_fwd, NTHREADS, LDS_BYTES) != hipSuccess || per_cu < 1) { fprintf(stderr, "kernel_launch: occupancy query says %d blocks per CU\n", per_cu); grid = -1; return; }
        (void)hipGetLastError();
        grid = cus;
        if (grid < 128) { fprintf(stderr, "kernel_launch: %d CUs: too few for this kernel's phase-role split\n", grid); grid = -1; return; }
    }
    if (grid < 0) return;
    if (hipMemsetAsync((char*)d_ws + WS_CTL, 0, CTL_ZERO_BYTES, stream) != hipSuccess) return;
    Args a{};
    for (int i = 0; i < 29; ++i) a.in[i] = (const float*)d_in[i];
    a.out = (float*)d_out; a.ws = (unsigned char*)d_ws;
#if MK_PER_PHASE
    for (int ph = 0; ph < N_PHASES; ++ph) { a.ph_lo = ph; a.ph_hi = ph + 1; hipLaunchKernelGGL(hybrid_fwd, dim3(grid), dim3(NTHREADS), LDS_BYTES, stream, a); }
#else
    a.ph_lo = 0; a.ph_hi = N_PHASES; hipLaunchKernelGGL(hybrid_fwd, dim3(grid), dim3(NTHREADS), LDS_BYTES, stream, a);
#endif
}
```

```cpp
#include <hip/hip_runtime.h>
#include <cstdio>
#include <cstdint>
namespace pg8 {
#define PG8_LAS __attribute__((address_space(3)))
typedef unsigned short bf16_t;
typedef short bf16x8 __attribute__((ext_vector_type(8)));
typedef float f32x4 __attribute__((ext_vector_type(4)));
typedef unsigned u32x4 __attribute__((ext_vector_type(4)));
constexpr int BM = 256, BK = 64, HALF = 128, HTB = HALF * BK * 2  , STAGE_BYTES = 8 * HTB, NXCD = 8, WGM = 8;

__host__ __device__ __forceinline__ int lds_byte(int r, int c) { const int st = (r >> 4) * 2 + (c >> 5), rr = r & 15, cc = c & 31, ob = rr * 64 + cc * 2; return st * 1024 + (ob ^ (((ob >> 9) & 1) << 5)); }
__host__ __device__ __forceinline__ void stage_rc(int b, int& R, int& C) { const int st = b / 1024, sb = b % 1024, swz = sb ^ (((sb >> 9) & 1) << 5); R = (st >> 1) * 16 + swz / 64; C = (st & 1) * 32 + (swz % 64) / 2; }
__host__ __device__ __forceinline__ int perm32(int rho) { const int n = rho >> 4, i = rho & 15; return 8 * (i >> 2) + 4 * n + (i & 3); }

struct Unit { int pm, pn, kt0, nkt, part; };
struct Gemm { const bf16_t* A; const bf16_t* Bt; int M, N, K; float* slab; int nparts; };

struct StaticOrder {
    int nM, nN, nwg, G, c;
    __host__ __device__ void init(int M, int N, int G_, int c_) { nM = M / BM; nN = N / BM; nwg = nM * nN; G = G_; c = c_; }
    __host__ __device__ bool next(int i, Unit& u) const {
        const long L = (long)i * G + c; if (L >= nwg) { u.pm = 0; u.pn = 0; u.kt0 = 0; u.nkt = 0; u.part = -1; return false; }
        int wgid = (int)L; { const int q = nwg / NXCD, r = nwg % NXCD, xcd = wgid % NXCD, off = wgid / NXCD; wgid = (xcd < r ? xcd * (q + 1) : r * (q + 1) + (xcd - r) * q) + off; }
        const int nig = WGM * nN, gid = wgid / nig, fm = gid * WGM, gsz = (nM - fm) < WGM ? (nM - fm) : WGM;
        u.pm = fm + ((wgid % nig) % gsz); u.pn = (wgid % nig) / gsz; u.kt0 = 0; u.nkt = 0; u.part = -1; return true;
    }
    __device__ __forceinline__ void a_ready(const Unit&) const {}
    __device__ __forceinline__ void done(const Unit&) const {}
};

__device__ __forceinline__ unsigned cvt_pk_bf16(float lo, float hi) { unsigned r; asm volatile("v_cvt_pk_bf16_f32 %0, %1, %2" : "=v"(r) : "v"(lo), "v"(hi)); return r; }
struct SplitOrder {
    StaticOrder so; int nparts;
    __host__ __device__ void init(int K, int G_, int c_) { so.init(64 * BM, 1024, G_, c_); nparts = K / BK / 4; }
    __host__ __device__ bool next(int i, Unit& u) const {
        Unit f; const bool full = so.next(i, f);
        const int L = i * so.G + so.c - so.nwg; const bool part = (L >= 0) && (L < 4 * nparts);
        const int q = part ? L / nparts : 0, p = part ? L % nparts : 0;
        Unit r; r.pm = full ? f.pm : 64; r.pn = full ? f.pn : q; r.kt0 = full ? 0 : 4 * p; r.nkt = full ? 0 : 4; r.part = full ? -1 : p;
        u = r; return full || part;
    }
    __device__ __forceinline__ void a_ready(const Unit&) const {}
    __device__ __forceinline__ void done(const Unit&) const {}
};
__device__ __forceinline__ void slab_dump(const f32x4 (&acc)[2][2][4][2], const Unit& u, float* slab, int nparts, int wr, int wc, int fr, int fq) {
    float* base = slab + (size_t)(u.pn * nparts + u.part) * 65536 + (size_t)(wr * 64 + fr) * 256 + wc * 32 + 8 * fq;
#pragma unroll
    for (int ai = 0; ai < 2; ++ai)
#pragma unroll
        for (int m = 0; m < 4; ++m)
#pragma unroll
            for (int bj = 0; bj < 2; ++bj) { float* p = base + (size_t)(ai * HALF + m * 16) * 256 + bj * HALF; *(f32x4*)p = acc[ai][bj][m][0]; *(f32x4*)(p + 4) = acc[ai][bj][m][1]; }
}
typedef unsigned u32x2 __attribute__((ext_vector_type(2)));
__device__ __forceinline__ float fast_sigmoid(float x) { return __builtin_amdgcn_rcpf(1.0f + __expf(-x)); }
__device__ __forceinline__ float fast_silu(float x) { return x * fast_sigmoid(x); }
constexpr int NP_ROWS = 16384;

struct EpiSwiglu {
    static constexpr bool PERM = true, AFTER_DRAIN = false;
    bf16_t* H; int ldh; const unsigned long long* ss;
    __device__ __forceinline__ void operator()(const f32x4 (&acc)[2][2][4][2], const Unit& u, int wr, int wc, int fr, int fq) const {
        const int row0 = u.pm * BM + wr * 64 + fr, col0 = u.pn * 128 + wc * 32 + 8 * fq;
        unsigned long long sv[8];
#pragma unroll
        for (int i = 0; i < 8; ++i) sv[i] = ss[row0 + (i >> 2) * HALF + (i & 3) * 16];
        float rsv[8];
#pragma unroll
        for (int i = 0; i < 8; ++i) rsv[i] = __builtin_amdgcn_rsqf((float)sv[i] * (1.0f / (1024.0f * 1048576.0f)) + 1e-6f);
#pragma unroll
        for (int ai = 0; ai < 2; ++ai)
#pragma unroll
            for (int m = 0; m < 4; ++m) {
                const int row = row0 + ai * HALF + m * 16;
                const float rs = rsv[ai * 4 + m];
                float hv[8];
#pragma unroll
                for (int n = 0; n < 2; ++n)
#pragma unroll
                    for (int e = 0; e < 4; ++e) { const float g = acc[ai][0][m][n][e] * rs, up = acc[ai][1][m][n][e] * rs; hv[4 * n + e] = fast_silu(g) * up; }
                u32x4 w; w.x = cvt_pk_bf16(hv[0], hv[1]); w.y = cvt_pk_bf16(hv[2], hv[3]); w.z = cvt_pk_bf16(hv[4], hv[5]); w.w = cvt_pk_bf16(hv[6], hv[7]);
                *(u32x4*)(H + (size_t)row * ldh + col0) = w;
            }
    }
};
struct EpiProj {
    static constexpr bool PERM = true, AFTER_DRAIN = false;
    bf16_t* PA; bf16_t* PB; const unsigned long long* ss; const float* gw;
    __device__ __forceinline__ void operator()(const f32x4 (&acc)[2][2][4][2], const Unit& u, int wr, int wc, int fr, int fq) const {
        const int row0 = u.pm * BM + wr * 64 + fr;
        bf16_t* base; int ld, colt;
        if (u.pn < 7) { base = PA; ld = 1792; colt = u.pn * 256; } else { base = PB; ld = 2048; colt = (u.pn - 7) * 256; }
        const int col0 = colt + wc * 32 + 8 * fq;
        unsigned long long sv[8];
#pragma unroll
        for (int i = 0; i < 8; ++i) sv[i] = ss[row0 + (i >> 2) * HALF + (i & 3) * 16];
        const bool gate = (u.pn == 7) | (u.pn == 8);
        f32x4 gv[2][2];
#pragma unroll
        for (int bj = 0; bj < 2; ++bj)
#pragma unroll
            for (int n = 0; n < 2; ++n) gv[bj][n] = gate ? *(const f32x4*)(gw + ((col0 + bj * HALF + 4 * n) & 127)) : (f32x4){1.f, 1.f, 1.f, 1.f};
        float rsv[8];
#pragma unroll
        for (int i = 0; i < 8; ++i) rsv[i] = __builtin_amdgcn_rsqf((float)sv[i] * (1.0f / (1024.0f * 1048576.0f)) + 1e-6f);
#pragma unroll
        for (int ai = 0; ai < 2; ++ai)
#pragma unroll
            for (int m = 0; m < 4; ++m) {
                const int row = row0 + ai * HALF + m * 16;
                const float rs = rsv[ai * 4 + m];
                bf16_t* rowp = base + (size_t)row * ld + col0;
#pragma unroll
                for (int bj = 0; bj < 2; ++bj) { f32x4 v0 = acc[ai][bj][m][0] * rs, v1 = acc[ai][bj][m][1] * rs;
                    if (gate) {
#pragma unroll
                        for (int e = 0; e < 4; ++e) { v0[e] = gv[bj][0][e] * fast_silu(v0[e]); v1[e] = gv[bj][1][e] * fast_silu(v1[e]); } }
                    u32x4 w; w.x = cvt_pk_bf16(v0[0], v0[1]); w.y = cvt_pk_bf16(v0[2], v0[3]); w.z = cvt_pk_bf16(v1[0], v1[1]); w.w = cvt_pk_bf16(v1[2], v1[3]);
                    *(u32x4*)(rowp + bj * HALF) = w; }
            }
    }
};
struct EpiResid {
    static constexpr bool PERM = true, AFTER_DRAIN = false;
    const float* xin32; bf16_t* xb; unsigned long long* ssn; float scale;
    __device__ __forceinline__ void operator()(const f32x4 (&acc)[2][2][4][2], const Unit& u, int wr, int wc, int fr, int fq) const {
        const int row0 = u.pm * BM + wr * 64 + fr, col0 = u.pn * BM + wc * 32 + 8 * fq;
        if (xin32) {
#pragma unroll
            for (int ah = 0; ah < 4; ++ah) { const int ai = ah >> 1, mh = (ah & 1) * 2;
                f32x4 xo[2][2][2];
#pragma unroll
                for (int mm = 0; mm < 2; ++mm) { const float* xi = xin32 + (size_t)(row0 + ai * HALF + (mh + mm) * 16) * 1024;
#pragma unroll
                    for (int bj = 0; bj < 2; ++bj) { xo[mm][bj][0] = *(const f32x4*)(xi + col0 + bj * HALF); xo[mm][bj][1] = *(const f32x4*)(xi + col0 + bj * HALF + 4); } }
#pragma unroll
                for (int mm = 0; mm < 2; ++mm) { const int m = mh + mm; const int row = row0 + ai * HALF + m * 16; float sq = 0.f;
#pragma unroll
                    for (int bj = 0; bj < 2; ++bj) sq += put(xo[mm][bj][0] + acc[ai][bj][m][0] * scale, xo[mm][bj][1] + acc[ai][bj][m][1] * scale, row, col0 + bj * HALF);
                    rowsq(sq, row, fr, fq); }
            }
        } else {
#pragma unroll
            for (int ai = 0; ai < 2; ++ai) {
                u32x4 xr[4][2];
#pragma unroll
                for (int m = 0; m < 4; ++m)
#pragma unroll
                    for (int bj = 0; bj < 2; ++bj) xr[m][bj] = *(const u32x4*)(xb + (size_t)(row0 + ai * HALF + m * 16) * 1024 + col0 + bj * HALF);
#pragma unroll
                for (int m = 0; m < 4; ++m) { const int row = row0 + ai * HALF + m * 16; float sq = 0.f;
#pragma unroll
                    for (int bj = 0; bj < 2; ++bj) { const u32x4 r = xr[m][bj];
                        const f32x4 x0 = (f32x4){__builtin_bit_cast(float, r.x << 16), __builtin_bit_cast(float, r.x & 0xffff0000u), __builtin_bit_cast(float, r.y << 16), __builtin_bit_cast(float, r.y & 0xffff0000u)};
                        const f32x4 x1 = (f32x4){__builtin_bit_cast(float, r.z << 16), __builtin_bit_cast(float, r.z & 0xffff0000u), __builtin_bit_cast(float, r.w << 16), __builtin_bit_cast(float, r.w & 0xffff0000u)};
                        sq += put(x0 + acc[ai][bj][m][0] * scale, x1 + acc[ai][bj][m][1] * scale, row, col0 + bj * HALF); }
                    rowsq(sq, row, fr, fq); }
            }
        }
    }
    __device__ __forceinline__ float put(const f32x4 a0, const f32x4 a1, int row, int c) const {
        u32x4 w; w.x = cvt_pk_bf16(a0[0], a0[1]); w.y = cvt_pk_bf16(a0[2], a0[3]); w.z = cvt_pk_bf16(a1[0], a1[1]); w.w = cvt_pk_bf16(a1[2], a1[3]);
        *(u32x4*)(xb + (size_t)row * 1024 + c) = w;
        return (a0[0] * a0[0] + a0[1] * a0[1]) + (a0[2] * a0[2] + a0[3] * a0[3]) + (a1[0] * a1[0] + a1[1] * a1[1]) + (a1[2] * a1[2] + a1[3] * a1[3]);
    }
    __device__ __forceinline__ void rowsq(float sq, int row, int fr, int fq) const {
        sq += __builtin_bit_cast(float, __builtin_amdgcn_ds_bpermute((fr + 16 * (fq ^ 1)) << 2, __builtin_bit_cast(int, sq))); sq += __builtin_bit_cast(float, __builtin_amdgcn_ds_bpermute((fr + 16 * (fq ^ 2)) << 2, __builtin_bit_cast(int, sq)));
        if (fq == 0) atomicAdd(ssn + row, (unsigned long long)(sq * 1048576.0f + 0.5f));
    }
};
template <class Epi, class Sched, bool ALIGN_EPI = false, bool SP2 = false>
__device__ __forceinline__ void gemm_phase(PG8_LAS unsigned char* lds, const Gemm g, const Sched& S, const Epi& E, const int tid_in) {
    int tid_ = tid_in; asm volatile("" : "+v"(tid_));
    const int tid = tid_, wid = __builtin_amdgcn_readfirstlane(tid >> 6), lane = tid & 63, wr = wid >> 2, wc = wid & 3, fr = lane & 15, fq = lane >> 4;
    const int K = g.K, nt = K / BK;
    unsigned voffA[2], voffB[2];
#pragma unroll
    for (int i = 0; i < 2; ++i) { int R, C; stage_rc(tid * 16 + i * 8192, R, C); const int Rb = Epi::PERM ? ((R & ~31) + perm32(R & 31)) : R;
        voffA[i] = (unsigned)(R * K + C) * 2u; voffB[i] = (unsigned)(Rb * K + C) * 2u; }
    const size_t kstep = (size_t)(BK * 2);
    const size_t hstep = (size_t)HALF * K * 2;
    const size_t tstep = 2 * hstep;
    const unsigned ldsw = (unsigned)wid * 1024u;
    const int aoff = lds_byte(wr * 64 + fr, fq * 8), boff = lds_byte(wc * 32 + fr, fq * 8);
#define PG8_SA(b, h) (((b) * 2 + (h)) * HTB)
#define PG8_SB(b, h) ((4 + (b) * 2 + (h)) * HTB)
#define PG8_STAGE(bufoff, gbase, voff) do { _Pragma("unroll") for (int _i = 0; _i < 2; ++_i) \
        __builtin_amdgcn_global_load_lds((const unsigned*)((const char*)(gbase) + (voff)[_i]), (PG8_LAS unsigned*)(lds + (bufoff) + ldsw + _i * 8192), 16, 0, 0); } while (0)
#define PG8_LDA(dst, b, h) do { _Pragma("unroll") for (int m = 0; m < 4; ++m) _Pragma("unroll") for (int k = 0; k < 2; ++k) dst[m][k] = *(const PG8_LAS bf16x8*)(lds + PG8_SA(b, h) + aoff + m * 2048 + k * 1024); } while (0)
#define PG8_LDB(dst, b, h) do { _Pragma("unroll") for (int n = 0; n < 2; ++n) _Pragma("unroll") for (int k = 0; k < 2; ++k) dst[n][k] = *(const PG8_LAS bf16x8*)(lds + PG8_SB(b, h) + boff + n * 2048 + k * 1024); } while (0)
#define PG8_MMA(ai, bj, At, Bt) do { __builtin_amdgcn_s_setprio(1); _Pragma("unroll") for (int m = 0; m < 4; ++m) _Pragma("unroll") for (int n = 0; n < 2; ++n) _Pragma("unroll") for (int k = 0; k < 2; ++k) \
        acc[ai][bj][m][n] = __builtin_amdgcn_mfma_f32_16x16x32_bf16(Bt[n][k], At[m][k], acc[ai][bj][m][n], 0, 0, 0); __builtin_amdgcn_s_setprio(0); } while (0)
#define PG8_WAIT_V(n) asm volatile("s_waitcnt vmcnt(" #n ")" ::: "memory")
#define PG8_WAIT_L(n) asm volatile("s_waitcnt lgkmcnt(" #n ")" ::: "memory")
#define PG8_BAR __builtin_amdgcn_s_barrier()
#define PG8_SCHED __builtin_amdgcn_sched_barrier(0)
    Unit cur, nxt; int ui = 0;
    if (!S.next(0, cur)) return;
    f32x4 acc[2][2][4][2];
#pragma unroll
    for (int a = 0; a < 2; ++a)
#pragma unroll
        for (int b = 0; b < 2; ++b)
#pragma unroll
            for (int m = 0; m < 4; ++m)
#pragma unroll
                for (int n = 0; n < 2; ++n) acc[a][b][m][n] = (f32x4){0.f, 0.f, 0.f, 0.f};
    bf16x8 At[4][2], B0[2][2], B1[2][2];
    int cnt = cur.nkt > 0 ? cur.nkt : nt;
    const char* cA = (const char*)g.A + (size_t)cur.pm * tstep + (size_t)cur.kt0 * kstep; const char* cB = (const char*)g.Bt + (size_t)cur.pn * tstep + (size_t)cur.kt0 * kstep;
    S.a_ready(cur);
    if constexpr (SP2) {
        PG8_STAGE(PG8_SB(0, 0), cB, voffB); PG8_STAGE(PG8_SB(0, 1), cB + hstep, voffB); PG8_STAGE(PG8_SA(0, 0), cA, voffA); PG8_STAGE(PG8_SA(0, 1), cA + hstep, voffA);
        if (wr == 1) PG8_BAR;
        PG8_WAIT_V(2); PG8_BAR;
        PG8_STAGE(PG8_SB(1, 0), cB + kstep, voffB); PG8_STAGE(PG8_SA(1, 0), cA + kstep, voffA); PG8_STAGE(PG8_SB(1, 1), cB + hstep + kstep, voffB);
        PG8_WAIT_V(6); PG8_BAR;
    } else {
        PG8_STAGE(PG8_SB(0, 0), cB, voffB); PG8_STAGE(PG8_SA(0, 0), cA, voffA); PG8_STAGE(PG8_SB(0, 1), cB + hstep, voffB); PG8_STAGE(PG8_SA(0, 1), cA + hstep, voffA);
        if (wr == 1) PG8_BAR;
        PG8_WAIT_V(4); PG8_BAR;
        PG8_STAGE(PG8_SB(1, 0), cB + kstep, voffB); PG8_STAGE(PG8_SA(1, 0), cA + kstep, voffA); PG8_STAGE(PG8_SB(1, 1), cB + hstep + kstep, voffB);
        PG8_WAIT_V(6); PG8_BAR;
    }
    for (;;) {
        const bool has_next = S.next(ui + 1, nxt);
        const char* nA = has_next ? (const char*)g.A + (size_t)nxt.pm * tstep + (size_t)nxt.kt0 * kstep : cA; const char* nB = has_next ? (const char*)g.Bt + (size_t)nxt.pn * tstep + (size_t)nxt.kt0 * kstep : cB;
        for (int t = 0; t < cnt; t += 2) {
            const bool last = (t == cnt - 2);
            const char* a1 = cA + (size_t)(t + 1) * kstep;
            const char* a2 = last ? nA : cA + (size_t)(t + 2) * kstep; const char* b2 = last ? nB : cB + (size_t)(t + 2) * kstep;
            const char* a3 = a2 + kstep; const char* b3 = b2 + kstep;
            if (last && has_next) S.a_ready(nxt);
            if constexpr (SP2) {
            PG8_LDB(B0, 0, 0); PG8_LDB(B1, 0, 1); PG8_SCHED; PG8_LDA(At, 0, 0); PG8_STAGE(PG8_SA(1, 1), a1 + hstep, voffA);
            PG8_WAIT_V(8); PG8_WAIT_L(0); PG8_BAR; PG8_MMA(0, 0, At, B0); PG8_MMA(0, 1, At, B1); PG8_BAR; PG8_SCHED;
            PG8_LDA(At, 0, 1); PG8_STAGE(PG8_SB(0, 0), b2, voffB); PG8_STAGE(PG8_SB(0, 1), b2 + hstep, voffB); PG8_STAGE(PG8_SA(0, 0), a2, voffA);
            PG8_WAIT_V(8); PG8_WAIT_L(0); PG8_BAR; PG8_MMA(1, 0, At, B0); PG8_MMA(1, 1, At, B1); PG8_BAR; PG8_SCHED;
            PG8_LDB(B0, 1, 0); PG8_LDB(B1, 1, 1); PG8_SCHED; PG8_LDA(At, 1, 0); PG8_STAGE(PG8_SA(0, 1), a2 + hstep, voffA);
            PG8_WAIT_V(8); PG8_WAIT_L(0); PG8_BAR; PG8_MMA(0, 0, At, B0); PG8_MMA(0, 1, At, B1); PG8_BAR; PG8_SCHED;
            PG8_LDA(At, 1, 1); PG8_STAGE(PG8_SB(1, 0), b3, voffB); PG8_STAGE(PG8_SB(1, 1), b3 + hstep, voffB); PG8_STAGE(PG8_SA(1, 0), a3, voffA);
            PG8_WAIT_V(8); PG8_WAIT_L(0); PG8_BAR; PG8_MMA(1, 0, At, B0); PG8_MMA(1, 1, At, B1); PG8_BAR; PG8_SCHED;
            } else {
            PG8_LDB(B0, 0, 0); PG8_SCHED; PG8_LDA(At, 0, 0); PG8_STAGE(PG8_SA(1, 1), a1 + hstep, voffA);
            PG8_WAIT_L(8); PG8_BAR; PG8_WAIT_L(0); PG8_MMA(0, 0, At, B0); PG8_BAR; PG8_SCHED;
            PG8_LDB(B1, 0, 1); PG8_STAGE(PG8_SB(0, 0), b2, voffB);
            PG8_BAR; PG8_WAIT_L(0); PG8_MMA(0, 1, At, B1); PG8_BAR;
            PG8_LDA(At, 0, 1); PG8_STAGE(PG8_SA(0, 0), a2, voffA);
            PG8_BAR; PG8_WAIT_L(0); PG8_MMA(1, 0, At, B0); PG8_BAR; PG8_SCHED;
            PG8_STAGE(PG8_SB(0, 1), b2 + hstep, voffB);
            PG8_WAIT_V(6); PG8_BAR; PG8_MMA(1, 1, At, B1); PG8_BAR;
            PG8_LDB(B0, 1, 0); PG8_SCHED; PG8_LDA(At, 1, 0); PG8_STAGE(PG8_SA(0, 1), a2 + hstep, voffA);
            PG8_WAIT_L(8); PG8_BAR; PG8_WAIT_L(0); PG8_MMA(0, 0, At, B0); PG8_BAR; PG8_SCHED;
            PG8_LDB(B1, 1, 1); PG8_STAGE(PG8_SB(1, 0), b3, voffB);
            PG8_BAR; PG8_WAIT_L(0); PG8_MMA(0, 1, At, B1); PG8_BAR;
            PG8_LDA(At, 1, 1); PG8_STAGE(PG8_SA(1, 0), a3, voffA);
            PG8_BAR; PG8_WAIT_L(0); PG8_MMA(1, 0, At, B0); PG8_BAR; PG8_SCHED;
            PG8_STAGE(PG8_SB(1, 1), b3 + hstep, voffB);
            PG8_WAIT_V(6); PG8_BAR; PG8_MMA(1, 1, At, B1); PG8_BAR;
            }
        }
        if constexpr (ALIGN_EPI) { if (wr == 0) PG8_BAR; }
        if constexpr (!Epi::AFTER_DRAIN) { if (cur.part >= 0) slab_dump(acc, cur, g.slab, g.nparts, wr, wc, fr, fq); else E(acc, cur, wr, wc, fr, fq); S.done(cur); }
        if (!has_next) break;
#pragma unroll
        for (int a = 0; a < 2; ++a)
#pragma unroll
            for (int b = 0; b < 2; ++b)
#pragma unroll
                for (int m = 0; m < 4; ++m)
#pragma unroll
                    for (int n = 0; n < 2; ++n) acc[a][b][m][n] = (f32x4){0.f, 0.f, 0.f, 0.f};
        cur = nxt; cA = nA; cB = nB; ++ui; cnt = cur.nkt > 0 ? cur.nkt : nt;
        if constexpr (ALIGN_EPI) { if (wr == 1) PG8_BAR; }
    }
    PG8_WAIT_V(0);
    if constexpr (!ALIGN_EPI) { if (wr == 0) PG8_BAR; }
    PG8_BAR;
    if constexpr (Epi::AFTER_DRAIN) { E.fused(acc, cur, wr, wc, fr, fq, lds, wid, lane); S.done(cur); }
#undef PG8_SA
#undef PG8_SB
#undef PG8_STAGE
#undef PG8_LDA
#undef PG8_LDB
#undef PG8_MMA
#undef PG8_WAIT_V
#undef PG8_WAIT_L
#undef PG8_BAR
#undef PG8_SCHED
}
}

constexpr int DM = 1024, NROWS = 16640, NPROMPT = 16384, NMETAROWS = 128, SROW0 = 16512;
constexpr int DFF = 2816, NCHUNK = 33, NB = 8, NSAMP = 128;
constexpr int PA_LD = 1792, PB_LD = 2048, DIN_PAD = 3840;
constexpr float EPS = 1e-6f;
constexpr size_t MiB = 1u << 20;
constexpr size_t WS_CTL = 0, WS_SS = 1 * MiB, CTL_ZERO_BYTES = 2 * MiB;
constexpr size_t WS_ROPE = 2 * MiB;
constexpr size_t WS_XE = 3 * MiB;
constexpr size_t WS_LWT = 6 * MiB;
constexpr size_t WS_GCA = 4 * MiB, WS_CA = 4 * MiB + 65536, WS_CB = WS_CA + 524288;
constexpr size_t WS_WT = 8 * MiB;
constexpr size_t WT_F1I = 0, WT_F1O = 11534336, WT_WIN = 17301504, WT_WOUT = 25165824, WT_F2I = 27262976, WT_F2O = 38797312, WT_END = 44564480;
constexpr size_t WS_XB = 52 * MiB;
constexpr size_t WS_R = 86 * MiB;
constexpr size_t WS_H = WS_R, WS_PA = WS_R, WS_O = WS_R, WS_PB = 144 * MiB, WS_DNI = 210 * MiB, WS_LA = 285 * MiB, WS_LB = 294 * MiB, WS_END = 303 * MiB;
static_assert(WS_SS + (size_t)7 * NROWS * 8 <= CTL_ZERO_BYTES, "ss arrays inside the memset");
static_assert(WS_WT + WT_END <= WS_XB && WS_XB + (size_t)NROWS * DM * 2 <= WS_R && WS_H + (size_t)NROWS * DFF * 2 <= WS_END, "ws map");
static_assert(WS_PA + (size_t)NROWS * PA_LD * 2 <= WS_PB && WS_PB + (size_t)NROWS * PB_LD * 2 <= WS_DNI, "ws map 2");
constexpr size_t WS_SLAB = WS_DNI;
constexpr int DNI_ITEM = 73728;
constexpr int DNI_W = 0, DNI_QG = 16384, DNI_KDT = 32768, DNI_UVT = 49152, DNI_P = 65536;
static_assert(WS_DNI + (size_t)1056 * DNI_ITEM <= WS_LA && WS_LA + (size_t)NROWS * 256 * 2 <= WS_LB && WS_LB + (size_t)NROWS * 256 * 2 <= WS_END, "ws map 3");
constexpr int CW_BAR = 4096;
constexpr size_t O_YP = 0, O_YS = 16777216, O_DNP = O_YS + 131072, O_DNCP = O_DNP + 1048576, O_LRUP = O_DNCP + 73728, O_LRUCP = O_LRUP + 4096, O_RETP = O_LRUCP + 12288,
                 O_DNS = O_RETP + 262144, O_DNCS = O_DNS + 16777216, O_LRUS = O_DNCS + 1179648, O_LRUCS = O_LRUS + 65536, O_RETS = O_LRUCS + 196608, O_END = O_RETS + 4194304;
constexpr int LDS_BYTES = 155648, MISC_OFF = LDS_BYTES - 256;
constexpr int NWAVES = 8, NTHREADS = 512;

#define GAS __attribute__((address_space(1)))
#define LAS __attribute__((address_space(3)))
typedef unsigned short bf16;
typedef float f32x4 __attribute__((ext_vector_type(4)));
typedef float f32x16 __attribute__((ext_vector_type(16)));
typedef short bf16x8 __attribute__((ext_vector_type(8)));
typedef unsigned u32x4 __attribute__((ext_vector_type(4)));
typedef unsigned u32x2 __attribute__((ext_vector_type(2)));
#define DI __device__ __forceinline__
DI unsigned f2bf(float f) { return (unsigned)__builtin_bit_cast(unsigned short, (__bf16)f); }
typedef __bf16 hwbf16x2 __attribute__((ext_vector_type(2)));
typedef float f32x2 __attribute__((ext_vector_type(2)));
DI unsigned pk2(float lo, float hi) { const f32x2 v = {lo, hi}; return __builtin_bit_cast(unsigned, __builtin_convertvector(v, hwbf16x2)); }
DI float bflo(unsigned w) { return __builtin_bit_cast(float, w << 16); }
DI float bfhi(unsigned w) { return __builtin_bit_cast(float, w & 0xffff0000u); }
DI f32x4 ld4bf(const bf16* p) { const u32x2 v = *(const u32x2*)p; return (f32x4){bflo(v.x), bfhi(v.x), bflo(v.y), bfhi(v.y)}; }
DI float bf1(bf16 b) { return __builtin_bit_cast(float, (unsigned)b << 16); }
DI float sigm(float x) { return __builtin_amdgcn_rcpf(1.0f + __expf(-x)); }
DI float silu(float x) { return x * sigm(x); }
DI float softplus(float x) { return x > 20.f ? x : log1pf(__expf(x)); }
DI float gelu_tanh(float y) { const float u = 0.7978845608028654f * (y + 0.044715f * y * y * y); const float t = 1.0f - 2.0f * __builtin_amdgcn_rcpf(__expf(2.0f * u) + 1.0f); return 0.5f * y * (1.0f + t); }
DI float xshfl(float v, int src) { return __builtin_bit_cast(float, __builtin_amdgcn_ds_bpermute(src << 2, __builtin_bit_cast(int, v))); }
DI float wave_sum(float v, int lane) {
#pragma unroll
    for (int o = 1; o < 64; o <<= 1) v += xshfl(v, lane ^ o);
    return v;
}
#define MFMA32(a, b, c) __builtin_amdgcn_mfma_f32_32x32x16_bf16((a), (b), (c), 0, 0, 0)
DI int crow(int reg, int hh) { return (reg & 3) + 8 * (reg >> 2) + 4 * hh; }

typedef GAS unsigned gu32;
#define RLX_AGENT __ATOMIC_RELAXED, __HIP_MEMORY_SCOPE_AGENT
#define XB_TMO      128
#define XB_XCNT(j)  (256  + 64 * (j))
#define XB_XSUB(j)  (1280 + 64 * (j))
#define XB_XGEN(j)  (2304 + 64 * (j))
#define XB_TOP      3328
#define XB_TOPGEN   3392
#define XCD_BAR_WORDS 3456
#define XB_SPIN_CAP (1u << 18)

__device__ __forceinline__ unsigned xb_ld(unsigned* p)              { return __hip_atomic_load(p, __ATOMIC_RELAXED, __HIP_MEMORY_SCOPE_AGENT); }
__device__ __forceinline__ unsigned xb_add(unsigned* p, unsigned v) { return __hip_atomic_fetch_add(p, v, __ATOMIC_RELAXED, __HIP_MEMORY_SCOPE_AGENT); }
__device__ __forceinline__ unsigned xb_xcc_id() { return (unsigned)__builtin_amdgcn_s_getreg((3 << 11) | 20) & 0xFu; }
#define XB_SPIN(cond, bar) do { unsigned _sp = 0; while (cond) { __builtin_amdgcn_s_sleep(1); \
    if ((++_sp & 255u) == 0u) { if (xb_ld(&(bar)[XB_TMO])) break; if (_sp > XB_SPIN_CAP) { atomicAdd(&(bar)[XB_TMO], 1u); break; } } } } while (0)

struct XcdBarrier {
    unsigned* bar; unsigned x;
    volatile LAS unsigned* st;
};

__device__ __forceinline__ XcdBarrier xcd_barrier_post(unsigned* bar, volatile LAS unsigned* st) {
    XcdBarrier b; b.bar = bar; b.x = xb_xcc_id(); b.st = st;
    if (threadIdx.x == 0) (void)xb_add(&bar[XB_XCNT(b.x)], 1u);
    return b;
}
__device__ __forceinline__ void xcd_barrier_complete(unsigned* bar, unsigned x, unsigned& nloc, unsigned& nx) {
    const unsigned G = gridDim.x * gridDim.y * gridDim.z;
    unsigned sum, cnt, mine, sp = 0u;
    for (;;) {
        sum = 0u; cnt = 0u; mine = 0u;
#pragma unroll
        for (unsigned j = 0; j < 16; ++j) { const unsigned c = xb_ld(&bar[XB_XCNT(j)]); sum += c; cnt += (c > 0u) ? 1u : 0u; mine = (j == x) ? c : mine; }
        if (sum == G) break;
        __builtin_amdgcn_s_sleep(1);
        if ((++sp & 255u) == 0u) { if (xb_ld(&bar[XB_TMO])) break; if (sp > XB_SPIN_CAP) { atomicAdd(&bar[XB_TMO], 1u); break; } }
    }
    nloc = mine > 0u ? mine : 1u; nx = cnt > 0u ? cnt : 1u;
}

__device__ __forceinline__ void xcd_barrier(const XcdBarrier& b, const int tid) {
    asm volatile("s_waitcnt vmcnt(0)" ::: "memory");
    __syncthreads();
    if (tid == 0) {
        unsigned* bar = b.bar;
        __builtin_amdgcn_s_waitcnt(0);
        unsigned nloc = b.st[0], nx = b.st[1];
        if (nloc == 0u) { xcd_barrier_complete(bar, b.x, nloc, nx); b.st[0] = nloc; b.st[1] = nx; }
        const unsigned old = xb_add(&bar[XB_XSUB(b.x)], 1u);
        const unsigned gen = old / nloc;
        if (old + 1u == (gen + 1u) * nloc) {
            __builtin_amdgcn_fence(__ATOMIC_RELEASE, "agent");
            asm volatile("s_waitcnt vmcnt(0)" ::: "memory");
            const unsigned og = xb_add(&bar[XB_TOP], 1u);
            const unsigned tg = og / nx;
            if (og + 1u == (tg + 1u) * nx) xb_add(&bar[XB_TOPGEN], 1u);
            else XB_SPIN(xb_ld(&bar[XB_TOPGEN]) == tg, bar);
            __builtin_amdgcn_fence(__ATOMIC_ACQUIRE, "agent");
            xb_add(&bar[XB_XGEN(b.x)], 1u);
            asm volatile("s_waitcnt vmcnt(0)" ::: "memory");
        } else {
            XB_SPIN(xb_ld(&bar[XB_XGEN(b.x)]) == gen, bar);
            __builtin_amdgcn_fence(__ATOMIC_ACQUIRE, "agent");
            asm volatile("s_waitcnt vmcnt(0)" ::: "memory");
        }
    }
    __syncthreads();
}

struct Args { const float* in[29]; float* out; unsigned char* ws; int ph_lo, ph_hi; };
typedef const float* const __attribute__((address_space(4))) * kargp_t;
DI const float* inp(int i) { kargp_t p = (kargp_t)__builtin_amdgcn_kernarg_segment_ptr(); asm volatile("" : "+s"(p)); return (const float*)(const GAS float*)(unsigned long long)p[i]; }
struct Ctx {
    float* out; unsigned char* ws;
    unsigned char* lds;
    int tid, lane, wave, G, bid;
};
DI Ctx fresh(const Ctx& C0) { Ctx C = C0; int t = C0.tid; asm volatile("" : "+v"(t)); C.tid = t; C.lane = t & 63; C.wave = __builtin_amdgcn_readfirstlane(t >> 6); return C; }
enum { I_XP = 0, I_XS, I_SDN, I_SDNC, I_SLRU, I_SLRUC, I_SRET, I_META, I_NF1, I_WF1I, I_WF1O, I_NMIX, I_WIN, I_DNCW, I_ALOG, I_DTB, I_DNNW, I_LCW, I_LCB, I_LWA, I_LBA, I_LWX, I_LBX, I_LLAM,
       I_WOUT, I_NF2, I_WF2I, I_WF2O, I_NFIN };

template <int MODE> DI int colmap(int n) {
    if (MODE == 0) return n;
    if (MODE == 1) { const int pn = n >> 8, bj = (n >> 7) & 1, j = n & 127; return bj * DFF + 128 * pn + j; }
    return n < 1544 ? n : (n < 1792 ? -1 : n - 248);
}
template <int MODE> DI void convert_item(const float* W, int K, int Nsrc, int Ndst, const float* scale, bf16* WT, float* scr, int item, int lane) {
    const int nblk = Ndst / 32, kb = item / nblk, nb = item % nblk, k0 = 64 * kb, n0 = 32 * nb;
    const int sc = colmap<MODE>(n0 + (lane & 31));
    float wv[32];
#pragma unroll
    for (int i = 0; i < 32; ++i) { const int kk = 2 * i + (lane >> 5); wv[i] = (sc >= 0) ? W[(size_t)(k0 + kk) * Nsrc + sc] : 0.f; }
#pragma unroll
    for (int i = 0; i < 32; ++i) { const int kk = 2 * i + (lane >> 5); float v = wv[i]; if (scale) v *= scale[k0 + kk]; scr[kk * 33 + (lane & 31)] = v; }
    asm volatile("s_waitcnt lgkmcnt(0)" ::: "memory");
    const int c = lane & 7;
#pragma unroll
    for (int j = 0; j < 4; ++j) { const int n = (lane >> 3) + 8 * j; const float* s = scr + (8 * c) * 33 + n;
        u32x4 o; o.x = pk2(s[0 * 33], s[1 * 33]); o.y = pk2(s[2 * 33], s[3 * 33]); o.z = pk2(s[4 * 33], s[5 * 33]); o.w = pk2(s[6 * 33], s[7 * 33]);
        *(u32x4*)(WT + (size_t)(n0 + n) * K + k0 + 8 * c) = o; }
    asm volatile("s_waitcnt lgkmcnt(0)" ::: "memory");
}
DI void convert_set(const Ctx& C, int l, int set, int gw, int nwaves) {
    float* scr = (float*)(C.lds + C.wave * 16384);
    constexpr int I1 = 16 * 176, I2 = 44 * 32, I3 = 16 * 120, I4 = 16 * 32;
    unsigned char* wt = C.ws + WS_WT;
    if (set == 0 || set == 2 || set == 3) {
        const int lo_ = (set == 3) ? I1 : 0, hi_ = (set == 2) ? I1 : I1 + I2 + I3;
        for (int it = lo_ + gw; it < hi_; it += nwaves) { int r = it;
            if (r < I1) { convert_item<1>(inp(I_WF1I) + (size_t)l * DM * 2 * DFF, DM, 2 * DFF, 2 * DFF, inp(I_NF1) + l * DM, (bf16*)(wt + WT_F1I), scr, r, C.lane); continue; } r -= I1;
            if (r < I2) { convert_item<0>(inp(I_WF1O) + (size_t)l * DFF * DM, DFF, DM, DM, nullptr, (bf16*)(wt + WT_F1O), scr, r, C.lane); continue; } r -= I2;
            convert_item<2>(inp(I_WIN) + (size_t)l * DM * 3592, DM, 3592, DIN_PAD, inp(I_NMIX) + l * DM, (bf16*)(wt + WT_WIN), scr, r, C.lane); }
    } else {
        for (int it = gw; it < I1 + I2 + I4; it += nwaves) { int r = it;
            if (r < I1) { convert_item<1>(inp(I_WF2I) + (size_t)l * DM * 2 * DFF, DM, 2 * DFF, 2 * DFF, inp(I_NF2) + l * DM, (bf16*)(wt + WT_F2I), scr, r, C.lane); continue; } r -= I1;
            if (r < I2) { convert_item<0>(inp(I_WF2O) + (size_t)l * DFF * DM, DFF, DM, DM, nullptr, (bf16*)(wt + WT_F2O), scr, r, C.lane); continue; } r -= I2;
            convert_item<0>(inp(I_WOUT) + (size_t)l * DM * DM, DM, DM, DM, nullptr, (bf16*)(wt + WT_WOUT), scr, r, C.lane); }
    }
}
DI void convert_lru_weights(const Ctx& C) {
    const int g = C.bid * NTHREADS + C.tid;
    if (g < 2 * 2 * 4 * 64 * 64) { const int l = g >> 15, mat = (g >> 14) & 1, n = (g >> 12) & 3, e = (g >> 6) & 63, d = g & 63;
        const float v = inp(mat ? I_LWX : I_LWA)[(size_t)((l * 4 + n) * 64 + d) * 64 + e]; ((bf16*)(C.ws + WS_LWT))[g] = (bf16)f2bf(v); }
}
DI void sincos_d(double ang, double& s, double& c) {
    const double TWO_PI = 6.283185307179586476925286766559, HALF_PI = 1.5707963267948966192313216916398;
    double n = __builtin_rint(ang / TWO_PI); double r = ang - n * TWO_PI;
    double k = __builtin_rint(r / HALF_PI); double y = r - k * HALF_PI;
    const double y2 = y * y;
    double sp = 1.0 / 1307674368000.0; sp = sp * y2 - 1.0 / 6227020800.0; sp = sp * y2 + 1.0 / 39916800.0; sp = sp * y2 - 1.0 / 362880.0; sp = sp * y2 + 1.0 / 5040.0; sp = sp * y2 - 1.0 / 120.0; sp = sp * y2 + 1.0 / 6.0;
    const double sy = y - y * y2 * sp;
    double cp = 1.0 / 20922789888000.0; cp = cp * y2 - 1.0 / 87178291200.0; cp = cp * y2 + 1.0 / 479001600.0; cp = cp * y2 - 1.0 / 3628800.0; cp = cp * y2 + 1.0 / 40320.0; cp = cp * y2 - 1.0 / 720.0; cp = cp * y2 + 1.0 / 24.0;
    const double cy = 1.0 - 0.5 * y2 + y2 * y2 * cp;
    const int q = ((int)k) & 3;
    s = (q == 0) ? sy : (q == 1) ? cy : (q == 2) ? -sy : -cy;
    c = (q == 0) ? cy : (q == 1) ? -sy : (q == 2) ? -cy : sy;
}
DI const float* p0_row_src(int row) { return row < NPROMPT ? inp(I_XP) + (size_t)row * DM : (row < SROW0 ? inp(I_META) + (size_t)((row - NPROMPT) & 15) * DM : inp(I_XS) + (size_t)(row - SROW0) * DM); }
DI void p0_rows(const Ctx& C) {
    const int gw = C.bid * NWAVES + C.wave, NGW = C.G * NWAVES;
    unsigned long long* ss0 = (unsigned long long*)(C.ws + WS_SS); bf16* XB = (bf16*)(C.ws + WS_XB); float* XE = (float*)(C.ws + WS_XE);
    f32x4 v[4], vn[4];
    if (gw < NROWS) { const float* src = p0_row_src(gw);
#pragma unroll
        for (int j = 0; j < 4; ++j) v[j] = *(const f32x4*)(src + 4 * C.lane + 256 * j); }
    for (int row = gw; row < NROWS; row += NGW) {
        const bool more = row + NGW < NROWS;
        if (more) { const float* src = p0_row_src(row + NGW);
#pragma unroll
            for (int j = 0; j < 4; ++j) vn[j] = *(const f32x4*)(src + 4 * C.lane + 256 * j); }
        float s = 0.f;
#pragma unroll
        for (int j = 0; j < 4; ++j) s += (v[j].x * v[j].x + v[j].y * v[j].y) + (v[j].z * v[j].z + v[j].w * v[j].w);
        s = wave_sum(s, C.lane);
        if (C.lane == 0) ss0[row] = (unsigned long long)(s * 1048576.0f + 0.5f);
#pragma unroll
        for (int j = 0; j < 4; ++j) { u32x2 w; w.x = pk2(v[j].x, v[j].y); w.y = pk2(v[j].z, v[j].w); *(u32x2*)(XB + (size_t)row * DM + 4 * C.lane + 256 * j) = w;
            if (row >= NPROMPT) *(f32x4*)(XE + (size_t)(row - NPROMPT) * DM + 4 * C.lane + 256 * j) = v[j]; }
        if (more) {
#pragma unroll
            for (int j = 0; j < 4; ++j) v[j] = vn[j]; }
    }
    float* rope = (float*)(C.ws + WS_ROPE);
    for (int e = C.bid * NTHREADS + C.tid; e < 2065 * 32; e += C.G * NTHREADS) {
        const int p = e >> 5, i = e & 31; double inv = 1.0; for (int k = 0; k < i; ++k) inv *= 0.7498942093324558;
        const double pos = (p == 2064) ? 16384.0 : (double)p; double s, c; sincos_d(pos * inv, s, c);
        rope[2 * e] = (float)c; rope[2 * e + 1] = (float)s;
    }
}
DI void final_norm(const Ctx& C) {
    const int gw = C.bid * NWAVES + C.wave, NGW = C.G * NWAVES;
    const unsigned long long* ss = (const unsigned long long*)(C.ws + WS_SS) + 6 * NROWS; const float* XE = (const float*)(C.ws + WS_XE); const float* nw = inp(I_NFIN);
    f32x4 w[4];
#pragma unroll
    for (int j = 0; j < 4; ++j) w[j] = *(const f32x4*)(nw + 4 * C.lane + 256 * j);
    for (int it = gw; it < NPROMPT + NSAMP; it += NGW) {
        const int row = it < NPROMPT ? it : SROW0 + (it - NPROMPT);
        const float* src = it < NPROMPT ? C.out + O_YP + (size_t)row * DM : XE + (size_t)(row - NPROMPT) * DM;
        float* dst = it < NPROMPT ? C.out + O_YP + (size_t)row * DM : C.out + O_YS + (size_t)(it - NPROMPT) * DM;
        const float rs = 1.0f / sqrtf((float)ss[row] * (1.0f / (1024.0f * 1048576.0f)) + EPS);
#pragma unroll
        for (int j = 0; j < 4; ++j) { const f32x4 v = *(const f32x4*)(src + 4 * C.lane + 256 * j); *(f32x4*)(dst + 4 * C.lane + 256 * j) = v * rs * w[j]; }
    }
}

template <int K> DI void tail_gemm(const Ctx& C, const bf16* A, const bf16* Wt, float scale, unsigned long long* ssn) {
    constexpr int KW = K / 8, NIT = KW / 16, NB1 = NIT;
    const int lane = C.lane, w = C.wave, r = lane & 31, hh = lane >> 5;
    float* XE = (float*)(C.ws + WS_XE); bf16* XB = (bf16*)(C.ws + WS_XB); float* red = (float*)(C.lds);
    for (int blk = C.bid; blk < 256; blk += C.G) {
        const int rg = blk >> 5, cg = blk & 31;
        const int orow = 32 * rg + (C.tid >> 4), ocol = 32 * cg + 2 * (C.tid & 15);
        const f32x2 xin = *(const f32x2*)(XE + (size_t)orow * DM + ocol);
        const bf16* ap = A + (size_t)(NPROMPT + 32 * rg + r) * K + w * KW + 8 * hh;
        const bf16* bp = Wt + (size_t)(32 * cg + r) * K + w * KW + 8 * hh;
        f32x16 acc;
#pragma unroll
        for (int i = 0; i < 16; ++i) acc[i] = 0.f;
#pragma unroll
        for (int i0 = 0; i0 < NIT; i0 += NB1) {
            bf16x8 a[NB1], b[NB1];
#pragma unroll
            for (int j = 0; j < NB1; ++j) if (i0 + j < NIT) { a[j] = *(const bf16x8*)(ap + 16 * (i0 + j)); b[j] = *(const bf16x8*)(bp + 16 * (i0 + j)); }
#pragma unroll
            for (int j = 0; j < NB1; ++j) if (i0 + j < NIT) acc = MFMA32(a[j], b[j], acc);
        }
        __syncthreads();
#pragma unroll
        for (int i = 0; i < 16; ++i) red[(w * 32 + crow(i, hh)) * 33 + r] = acc[i];
        __syncthreads();
        const int rr = C.tid >> 4, cc = 2 * (C.tid & 15);
        float s0 = 0.f, s1 = 0.f;
#pragma unroll
        for (int w2 = 0; w2 < 8; ++w2) { s0 += red[(w2 * 32 + rr) * 33 + cc]; s1 += red[(w2 * 32 + rr) * 33 + cc + 1]; }
        const float x0 = xin.x + scale * s0, x1 = xin.y + scale * s1;
        *(f32x2*)(XE + (size_t)orow * DM + ocol) = (f32x2){x0, x1};
        *(unsigned*)(XB + (size_t)(NPROMPT + orow) * DM + ocol) = pk2(x0, x1);
        float sq = x0 * x0 + x1 * x1;
        sq += xshfl(sq, lane ^ 1); sq += xshfl(sq, lane ^ 2); sq += xshfl(sq, lane ^ 4); sq += xshfl(sq, lane ^ 8);
        if ((lane & 15) == 0) atomicAdd(ssn + NPROMPT + orow, (unsigned long long)(sq * 1048576.0f + 0.5f));
    }
}
DI void fix_rows(const Ctx& C, int nparts, float scale, unsigned long long* ssn) {
    const int gw = C.bid * NWAVES + C.wave, NGW = C.G * NWAVES;
    const float* slab = (const float*)(C.ws + WS_SLAB); float* XE = (float*)(C.ws + WS_XE); bf16* XB = (bf16*)(C.ws + WS_XB);
    for (int job = gw; job < 256 * 4; job += NGW) {
        const int r = job >> 2, pn = job & 3;
        const float* sp = slab + (size_t)(pn * nparts) * 65536 + (size_t)r * 256 + 4 * C.lane;
        f32x4 a = (f32x4){0.f, 0.f, 0.f, 0.f};
        for (int p = 0; p < nparts; ++p) a = a + *(const f32x4*)(sp + (size_t)p * 65536);
        float* xp = XE + (size_t)r * DM + 256 * pn + 4 * C.lane;
        const f32x4 x = *(const f32x4*)xp + a * scale;
        *(f32x4*)xp = x;
        u32x2 w; w.x = pk2(x.x, x.y); w.y = pk2(x.z, x.w); *(u32x2*)(XB + (size_t)(NPROMPT + r) * DM + 256 * pn + 4 * C.lane) = w;
        const float sq = wave_sum((x.x * x.x + x.y * x.y) + (x.z * x.z + x.w * x.w), C.lane);
        if (C.lane == 0) atomicAdd(ssn + NPROMPT + r, (unsigned long long)(sq * 1048576.0f + 0.5f));
    }
}

DI void final_fix_norm(const Ctx& C) {
    const int gw = C.bid * NWAVES + C.wave, NGW = C.G * NWAVES;
    const unsigned long long* ss = (const unsigned long long*)(C.ws + WS_SS) + 6 * NROWS; const float* nw = inp(I_NFIN);
    const float* slab = (const float*)(C.ws + WS_SLAB); const float* XE = (const float*)(C.ws + WS_XE); const bf16* XB = (const bf16*)(C.ws + WS_XB);
    f32x4 w[4];
#pragma unroll
    for (int j = 0; j < 4; ++j) w[j] = *(const f32x4*)(nw + 4 * C.lane + 256 * j);
    if (gw < NSAMP) {
        const int it = gw, r = 128 + it;
        const float rs = 1.0f / sqrtf((float)ss[NPROMPT + r] * (1.0f / (1024.0f * 1048576.0f)) + EPS);
#pragma unroll
        for (int pn = 0; pn < 4; ++pn) *(f32x4*)(C.out + O_YS + (size_t)it * DM + 256 * pn + 4 * C.lane) = *(const f32x4*)(XE + (size_t)r * DM + 256 * pn + 4 * C.lane) * rs * w[pn];
    }
    u32x2 v[2][4], vn[2][4]; unsigned long long sv[2], svn[2];
#define FN_LOAD(V, SV, base) do { _Pragma("unroll") for (int q = 0; q < 2; ++q) { const int row_ = (base) + q * NGW; if (row_ < NPROMPT) { SV[q] = ss[row_]; \
        _Pragma("unroll") for (int j = 0; j < 4; ++j) V[q][j] = *(const u32x2*)(XB + (size_t)row_ * DM + 4 * C.lane + 256 * j); } } } while (0)
    FN_LOAD(v, sv, gw);
    for (int row = gw; row < NPROMPT; row += 2 * NGW) {
        if (row + 2 * NGW < NPROMPT) FN_LOAD(vn, svn, row + 2 * NGW);
#pragma unroll
        for (int q = 0; q < 2; ++q) { const int rw = row + q * NGW;
            if (rw < NPROMPT) { const float rs = 1.0f / sqrtf((float)sv[q] * (1.0f / (1024.0f * 1048576.0f)) + EPS);
#pragma unroll
                for (int j = 0; j < 4; ++j) { const f32x4 x = (f32x4){bflo(v[q][j].x), bfhi(v[q][j].x), bflo(v[q][j].y), bfhi(v[q][j].y)}; *(f32x4*)(C.out + O_YP + (size_t)rw * DM + 4 * C.lane + 256 * j) = x * rs * w[j]; } } }
#pragma unroll
        for (int q = 0; q < 2; ++q) { sv[q] = svn[q];
#pragma unroll
            for (int j = 0; j < 4; ++j) v[q][j] = vn[q][j]; }
    }
#undef FN_LOAD
}
DI int chunk_row0(int b, int c) { return c == 0 ? NPROMPT + 16 * b : b * 2048 + 64 * (c - 1); }
DI int halo_row(int b, int c, int back) { return c == 0 ? -1 : (c == 1 ? NPROMPT + 16 * b + 16 - back : b * 2048 + 64 * (c - 1) - back); }

constexpr int N1_R = 0, N1_QB = 52736, N1_KB = 70144, N1_RT = 87552, N1_SM = 124416, N1_CW = 126464, N1_AB = 0, N1_AD = 9216, N1_TD = 14336, N1_WS = 18432;
#define MFMA16(a, b, c) __builtin_amdgcn_mfma_f32_16x16x32_bf16((a), (b), (c), 0, 0, 0)
DI void m1_dn_load(const Ctx& C, int b, int c, int h, u32x4 (&rv)[7]) {
    const bf16* PA = (const bf16*)(C.ws + WS_PA);
    const int L = (c == 0) ? 16 : 64, row0 = chunk_row0(b, c);
#pragma unroll
    for (int k = 0; k < 7; ++k) { const int p = C.tid + 512 * k; rv[k] = (u32x4){0u, 0u, 0u, 0u};
        if (p < 67 * 48) { const int ri = p / 48, pc = p % 48, t = ri - 3; int row = -1;
            if (t < 0) row = halo_row(b, c, -t); else if (t < L) row = row0 + t;
            if (row >= 0) rv[k] = *(const u32x4*)(PA + (size_t)row * PA_LD + (pc >> 4) * 512 + h * 128 + 8 * (pc & 15)); } }
}
DI void m1_dn_item(const Ctx& C, int l, int b, int c, int h, u32x4 (&rv)[7], int nb, int nc, int nh) {
    const int tid = C.tid, lane = C.lane, wid = C.wave;
    bf16* R = (bf16*)(C.lds + N1_R); bf16* QB = (bf16*)(C.lds + N1_QB); bf16* KB = (bf16*)(C.lds + N1_KB); bf16* RT = (bf16*)(C.lds + N1_RT);
    float* sm = (float*)(C.lds + N1_SM); float* CW = (float*)(C.lds + N1_CW);
    bf16* AB = (bf16*)(C.lds + N1_AB); float* AD = (float*)(C.lds + N1_AD); bf16* TD = (bf16*)(C.lds + N1_TD); bf16* WS = (bf16*)(C.lds + N1_WS);
    const bf16* PA = (const bf16*)(C.ws + WS_PA);
    const int L = (c == 0) ? 16 : 64, row0 = chunk_row0(b, c), item = (b * NCHUNK + c) * 4 + h;
    unsigned char* dni = C.ws + WS_DNI + (size_t)item * DNI_ITEM;
    const float* vcw = inp(I_DNCW) + (size_t)l * 4 * 1536 + 2 * 512 + h * 128 + 4 * (tid & 31);
    const f32x4 vw0 = *(const f32x4*)(vcw), vw1 = *(const f32x4*)(vcw + 1536), vw2 = *(const f32x4*)(vcw + 2 * 1536), vw3 = *(const f32x4*)(vcw + 3 * 1536);
    {
      f32x4 cwv = (f32x4){0.f, 0.f, 0.f, 0.f};
      if (tid < 384) { const int tap = tid / 96, q4 = tid % 96; cwv = *(const f32x4*)(inp(I_DNCW) + (size_t)l * 4 * 1536 + tap * 1536 + (q4 >> 5) * 512 + h * 128 + 4 * (q4 & 31)); }
      if (wid == 7) {
          const int t = lane; float g = 0.f, be = 0.f;
          if (t < L) { const bf16* pr = PA + (size_t)(row0 + t) * PA_LD + 1536 + h; const float a = bf1(pr[0]), bb = bf1(pr[4]);
              g = -__expf(inp(I_ALOG)[l * 4 + h]) * softplus(a + inp(I_DTB)[l * 4 + h]); be = sigm(bb); }
          float G = g;
#pragma unroll
          for (int o = 1; o < 64; o <<= 1) { const float v = xshfl(G, (lane - o) & 63); if (lane >= o) G += v; }
          const float GC = xshfl(G, 63);
          sm[t] = G; sm[64 + t] = be; sm[128 + t] = __expf(G); sm[192 + t] = __expf(GC - G);
          if (lane == 0) ((float*)(C.ws + WS_GCA))[item] = __expf(GC);
      }
#pragma unroll
      for (int k = 0; k < 7; ++k) { const int p = tid + 512 * k; if (p < 67 * 48) *(u32x4*)((unsigned char*)R + (p / 48) * 784 + (p % 48) * 16) = rv[k]; }
      if (tid < 384) { const int tap = tid / 96, q4 = tid % 96; *(f32x4*)(CW + tap * 384 + 4 * q4) = cwv; } }
    __syncthreads();
    { const int t = tid >> 3, cg = tid & 7; const bool live = t < L;
#pragma unroll
      for (int part = 0; part < 2; ++part) {
          float y[16];
#pragma unroll
          for (int j = 0; j < 16; ++j) y[j] = 0.f;
          u32x4 x3[2] = {(u32x4){0u, 0u, 0u, 0u}, (u32x4){0u, 0u, 0u, 0u}};
#pragma unroll
          for (int tap = 0; tap < 4; ++tap)
#pragma unroll
              for (int hf = 0; hf < 2; ++hf) { const u32x4 xv = *(const u32x4*)(R + (t + tap) * 392 + part * 128 + 16 * cg + 8 * hf); if (tap == 3) x3[hf] = xv;
                  const f32x4 w0 = *(const f32x4*)(CW + tap * 384 + part * 128 + 16 * cg + 8 * hf), w1 = *(const f32x4*)(CW + tap * 384 + part * 128 + 16 * cg + 8 * hf + 4);
                  y[8 * hf + 0] += w0.x * bflo(xv.x); y[8 * hf + 1] += w0.y * bfhi(xv.x); y[8 * hf + 2] += w0.z * bflo(xv.y); y[8 * hf + 3] += w0.w * bfhi(xv.y);
                  y[8 * hf + 4] += w1.x * bflo(xv.z); y[8 * hf + 5] += w1.y * bfhi(xv.z); y[8 * hf + 6] += w1.z * bflo(xv.w); y[8 * hf + 7] += w1.w * bfhi(xv.w); }
          float ss = 0.f;
#pragma unroll
          for (int j = 0; j < 16; ++j) { y[j] = live ? silu(y[j]) : 0.f; ss += y[j] * y[j]; }
          ss += xshfl(ss, lane ^ 1); ss += xshfl(ss, lane ^ 2); ss += xshfl(ss, lane ^ 4);
          const float sc = __builtin_amdgcn_rsqf(ss + EPS) * (part == 0 ? 0.08838834764831845f : 1.0f);
          bf16* dst = (part == 0 ? QB : KB) + t * 136 + 16 * cg;
          *(u32x4*)(dst) = (u32x4){pk2(y[0] * sc, y[1] * sc), pk2(y[2] * sc, y[3] * sc), pk2(y[4] * sc, y[5] * sc), pk2(y[6] * sc, y[7] * sc)};
          *(u32x4*)(dst + 8) = (u32x4){pk2(y[8] * sc, y[9] * sc), pk2(y[10] * sc, y[11] * sc), pk2(y[12] * sc, y[13] * sc), pk2(y[14] * sc, y[15] * sc)};
          if (part == 0) { const float sq = sc * sm[128 + t]; bf16* qo = (bf16*)(dni + DNI_QG) + t * 128 + 16 * cg;
              *(u32x4*)(qo) = (u32x4){pk2(y[0] * sq, y[1] * sq), pk2(y[2] * sq, y[3] * sq), pk2(y[4] * sq, y[5] * sq), pk2(y[6] * sq, y[7] * sq)};
              *(u32x4*)(qo + 8) = (u32x4){pk2(y[8] * sq, y[9] * sq), pk2(y[10] * sq, y[11] * sq), pk2(y[12] * sq, y[13] * sq), pk2(y[14] * sq, y[15] * sq)}; }
          else if (cg == 0) sm[256 + t] = sc;
          if (c == NCHUNK - 1 && t >= 61) { float* co = C.out + O_DNCP + ((size_t)(l * NB + b) * 3 + (t - 61)) * 1536 + part * 512 + h * 128 + 16 * cg;
#pragma unroll
              for (int hf = 0; hf < 2; ++hf) { *(f32x4*)(co + 8 * hf) = (f32x4){bflo(x3[hf].x), bfhi(x3[hf].x), bflo(x3[hf].y), bfhi(x3[hf].y)}; *(f32x4*)(co + 8 * hf + 4) = (f32x4){bflo(x3[hf].z), bfhi(x3[hf].z), bflo(x3[hf].w), bfhi(x3[hf].w)}; } }
      } }
    __syncthreads();
    { const int cq = tid & 31, tq = tid >> 5, t0 = 4 * tq;
      const bf16* rp = R + 2 * 128 + 4 * cq;
      f32x4 x0 = ld4bf(rp + (t0 + 0) * 392), x1 = ld4bf(rp + (t0 + 1) * 392), x2 = ld4bf(rp + (t0 + 2) * 392);
      f32x4 vv[4], ra[4], kd[4];
#pragma unroll
      for (int u = 0; u < 4; ++u) { const int t = t0 + u; const f32x4 x3 = ld4bf(rp + (t + 3) * 392);
          f32x4 y = vw0 * x0 + vw1 * x1 + vw2 * x2 + vw3 * x3; x0 = x1; x1 = x2; x2 = x3;
          y = (t < L) ? (f32x4){silu(y.x), silu(y.y), silu(y.z), silu(y.w)} : (f32x4){0.f, 0.f, 0.f, 0.f};
          if (c == NCHUNK - 1 && t >= 61) *(f32x4*)(C.out + O_DNCP + ((size_t)(l * NB + b) * 3 + (t - 61)) * 1536 + 1024 + h * 128 + 4 * cq) = x3;
          vv[u] = y * sm[64 + t];
          const f32x4 n = ld4bf(KB + t * 136 + 4 * cq);
          ra[u] = n * (sm[64 + t] * sm[128 + t]); kd[u] = n * sm[192 + t]; }
#pragma unroll
      for (int jj = 0; jj < 4; ++jj) {
          *(u32x2*)(RT + (4 * cq + jj) * 72 + t0) = (u32x2){pk2(vv[0][jj], vv[1][jj]), pk2(vv[2][jj], vv[3][jj])};
          *(u32x2*)(RT + (128 + 4 * cq + jj) * 72 + t0) = (u32x2){pk2(ra[0][jj], ra[1][jj]), pk2(ra[2][jj], ra[3][jj])};
          *(u32x2*)((bf16*)(dni + DNI_KDT) + (4 * cq + jj) * 64 + t0) = (u32x2){pk2(kd[0][jj], kd[1][jj]), pk2(kd[2][jj], kd[3][jj])}; }
    }
    __syncthreads();
    { const int kind = wid >> 2, ti = (wid >> 1) & 1, tj = wid & 1, r = lane & 31, hh = lane >> 5;
      const bf16* Aop = KB + (32 * ti + r) * 136 + 8 * hh; const bf16* Bop = (kind ? QB : KB) + (32 * tj + r) * 136 + 8 * hh;
      f32x16 acc;
#pragma unroll
      for (int i = 0; i < 16; ++i) acc[i] = 0.f;
#pragma unroll
      for (int ks = 0; ks < 8; ++ks) { const bf16x8 a = *(const bf16x8*)(Aop + 16 * ks), bq = *(const bf16x8*)(Bop + 16 * ks); acc = MFMA32(a, bq, acc); }
      const int t = 32 * tj + r; const float Gt = sm[t], bet = sm[64 + t];
#pragma unroll
      for (int g4 = 0; g4 < 4; ++g4) { const int i0 = 32 * ti + 8 * g4 + 4 * hh; float o[4];
          const f32x4 Gi = *(const f32x4*)(sm + i0);
#pragma unroll
          for (int e = 0; e < 4; ++e) { const int i = i0 + e; const float dec = __expf(Gt - Gi[e]); const float v = acc[4 * g4 + e] * dec;
              o[e] = kind ? (t >= i ? v : 0.f) : (t > i ? bet * v : 0.f); }
          if (kind == 0) { const bool diag = (i0 >> 4) == (t >> 4);
              u32x2 w; w.x = diag ? 0u : pk2(-o[0], -o[1]); w.y = diag ? 0u : pk2(-o[2], -o[3]); *(u32x2*)(AB + t * 72 + i0) = w;
              if (diag) *(f32x4*)(AD + ((t >> 4) * 16 + (t & 15)) * 20 + (i0 & 15)) = (f32x4){o[0], o[1], o[2], o[3]}; }
          else { u32x2 w; w.x = pk2(o[0], o[1]); w.y = pk2(o[2], o[3]); *(u32x2*)((bf16*)(dni + DNI_P) + t * 64 + i0) = w; } } }
    __syncthreads();
    if (wid == 0) { const int blk = lane >> 4, j = lane & 15; float x[16];
#pragma unroll
        for (int t = 0; t < 16; ++t) x[t] = 0.f;
#pragma unroll
        for (int t = 0; t < 16; ++t) { float s = (t == j) ? 1.0f : 0.f;
#pragma unroll
            for (int s4 = 0; s4 < (t + 3) / 4; ++s4) { const f32x4 a = *(const f32x4*)(AD + (blk * 16 + t) * 20 + 4 * s4);
                s -= a.x * x[4 * s4]; s -= a.y * x[4 * s4 + 1]; s -= a.z * x[4 * s4 + 2]; s -= a.w * x[4 * s4 + 3]; }
            x[t] = s; }
#pragma unroll
        for (int t = 0; t < 16; ++t) { TD[(blk * 16 + t) * 32 + j] = (bf16)f2bf(x[t] - ((t == j) ? 1.0f : 0.f)); TD[(blk * 16 + t) * 32 + 16 + j] = (bf16)0; } }
    __syncthreads();
    if (nb >= 0) m1_dn_load(C, nb, nc, nh, rv);
    { const int cl = lane & 15, kq = lane >> 4, c0 = 32 * wid;
#pragma unroll
      for (int i = 0; i < 4; ++i) {
          f32x4 acc[2];
#pragma unroll
          for (int nf = 0; nf < 2; ++nf) acc[nf] = ld4bf(RT + (c0 + 16 * nf + cl) * 72 + 16 * i + 4 * kq);
          if (i >= 1) {
#pragma unroll
              for (int ks = 0; ks < (i == 3 ? 2 : 1); ++ks) { const bf16x8 a = *(const bf16x8*)(AB + (16 * i + cl) * 72 + 32 * ks + 8 * kq);
#pragma unroll
                  for (int nf = 0; nf < 2; ++nf) { const bf16x8 bb = *(const bf16x8*)(RT + (c0 + 16 * nf + cl) * 72 + 32 * ks + 8 * kq); acc[nf] = MFMA16(a, bb, acc[nf]); } } }
#pragma unroll
          for (int nf = 0; nf < 2; ++nf) { u32x2 w; w.x = pk2(acc[nf].x, acc[nf].y); w.y = pk2(acc[nf].z, acc[nf].w); *(u32x2*)(RT + (c0 + 16 * nf + cl) * 72 + 16 * i + 4 * kq) = w; }
          asm volatile("" ::: "memory");
          const bf16x8 a2 = *(const bf16x8*)(TD + (i * 16 + cl) * 32 + 8 * kq);
#pragma unroll
          for (int nf = 0; nf < 2; ++nf) { bf16x8 b2 = *(const bf16x8*)(RT + (c0 + 16 * nf + cl) * 72 + 16 * i + 8 * (kq & 1));
              if (kq >= 2) b2 = (bf16x8){0, 0, 0, 0, 0, 0, 0, 0};
              acc[nf] = MFMA16(a2, b2, acc[nf]);
              u32x2 w; w.x = pk2(acc[nf].x, acc[nf].y); w.y = pk2(acc[nf].z, acc[nf].w); *(u32x2*)(RT + (c0 + 16 * nf + cl) * 72 + 16 * i + 4 * kq) = w;
              if (wid >= 4) { const int d = c0 - 128 + 16 * nf + cl; bf16* wp = WS + (16 * i + 4 * kq) * 136 + d;
                  wp[0] = (bf16)(w.x & 0xffffu); wp[136] = (bf16)(w.x >> 16); wp[272] = (bf16)(w.y & 0xffffu); wp[408] = (bf16)(w.y >> 16); } }
          asm volatile("" ::: "memory");
      } }
    __syncthreads();
#pragma unroll
    for (int k = 0; k < 2; ++k) { const int p = tid + 512 * k;
        *(u32x4*)(dni + DNI_UVT + 16 * p) = *(const u32x4*)((const unsigned char*)RT + (p >> 3) * 144 + (p & 7) * 16);
        *(u32x4*)(dni + DNI_W + 16 * p) = *(const u32x4*)((const unsigned char*)WS + (p >> 4) * 272 + (p & 15) * 16); }
    __syncthreads();
}

constexpr int L1_XL = 0, L1_WT = 33792, L1_LA = 33792, L1_LB = 70656, L1_XCH = 107520;
DI void m1_lru_item(const Ctx& C, int l, int b, int c) {
    const int tid = C.tid, lane = C.lane, wid = C.wave, r = lane & 31, hh = lane >> 5;
    bf16* XL = (bf16*)(C.lds + L1_XL); bf16* WT = (bf16*)(C.lds + L1_WT); bf16* LA = (bf16*)(C.lds + L1_LA); bf16* LB = (bf16*)(C.lds + L1_LB); float* xch = (float*)(C.lds + L1_XCH);
    const bf16* PB = (const bf16*)(C.ws + WS_PB);
    const int L = (c == 0) ? 16 : 64, row0 = chunk_row0(b, c);
    {
      u32x4 wv[8];
#pragma unroll
      for (int k = 0; k < 8; ++k) wv[k] = *(const u32x4*)(C.ws + WS_LWT + (size_t)l * 65536 + (size_t)(tid + 512 * k) * 16);
      const int cq = tid & 63, tq = tid >> 6, col = 4 * cq, t0 = 8 * tq;
      const float* cw = inp(I_LCW) + (size_t)l * 4 * 256 + col;
      const f32x4 w0 = *(const f32x4*)(cw), w1 = *(const f32x4*)(cw + 256), w2 = *(const f32x4*)(cw + 512), w3 = *(const f32x4*)(cw + 768), bias = *(const f32x4*)(inp(I_LCB) + l * 256 + col);
      f32x4 x0 = (f32x4){0.f, 0.f, 0.f, 0.f}, x1 = x0, x2 = x0;
      if (t0 < L) {
          if (t0 == 0) { const int r3 = halo_row(b, c, 3); if (r3 >= 0) { x0 = ld4bf(PB + (size_t)r3 * PB_LD + 512 + col); x1 = ld4bf(PB + (size_t)(r3 + 1) * PB_LD + 512 + col); x2 = ld4bf(PB + (size_t)(r3 + 2) * PB_LD + 512 + col); } }
          else { x0 = ld4bf(PB + (size_t)(row0 + t0 - 3) * PB_LD + 512 + col); x1 = ld4bf(PB + (size_t)(row0 + t0 - 2) * PB_LD + 512 + col); x2 = ld4bf(PB + (size_t)(row0 + t0 - 1) * PB_LD + 512 + col); }
      }
#pragma unroll
      for (int i = 0; i < 8; ++i) { const int t = t0 + i; f32x4 y = (f32x4){0.f, 0.f, 0.f, 0.f};
          if (t < L) { const f32x4 x3 = ld4bf(PB + (size_t)(row0 + t) * PB_LD + 512 + col); y = w0 * x0 + w1 * x1 + w2 * x2 + w3 * x3 + bias;
              if (c == NCHUNK - 1 && t >= 61) *(f32x4*)(C.out + O_LRUCP + ((size_t)(l * NB + b) * 3 + (t - 61)) * 256 + col) = x3;
              x0 = x1; x1 = x2; x2 = x3; }
          u32x2 w; w.x = pk2(y.x, y.y); w.y = pk2(y.z, y.w); *(u32x2*)(XL + t * 264 + col) = w; }
#pragma unroll
      for (int k = 0; k < 8; ++k) { const int p = tid + 512 * k; *(u32x4*)((unsigned char*)WT + (p >> 3) * 144 + (p & 7) * 16) = wv[k]; } }
    __syncthreads();
    const int n = wid >> 1, eh = wid & 1, e = n * 64 + 32 * eh + r;
    f32x16 pa[2], px[2];
#pragma unroll
    for (int th = 0; th < 2; ++th)
#pragma unroll
        for (int i = 0; i < 16; ++i) { pa[th][i] = 0.f; px[th][i] = 0.f; }
#pragma unroll
    for (int ks = 0; ks < 4; ++ks) {
        const bf16x8 ba_ = *(const bf16x8*)(WT + ((0 * 4 + n) * 64 + 32 * eh + r) * 72 + 16 * ks + 8 * hh), bx_ = *(const bf16x8*)(WT + ((1 * 4 + n) * 64 + 32 * eh + r) * 72 + 16 * ks + 8 * hh);
#pragma unroll
        for (int th = 0; th < 2; ++th) { const bf16x8 a = *(const bf16x8*)(XL + (32 * th + r) * 264 + n * 64 + 16 * ks + 8 * hh); pa[th] = MFMA32(a, ba_, pa[th]); px[th] = MFMA32(a, bx_, px[th]); } }
    __syncthreads();
    { const float ba = inp(I_LBA)[l * 256 + e], bx = inp(I_LBX)[l * 256 + e], sp = softplus(-inp(I_LLAM)[l * 256 + e]);
#pragma unroll
      for (int th = 0; th < 2; ++th)
#pragma unroll
          for (int g4 = 0; g4 < 4; ++g4) { float la4[4], bm4[4];
#pragma unroll
              for (int k = 0; k < 4; ++k) { const int t = 32 * th + 8 * g4 + 4 * hh + k; const float xv = bf1(XL[t * 264 + e]);
                  const float rg = sigm(pa[th][4 * g4 + k] + ba), ig = sigm(px[th][4 * g4 + k] + bx), la = -8.0f * rg * sp;
                  la4[k] = (t < L) ? la : 0.f; bm4[k] = (t < L) ? sqrtf(fmaxf(1.0f - __expf(2.0f * la), 0.f)) * (ig * xv) : 0.f; }
              u32x2 w; w.x = pk2(la4[0], la4[1]); w.y = pk2(la4[2], la4[3]); *(u32x2*)(LA + e * 72 + 32 * th + 8 * g4 + 4 * hh) = w;
              w.x = pk2(bm4[0], bm4[1]); w.y = pk2(bm4[2], bm4[3]); *(u32x2*)(LB + e * 72 + 32 * th + 8 * g4 + 4 * hh) = w; } }
    __syncthreads();
    { const int ec = tid & 255, th = tid >> 8; float ar[32], ai[32];
#pragma unroll
      for (int i = 0; i < 4; ++i) { const u32x4 la = *(const u32x4*)(LA + ec * 72 + 32 * th + 8 * i), lb = *(const u32x4*)(LB + ec * 72 + 32 * th + 8 * i);
          const unsigned lw[4] = {la.x, la.y, la.z, la.w}, bw[4] = {lb.x, lb.y, lb.z, lb.w};
#pragma unroll
          for (int k = 0; k < 4; ++k) { ar[8 * i + 2 * k] = __expf(bflo(lw[k])); ar[8 * i + 2 * k + 1] = __expf(bfhi(lw[k])); ai[8 * i + 2 * k] = bflo(bw[k]); ai[8 * i + 2 * k + 1] = bfhi(bw[k]); } }
      { float hl = 0.f, ac = 1.f;
#pragma unroll
        for (int t = 0; t < 32; ++t) { hl = ar[t] * hl + ai[t]; ac *= ar[t]; ai[t] = hl; ar[t] = ac; } }
      if (th == 0) { xch[2 * ec] = ai[31]; xch[2 * ec + 1] = ar[31]; }
      __syncthreads();
      if (th == 1) { const float h0 = xch[2 * ec], a0 = xch[2 * ec + 1];
#pragma unroll
        for (int t = 0; t < 32; ++t) { ai[t] = ar[t] * h0 + ai[t]; ar[t] = ar[t] * a0; }
        ((float*)(C.ws + WS_CA))[(size_t)(b * NCHUNK + c) * 256 + ec] = ar[31]; ((float*)(C.ws + WS_CB))[(size_t)(b * NCHUNK + c) * 256 + ec] = ai[31]; }
      bf16* AC = (bf16*)(C.ws + WS_LA); bf16* HL = (bf16*)(C.ws + WS_LB);
#pragma unroll
      for (int t = 0; t < 32; ++t) { const int tt = 32 * th + t;
          if (tt < L) { AC[(size_t)(row0 + tt) * 256 + ec] = (bf16)f2bf(ar[t]); HL[(size_t)(row0 + tt) * 256 + ec] = (bf16)f2bf(ai[t]); } } }
    __syncthreads();
}
DI void m1_phase(const Ctx& C0, int l) {
    constexpr int NDN = NB * NCHUNK * 4, NLRU = NB * NCHUNK;
#ifndef M1_SUB
#define M1_SUB 3
#endif
    u32x4 rv[7]; bool have = false;
    for (int it = C0.bid; it < NDN + NLRU; it += C0.G) {
        const Ctx C = fresh(C0);
#ifndef M1_DUP
#define M1_DUP 0
#endif
        if (it < NDN) { const int h = it & 3, bc = it >> 2, itn = it + C0.G; const bool nx = itn < NDN;
            if (!have) m1_dn_load(C, bc / NCHUNK, bc % NCHUNK, h, rv);
            m1_dn_item(C, l, bc / NCHUNK, bc % NCHUNK, h, rv, nx ? (itn >> 2) / NCHUNK : -1, nx ? (itn >> 2) % NCHUNK : 0, nx ? (itn & 3) : 0); have = nx; }
        else if (M1_SUB & 2) { const int bc = it - NDN; for (int rep = 0; rep < ((M1_DUP & 2) ? 2 : 1); ++rep) { const Ctx Cr = fresh(C0); m1_lru_item(Cr, l, bc / NCHUNK, bc % NCHUNK); } }
    }
}
constexpr int M2_WL = 0, M2_QL = 17408, M2_PL = 34816, M2_KL = 44032, M2_UT = 62464, M2_ST = 80896, M2_OS = 115712;
DI void m2_dn(const Ctx& C, int l, int b, int h) {
    const int tid = C.tid, lane = C.lane, wid = C.wave, tm = wid >> 2, tn = wid & 3, r = lane & 31, hh = lane >> 5;
    bf16* WL = (bf16*)(C.lds + M2_WL); bf16* QL = (bf16*)(C.lds + M2_QL); bf16* PL = (bf16*)(C.lds + M2_PL); bf16* KL = (bf16*)(C.lds + M2_KL);
    bf16* UT = (bf16*)(C.lds + M2_UT); bf16* ST = (bf16*)(C.lds + M2_ST); float* OS = (float*)(C.lds + M2_OS);
    const bf16* PB = (const bf16*)(C.ws + WS_PB); bf16* O = (bf16*)(C.ws + WS_O); const float* GCA = (const float*)(C.ws + WS_GCA);
    f32x16 S0, S1;
#pragma unroll
    for (int i = 0; i < 16; ++i) { S0[i] = 0.f; S1[i] = 0.f; }
    for (int i = tid; i < 128 * 136 / 2; i += NTHREADS) ((unsigned*)ST)[i] = 0u;
    u32x4 pre[7];
    const unsigned char* dni0 = C.ws + WS_DNI + (size_t)((b * NCHUNK) * 4 + h) * DNI_ITEM;
#define M2_LOAD(dn) do { \
        pre[0] = *(const u32x4*)((dn) + DNI_W + 16 * tid); pre[1] = *(const u32x4*)((dn) + DNI_W + 16 * (tid + 512)); \
        pre[2] = *(const u32x4*)((dn) + DNI_QG + 16 * tid); pre[3] = *(const u32x4*)((dn) + DNI_QG + 16 * (tid + 512)); \
        pre[4] = *(const u32x4*)((dn) + DNI_P + 16 * tid); \
        pre[5] = *(const u32x4*)((dn) + DNI_KDT + 16 * tid); pre[6] = *(const u32x4*)((dn) + DNI_KDT + 16 * (tid + 512)); } while (0)
#define M2_STORE_A() do { \
        { const int p = tid; *(u32x4*)((unsigned char*)WL + (p >> 4) * 272 + (p & 15) * 16) = pre[0]; *(u32x4*)((unsigned char*)QL + (p >> 4) * 272 + (p & 15) * 16) = pre[2]; } \
        { const int p = tid + 512; *(u32x4*)((unsigned char*)WL + (p >> 4) * 272 + (p & 15) * 16) = pre[1]; *(u32x4*)((unsigned char*)QL + (p >> 4) * 272 + (p & 15) * 16) = pre[3]; } } while (0)
#define M2_STORE_B() do { \
        { const int p = tid; *(u32x4*)((unsigned char*)PL + (p >> 3) * 144 + (p & 7) * 16) = pre[4]; *(u32x4*)((unsigned char*)KL + (p >> 3) * 144 + (p & 7) * 16) = pre[5]; } \
        { const int p = tid + 512; *(u32x4*)((unsigned char*)KL + (p >> 3) * 144 + (p & 7) * 16) = pre[6]; } } while (0)
#define M2_STORE() do { M2_STORE_A(); M2_STORE_B(); } while (0)
    M2_LOAD(dni0);
    M2_STORE();
    const int nt_ = tid >> 3, nsg = tid & 7;
    u32x2 uv[4], uvn[4]; u32x4 zz[2], zzn[2]; float egc, egcn;
#define M2_LOAD2(cc, UV, ZZ, EG) do { const unsigned char* dn_ = C.ws + WS_DNI + (size_t)((b * NCHUNK + (cc)) * 4 + h) * DNI_ITEM; \
        const bf16* uvt_ = (const bf16*)(dn_ + DNI_UVT) + (32 * tn + r) * 64 + 32 * tm + 4 * hh; \
        _Pragma("unroll") for (int g4 = 0; g4 < 4; ++g4) UV[g4] = *(const u32x2*)(uvt_ + 8 * g4); \
        EG = GCA[(b * NCHUNK + (cc)) * 4 + h]; \
        const int vr_ = ((cc) > 0 || nt_ < 16) ? chunk_row0(b, (cc)) + nt_ : chunk_row0(b, (cc)); \
        const bf16* zp_ = PB + (size_t)vr_ * PB_LD + h * 128 + 16 * nsg; ZZ[0] = *(const u32x4*)(zp_); ZZ[1] = *(const u32x4*)(zp_ + 8); } while (0)
    M2_LOAD2(0, uv, zz, egc);
    asm volatile("" :: "v"(uv[0]), "v"(uv[1]), "v"(uv[2]), "v"(uv[3]), "v"(zz[0]), "v"(zz[1]), "v"(egc));
    __syncthreads();
    u32x4 zzp[2] = {zz[0], zz[1]};
#define M2_NORM(cc) do { const int t = tid >> 3, sg = tid & 7; f32x4 v[4]; float s = 0.f; \
        _Pragma("unroll") for (int i = 0; i < 4; ++i) { v[i] = *(const f32x4*)(OS + t * 132 + 16 * sg + 4 * i); s += (v[i].x * v[i].x + v[i].y * v[i].y) + (v[i].z * v[i].z + v[i].w * v[i].w); } \
        s += xshfl(s, lane ^ 1); s += xshfl(s, lane ^ 2); s += xshfl(s, lane ^ 4); \
        const float rs = __builtin_amdgcn_rsqf(s * (1.0f / 128.0f) + EPS); \
        if ((cc) > 0 || t < 16) { const int row = chunk_row0(b, (cc)) + t; unsigned w[8]; \
            const unsigned zw[8] = {zzp[0].x, zzp[0].y, zzp[0].z, zzp[0].w, zzp[1].x, zzp[1].y, zzp[1].z, zzp[1].w}; \
            _Pragma("unroll") for (int i = 0; i < 4; ++i) { const f32x4 z = (f32x4){bflo(zw[2 * i]), bfhi(zw[2 * i]), bflo(zw[2 * i + 1]), bfhi(zw[2 * i + 1])};     \
                w[2 * i] = pk2(v[i].x * rs * z.x, v[i].y * rs * z.y); w[2 * i + 1] = pk2(v[i].z * rs * z.z, v[i].w * rs * z.w); } \
            bf16* op = O + (size_t)row * DM + h * 128 + 16 * sg; \
            *(u32x4*)(op) = (u32x4){w[0], w[1], w[2], w[3]}; *(u32x4*)(op + 8) = (u32x4){w[4], w[5], w[6], w[7]}; } } while (0)
    for (int c = 0; c < NCHUNK; ++c) {
        const int item = (b * NCHUNK + c) * 4 + h;
        const unsigned char* dni = C.ws + WS_DNI + (size_t)item * DNI_ITEM;
        if (c + 1 < NCHUNK) { M2_LOAD(dni + 4 * DNI_ITEM); M2_LOAD2(c + 1, uvn, zzn, egcn); }
        f32x16 ws, qs;
#pragma unroll
        for (int i = 0; i < 16; ++i) { ws[i] = 0.f; qs[i] = 0.f; }
#pragma unroll
        for (int ks = 0; ks < 4; ++ks) {
            const bf16x8 bfr = *(const bf16x8*)(ST + (32 * tn + r) * 136 + 16 * ks + 8 * hh);
            const bf16x8 aw = *(const bf16x8*)(WL + (32 * tm + r) * 136 + 16 * ks + 8 * hh), aq = *(const bf16x8*)(QL + (32 * tm + r) * 136 + 16 * ks + 8 * hh);
            ws = MFMA32(aw, bfr, ws); qs = MFMA32(aq, bfr, qs); }
        if (c > 0) M2_NORM(c - 1);
#pragma unroll
        for (int ks = 4; ks < 8; ++ks) {
            const bf16x8 bfr = *(const bf16x8*)(ST + (32 * tn + r) * 136 + 16 * ks + 8 * hh);
            const bf16x8 aw = *(const bf16x8*)(WL + (32 * tm + r) * 136 + 16 * ks + 8 * hh), aq = *(const bf16x8*)(QL + (32 * tm + r) * 136 + 16 * ks + 8 * hh);
            ws = MFMA32(aw, bfr, ws); qs = MFMA32(aq, bfr, qs); }
        {
#pragma unroll
          for (int g4 = 0; g4 < 4; ++g4) { const f32x4 uf = (f32x4){bflo(uv[g4].x), bfhi(uv[g4].x), bflo(uv[g4].y), bfhi(uv[g4].y)};
              u32x2 w; w.x = pk2(uf.x - ws[4 * g4], uf.y - ws[4 * g4 + 1]); w.y = pk2(uf.z - ws[4 * g4 + 2], uf.w - ws[4 * g4 + 3]);
              *(u32x2*)(UT + (32 * tn + r) * 72 + 32 * tm + 8 * g4 + 4 * hh) = w; } }
        __syncthreads();
        if (c + 1 < NCHUNK) M2_STORE_A();
        { S0 = S0 * egc; S1 = S1 * egc;
#pragma unroll
          for (int ks = 0; ks < 4; ++ks) {
              const bf16x8 bfr = *(const bf16x8*)(UT + (32 * tn + r) * 72 + 16 * ks + 8 * hh);
              const bf16x8 ap = *(const bf16x8*)(PL + (32 * tm + r) * 72 + 16 * ks + 8 * hh);
              const bf16x8 a0 = *(const bf16x8*)(KL + (64 * tm + r) * 72 + 16 * ks + 8 * hh), a1 = *(const bf16x8*)(KL + (64 * tm + 32 + r) * 72 + 16 * ks + 8 * hh);
              qs = MFMA32(ap, bfr, qs); S0 = MFMA32(a0, bfr, S0); S1 = MFMA32(a1, bfr, S1); } }
        __syncthreads();
#pragma unroll
        for (int g4 = 0; g4 < 4; ++g4) {
            u32x2 w; w.x = pk2(S0[4 * g4], S0[4 * g4 + 1]); w.y = pk2(S0[4 * g4 + 2], S0[4 * g4 + 3]); *(u32x2*)(ST + (32 * tn + r) * 136 + 64 * tm + 8 * g4 + 4 * hh) = w;
            w.x = pk2(S1[4 * g4], S1[4 * g4 + 1]); w.y = pk2(S1[4 * g4 + 2], S1[4 * g4 + 3]); *(u32x2*)(ST + (32 * tn + r) * 136 + 64 * tm + 32 + 8 * g4 + 4 * hh) = w; }
#pragma unroll
        for (int i = 0; i < 16; ++i) OS[(32 * tm + crow(i, hh)) * 132 + 32 * tn + r] = qs[i];
        zzp[0] = zz[0]; zzp[1] = zz[1];
        if (c + 1 < NCHUNK) { M2_STORE_B();
#pragma unroll
            for (int g4 = 0; g4 < 4; ++g4) uv[g4] = uvn[g4];
            zz[0] = zzn[0]; zz[1] = zzn[1]; egc = egcn; }
        __syncthreads();
    }
    M2_NORM(NCHUNK - 1);
#undef M2_NORM
#undef M2_LOAD
#undef M2_LOAD2
#undef M2_STORE
#undef M2_STORE_A
#undef M2_STORE_B
    { float* so = C.out + O_DNP + ((size_t)((l * NB + b) * 4 + h)) * 16384;
#pragma unroll
      for (int i = 0; i < 16; ++i) { so[(size_t)(64 * tm + crow(i, hh)) * 128 + 32 * tn + r] = S0[i]; so[(size_t)(64 * tm + 32 + crow(i, hh)) * 128 + 32 * tn + r] = S1[i]; } }
}

constexpr int M2_EG = 149504;
DI u32x4 q4(const f32x16& v, int q) { const f32x4 t = {v[4 * q], v[4 * q + 1], v[4 * q + 2], v[4 * q + 3]}; return __builtin_bit_cast(u32x4, t); }
DI void sq4(f32x16& v, int q, u32x4 x) { const f32x4 t = __builtin_bit_cast(f32x4, x); v[4 * q] = t.x; v[4 * q + 1] = t.y; v[4 * q + 2] = t.z; v[4 * q + 3] = t.w; }
DI void m2_dn2(const Ctx& C, int l, int b, int h) {
    const int tid = C.tid, lane = C.lane, wid = C.wave, r = lane & 31, hh = lane >> 5;
    bf16* WL = (bf16*)(C.lds + M2_WL); bf16* QL = (bf16*)(C.lds + M2_QL); bf16* PL = (bf16*)(C.lds + M2_PL); bf16* KL = (bf16*)(C.lds + M2_KL);
    bf16* UT = (bf16*)(C.lds + M2_UT); bf16* ST = (bf16*)(C.lds + M2_ST); float* OS = (float*)(C.lds + M2_OS); float* EGS = (float*)(C.lds + M2_EG);
    const bf16* PB = (const bf16*)(C.ws + WS_PB); bf16* O = (bf16*)(C.ws + WS_O); const float* GCA = (const float*)(C.ws + WS_GCA);
    const bool comp = wid < 4;
    const int tn = wid & 3;
    const int ta = tid & 255, nt = ta >> 2, nq = ta & 3;
    f32x16 S_[4];
#pragma unroll
    for (int j = 0; j < 4; ++j)
#pragma unroll
        for (int i = 0; i < 16; ++i) S_[j][i] = 0.f;
    for (int i = tid; i < 128 * 136 / 2; i += NTHREADS) ((unsigned*)ST)[i] = 0u;
    f32x16 ws[2], qs[2]; float egr = 0.f;
#define WQR(k) S_[(k) >> 2], (k) & 3
#define UVR(k) S_[2], (k)
#define ZRR(k) S_[3], (k)
#define PKR(k) qs[(k) >> 2], (k) & 3
#define D2_PTR(cc) (C.ws + WS_DNI + (size_t)((b * NCHUNK + (cc)) * 4 + h) * DNI_ITEM)
#define D2_LD_WQ(dn) do { _Pragma("unroll") for (int k = 0; k < 4; ++k) { sq4(WQR(k), *(const u32x4*)((dn) + DNI_W + 16 * (ta + 256 * k))); sq4(WQR(4 + k), *(const u32x4*)((dn) + DNI_QG + 16 * (ta + 256 * k))); } } while (0)
#define D2_LD_U(dn) do { _Pragma("unroll") for (int k = 0; k < 4; ++k) sq4(UVR(k), *(const u32x4*)((dn) + DNI_UVT + 16 * (ta + 256 * k))); } while (0)
#define D2_LD_WQU(dn) do { D2_LD_WQ(dn); D2_LD_U(dn); } while (0)
#define D2_LD_PK(dn) do { sq4(PKR(0), *(const u32x4*)((dn) + DNI_P + 16 * ta)); sq4(PKR(1), *(const u32x4*)((dn) + DNI_P + 16 * (ta + 256))); \
        _Pragma("unroll") for (int k = 0; k < 4; ++k) sq4(PKR(2 + k), *(const u32x4*)((dn) + DNI_KDT + 16 * (ta + 256 * k))); } while (0)
#define D2_LD_Z(cc) do { const int vr_ = ((cc) > 0 || nt < 16) ? chunk_row0(b, (cc)) + nt : chunk_row0(b, (cc)); const bf16* zp_ = PB + (size_t)vr_ * PB_LD + h * 128 + 32 * nq; \
        _Pragma("unroll") for (int k = 0; k < 4; ++k) sq4(ZRR(k), *(const u32x4*)(zp_ + 8 * k)); } while (0)
#define D2_ST_WQ() do { _Pragma("unroll") for (int k = 0; k < 4; ++k) { const int p = ta + 256 * k; *(u32x4*)((unsigned char*)WL + (p >> 4) * 272 + (p & 15) * 16) = q4(WQR(k)); *(u32x4*)((unsigned char*)QL + (p >> 4) * 272 + (p & 15) * 16) = q4(WQR(4 + k)); } } while (0)
#define D2_ST_U() do { _Pragma("unroll") for (int k = 0; k < 4; ++k) { const int p = ta + 256 * k; *(u32x4*)((unsigned char*)UT + (p >> 3) * 144 + (p & 7) * 16) = q4(UVR(k)); } } while (0)
#define D2_ST_PK() do { { const int p = ta; *(u32x4*)((unsigned char*)PL + (p >> 3) * 144 + (p & 7) * 16) = q4(PKR(0)); } { const int p = ta + 256; *(u32x4*)((unsigned char*)PL + (p >> 3) * 144 + (p & 7) * 16) = q4(PKR(1)); } \
        _Pragma("unroll") for (int k = 0; k < 4; ++k) { const int p = ta + 256 * k; *(u32x4*)((unsigned char*)KL + (p >> 3) * 144 + (p & 7) * 16) = q4(PKR(2 + k)); } } while (0)
#define D2_NORM(cc) do { float s = 0.f; \
        _Pragma("unroll") for (int i = 0; i < 8; ++i) { const f32x4 vv = *(const f32x4*)(OS + nt * 132 + 32 * nq + 4 * i); s += (vv.x * vv.x + vv.y * vv.y) + (vv.z * vv.z + vv.w * vv.w); sq4(ws[i >> 2], i & 3, __builtin_bit_cast(u32x4, vv)); } \
        s += xshfl(s, lane ^ 1); s += xshfl(s, lane ^ 2); \
        const float rs = __builtin_amdgcn_rsqf(s * (1.0f / 128.0f) + EPS); \
        if ((cc) > 0 || nt < 16) { const int row = chunk_row0(b, (cc)) + nt; bf16* op = O + (size_t)row * DM + h * 128 + 32 * nq; \
            _Pragma("unroll") for (int k = 0; k < 4; ++k) { const u32x4 zq = q4(ZRR(k)); const unsigned zw[4] = {zq.x, zq.y, zq.z, zq.w}; unsigned w[4]; \
                _Pragma("unroll") for (int e = 0; e < 4; ++e) { const f32x4 vv = __builtin_bit_cast(f32x4, q4(ws[(2 * k + (e >> 1)) >> 2], (2 * k + (e >> 1)) & 3)); const float a0 = (e & 1) ? vv.z : vv.x, a1 = (e & 1) ? vv.w : vv.y; \
                    w[e] = pk2(a0 * rs * bflo(zw[e]), a1 * rs * bfhi(zw[e])); }     \
                *(u32x4*)(op + 8 * k) = (u32x4){w[0], w[1], w[2], w[3]}; } } } while (0)
    if (!comp) { const unsigned char* d0 = D2_PTR(0); D2_LD_WQU(d0); D2_LD_PK(d0); egr = GCA[(b * NCHUNK) * 4 + h];
        D2_ST_WQ(); D2_ST_U(); if (ta == 0) EGS[0] = egr;
        const unsigned char* d1 = D2_PTR(1); D2_LD_WQU(d1); }
    __syncthreads();
    for (int c = 0; c < NCHUNK; ++c) {
        const int cn = (c + 1 < NCHUNK) ? c + 1 : NCHUNK - 1, cn2 = (c + 2 < NCHUNK) ? c + 2 : NCHUNK - 1;
        if (comp) {
#pragma unroll
            for (int mq = 0; mq < 2; ++mq)
#pragma unroll
                for (int i = 0; i < 16; ++i) { ws[mq][i] = 0.f; qs[mq][i] = 0.f; }
#pragma unroll
            for (int ks = 0; ks < 8; ++ks) {
                const bf16x8 bfr = *(const bf16x8*)(ST + (32 * tn + r) * 136 + 16 * ks + 8 * hh);
#pragma unroll
                for (int mq = 0; mq < 2; ++mq) { const bf16x8 aw = *(const bf16x8*)(WL + (32 * mq + r) * 136 + 16 * ks + 8 * hh), aq = *(const bf16x8*)(QL + (32 * mq + r) * 136 + 16 * ks + 8 * hh);
                    ws[mq] = MFMA32(aw, bfr, ws[mq]); qs[mq] = MFMA32(aq, bfr, qs[mq]); } }
#pragma unroll
            for (int mq = 0; mq < 2; ++mq)
#pragma unroll
                for (int g4 = 0; g4 < 4; ++g4) { bf16* up = UT + (32 * tn + r) * 72 + 32 * mq + 8 * g4 + 4 * hh; const u32x2 u0 = *(const u32x2*)up;
                    u32x2 w; w.x = pk2(bflo(u0.x) - ws[mq][4 * g4], bfhi(u0.x) - ws[mq][4 * g4 + 1]); w.y = pk2(bflo(u0.y) - ws[mq][4 * g4 + 2], bfhi(u0.y) - ws[mq][4 * g4 + 3]); *(u32x2*)up = w; }
        } else {
            D2_ST_PK();
            { const unsigned char* dn = D2_PTR(cn); D2_LD_PK(dn); }
            if (c > 0) D2_NORM(c - 1);
            D2_LD_Z(c);
            egr = GCA[(b * NCHUNK + cn) * 4 + h];
        }
        __syncthreads();
        if (comp) {
            const float egc = EGS[0];
#pragma unroll
            for (int j = 0; j < 4; ++j) S_[j] = S_[j] * egc;
#pragma unroll
            for (int ks = 0; ks < 4; ++ks) {
                const bf16x8 bfr = *(const bf16x8*)(UT + (32 * tn + r) * 72 + 16 * ks + 8 * hh);
#pragma unroll
                for (int mq = 0; mq < 2; ++mq) { const bf16x8 ap = *(const bf16x8*)(PL + (32 * mq + r) * 72 + 16 * ks + 8 * hh); qs[mq] = MFMA32(ap, bfr, qs[mq]); }
#pragma unroll
                for (int j = 0; j < 4; ++j) { const bf16x8 ak = *(const bf16x8*)(KL + (32 * j + r) * 72 + 16 * ks + 8 * hh); S_[j] = MFMA32(ak, bfr, S_[j]); } }
        } else {
            D2_ST_WQ();
            { const unsigned char* dn = D2_PTR(cn2); D2_LD_WQ(dn); }
        }
        __syncthreads();
        if (comp) {
#pragma unroll
            for (int j = 0; j < 4; ++j)
#pragma unroll
                for (int g4 = 0; g4 < 4; ++g4) { u32x2 w; w.x = pk2(S_[j][4 * g4], S_[j][4 * g4 + 1]); w.y = pk2(S_[j][4 * g4 + 2], S_[j][4 * g4 + 3]); *(u32x2*)(ST + (32 * tn + r) * 136 + 32 * j + 8 * g4 + 4 * hh) = w; }
#pragma unroll
            for (int mq = 0; mq < 2; ++mq)
#pragma unroll
                for (int i = 0; i < 16; ++i) OS[(32 * mq + crow(i, hh)) * 132 + 32 * tn + r] = qs[mq][i];
        } else {
            D2_ST_U();
            { const unsigned char* dn = D2_PTR(cn2); D2_LD_U(dn); }
            if (ta == 0) EGS[0] = egr;
        }
        __syncthreads();
    }
    if (!comp) D2_NORM(NCHUNK - 1);
#undef D2_PTR
#undef WQR
#undef UVR
#undef ZRR
#undef PKR
#undef D2_LD_WQU
#undef D2_LD_WQ
#undef D2_LD_U
#undef D2_LD_PK
#undef D2_LD_Z
#undef D2_ST_WQ
#undef D2_ST_U
#undef D2_ST_PK
#undef D2_NORM
    if (comp) { float* so = C.out + O_DNP + ((size_t)((l * NB + b) * 4 + h)) * 16384;
#pragma unroll
      for (int j = 0; j < 4; ++j)
#pragma unroll
          for (int i = 0; i < 16; ++i) so[(size_t)(32 * j + crow(i, hh)) * 128 + 32 * tn + r] = S_[j][i]; }
}

constexpr int R_QL = 0, R_QG = 9216, R_KL = 18432, R_KDT = 27648, R_VT = 36864, R_ST = 46080, R_PL = 55296, R_OS = 64512, R_GL = 81920;
DI void m2_ret(const Ctx& C, int l, int b, int h) {
    const int tid = C.tid, lane = C.lane, wid = C.wave, r = lane & 31, hh = lane >> 5;
    bf16* QL = (bf16*)(C.lds + R_QL); bf16* QG = (bf16*)(C.lds + R_QG); bf16* KL = (bf16*)(C.lds + R_KL); bf16* KDT = (bf16*)(C.lds + R_KDT); bf16* VT = (bf16*)(C.lds + R_VT);
    bf16* ST = (bf16*)(C.lds + R_ST); bf16* PL = (bf16*)(C.lds + R_PL); float* OS = (float*)(C.lds + R_OS); bf16* GL = (bf16*)(C.lds + R_GL);
    const bf16* PB = (const bf16*)(C.ws + WS_PB); bf16* O = (bf16*)(C.ws + WS_O); const float* rope = (const float*)(C.ws + WS_ROPE);
    const float lg = (h == 0) ? -0.0317486983145803f : (h == 1) ? -0.015748356968139168f : (h == 2) ? -0.007843177461025893f : -0.003913899321136329f;
    f32x16 acc;
#pragma unroll
    for (int i = 0; i < 16; ++i) acc[i] = 0.f;
    for (int i = tid; i < 64 * 72 / 2; i += NTHREADS) ((unsigned*)ST)[i] = 0u;
    __syncthreads();
    u32x2 rq1, rq2, rk1, rk2; u32x4 rv, rg; f32x4 rc0, rc1;
    u32x2 nq1, nq2, nk1, nk2; u32x4 nv, ng; f32x4 nc0, nc1;
#define R_LOAD(cc, Q1, Q2, K1, K2, VV, GV, C0_, C1_) do { const int t_ = tid >> 3, j_ = tid & 7; const int L_ = ((cc) == 0) ? 16 : 64; \
        const bf16* pr_ = PB + (size_t)(chunk_row0(b, (cc)) + (t_ < L_ ? t_ : 0)) * PB_LD; \
        Q1 = *(const u32x2*)(pr_ + 1024 + 64 * h + 4 * j_); Q2 = *(const u32x2*)(pr_ + 1024 + 64 * h + 32 + 4 * j_); K1 = *(const u32x2*)(pr_ + 1280 + 64 * h + 4 * j_); K2 = *(const u32x2*)(pr_ + 1280 + 64 * h + 32 + 4 * j_); \
        VV = *(const u32x4*)(pr_ + 1536 + 64 * h + 8 * j_); GV = *(const u32x4*)(pr_ + 1792 + 64 * h + 8 * j_); \
        const float* rp_ = rope + ((size_t)((((cc) == 0) ? 0 : 16 + 64 * ((cc) - 1)) + t_) * 32 + 4 * j_) * 2; C0_ = *(const f32x4*)(rp_); C1_ = *(const f32x4*)(rp_ + 4); } while (0)
    R_LOAD(0, rq1, rq2, rk1, rk2, rv, rg, rc0, rc1);
    asm volatile("" :: "v"(rq1), "v"(rq2), "v"(rk1), "v"(rk2), "v"(rv), "v"(rg), "v"(rc0), "v"(rc1));
    for (int c = 0; c < NCHUNK; ++c) {
        const int L = (c == 0) ? 16 : 64, row0 = chunk_row0(b, c);
        if (c + 1 < NCHUNK) R_LOAD(c + 1, nq1, nq2, nk1, nk2, nv, ng, nc0, nc1);
        { const int t = tid >> 3, j = tid & 7;
          f32x4 q1 = (f32x4){0.f, 0.f, 0.f, 0.f}, q2 = q1, k1 = q1, k2 = q1; u32x4 vv = (u32x4){0u, 0u, 0u, 0u}, gv = vv;
          if (t < L) { q1 = (f32x4){bflo(rq1.x), bfhi(rq1.x), bflo(rq1.y), bfhi(rq1.y)}; q2 = (f32x4){bflo(rq2.x), bfhi(rq2.x), bflo(rq2.y), bfhi(rq2.y)};
              k1 = (f32x4){bflo(rk1.x), bfhi(rk1.x), bflo(rk1.y), bfhi(rk1.y)}; k2 = (f32x4){bflo(rk2.x), bfhi(rk2.x), bflo(rk2.y), bfhi(rk2.y)}; vv = rv; gv = rg; }
          const f32x4 cs0 = rc0, cs1 = rc1;
          const float cc[4] = {cs0.x, cs0.z, cs1.x, cs1.z}, sn[4] = {cs0.y, cs0.w, cs1.y, cs1.w};
          const float dq = __expf(lg * (float)(t + 1)), dk = (t < L) ? 0.125f * __expf(lg * (float)(L - 1 - t)) : 0.f;
          float qa[4], qb[4], ka[4], kb[4];
#pragma unroll
          for (int e = 0; e < 4; ++e) { qa[e] = q1[e] * cc[e] - q2[e] * sn[e]; qb[e] = q1[e] * sn[e] + q2[e] * cc[e]; ka[e] = k1[e] * cc[e] - k2[e] * sn[e]; kb[e] = k1[e] * sn[e] + k2[e] * cc[e]; }
          u32x2 w;
          w.x = pk2(qa[0], qa[1]); w.y = pk2(qa[2], qa[3]); *(u32x2*)(QL + t * 72 + 4 * j) = w; w.x = pk2(qb[0], qb[1]); w.y = pk2(qb[2], qb[3]); *(u32x2*)(QL + t * 72 + 32 + 4 * j) = w;
          w.x = pk2(qa[0] * dq, qa[1] * dq); w.y = pk2(qa[2] * dq, qa[3] * dq); *(u32x2*)(QG + t * 72 + 4 * j) = w; w.x = pk2(qb[0] * dq, qb[1] * dq); w.y = pk2(qb[2] * dq, qb[3] * dq); *(u32x2*)(QG + t * 72 + 32 + 4 * j) = w;
          w.x = pk2(ka[0] * 0.125f, ka[1] * 0.125f); w.y = pk2(ka[2] * 0.125f, ka[3] * 0.125f); *(u32x2*)(KL + t * 72 + 4 * j) = w;
          w.x = pk2(kb[0] * 0.125f, kb[1] * 0.125f); w.y = pk2(kb[2] * 0.125f, kb[3] * 0.125f); *(u32x2*)(KL + t * 72 + 32 + 4 * j) = w;
#pragma unroll
          for (int e = 0; e < 4; ++e) { KDT[(4 * j + e) * 72 + t] = (bf16)f2bf(ka[e] * dk); KDT[(32 + 4 * j + e) * 72 + t] = (bf16)f2bf(kb[e] * dk); }
          const unsigned vw[4] = {vv.x, vv.y, vv.z, vv.w};
#pragma unroll
          for (int e = 0; e < 4; ++e) { VT[(8 * j + 2 * e) * 72 + t] = (bf16)(vw[e] & 0xffffu); VT[(8 * j + 2 * e + 1) * 72 + t] = (bf16)(vw[e] >> 16); }
          *(u32x4*)(GL + t * 72 + 8 * j) = gv; }
        __syncthreads();
        if (wid < 4) { const int ti = wid >> 1, tj = wid & 1; f32x16 p;
#pragma unroll
            for (int i = 0; i < 16; ++i) p[i] = 0.f;
#pragma unroll
            for (int ks = 0; ks < 4; ++ks) { const bf16x8 a = *(const bf16x8*)(KL + (32 * ti + r) * 72 + 16 * ks + 8 * hh), bq = *(const bf16x8*)(QL + (32 * tj + r) * 72 + 16 * ks + 8 * hh); p = MFMA32(a, bq, p); }
            const int t = 32 * tj + r;
#pragma unroll
            for (int g4 = 0; g4 < 4; ++g4) { const int i0 = 32 * ti + 8 * g4 + 4 * hh; float o[4];
#pragma unroll
                for (int e = 0; e < 4; ++e) { const int i = i0 + e; o[e] = (t >= i) ? p[4 * g4 + e] * __expf(lg * (float)(t - i)) : 0.f; }
                u32x2 w; w.x = pk2(o[0], o[1]); w.y = pk2(o[2], o[3]); *(u32x2*)(PL + t * 72 + i0) = w; }
        } else { const int tm = (wid >> 1) & 1, en = wid & 1;
#pragma unroll
            for (int i = 0; i < 16; ++i) acc[i] = 0.f;
#pragma unroll
            for (int ks = 0; ks < 4; ++ks) { const bf16x8 a = *(const bf16x8*)(QG + (32 * tm + r) * 72 + 16 * ks + 8 * hh), bs = *(const bf16x8*)(ST + (32 * en + r) * 72 + 16 * ks + 8 * hh); acc = MFMA32(a, bs, acc); }
        }
        __syncthreads();
        if (wid < 4) { const int dm = wid >> 1, en = wid & 1; acc = acc * __expf(lg * (float)L);
#pragma unroll
            for (int ks = 0; ks < 4; ++ks) { const bf16x8 a = *(const bf16x8*)(KDT + (32 * dm + r) * 72 + 16 * ks + 8 * hh), bv = *(const bf16x8*)(VT + (32 * en + r) * 72 + 16 * ks + 8 * hh); acc = MFMA32(a, bv, acc); }
        } else { const int tm = (wid >> 1) & 1, en = wid & 1;
#pragma unroll
            for (int ks = 0; ks < 4; ++ks) { const bf16x8 a = *(const bf16x8*)(PL + (32 * tm + r) * 72 + 16 * ks + 8 * hh), bv = *(const bf16x8*)(VT + (32 * en + r) * 72 + 16 * ks + 8 * hh); acc = MFMA32(a, bv, acc); }
        }
        __syncthreads();
        if (wid < 4) { const int dm = wid >> 1, en = wid & 1;
#pragma unroll
            for (int g4 = 0; g4 < 4; ++g4) { u32x2 w; w.x = pk2(acc[4 * g4], acc[4 * g4 + 1]); w.y = pk2(acc[4 * g4 + 2], acc[4 * g4 + 3]); *(u32x2*)(ST + (32 * en + r) * 72 + 32 * dm + 8 * g4 + 4 * hh) = w; }
        } else { const int tm = (wid >> 1) & 1, en = wid & 1;
#pragma unroll
            for (int i = 0; i < 16; ++i) OS[(32 * tm + crow(i, hh)) * 68 + 32 * en + r] = acc[i];
        }
        __syncthreads();
        { const int t = tid >> 3, sg = tid & 7; const f32x4 v0 = *(const f32x4*)(OS + t * 68 + 8 * sg), v1 = *(const f32x4*)(OS + t * 68 + 8 * sg + 4);
          float s = (v0.x + v0.y) + (v0.z + v0.w) + (v1.x + v1.y) + (v1.z + v1.w);
          s += xshfl(s, lane ^ 1); s += xshfl(s, lane ^ 2); s += xshfl(s, lane ^ 4);
          const float mu = s * (1.0f / 64.0f);
          const f32x4 d0 = v0 - mu, d1 = v1 - mu; float q = (d0.x * d0.x + d0.y * d0.y) + (d0.z * d0.z + d0.w * d0.w) + (d1.x * d1.x + d1.y * d1.y) + (d1.z * d1.z + d1.w * d1.w);
          q += xshfl(q, lane ^ 1); q += xshfl(q, lane ^ 2); q += xshfl(q, lane ^ 4);
          const float rs = __builtin_amdgcn_rsqf(q * (1.0f / 64.0f) + EPS);
          if (t < L) { const u32x4 gv = *(const u32x4*)(GL + t * 72 + 8 * sg); u32x4 w;
              w.x = pk2(d0.x * rs * silu(bflo(gv.x)), d0.y * rs * silu(bfhi(gv.x))); w.y = pk2(d0.z * rs * silu(bflo(gv.y)), d0.w * rs * silu(bfhi(gv.y)));
              w.z = pk2(d1.x * rs * silu(bflo(gv.z)), d1.y * rs * silu(bfhi(gv.z))); w.w = pk2(d1.z * rs * silu(bflo(gv.w)), d1.w * rs * silu(bfhi(gv.w)));
              *(u32x4*)(O + (size_t)(row0 + t) * DM + 768 + 64 * h + 8 * sg) = w; } }
        if (c + 1 < NCHUNK) { rq1 = nq1; rq2 = nq2; rk1 = nk1; rk2 = nk2; rv = nv; rg = ng; rc0 = nc0; rc1 = nc1; }
        __syncthreads();
    }
#undef R_LOAD
    if (wid < 4) { const int dm = wid >> 1, en = wid & 1; float* so = C.out + O_RETP + ((size_t)((l * NB + b) * 4 + h)) * 4096;
#pragma unroll
        for (int i = 0; i < 16; ++i) so[(size_t)(32 * dm + crow(i, hh)) * 64 + 32 * en + r] = acc[i]; }
}

DI void m2_lru_item(const Ctx& C, int l, int b, int c) {
    const int e = C.tid & 255, th = C.tid >> 8;
    const bf16* AC = (const bf16*)(C.ws + WS_LA); const bf16* HL = (const bf16*)(C.ws + WS_LB); const bf16* PB = (const bf16*)(C.ws + WS_PB); bf16* O = (bf16*)(C.ws + WS_O);
    const float* CA = (const float*)(C.ws + WS_CA) + (size_t)(b * NCHUNK) * 256 + e; const float* CB = (const float*)(C.ws + WS_CB) + (size_t)(b * NCHUNK) * 256 + e;
    float hin = 0.f;
#pragma unroll 8
    for (int cc = 0; cc < c; ++cc) hin = CA[cc * 256] * hin + CB[cc * 256];
    const int L = (c == 0) ? 16 : 64, row0 = chunk_row0(b, c);
#pragma unroll 8
    for (int t = 0; t < 32; ++t) { const int tt = 32 * th + t;
        if (tt < L) { const size_t row = (size_t)(row0 + tt);
            const float hv = bf1(AC[row * 256 + e]) * hin + bf1(HL[row * 256 + e]);
            O[row * DM + 512 + e] = (bf16)f2bf(hv * gelu_tanh(bf1(PB[row * PB_LD + 768 + e]))); } }
    if (c == NCHUNK - 1 && th == 1) C.out[O_LRUP + (size_t)(l * NB + b) * 256 + e] = CA[c * 256] * hin + CB[c * 256];
}
DI void ms_dn(const Ctx& C, int l, int s, int h) {
    const int tid = C.tid, lane = C.lane, wid = C.wave, row = SROW0 + s;
    float* sh = (float*)C.lds; float* scal = sh + 384; float* Ush = sh + 400; float* osh = sh + 528; float* red = sh + 1024;
    const bf16* PA = (const bf16*)(C.ws + WS_PA); const bf16* PB = (const bf16*)(C.ws + WS_PB); bf16* O = (bf16*)(C.ws + WS_O);
    const int e4 = tid & 31, dg = tid >> 5;
    const float* S0p = inp(I_SDN) + ((size_t)((l * NSAMP + s) * 4 + h) * 128) * 128;
    f32x4 sv[8];
#pragma unroll
    for (int i = 0; i < 8; ++i) sv[i] = *(const f32x4*)(S0p + (size_t)(8 * dg + i) * 128 + 4 * e4);
    const int part = tid >> 7, d_ = tid & 127, col = (part < 3 ? part : 0) * 512 + h * 128 + d_;
    const float* buf = inp(I_SDNC) + ((size_t)(l * NSAMP + s) * 3) * 1536 + col; const float* cw = inp(I_DNCW) + (size_t)l * 4 * 1536 + col;
    const float x0 = buf[0], x1 = buf[1536], x2 = buf[3072], x3 = bf1(PA[(size_t)row * PA_LD + col]), c0 = cw[0], c1 = cw[1536], c2 = cw[3072], c3 = cw[4608];
    const float a_ = bf1(PA[(size_t)row * PA_LD + 1536 + h]), b_ = bf1(PA[(size_t)row * PA_LD + 1540 + h]), alog = inp(I_ALOG)[l * 4 + h], dtb = inp(I_DTB)[l * 4 + h];
    const float z0 = bf1(PB[(size_t)row * PB_LD + h * 128 + lane]), z1 = bf1(PB[(size_t)row * PB_LD + h * 128 + 64 + lane]);
    if (tid < 384) { sh[part * 128 + d_] = silu(c0 * x0 + c1 * x1 + c2 * x2 + c3 * x3);
        float* co = C.out + O_DNCS + ((size_t)(l * NSAMP + s) * 3) * 1536 + col; co[0] = x1; co[1536] = x2; co[3072] = x3; }
    __syncthreads();
    if (wid < 2) { const float v0 = sh[wid * 128 + lane], v1 = sh[wid * 128 + 64 + lane]; const float ss = wave_sum(v0 * v0 + v1 * v1, lane);
        const float sc = __builtin_amdgcn_rsqf(ss + EPS) * (wid == 0 ? 0.08838834764831845f : 1.0f); sh[wid * 128 + lane] = v0 * sc; sh[wid * 128 + 64 + lane] = v1 * sc; }
    __syncthreads();
    if (wid == 0) { const float qk = wave_sum(sh[lane] * sh[128 + lane] + sh[64 + lane] * sh[192 + lane], lane);
        if (lane == 0) { const float g = -__expf(alog) * softplus(a_ + dtb); scal[0] = qk; scal[1] = __expf(g); scal[2] = sigm(b_); } }
    f32x4 kS = (f32x4){0.f, 0.f, 0.f, 0.f}, qS = kS;
#pragma unroll
    for (int i = 0; i < 8; ++i) { const int d = 8 * dg + i; kS = kS + sv[i] * sh[128 + d]; qS = qS + sv[i] * sh[d]; }
    *(f32x4*)(red + dg * 256 + 4 * e4) = kS; *(f32x4*)(red + dg * 256 + 128 + 4 * e4) = qS;
    __syncthreads();
    if (tid < 128) { float ks = 0.f, qs = 0.f;
#pragma unroll
        for (int g = 0; g < 16; ++g) { ks += red[g * 256 + tid]; qs += red[g * 256 + 128 + tid]; }
        const float eG = scal[1], U = scal[2] * (sh[256 + tid] - eG * ks); Ush[tid] = U; osh[tid] = eG * qs + scal[0] * U; }
    __syncthreads();
    { const f32x4 U4 = *(const f32x4*)(Ush + 4 * e4); const float eG = scal[1];
      float* So = C.out + O_DNS + ((size_t)((l * NSAMP + s) * 4 + h) * 128) * 128;
#pragma unroll
      for (int i = 0; i < 8; ++i) { const int d = 8 * dg + i; *(f32x4*)(So + (size_t)d * 128 + 4 * e4) = sv[i] * eG + U4 * sh[128 + d]; } }
    if (wid == 0) { const float o0 = osh[lane], o1 = osh[lane + 64]; const float ss = wave_sum(o0 * o0 + o1 * o1, lane); const float rs = __builtin_amdgcn_rsqf(ss * (1.0f / 128.0f) + EPS);
        bf16* op = O + (size_t)row * DM + h * 128;
        op[lane] = (bf16)f2bf(o0 * rs * z0); op[lane + 64] = (bf16)f2bf(o1 * rs * z1); }
    __syncthreads();
}
DI void ms_ret(const Ctx& C, int l, int s, int h) {
    const int tid = C.tid, lane = C.lane, wid = C.wave, row = SROW0 + s;
    float* sh = (float*)C.lds; float* osh = sh + 256; float* red = sh + 1024;
    const bf16* PB = (const bf16*)(C.ws + WS_PB); bf16* O = (bf16*)(C.ws + WS_O); const float* rope = (const float*)(C.ws + WS_ROPE) + (size_t)2064 * 32 * 2;
    const float gam = 1.0f - exp2f(-5.0f - (float)h);
    const bf16* pr = PB + (size_t)row * PB_LD;
    const int e4 = tid & 15, dg = tid >> 4;
    const float* S0p = inp(I_SRET) + ((size_t)((l * NSAMP + s) * 4 + h) * 64) * 64;
    f32x4 sv[2];
#pragma unroll
    for (int i = 0; i < 2; ++i) sv[i] = *(const f32x4*)(S0p + (size_t)(2 * dg + i) * 64 + 4 * e4);
    const int i_ = tid & 31;
    const float q1 = bf1(pr[1024 + 64 * h + i_]), q2 = bf1(pr[1024 + 64 * h + 32 + i_]), k1 = bf1(pr[1280 + 64 * h + i_]), k2 = bf1(pr[1280 + 64 * h + 32 + i_]), cr = rope[2 * i_], sr = rope[2 * i_ + 1];
    const float vv = bf1(pr[1536 + 64 * h + lane]), gg = bf1(pr[1792 + 64 * h + lane]);
    if (tid < 32) { sh[i_] = q1 * cr - q2 * sr; sh[32 + i_] = q1 * sr + q2 * cr; sh[64 + i_] = 0.125f * (k1 * cr - k2 * sr); sh[96 + i_] = 0.125f * (k1 * sr + k2 * cr); }
    else if (tid >= 64 && tid < 128) sh[128 + lane] = vv;
    __syncthreads();
    if (wid == 0) { const float qk = wave_sum(sh[lane] * sh[64 + lane], lane); if (lane == 0) sh[192] = qk; }
    f32x4 qS = (f32x4){0.f, 0.f, 0.f, 0.f};
#pragma unroll
    for (int i = 0; i < 2; ++i) { const int d = 2 * dg + i; qS = qS + sv[i] * sh[d]; }
    *(f32x4*)(red + dg * 64 + 4 * e4) = qS;
    __syncthreads();
    if (tid < 64) { float qs = 0.f;
#pragma unroll
        for (int g = 0; g < 32; ++g) qs += red[g * 64 + tid];
        osh[tid] = gam * qs + sh[192] * sh[128 + tid]; }
    { const f32x4 v4 = *(const f32x4*)(sh + 128 + 4 * e4); float* So = C.out + O_RETS + ((size_t)((l * NSAMP + s) * 4 + h) * 64) * 64;
#pragma unroll
      for (int i = 0; i < 2; ++i) { const int d = 2 * dg + i; *(f32x4*)(So + (size_t)d * 64 + 4 * e4) = sv[i] * gam + v4 * sh[64 + d]; } }
    __syncthreads();
    if (wid == 0) { const float o = osh[lane]; const float mu = wave_sum(o, lane) * (1.0f / 64.0f); const float d = o - mu; const float var = wave_sum(d * d, lane) * (1.0f / 64.0f);
        O[(size_t)row * DM + 768 + 64 * h + lane] = (bf16)f2bf(d * __builtin_amdgcn_rsqf(var + EPS) * silu(gg)); }
    __syncthreads();
}
DI void ms_lru(const Ctx& C, int l, int s) {
    const int tid = C.tid, row = SROW0 + s; float* sh = (float*)C.lds;
    const bf16* PB = (const bf16*)(C.ws + WS_PB); bf16* O = (bf16*)(C.ws + WS_O);
    const int e = tid & 255, n = e >> 6, ee = e & 63;
    u32x4 wa8[8], wx8[8];
    { const unsigned char* wp = C.ws + WS_LWT + (size_t)l * 65536 + (size_t)((n * 64 + ee) * 64) * 2;
#pragma unroll
      for (int i = 0; i < 8; ++i) { wa8[i] = *(const u32x4*)(wp + 16 * i); wx8[i] = *(const u32x4*)(wp + 32768 + 16 * i); } }
    const float* buf = inp(I_SLRUC) + ((size_t)(l * NSAMP + s) * 3) * 256 + e; const float* cw = inp(I_LCW) + (size_t)l * 4 * 256 + e;
    const float x0 = buf[0], x1 = buf[256], x2 = buf[512], x3 = bf1(PB[(size_t)row * PB_LD + 512 + e]);
    const float xl = cw[0] * x0 + cw[256] * x1 + cw[512] * x2 + cw[768] * x3 + inp(I_LCB)[l * 256 + e];
    const float ba = inp(I_LBA)[l * 256 + e], bx = inp(I_LBX)[l * 256 + e], lam = inp(I_LLAM)[l * 256 + e], h0 = inp(I_SLRU)[(size_t)(l * NSAMP + s) * 256 + e], yv = bf1(PB[(size_t)row * PB_LD + 768 + e]);
    if (tid < 256) { sh[e] = xl; float* co = C.out + O_LRUCS + ((size_t)(l * NSAMP + s) * 3) * 256 + e; co[0] = x1; co[256] = x2; co[512] = x3; }
    __syncthreads();
    if (tid < 256) { float ar = 0.f, ai = 0.f;
#pragma unroll
        for (int i = 0; i < 8; ++i) { const unsigned aw[4] = {wa8[i].x, wa8[i].y, wa8[i].z, wa8[i].w}, xw[4] = {wx8[i].x, wx8[i].y, wx8[i].z, wx8[i].w};
#pragma unroll
            for (int k = 0; k < 4; ++k) { const float xa = sh[n * 64 + 8 * i + 2 * k], xb = sh[n * 64 + 8 * i + 2 * k + 1];
                ar += xa * bflo(aw[k]) + xb * bfhi(aw[k]); ai += xa * bflo(xw[k]) + xb * bfhi(xw[k]); } }
        const float rg = sigm(ar + ba), ig = sigm(ai + bx), la = -8.0f * rg * softplus(-lam);
        const float a = __expf(la), bm = sqrtf(fmaxf(1.0f - __expf(2.0f * la), 0.f)) * (ig * xl);
        const float hn = a * h0 + bm;
        C.out[O_LRUS + (size_t)(l * NSAMP + s) * 256 + e] = hn;
        O[(size_t)row * DM + 512 + e] = (bf16)f2bf(hn * gelu_tanh(yv)); }
    __syncthreads();
}
DI void m2_phase(const Ctx& C0, int l) {
    const int bid = C0.bid;
#ifndef M2_SUB
#define M2_SUB 0xf
#endif
#ifndef M2_DUP
#define M2_DUP 0
#endif
    if (bid < 32) { if (M2_SUB & 1) { for (int rep = 0; rep < ((M2_DUP & 1) ? 2 : 1); ++rep) { const Ctx Cr = fresh(C0); m2_dn2(Cr, l, bid >> 2, bid & 3); __syncthreads(); } } return; }
    if (bid < 64) { if (M2_SUB & 2) { for (int rep = 0; rep < ((M2_DUP & 2) ? 2 : 1); ++rep) { const Ctx Cr = fresh(C0); m2_ret(Cr, l, (bid - 32) >> 2, (bid - 32) & 3); __syncthreads(); } } }
    else if (M2_SUB & 8) { const int nb = C0.G - 64;
        for (int rep = 0; rep < ((M2_DUP & 8) ? 2 : 1); ++rep)
        for (int it = bid - 64; it < NB * NCHUNK + NSAMP * 9; it += nb) { const Ctx C = fresh(C0);
            if (it < NB * NCHUNK) { m2_lru_item(C, l, it / NCHUNK, it % NCHUNK); }
            else { const int s = (it - NB * NCHUNK) / 9, k = (it - NB * NCHUNK) % 9;
                if (k < 4) ms_dn(C, l, s, k); else if (k < 8) ms_ret(C, l, s, k - 4); else ms_lru(C, l, s); } } }
    { const Ctx C = fresh(C0); __syncthreads();
      const int gw = (bid - 32) * NWAVES + C.wave, nw = (C0.G - 32) * NWAVES;
      convert_set(C, l, 1, gw, nw);
      if (l + 1 < 2) convert_set(C, l + 1, 0, gw, nw); }
}
constexpr int N_PHASES = 17;
#ifndef PH_MASK
#define PH_MASK 0x3ff
#endif
#define PH_EN(k) ((PH_MASK >> (k)) & 1)
#ifndef MK_PER_PHASE
#define MK_PER_PHASE 0
#endif
__global__ void __launch_bounds__(NTHREADS, 2) hybrid_fwd(Args args) {
    extern __shared__ __attribute__((aligned(16))) unsigned char lds[];
    Ctx C0;
    C0.out = args.out; C0.ws = args.ws; C0.lds = lds;
    C0.tid = threadIdx.x; C0.lane = C0.tid & 63; C0.wave = __builtin_amdgcn_readfirstlane(C0.tid >> 6); C0.G = gridDim.x; C0.bid = blockIdx.x;
    const int wave0 = C0.wave;
    volatile LAS unsigned* MISC = (volatile LAS unsigned*)((LAS unsigned char*)lds + MISC_OFF);
    if (C0.tid < 64) MISC[C0.tid] = 0u;
    __syncthreads();
    XcdBarrier bar; bar.bar = (unsigned*)(C0.ws + WS_CTL) + CW_BAR; bar.x = 0; bar.st = nullptr;
    const int lo = args.ph_lo, hi = args.ph_hi;
    if (hi - lo > 1) bar = xcd_barrier_post((unsigned*)(C0.ws + WS_CTL) + CW_BAR, MISC + 8);
    LAS unsigned char* ldsl = (LAS unsigned char*)lds;
    if (lo == 0) {
#ifndef AMP_K
#define AMP_K 0
#define AMP_PH 0
#endif
        unsigned long long amp_p0 = 0; if (AMP_K && AMP_PH == 8) amp_p0 = __builtin_amdgcn_s_memrealtime();
        if (PH_EN(9)) { const Ctx C = fresh(C0); p0_rows(C); convert_lru_weights(C); convert_set(C, 0, 0, C.bid * NWAVES + C.wave, C.G * NWAVES); }
        if (AMP_K && AMP_PH == 8) { __syncthreads(); const unsigned long long t1 = __builtin_amdgcn_s_memrealtime(), te = t1 + (unsigned long long)AMP_K * (t1 - amp_p0); while (__builtin_amdgcn_s_memrealtime() < te) __builtin_amdgcn_s_sleep(16); }
        if (1 < hi) { XcdBarrier b2 = bar; asm volatile("" : "+s"(b2.bar), "+s"(b2.x)); int t0 = C0.tid; asm volatile("" : "+v"(t0)); xcd_barrier(b2, t0); }
    }
#define GRID_BAR_IN() do { XcdBarrier b4 = bar; asm volatile("" : "+s"(b4.bar), "+s"(b4.x)); xcd_barrier(b4, C.tid); } while (0)
    for (int ph = (lo == 0 ? 1 : lo); ph < hi; ++ph) {
#ifndef DUP_MASK
#define DUP_MASK 0
#endif
        const int nrep = ((DUP_MASK >> ((ph - 1) % 8)) & 1) ? 2 : 1;
#ifndef AMP_K
#define AMP_K 0
#define AMP_PH 0
#endif
        unsigned long long amp_t0 = 0;
        if (AMP_K && (ph - 1) % 8 == AMP_PH) amp_t0 = __builtin_amdgcn_s_memrealtime();
        for (int rep = 0; rep < nrep; ++rep) {
        Ctx C = C0;
        { int ln = (int)__builtin_amdgcn_mbcnt_hi(~0u, __builtin_amdgcn_mbcnt_lo(~0u, 0u)); int wv = wave0; asm volatile("" : "+v"(ln), "+s"(wv)); C.lane = ln; C.wave = wv; C.tid = wv * 64 + ln; }
        { unsigned long long w = (unsigned long long)C0.ws, o = (unsigned long long)C0.out; asm volatile("" : "+s"(w), "+s"(o));
          C.ws = (unsigned char*)(GAS unsigned char*)w; C.out = (float*)(GAS float*)o; }
        { int bb = C0.bid, gg = C0.G; asm volatile("" : "+s"(bb), "+s"(gg)); C.bid = bb; C.G = gg; }
        unsigned long long* SS = (unsigned long long*)(C.ws + WS_SS);
        bf16* XB = (bf16*)(C.ws + WS_XB); bf16* H = (bf16*)(C.ws + WS_H); bf16* PA = (bf16*)(C.ws + WS_PA); bf16* PB = (bf16*)(C.ws + WS_PB); bf16* O = (bf16*)(C.ws + WS_O);
        float* XE = (float*)(C.ws + WS_XE); unsigned char* wt = C.ws + WS_WT;
            if (rep) { XcdBarrier b3 = bar; asm volatile("" : "+s"(b3.bar), "+s"(b3.x)); xcd_barrier(b3, C.tid); }
            const int l = (ph - 1) / 8, k = (ph - 1) % 8;
            unsigned long long* ss_in1 = SS + (size_t)(3 * l) * NROWS;
            if (k == 0 && PH_EN(0)) {
                pg8::Gemm g{XB, (const bf16*)(wt + WT_F1I), NROWS, 2 * DFF, DM, nullptr, 0}; pg8::StaticOrder S; S.init(NROWS, 2 * DFF, C.G, C.bid);
                pg8::EpiSwiglu E{H, DFF, ss_in1};
                pg8::gemm_phase<pg8::EpiSwiglu, pg8::StaticOrder, true, true>(ldsl, g, S, E, C.tid);
            } else if (k == 1 && PH_EN(1)) {
                pg8::Gemm g{H, (const bf16*)(wt + WT_F1O), NROWS, DM, DFF, nullptr, 0}; pg8::StaticOrder S; S.init(64 * 256, DM, C.G, C.bid);
                pg8::EpiResid E{l == 0 ? inp(I_XP) : nullptr, XB, ss_in1 + NROWS, 0.5f};
                pg8::gemm_phase<pg8::EpiResid, pg8::StaticOrder, true, true>(ldsl, g, S, E, C.tid);
                tail_gemm<DFF>(C, H, (const bf16*)(wt + WT_F1O), E.scale, E.ssn);
            } else if (k == 2 && PH_EN(2)) {
                pg8::Gemm g{XB, (const bf16*)(wt + WT_WIN), NROWS, DIN_PAD, DM, nullptr, 0}; pg8::StaticOrder S; S.init(NROWS, DIN_PAD, C.G, C.bid);
                pg8::EpiProj E{PA, PB, ss_in1 + NROWS, inp(I_DNNW) + l * 128};
                pg8::gemm_phase<pg8::EpiProj, pg8::StaticOrder, true, true>(ldsl, g, S, E, C.tid);
            } else if (k == 3 && PH_EN(3)) { m1_phase(C, l);
            } else if (k == 4 && PH_EN(4)) { m2_phase(C, l);
            } else if (k == 5 && PH_EN(5)) {
                pg8::Gemm g{O, (const bf16*)(wt + WT_WOUT), NROWS, DM, DM, nullptr, 0}; pg8::StaticOrder S; S.init(64 * 256, DM, C.G, C.bid);
                pg8::EpiResid E{nullptr, XB, ss_in1 + 2 * NROWS, 1.0f};
                pg8::gemm_phase<pg8::EpiResid, pg8::StaticOrder, true, true>(ldsl, g, S, E, C.tid);
                tail_gemm<DM>(C, O, (const bf16*)(wt + WT_WOUT), E.scale, E.ssn);
            } else if (k == 6 && PH_EN(6)) {
                pg8::Gemm g{XB, (const bf16*)(wt + WT_F2I), NROWS, 2 * DFF, DM, nullptr, 0}; pg8::StaticOrder S; S.init(NROWS, 2 * DFF, C.G, C.bid);
                pg8::EpiSwiglu E{H, DFF, ss_in1 + 2 * NROWS};
                pg8::gemm_phase<pg8::EpiSwiglu, pg8::StaticOrder, true, true>(ldsl, g, S, E, C.tid);
            } else if (k == 7 && PH_EN(7)) {
                pg8::Gemm g{H, (const bf16*)(wt + WT_F2O), NROWS, DM, DFF, nullptr, 0}; pg8::StaticOrder S; S.init(64 * 256, DM, C.G, C.bid);
                pg8::EpiResid E{nullptr, XB, ss_in1 + 3 * NROWS, 0.5f};
                pg8::gemm_phase<pg8::EpiResid, pg8::StaticOrder, true, true>(ldsl, g, S, E, C.tid);
                tail_gemm<DFF>(C, H, (const bf16*)(wt + WT_F2O), E.scale, E.ssn);
                if (l == 1) { GRID_BAR_IN(); final_fix_norm(C); }
            }
        }
        if (AMP_K && (ph - 1) % 8 == AMP_PH) { __syncthreads(); const unsigned long long t1 = __builtin_amdgcn_s_memrealtime(), te = t1 + (unsigned long long)AMP_K * (t1 - amp_t0); while (__builtin_amdgcn_s_memrealtime() < te) __builtin_amdgcn_s_sleep(16); }
        if (ph + 1 < hi) { XcdBarrier b2 = bar; asm volatile("" : "+s"(b2.bar), "+s"(b2.x)); int ln = (int)__builtin_amdgcn_mbcnt_hi(~0u, __builtin_amdgcn_mbcnt_lo(~0u, 0u)); int wv = wave0; asm volatile("" : "+v"(ln), "+s"(wv)); xcd_barrier(b2, wv * 64 + ln); }
    }
}

extern "C" void kernel_launch(void* const* d_in, const int* in_sizes, int n_in, void* d_out, int out_size, void* d_ws, size_t ws_size, hipStream_t stream) {
    static int grid = 0;
    if (grid == 0) {
        if (n_in != 29 || out_size != (int)O_END || ws_size < WS_END) { fprintf(stderr, "kernel_launch: unexpected shapes: n_in %d out %d ws %zu (need %zu)\n", n_in, out_size, ws_size, (size_t)WS_END); grid = -1; return; }
        int dev = 0, cus = 0, per_cu = 0;
        if (hipGetDevice(&dev) != hipSuccess || hipDeviceGetAttribute(&cus, hipDeviceAttributeMultiprocessorCount, dev) != hipSuccess) { grid = -1; return; }
        if (hipFuncSetAttribute((const void*)hybrid_fwd, hipFuncAttributeMaxDynamicSharedMemorySize, LDS_BYTES) != hipSuccess) { fprintf(stderr, "kernel_launch: hipFuncSetAttribute failed\n"); grid = -1; return; }
        if (hipOccupancyMaxActiveBlocksPerMultiprocessor(&per_cu, (const void*)hybrid_fwd, NTHREADS, LDS_BYTES) != hipSuccess || per_cu < 1) { fprintf(stderr, "kernel_launch: occupancy query says %d blocks per CU\n", per_cu); grid = -1; return; }
        (void)hipGetLastError();
        grid = cus;
        if (grid < 128) { fprintf(stderr, "kernel_launch: %d CUs: too few for this kernel's phase-role split\n", grid); grid = -1; return; }
    }
    if (grid < 0) return;
    if (hipMemsetAsync((char*)d_ws + WS_CTL, 0, CTL_ZERO_BYTES, stream) != hipSuccess) return;
    Args a{};
    for (int i = 0; i < 29; ++i) a.in[i] = (const float*)d_in[i];
    a.out = (float*)d_out; a.ws = (unsigned char*)d_ws;
#if MK_PER_PHASE
    for (int ph = 0; ph < N_PHASES; ++ph) { a.ph_lo = ph; a.ph_hi = ph + 1; hipLaunchKernelGGL(hybrid_fwd, dim3(grid), dim3(NTHREADS), LDS_BYTES, stream, a); }
#else
    a.ph_lo = 0; a.ph_hi = N_PHASES; hipLaunchKernelGGL(hybrid_fwd, dim3(grid), dim3(NTHREADS), LDS_BYTES, stream, a);
#endif
}
```

```cpp
#include <hip/hip_runtime.h>
#include <cstdio>
#include <cstdint>
namespace pg8 {
#define PG8_LAS __attribute__((address_space(3)))
typedef unsigned short bf16_t;
typedef short bf16x8 __attribute__((ext_vector_type(8)));
typedef float f32x4 __attribute__((ext_vector_type(4)));
typedef unsigned u32x4 __attribute__((ext_vector_type(4)));
constexpr int BM = 256, BK = 64, HALF = 128, HTB = HALF * BK * 2  , STAGE_BYTES = 8 * HTB, NXCD = 8, WGM = 8;

__host__ __device__ __forceinline__ int lds_byte(int r, int c) { const int st = (r >> 4) * 2 + (c >> 5), rr = r & 15, cc = c & 31, ob = rr * 64 + cc * 2; return st * 1024 + (ob ^ (((ob >> 9) & 1) << 5)); }
__host__ __device__ __forceinline__ void stage_rc(int b, int& R, int& C) { const int st = b / 1024, sb = b % 1024, swz = sb ^ (((sb >> 9) & 1) << 5); R = (st >> 1) * 16 + swz / 64; C = (st & 1) * 32 + (swz % 64) / 2; }
__host__ __device__ __forceinline__ int perm32(int rho) { const int n = rho >> 4, i = rho & 15; return 8 * (i >> 2) + 4 * n + (i & 3); }

struct Unit { int pm, pn, kt0, nkt, part; };
struct Gemm { const bf16_t* A; const bf16_t* Bt; int M, N, K; float* slab; int nparts; };

struct StaticOrder {
    int nM, nN, nwg, G, c;
    __host__ __device__ void init(int M, int N, int G_, int c_) { nM = M / BM; nN = N / BM; nwg = nM * nN; G = G_; c = c_; }
    __host__ __device__ bool next(int i, Unit& u) const {
        const long L = (long)i * G + c; if (L >= nwg) { u.pm = 0; u.pn = 0; u.kt0 = 0; u.nkt = 0; u.part = -1; return false; }
        int wgid = (int)L; { const int q = nwg / NXCD, r = nwg % NXCD, xcd = wgid % NXCD, off = wgid / NXCD; wgid = (xcd < r ? xcd * (q + 1) : r * (q + 1) + (xcd - r) * q) + off; }
        const int nig = WGM * nN, gid = wgid / nig, fm = gid * WGM, gsz = (nM - fm) < WGM ? (nM - fm) : WGM;
        u.pm = fm + ((wgid % nig) % gsz); u.pn = (wgid % nig) / gsz; u.kt0 = 0; u.nkt = 0; u.part = -1; return true;
    }
    __device__ __forceinline__ void a_ready(const Unit&) const {}
    __device__ __forceinline__ void done(const Unit&) const {}
};

__device__ __forceinline__ unsigned cvt_pk_bf16(float lo, float hi) { unsigned r; asm volatile("v_cvt_pk_bf16_f32 %0, %1, %2" : "=v"(r) : "v"(lo), "v"(hi)); return r; }
struct SplitOrder {
    StaticOrder so; int nparts;
    __host__ __device__ void init(int K, int G_, int c_) { so.init(64 * BM, 1024, G_, c_); nparts = K / BK / 4; }
    __host__ __device__ bool next(int i, Unit& u) const {
        Unit f; const bool full = so.next(i, f);
        const int L = i * so.G + so.c - so.nwg; const bool part = (L >= 0) && (L < 4 * nparts);
        const int q = part ? L / nparts : 0, p = part ? L % nparts : 0;
        Unit r; r.pm = full ? f.pm : 64; r.pn = full ? f.pn : q; r.kt0 = full ? 0 : 4 * p; r.nkt = full ? 0 : 4; r.part = full ? -1 : p;
        u = r; return full || part;
    }
    __device__ __forceinline__ void a_ready(const Unit&) const {}
    __device__ __forceinline__ void done(const Unit&) const {}
};
__device__ __forceinline__ void slab_dump(const f32x4 (&acc)[2][2][4][2], const Unit& u, float* slab, int nparts, int wr, int wc, int fr, int fq) {
    float* base = slab + (size_t)(u.pn * nparts + u.part) * 65536 + (size_t)(wr * 64 + fr) * 256 + wc * 32 + 8 * fq;
#pragma unroll
    for (int ai = 0; ai < 2; ++ai)
#pragma unroll
        for (int m = 0; m < 4; ++m)
#pragma unroll
            for (int bj = 0; bj < 2; ++bj) { float* p = base + (size_t)(ai * HALF + m * 16) * 256 + bj * HALF; *(f32x4*)p = acc[ai][bj][m][0]; *(f32x4*)(p + 4) = acc[ai][bj][m][1]; }
}
typedef unsigned u32x2 __attribute__((ext_vector_type(2)));
__device__ __forceinline__ float fast_sigmoid(float x) { return __builtin_amdgcn_rcpf(1.0f + __expf(-x)); }
__device__ __forceinline__ float fast_silu(float x) { return x * fast_sigmoid(x); }
constexpr int NP_ROWS = 16384;

struct EpiSwiglu {
    static constexpr bool PERM = true, AFTER_DRAIN = false;
    bf16_t* H; int ldh; const unsigned long long* ss;
    __device__ __forceinline__ void operator()(const f32x4 (&acc)[2][2][4][2], const Unit& u, int wr, int wc, int fr, int fq) const {
        const int row0 = u.pm * BM + wr * 64 + fr, col0 = u.pn * 128 + wc * 32 + 8 * fq;
        unsigned long long sv[8];
#pragma unroll
        for (int i = 0; i < 8; ++i) sv[i] = ss[row0 + (i >> 2) * HALF + (i & 3) * 16];
        float rsv[8];
#pragma unroll
        for (int i = 0; i < 8; ++i) rsv[i] = __builtin_amdgcn_rsqf((float)sv[i] * (1.0f / (1024.0f * 1048576.0f)) + 1e-6f);
#pragma unroll
        for (int ai = 0; ai < 2; ++ai)
#pragma unroll
            for (int m = 0; m < 4; ++m) {
                const int row = row0 + ai * HALF + m * 16;
                const float rs = rsv[ai * 4 + m];
                float hv[8];
#pragma unroll
                for (int n = 0; n < 2; ++n)
#pragma unroll
                    for (int e = 0; e < 4; ++e) { const float g = acc[ai][0][m][n][e] * rs, up = acc[ai][1][m][n][e] * rs; hv[4 * n + e] = fast_silu(g) * up; }
                u32x4 w; w.x = cvt_pk_bf16(hv[0], hv[1]); w.y = cvt_pk_bf16(hv[2], hv[3]); w.z = cvt_pk_bf16(hv[4], hv[5]); w.w = cvt_pk_bf16(hv[6], hv[7]);
                *(u32x4*)(H + (size_t)row * ldh + col0) = w;
            }
    }
};
struct EpiProj {
    static constexpr bool PERM = true, AFTER_DRAIN = false;
    bf16_t* PA; bf16_t* PB; const unsigned long long* ss; const float* gw;
    __device__ __forceinline__ void operator()(const f32x4 (&acc)[2][2][4][2], const Unit& u, int wr, int wc, int fr, int fq) const {
        const int row0 = u.pm * BM + wr * 64 + fr;
        bf16_t* base; int ld, colt;
        if (u.pn < 7) { base = PA; ld = 1792; colt = u.pn * 256; } else { base = PB; ld = 2048; colt = (u.pn - 7) * 256; }
        const int col0 = colt + wc * 32 + 8 * fq;
        unsigned long long sv[8];
#pragma unroll
        for (int i = 0; i < 8; ++i) sv[i] = ss[row0 + (i >> 2) * HALF + (i & 3) * 16];
        const bool gate = (u.pn == 7) | (u.pn == 8);
        f32x4 gv[2][2];
#pragma unroll
        for (int bj = 0; bj < 2; ++bj)
#pragma unroll
            for (int n = 0; n < 2; ++n) gv[bj][n] = gate ? *(const f32x4*)(gw + ((col0 + bj * HALF + 4 * n) & 127)) : (f32x4){1.f, 1.f, 1.f, 1.f};
        float rsv[8];
#pragma unroll
        for (int i = 0; i < 8; ++i) rsv[i] = __builtin_amdgcn_rsqf((float)sv[i] * (1.0f / (1024.0f * 1048576.0f)) + 1e-6f);
#pragma unroll
        for (int ai = 0; ai < 2; ++ai)
#pragma unroll
            for (int m = 0; m < 4; ++m) {
                const int row = row0 + ai * HALF + m * 16;
                const float rs = rsv[ai * 4 + m];
                bf16_t* rowp = base + (size_t)row * ld + col0;
#pragma unroll
                for (int bj = 0; bj < 2; ++bj) { f32x4 v0 = acc[ai][bj][m][0] * rs, v1 = acc[ai][bj][m][1] * rs;
                    if (gate) {
#pragma unroll
                        for (int e = 0; e < 4; ++e) { v0[e] = gv[bj][0][e] * fast_silu(v0[e]); v1[e] = gv[bj][1][e] * fast_silu(v1[e]); } }
                    u32x4 w; w.x = cvt_pk_bf16(v0[0], v0[1]); w.y = cvt_pk_bf16(v0[2], v0[3]); w.z = cvt_pk_bf16(v1[0], v1[1]); w.w = cvt_pk_bf16(v1[2], v1[3]);
                    *(u32x4*)(rowp + bj * HALF) = w; }
            }
    }
};
struct EpiResid {
    static constexpr bool PERM = true, AFTER_DRAIN = false;
    const float* xin32; bf16_t* xb; unsigned long long* ssn; float scale;
    __device__ __forceinline__ void operator()(const f32x4 (&acc)[2][2][4][2], const Unit& u, int wr, int wc, int fr, int fq) const {
        const int row0 = u.pm * BM + wr * 64 + fr, col0 = u.pn * BM + wc * 32 + 8 * fq;
        if (xin32) {
#pragma unroll
            for (int ah = 0; ah < 4; ++ah) { const int ai = ah >> 1, mh = (ah & 1) * 2;
                f32x4 xo[2][2][2];
#pragma unroll
                for (int mm = 0; mm < 2; ++mm) { const float* xi = xin32 + (size_t)(row0 + ai * HALF + (mh + mm) * 16) * 1024;
#pragma unroll
                    for (int bj = 0; bj < 2; ++bj) { xo[mm][bj][0] = *(const f32x4*)(xi + col0 + bj * HALF); xo[mm][bj][1] = *(const f32x4*)(xi + col0 + bj * HALF + 4); } }
#pragma unroll
                for (int mm = 0; mm < 2; ++mm) { const int m = mh + mm; const int row = row0 + ai * HALF + m * 16; float sq = 0.f;
#pragma unroll
                    for (int bj = 0; bj < 2; ++bj) sq += put(xo[mm][bj][0] + acc[ai][bj][m][0] * scale, xo[mm][bj][1] + acc[ai][bj][m][1] * scale, row, col0 + bj * HALF);
                    rowsq(sq, row, fr, fq); }
            }
        } else {
#pragma unroll
            for (int ai = 0; ai < 2; ++ai) {
                u32x4 xr[4][2];
#pragma unroll
                for (int m = 0; m < 4; ++m)
#pragma unroll
                    for (int bj = 0; bj < 2; ++bj) xr[m][bj] = *(const u32x4*)(xb + (size_t)(row0 + ai * HALF + m * 16) * 1024 + col0 + bj * HALF);
#pragma unroll
                for (int m = 0; m < 4; ++m) { const int row = row0 + ai * HALF + m * 16; float sq = 0.f;
#pragma unroll
                    for (int bj = 0; bj < 2; ++bj) { const u32x4 r = xr[m][bj];
                        const f32x4 x0 = (f32x4){__builtin_bit_cast(float, r.x << 16), __builtin_bit_cast(float, r.x & 0xffff0000u), __builtin_bit_cast(float, r.y << 16), __builtin_bit_cast(float, r.y & 0xffff0000u)};
                        const f32x4 x1 = (f32x4){__builtin_bit_cast(float, r.z << 16), __builtin_bit_cast(float, r.z & 0xffff0000u), __builtin_bit_cast(float, r.w << 16), __builtin_bit_cast(float, r.w & 0xffff0000u)};
                        sq += put(x0 + acc[ai][bj][m][0] * scale, x1 + acc[ai][bj][m][1] * scale, row, col0 + bj * HALF); }
                    rowsq(sq, row, fr, fq); }
            }
        }
    }
    __device__ __forceinline__ float put(const f32x4 a0, const f32x4 a1, int row, int c) const {
        u32x4 w; w.x = cvt_pk_bf16(a0[0], a0[1]); w.y = cvt_pk_bf16(a0[2], a0[3]); w.z = cvt_pk_bf16(a1[0], a1[1]); w.w = cvt_pk_bf16(a1[2], a1[3]);
        *(u32x4*)(xb + (size_t)row * 1024 + c) = w;
        return (a0[0] * a0[0] + a0[1] * a0[1]) + (a0[2] * a0[2] + a0[3] * a0[3]) + (a1[0] * a1[0] + a1[1] * a1[1]) + (a1[2] * a1[2] + a1[3] * a1[3]);
    }
    __device__ __forceinline__ void rowsq(float sq, int row, int fr, int fq) const {
        sq += __builtin_bit_cast(float, __builtin_amdgcn_ds_bpermute((fr + 16 * (fq ^ 1)) << 2, __builtin_bit_cast(int, sq))); sq += __builtin_bit_cast(float, __builtin_amdgcn_ds_bpermute((fr + 16 * (fq ^ 2)) << 2, __builtin_bit_cast(int, sq)));
        if (fq == 0) atomicAdd(ssn + row, (unsigned long long)(sq * 1048576.0f + 0.5f));
    }
};
template <class Epi, class Sched, bool ALIGN_EPI = false, bool SP2 = false>
__device__ __forceinline__ void gemm_phase(PG8_LAS unsigned char* lds, const Gemm g, const Sched& S, const Epi& E, const int tid_in) {
    int tid_ = tid_in; asm volatile("" : "+v"(tid_));
    const int tid = tid_, wid = __builtin_amdgcn_readfirstlane(tid >> 6), lane = tid & 63, wr = wid >> 2, wc = wid & 3, fr = lane & 15, fq = lane >> 4;
    const int K = g.K, nt = K / BK;
    unsigned voffA[2], voffB[2];
#pragma unroll
    for (int i = 0; i < 2; ++i) { int R, C; stage_rc(tid * 16 + i * 8192, R, C); const int Rb = Epi::PERM ? ((R & ~31) + perm32(R & 31)) : R;
        voffA[i] = (unsigned)(R * K + C) * 2u; voffB[i] = (unsigned)(Rb * K + C) * 2u; }
    const size_t kstep = (size_t)(BK * 2);
    const size_t hstep = (size_t)HALF * K * 2;
    const size_t tstep = 2 * hstep;
    const unsigned ldsw = (unsigned)wid * 1024u;
    const int aoff = lds_byte(wr * 64 + fr, fq * 8), boff = lds_byte(wc * 32 + fr, fq * 8);
#define PG8_SA(b, h) (((b) * 2 + (h)) * HTB)
#define PG8_SB(b, h) ((4 + (b) * 2 + (h)) * HTB)
#define PG8_STAGE(bufoff, gbase, voff) do { _Pragma("unroll") for (int _i = 0; _i < 2; ++_i) \
        __builtin_amdgcn_global_load_lds((const unsigned*)((const char*)(gbase) + (voff)[_i]), (PG8_LAS unsigned*)(lds + (bufoff) + ldsw + _i * 8192), 16, 0, 0); } while (0)
#define PG8_LDA(dst, b, h) do { _Pragma("unroll") for (int m = 0; m < 4; ++m) _Pragma("unroll") for (int k = 0; k < 2; ++k) dst[m][k] = *(const PG8_LAS bf16x8*)(lds + PG8_SA(b, h) + aoff + m * 2048 + k * 1024); } while (0)
#define PG8_LDB(dst, b, h) do { _Pragma("unroll") for (int n = 0; n < 2; ++n) _Pragma("unroll") for (int k = 0; k < 2; ++k) dst[n][k] = *(const PG8_LAS bf16x8*)(lds + PG8_SB(b, h) + boff + n * 2048 + k * 1024); } while (0)
#define PG8_MMA(ai, bj, At, Bt) do { __builtin_amdgcn_s_setprio(1); _Pragma("unroll") for (int m = 0; m < 4; ++m) _Pragma("unroll") for (int n = 0; n < 2; ++n) _Pragma("unroll") for (int k = 0; k < 2; ++k) \
        acc[ai][bj][m][n] = __builtin_amdgcn_mfma_f32_16x16x32_bf16(Bt[n][k], At[m][k], acc[ai][bj][m][n], 0, 0, 0); __builtin_amdgcn_s_setprio(0); } while (0)
#define PG8_WAIT_V(n) asm volatile("s_waitcnt vmcnt(" #n ")" ::: "memory")
#define PG8_WAIT_L(n) asm volatile("s_waitcnt lgkmcnt(" #n ")" ::: "memory")
#define PG8_BAR __builtin_amdgcn_s_barrier()
#define PG8_SCHED __builtin_amdgcn_sched_barrier(0)
    Unit cur, nxt; int ui = 0;
    if (!S.next(0, cur)) return;
    f32x4 acc[2][2][4][2];
#pragma unroll
    for (int a = 0; a < 2; ++a)
#pragma unroll
        for (int b = 0; b < 2; ++b)
#pragma unroll
            for (int m = 0; m < 4; ++m)
#pragma unroll
                for (int n = 0; n < 2; ++n) acc[a][b][m][n] = (f32x4){0.f, 0.f, 0.f, 0.f};
    bf16x8 At[4][2], B0[2][2], B1[2][2];
    int cnt = cur.nkt > 0 ? cur.nkt : nt;
    const char* cA = (const char*)g.A + (size_t)cur.pm * tstep + (size_t)cur.kt0 * kstep; const char* cB = (const char*)g.Bt + (size_t)cur.pn * tstep + (size_t)cur.kt0 * kstep;
    S.a_ready(cur);
    if constexpr (SP2) {
        PG8_STAGE(PG8_SB(0, 0), cB, voffB); PG8_STAGE(PG8_SB(0, 1), cB + hstep, voffB); PG8_STAGE(PG8_SA(0, 0), cA, voffA); PG8_STAGE(PG8_SA(0, 1), cA + hstep, voffA);
        if (wr == 1) PG8_BAR;
        PG8_WAIT_V(2); PG8_BAR;
        PG8_STAGE(PG8_SB(1, 0), cB + kstep, voffB); PG8_STAGE(PG8_SA(1, 0), cA + kstep, voffA); PG8_STAGE(PG8_SB(1, 1), cB + hstep + kstep, voffB);
        PG8_WAIT_V(6); PG8_BAR;
    } else {
        PG8_STAGE(PG8_SB(0, 0), cB, voffB); PG8_STAGE(PG8_SA(0, 0), cA, voffA); PG8_STAGE(PG8_SB(0, 1), cB + hstep, voffB); PG8_STAGE(PG8_SA(0, 1), cA + hstep, voffA);
        if (wr == 1) PG8_BAR;
        PG8_WAIT_V(4); PG8_BAR;
        PG8_STAGE(PG8_SB(1, 0), cB + kstep, voffB); PG8_STAGE(PG8_SA(1, 0), cA + kstep, voffA); PG8_STAGE(PG8_SB(1, 1), cB + hstep + kstep, voffB);
        PG8_WAIT_V(6); PG8_BAR;
    }
    for (;;) {
        const bool has_next = S.next(ui + 1, nxt);
        const char* nA = has_next ? (const char*)g.A + (size_t)nxt.pm * tstep + (size_t)nxt.kt0 * kstep : cA; const char* nB = has_next ? (const char*)g.Bt + (size_t)nxt.pn * tstep + (size_t)nxt.kt0 * kstep : cB;
        for (int t = 0; t < cnt; t += 2) {
            const bool last = (t == cnt - 2);
            const char* a1 = cA + (size_t)(t + 1) * kstep;
            const char* a2 = last ? nA : cA + (size_t)(t + 2) * kstep; const char* b2 = last ? nB : cB + (size_t)(t + 2) * kstep;
            const char* a3 = a2 + kstep; const char* b3 = b2 + kstep;
            if (last && has_next) S.a_ready(nxt);
            if constexpr (SP2) {
            PG8_LDB(B0, 0, 0); PG8_LDB(B1, 0, 1); PG8_SCHED; PG8_LDA(At, 0, 0); PG8_STAGE(PG8_SA(1, 1), a1 + hstep, voffA);
            PG8_WAIT_V(8); PG8_WAIT_L(0); PG8_BAR; PG8_MMA(0, 0, At, B0); PG8_MMA(0, 1, At, B1); PG8_BAR; PG8_SCHED;
            PG8_LDA(At, 0, 1); PG8_STAGE(PG8_SB(0, 0), b2, voffB); PG8_STAGE(PG8_SB(0, 1), b2 + hstep, voffB); PG8_STAGE(PG8_SA(0, 0), a2, voffA);
            PG8_WAIT_V(8); PG8_WAIT_L(0); PG8_BAR; PG8_MMA(1, 0, At, B0); PG8_MMA(1, 1, At, B1); PG8_BAR; PG8_SCHED;
            PG8_LDB(B0, 1, 0); PG8_LDB(B1, 1, 1); PG8_SCHED; PG8_LDA(At, 1, 0); PG8_STAGE(PG8_SA(0, 1), a2 + hstep, voffA);
            PG8_WAIT_V(8); PG8_WAIT_L(0); PG8_BAR; PG8_MMA(0, 0, At, B0); PG8_MMA(0, 1, At, B1); PG8_BAR; PG8_SCHED;
            PG8_LDA(At, 1, 1); PG8_STAGE(PG8_SB(1, 0), b3, voffB); PG8_STAGE(PG8_SB(1, 1), b3 + hstep, voffB); PG8_STAGE(PG8_SA(1, 0), a3, voffA);
            PG8_WAIT_V(8); PG8_WAIT_L(0); PG8_BAR; PG8_MMA(1, 0, At, B0); PG8_MMA(1, 1, At, B1); PG8_BAR; PG8_SCHED;
            } else {
            PG8_LDB(B0, 0, 0); PG8_SCHED; PG8_LDA(At, 0, 0); PG8_STAGE(PG8_SA(1, 1), a1 + hstep, voffA);
            PG8_WAIT_L(8); PG8_BAR; PG8_WAIT_L(0); PG8_MMA(0, 0, At, B0); PG8_BAR; PG8_SCHED;
            PG8_LDB(B1, 0, 1); PG8_STAGE(PG8_SB(0, 0), b2, voffB);
            PG8_BAR; PG8_WAIT_L(0); PG8_MMA(0, 1, At, B1); PG8_BAR;
            PG8_LDA(At, 0, 1); PG8_STAGE(PG8_SA(0, 0), a2, voffA);
            PG8_BAR; PG8_WAIT_L(0); PG8_MMA(1, 0, At, B0); PG8_BAR; PG8_SCHED;
            PG8_STAGE(PG8_SB(0, 1), b2 + hstep, voffB);
            PG8_WAIT_V(6); PG8_BAR; PG8_MMA(1, 1, At, B1); PG8_BAR;
            PG8_LDB(B0, 1, 0); PG8_SCHED; PG8_LDA(At, 1, 0); PG8_STAGE(PG8_SA(0, 1), a2 + hstep, voffA);
            PG8_WAIT_L(8); PG8_BAR; PG8_WAIT_L(0); PG8_MMA(0, 0, At, B0); PG8_BAR; PG8_SCHED;
            PG8_LDB(B1, 1, 1); PG8_STAGE(PG8_SB(1, 0), b3, voffB);
            PG8_BAR; PG8_WAIT_L(0); PG8_MMA(0, 1, At, B1); PG8_BAR;
            PG8_LDA(At, 1, 1); PG8_STAGE(PG8_SA(1, 0), a3, voffA);
            PG8_BAR; PG8_WAIT_L(0); PG8_MMA(1, 0, At, B0); PG8_BAR; PG8_SCHED;
            PG8_STAGE(PG8_SB(1, 1), b3 + hstep, voffB);
            PG8_WAIT_V(6); PG8_BAR; PG8_MMA(1, 1, At, B1); PG8_BAR;
            }
        }
        if constexpr (ALIGN_EPI) { if (wr == 0) PG8_BAR; }
        if constexpr (!Epi::AFTER_DRAIN) { if (cur.part >= 0) slab_dump(acc, cur, g.slab, g.nparts, wr, wc, fr, fq); else E(acc, cur, wr, wc, fr, fq); S.done(cur); }
        if (!has_next) break;
#pragma unroll
        for (int a = 0; a < 2; ++a)
#pragma unroll
            for (int b = 0; b < 2; ++b)
#pragma unroll
                for (int m = 0; m < 4; ++m)
#pragma unroll
                    for (int n = 0; n < 2; ++n) acc[a][b][m][n] = (f32x4){0.f, 0.f, 0.f, 0.f};
        cur = nxt; cA = nA; cB = nB; ++ui; cnt = cur.nkt > 0 ? cur.nkt : nt;
        if constexpr (ALIGN_EPI) { if (wr == 1) PG8_BAR; }
    }
    PG8_WAIT_V(0);
    if constexpr (!ALIGN_EPI) { if (wr == 0) PG8_BAR; }
    PG8_BAR;
    if constexpr (Epi::AFTER_DRAIN) { E.fused(acc, cur, wr, wc, fr, fq, lds, wid, lane); S.done(cur); }
#undef PG8_SA
#undef PG8_SB
#undef PG8_STAGE
#undef PG8_LDA
#undef PG8_LDB
#undef PG8_MMA
#undef PG8_WAIT_V
#undef PG8_WAIT_L
#undef PG8_BAR
#undef PG8_SCHED
}
}

constexpr int DM = 1024, NROWS = 16640, NPROMPT = 16384, NMETAROWS = 128, SROW0 = 16512;
constexpr int DFF = 2816, NCHUNK = 33, NB = 8, NSAMP = 128;
constexpr int PA_LD = 1792, PB_LD = 2048, DIN_PAD = 3840;
constexpr float EPS = 1e-6f;
constexpr size_t MiB = 1u << 20;
constexpr size_t WS_CTL = 0, WS_SS = 1 * MiB, CTL_ZERO_BYTES = 2 * MiB;
constexpr size_t WS_ROPE = 2 * MiB;
constexpr size_t WS_XE = 3 * MiB;
constexpr size_t WS_LWT = 6 * MiB;
constexpr size_t WS_GCA = 4 * MiB, WS_CA = 4 * MiB + 65536, WS_CB = WS_CA + 524288;
constexpr size_t WS_WT = 8 * MiB;
constexpr size_t WT_F1I = 0, WT_F1O = 11534336, WT_WIN = 17301504, WT_WOUT = 25165824, WT_F2I = 27262976, WT_F2O = 38797312, WT_END = 44564480;
constexpr size_t WS_XB = 52 * MiB;
constexpr size_t WS_R = 86 * MiB;
constexpr size_t WS_H = WS_R, WS_PA = WS_R, WS_O = WS_R, WS_PB = 144 * MiB, WS_DNI = 210 * MiB, WS_LA = 285 * MiB, WS_LB = 294 * MiB, WS_END = 303 * MiB;
static_assert(WS_SS + (size_t)7 * NROWS * 8 <= CTL_ZERO_BYTES, "ss arrays inside the memset");
static_assert(WS_WT + WT_END <= WS_XB && WS_XB + (size_t)NROWS * DM * 2 <= WS_R && WS_H + (size_t)NROWS * DFF * 2 <= WS_END, "ws map");
static_assert(WS_PA + (size_t)NROWS * PA_LD * 2 <= WS_PB && WS_PB + (size_t)NROWS * PB_LD * 2 <= WS_DNI, "ws map 2");
constexpr size_t WS_SLAB = WS_DNI;
constexpr int DNI_ITEM = 73728;
constexpr int DNI_W = 0, DNI_QG = 16384, DNI_KDT = 32768, DNI_UVT = 49152, DNI_P = 65536;
static_assert(WS_DNI + (size_t)1056 * DNI_ITEM <= WS_LA && WS_LA + (size_t)NROWS * 256 * 2 <= WS_LB && WS_LB + (size_t)NROWS * 256 * 2 <= WS_END, "ws map 3");
constexpr int CW_BAR = 4096;
constexpr size_t O_YP = 0, O_YS = 16777216, O_DNP = O_YS + 131072, O_DNCP = O_DNP + 1048576, O_LRUP = O_DNCP + 73728, O_LRUCP = O_LRUP + 4096, O_RETP = O_LRUCP + 12288,
                 O_DNS = O_RETP + 262144, O_DNCS = O_DNS + 16777216, O_LRUS = O_DNCS + 1179648, O_LRUCS = O_LRUS + 65536, O_RETS = O_LRUCS + 196608, O_END = O_RETS + 4194304;
constexpr int LDS_BYTES = 155648, MISC_OFF = LDS_BYTES - 256;
constexpr int NWAVES = 8, NTHREADS = 512;

#define GAS __attribute__((address_space(1)))
#define LAS __attribute__((address_space(3)))
typedef unsigned short bf16;
typedef float f32x4 __attribute__((ext_vector_type(4)));
typedef float f32x16 __attribute__((ext_vector_type(16)));
typedef short bf16x8 __attribute__((ext_vector_type(8)));
typedef unsigned u32x4 __attribute__((ext_vector_type(4)));
typedef unsigned u32x2 __attribute__((ext_vector_type(2)));
#define DI __device__ __forceinline__
DI unsigned f2bf(float f) { return (unsigned)__builtin_bit_cast(unsigned short, (__bf16)f); }
typedef __bf16 hwbf16x2 __attribute__((ext_vector_type(2)));
typedef float f32x2 __attribute__((ext_vector_type(2)));
DI unsigned pk2(float lo, float hi) { const f32x2 v = {lo, hi}; return __builtin_bit_cast(unsigned, __builtin_convertvector(v, hwbf16x2)); }
DI float bflo(unsigned w) { return __builtin_bit_cast(float, w << 16); }
DI float bfhi(unsigned w) { return __builtin_bit_cast(float, w & 0xffff0000u); }
DI f32x4 ld4bf(const bf16* p) { const u32x2 v = *(const u32x2*)p; return (f32x4){bflo(v.x), bfhi(v.x), bflo(v.y), bfhi(v.y)}; }
DI float bf1(bf16 b) { return __builtin_bit_cast(float, (unsigned)b << 16); }
DI float sigm(float x) { return __builtin_amdgcn_rcpf(1.0f + __expf(-x)); }
DI float silu(float x) { return x * sigm(x); }
DI float softplus(float x) { return x > 20.f ? x : log1pf(__expf(x)); }
DI float gelu_tanh(float y) { const float u = 0.7978845608028654f * (y + 0.044715f * y * y * y); const float t = 1.0f - 2.0f * __builtin_amdgcn_rcpf(__expf(2.0f * u) + 1.0f); return 0.5f * y * (1.0f + t); }
DI float xshfl(float v, int src) { return __builtin_bit_cast(float, __builtin_amdgcn_ds_bpermute(src << 2, __builtin_bit_cast(int, v))); }
DI float wave_sum(float v, int lane) {
#pragma unroll
    for (int o = 1; o < 64; o <<= 1) v += xshfl(v, lane ^ o);
    return v;
}
#define MFMA32(a, b, c) __builtin_amdgcn_mfma_f32_32x32x16_bf16((a), (b), (c), 0, 0, 0)
DI int crow(int reg, int hh) { return (reg & 3) + 8 * (reg >> 2) + 4 * hh; }

typedef GAS unsigned gu32;
#define RLX_AGENT __ATOMIC_RELAXED, __HIP_MEMORY_SCOPE_AGENT
#define XB_TMO      128
#define XB_XCNT(j)  (256  + 64 * (j))
#define XB_XSUB(j)  (1280 + 64 * (j))
#define XB_XGEN(j)  (2304 + 64 * (j))
#define XB_TOP      3328
#define XB_TOPGEN   3392
#define XCD_BAR_WORDS 3456
#define XB_SPIN_CAP (1u << 18)

__device__ __forceinline__ unsigned xb_ld(unsigned* p)              { return __hip_atomic_load(p, __ATOMIC_RELAXED, __HIP_MEMORY_SCOPE_AGENT); }
__device__ __forceinline__ unsigned xb_add(unsigned* p, unsigned v) { return __hip_atomic_fetch_add(p, v, __ATOMIC_RELAXED, __HIP_MEMORY_SCOPE_AGENT); }
__device__ __forceinline__ unsigned xb_xcc_id() { return (unsigned)__builtin_amdgcn_s_getreg((3 << 11) | 20) & 0xFu; }
#define XB_SPIN(cond, bar) do { unsigned _sp = 0; while (cond) { __builtin_amdgcn_s_sleep(1); \
    if ((++_sp & 255u) == 0u) { if (xb_ld(&(bar)[XB_TMO])) break; if (_sp > XB_SPIN_CAP) { atomicAdd(&(bar)[XB_TMO], 1u); break; } } } } while (0)

struct XcdBarrier {
    unsigned* bar; unsigned x;
    volatile LAS unsigned* st;
};

__device__ __forceinline__ XcdBarrier xcd_barrier_post(unsigned* bar, volatile LAS unsigned* st) {
    XcdBarrier b; b.bar = bar; b.x = xb_xcc_id(); b.st = st;
    if (threadIdx.x == 0) (void)xb_add(&bar[XB_XCNT(b.x)], 1u);
    return b;
}
__device__ __forceinline__ void xcd_barrier_complete(unsigned* bar, unsigned x, unsigned& nloc, unsigned& nx) {
    const unsigned G = gridDim.x * gridDim.y * gridDim.z;
    unsigned sum, cnt, mine, sp = 0u;
    for (;;) {
        sum = 0u; cnt = 0u; mine = 0u;
#pragma unroll
        for (unsigned j = 0; j < 16; ++j) { const unsigned c = xb_ld(&bar[XB_XCNT(j)]); sum += c; cnt += (c > 0u) ? 1u : 0u; mine = (j == x) ? c : mine; }
        if (sum == G) break;
        __builtin_amdgcn_s_sleep(1);
        if ((++sp & 255u) == 0u) { if (xb_ld(&bar[XB_TMO])) break; if (sp > XB_SPIN_CAP) { atomicAdd(&bar[XB_TMO], 1u); break; } }
    }
    nloc = mine > 0u ? mine : 1u; nx = cnt > 0u ? cnt : 1u;
}

__device__ __forceinline__ void xcd_barrier(const XcdBarrier& b, const int tid) {
    asm volatile("s_waitcnt vmcnt(0)" ::: "memory");
    __syncthreads();
    if (tid == 0) {
        unsigned* bar = b.bar;
        __builtin_amdgcn_s_waitcnt(0);
        unsigned nloc = b.st[0], nx = b.st[1];
        if (nloc == 0u) { xcd_barrier_complete(bar, b.x, nloc, nx); b.st[0] = nloc; b.st[1] = nx; }
        const unsigned old = xb_add(&bar[XB_XSUB(b.x)], 1u);
        const unsigned gen = old / nloc;
        if (old + 1u == (gen + 1u) * nloc) {
            __builtin_amdgcn_fence(__ATOMIC_RELEASE, "agent");
            asm volatile("s_waitcnt vmcnt(0)" ::: "memory");
            const unsigned og = xb_add(&bar[XB_TOP], 1u);
            const unsigned tg = og / nx;
            if (og + 1u == (tg + 1u) * nx) xb_add(&bar[XB_TOPGEN], 1u);
            else XB_SPIN(xb_ld(&bar[XB_TOPGEN]) == tg, bar);
            __builtin_amdgcn_fence(__ATOMIC_ACQUIRE, "agent");
            xb_add(&bar[XB_XGEN(b.x)], 1u);
            asm volatile("s_waitcnt vmcnt(0)" ::: "memory");
        } else {
            XB_SPIN(xb_ld(&bar[XB_XGEN(b.x)]) == gen, bar);
            __builtin_amdgcn_fence(__ATOMIC_ACQUIRE, "agent");
            asm volatile("s_waitcnt vmcnt(0)" ::: "memory");
        }
    }
    __syncthreads();
}

struct Args { const float* in[29]; float* out; unsigned char* ws; int ph_lo, ph_hi; };
typedef const float* const __attribute__((address_space(4))) * kargp_t;
DI const float* inp(int i) { kargp_t p = (kargp_t)__builtin_amdgcn_kernarg_segment_ptr(); asm volatile("" : "+s"(p)); return (const float*)(const GAS float*)(unsigned long long)p[i]; }
struct Ctx {
    float* out; unsigned char* ws;
    unsigned char* lds;
    int tid, lane, wave, G, bid;
};
DI Ctx fresh(const Ctx& C0) { Ctx C = C0; int t = C0.tid; asm volatile("" : "+v"(t)); C.tid = t; C.lane = t & 63; C.wave = __builtin_amdgcn_readfirstlane(t >> 6); return C; }
enum { I_XP = 0, I_XS, I_SDN, I_SDNC, I_SLRU, I_SLRUC, I_SRET, I_META, I_NF1, I_WF1I, I_WF1O, I_NMIX, I_WIN, I_DNCW, I_ALOG, I_DTB, I_DNNW, I_LCW, I_LCB, I_LWA, I_LBA, I_LWX, I_LBX, I_LLAM,
       I_WOUT, I_NF2, I_WF2I, I_WF2O, I_NFIN };

template <int MODE> DI int colmap(int n) {
    if (MODE == 0) return n;
    if (MODE == 1) { const int pn = n >> 8, bj = (n >> 7) & 1, j = n & 127; return bj * DFF + 128 * pn + j; }
    return n < 1544 ? n : (n < 1792 ? -1 : n - 248);
}
template <int MODE> DI void convert_item(const float* W, int K, int Nsrc, int Ndst, const float* scale, bf16* WT, float* scr, int item, int lane) {
    const int nblk = Ndst / 32, kb = item / nblk, nb = item % nblk, k0 = 64 * kb, n0 = 32 * nb;
    const int sc = colmap<MODE>(n0 + (lane & 31));
    float wv[32];
#pragma unroll
    for (int i = 0; i < 32; ++i) { const int kk = 2 * i + (lane >> 5); wv[i] = (sc >= 0) ? W[(size_t)(k0 + kk) * Nsrc + sc] : 0.f; }
#pragma unroll
    for (int i = 0; i < 32; ++i) { const int kk = 2 * i + (lane >> 5); float v = wv[i]; if (scale) v *= scale[k0 + kk]; scr[kk * 33 + (lane & 31)] = v; }
    asm volatile("s_waitcnt lgkmcnt(0)" ::: "memory");
    const int c = lane & 7;
#pragma unroll
    for (int j = 0; j < 4; ++j) { const int n = (lane >> 3) + 8 * j; const float* s = scr + (8 * c) * 33 + n;
        u32x4 o; o.x = pk2(s[0 * 33], s[1 * 33]); o.y = pk2(s[2 * 33], s[3 * 33]); o.z = pk2(s[4 * 33], s[5 * 33]); o.w = pk2(s[6 * 33], s[7 * 33]);
        *(u32x4*)(WT + (size_t)(n0 + n) * K + k0 + 8 * c) = o; }
    asm volatile("s_waitcnt lgkmcnt(0)" ::: "memory");
}
DI void convert_set(const Ctx& C, int l, int set, int gw, int nwaves, int lo0 = 0, int hi0 = 16 * 176 + 44 * 32 + 16 * 120) {
    float* scr = (float*)(C.lds + C.wave * 16384);
    constexpr int I1 = 16 * 176, I2 = 44 * 32, I3 = 16 * 120, I4 = 16 * 32;
    unsigned char* wt = C.ws + WS_WT;
    if (set == 0 || set == 2 || set == 3) {
        const int lo_ = (set == 3) ? I1 : lo0, hi_ = (set == 2) ? I1 : hi0;
        for (int it = lo_ + gw; it < hi_; it += nwaves) { int r = it;
            if (r < I1) { convert_item<1>(inp(I_WF1I) + (size_t)l * DM * 2 * DFF, DM, 2 * DFF, 2 * DFF, inp(I_NF1) + l * DM, (bf16*)(wt + WT_F1I), scr, r, C.lane); continue; } r -= I1;
            if (r < I2) { convert_item<0>(inp(I_WF1O) + (size_t)l * DFF * DM, DFF, DM, DM, nullptr, (bf16*)(wt + WT_F1O), scr, r, C.lane); continue; } r -= I2;
            convert_item<2>(inp(I_WIN) + (size_t)l * DM * 3592, DM, 3592, DIN_PAD, inp(I_NMIX) + l * DM, (bf16*)(wt + WT_WIN), scr, r, C.lane); }
    } else {
        for (int it = gw; it < I1 + I2 + I4; it += nwaves) { int r = it;
            if (r < I1) { convert_item<1>(inp(I_WF2I) + (size_t)l * DM * 2 * DFF, DM, 2 * DFF, 2 * DFF, inp(I_NF2) + l * DM, (bf16*)(wt + WT_F2I), scr, r, C.lane); continue; } r -= I1;
            if (r < I2) { convert_item<0>(inp(I_WF2O) + (size_t)l * DFF * DM, DFF, DM, DM, nullptr, (bf16*)(wt + WT_F2O), scr, r, C.lane); continue; } r -= I2;
            convert_item<0>(inp(I_WOUT) + (size_t)l * DM * DM, DM, DM, DM, nullptr, (bf16*)(wt + WT_WOUT), scr, r, C.lane); }
    }
}
DI void convert_lru_weights(const Ctx& C) {
    const int g = C.bid * NTHREADS + C.tid;
    if (g < 2 * 2 * 4 * 64 * 64) { const int l = g >> 15, mat = (g >> 14) & 1, n = (g >> 12) & 3, e = (g >> 6) & 63, d = g & 63;
        const float v = inp(mat ? I_LWX : I_LWA)[(size_t)((l * 4 + n) * 64 + d) * 64 + e]; ((bf16*)(C.ws + WS_LWT))[g] = (bf16)f2bf(v); }
}
DI void sincos_d(double ang, double& s, double& c) {
    const double TWO_PI = 6.283185307179586476925286766559, HALF_PI = 1.5707963267948966192313216916398;
    double n = __builtin_rint(ang / TWO_PI); double r = ang - n * TWO_PI;
    double k = __builtin_rint(r / HALF_PI); double y = r - k * HALF_PI;
    const double y2 = y * y;
    double sp = 1.0 / 1307674368000.0; sp = sp * y2 - 1.0 / 6227020800.0; sp = sp * y2 + 1.0 / 39916800.0; sp = sp * y2 - 1.0 / 362880.0; sp = sp * y2 + 1.0 / 5040.0; sp = sp * y2 - 1.0 / 120.0; sp = sp * y2 + 1.0 / 6.0;
    const double sy = y - y * y2 * sp;
    double cp = 1.0 / 20922789888000.0; cp = cp * y2 - 1.0 / 87178291200.0; cp = cp * y2 + 1.0 / 479001600.0; cp = cp * y2 - 1.0 / 3628800.0; cp = cp * y2 + 1.0 / 40320.0; cp = cp * y2 - 1.0 / 720.0; cp = cp * y2 + 1.0 / 24.0;
    const double cy = 1.0 - 0.5 * y2 + y2 * y2 * cp;
    const int q = ((int)k) & 3;
    s = (q == 0) ? sy : (q == 1) ? cy : (q == 2) ? -sy : -cy;
    c = (q == 0) ? cy : (q == 1) ? -sy : (q == 2) ? -cy : sy;
}
DI const float* p0_row_src(int row) { return row < NPROMPT ? inp(I_XP) + (size_t)row * DM : (row < SROW0 ? inp(I_META) + (size_t)((row - NPROMPT) & 15) * DM : inp(I_XS) + (size_t)(row - SROW0) * DM); }
DI void p0_rows(const Ctx& C) {
    const int gw = C.bid * NWAVES + C.wave, NGW = C.G * NWAVES;
    unsigned long long* ss0 = (unsigned long long*)(C.ws + WS_SS); bf16* XB = (bf16*)(C.ws + WS_XB); float* XE = (float*)(C.ws + WS_XE);
    f32x4 v[4], vn[4];
    if (gw < NROWS) { const float* src = p0_row_src(gw);
#pragma unroll
        for (int j = 0; j < 4; ++j) v[j] = *(const f32x4*)(src + 4 * C.lane + 256 * j); }
    for (int row = gw; row < NROWS; row += NGW) {
        const bool more = row + NGW < NROWS;
        if (more) { const float* src = p0_row_src(row + NGW);
#pragma unroll
            for (int j = 0; j < 4; ++j) vn[j] = *(const f32x4*)(src + 4 * C.lane + 256 * j); }
        float s = 0.f;
#pragma unroll
        for (int j = 0; j < 4; ++j) s += (v[j].x * v[j].x + v[j].y * v[j].y) + (v[j].z * v[j].z + v[j].w * v[j].w);
        s = wave_sum(s, C.lane);
        if (C.lane == 0) ss0[row] = (unsigned long long)(s * 1048576.0f + 0.5f);
#pragma unroll
        for (int j = 0; j < 4; ++j) { u32x2 w; w.x = pk2(v[j].x, v[j].y); w.y = pk2(v[j].z, v[j].w); *(u32x2*)(XB + (size_t)row * DM + 4 * C.lane + 256 * j) = w;
            if (row >= NPROMPT) *(f32x4*)(XE + (size_t)(row - NPROMPT) * DM + 4 * C.lane + 256 * j) = v[j]; }
        if (more) {
#pragma unroll
            for (int j = 0; j < 4; ++j) v[j] = vn[j]; }
    }
    float* rope = (float*)(C.ws + WS_ROPE);
    for (int e = C.bid * NTHREADS + C.tid; e < 2065 * 32; e += C.G * NTHREADS) {
        const int p = e >> 5, i = e & 31; double inv = 1.0; for (int k = 0; k < i; ++k) inv *= 0.7498942093324558;
        const double pos = (p == 2064) ? 16384.0 : (double)p; double s, c; sincos_d(pos * inv, s, c);
        rope[2 * e] = (float)c; rope[2 * e + 1] = (float)s;
    }
}
DI void final_norm(const Ctx& C) {
    const int gw = C.bid * NWAVES + C.wave, NGW = C.G * NWAVES;
    const unsigned long long* ss = (const unsigned long long*)(C.ws + WS_SS) + 6 * NROWS; const float* XE = (const float*)(C.ws + WS_XE); const float* nw = inp(I_NFIN);
    f32x4 w[4];
#pragma unroll
    for (int j = 0; j < 4; ++j) w[j] = *(const f32x4*)(nw + 4 * C.lane + 256 * j);
    for (int it = gw; it < NPROMPT + NSAMP; it += NGW) {
        const int row = it < NPROMPT ? it : SROW0 + (it - NPROMPT);
        const float* src = it < NPROMPT ? C.out + O_YP + (size_t)row * DM : XE + (size_t)(row - NPROMPT) * DM;
        float* dst = it < NPROMPT ? C.out + O_YP + (size_t)row * DM : C.out + O_YS + (size_t)(it - NPROMPT) * DM;
        const float rs = 1.0f / sqrtf((float)ss[row] * (1.0f / (1024.0f * 1048576.0f)) + EPS);
#pragma unroll
        for (int j = 0; j < 4; ++j) { const f32x4 v = *(const f32x4*)(src + 4 * C.lane + 256 * j); *(f32x4*)(dst + 4 * C.lane + 256 * j) = v * rs * w[j]; }
    }
}

template <int K> DI void tail_gemm(const Ctx& C, const bf16* A, const bf16* Wt, float scale, unsigned long long* ssn) {
    constexpr int NCH = K / 64, CBASE = NCH / 8, CREM = NCH % 8;
    const int lane = C.lane, w = C.wave, r = lane & 31, hh = lane >> 5, lrow = lane >> 3, lp = lane & 7;
    const int nch = CBASE + (w < CREM ? 1 : 0), ch0 = w * CBASE + (w < CREM ? w : CREM);
    float* XE = (float*)(C.ws + WS_XE); bf16* XB = (bf16*)(C.ws + WS_XB); float* red = (float*)(C.lds);
    unsigned char* wl = C.lds + w * 18432;
    for (int blk = C.bid; blk < 256; blk += C.G) {
        const int rg = blk >> 5, cg = blk & 31;
        const int orow = 32 * rg + (C.tid >> 4), ocol = 32 * cg + 2 * (C.tid & 15);
        const f32x2 xin = *(const f32x2*)(XE + (size_t)orow * DM + ocol);
        const bf16* ag = A + (size_t)(NPROMPT + 32 * rg + lrow) * K + 8 * lp;
        const bf16* bg = Wt + (size_t)(32 * cg + lrow) * K + 8 * lp;
        u32x4 ra[4], rb[4], na[4], nb[4];
#define TG_LOAD(RA, RB, ch) do { _Pragma("unroll") for (int i = 0; i < 4; ++i) { RA[i] = *(const u32x4*)(ag + (size_t)(8 * i) * K + 64 * (ch)); RB[i] = *(const u32x4*)(bg + (size_t)(8 * i) * K + 64 * (ch)); } } while (0)
        TG_LOAD(ra, rb, ch0);
        f32x16 acc;
#pragma unroll
        for (int i = 0; i < 16; ++i) acc[i] = 0.f;
        for (int c = 0; c < nch; ++c) {
            const int cn = (c + 1 < nch) ? c + 1 : nch - 1;
            TG_LOAD(na, nb, ch0 + cn);
            unsigned char* buf = wl + (c & 1) * 9216;
#pragma unroll
            for (int i = 0; i < 4; ++i) { *(u32x4*)(buf + (8 * i + lrow) * 144 + 16 * lp) = ra[i]; *(u32x4*)(buf + 4608 + (8 * i + lrow) * 144 + 16 * lp) = rb[i]; }
            asm volatile("s_waitcnt lgkmcnt(0)" ::: "memory");
#pragma unroll
            for (int j = 0; j < 4; ++j) { const bf16x8 a = *(const bf16x8*)(buf + r * 144 + 32 * j + 16 * hh), b = *(const bf16x8*)(buf + 4608 + r * 144 + 32 * j + 16 * hh); acc = MFMA32(a, b, acc); }
            asm volatile("" ::: "memory");
#pragma unroll
            for (int i = 0; i < 4; ++i) { ra[i] = na[i]; rb[i] = nb[i]; }
        }
#undef TG_LOAD
        __syncthreads();
#pragma unroll
        for (int i = 0; i < 16; ++i) red[(w * 32 + crow(i, hh)) * 33 + r] = acc[i];
        __syncthreads();
        const int rr = C.tid >> 4, cc = 2 * (C.tid & 15);
        float s0 = 0.f, s1 = 0.f;
#pragma unroll
        for (int w2 = 0; w2 < 8; ++w2) { s0 += red[(w2 * 32 + rr) * 33 + cc]; s1 += red[(w2 * 32 + rr) * 33 + cc + 1]; }
        const float x0 = xin.x + scale * s0, x1 = xin.y + scale * s1;
        *(f32x2*)(XE + (size_t)orow * DM + ocol) = (f32x2){x0, x1};
        *(unsigned*)(XB + (size_t)(NPROMPT + orow) * DM + ocol) = pk2(x0, x1);
        float sq = x0 * x0 + x1 * x1;
        sq += xshfl(sq, lane ^ 1); sq += xshfl(sq, lane ^ 2); sq += xshfl(sq, lane ^ 4); sq += xshfl(sq, lane ^ 8);
        if ((lane & 15) == 0) atomicAdd(ssn + NPROMPT + orow, (unsigned long long)(sq * 1048576.0f + 0.5f));
        if (blk + C.G < 256) __syncthreads();
    }
}
DI void fix_rows(const Ctx& C, int nparts, float scale, unsigned long long* ssn) {
    const int gw = C.bid * NWAVES + C.wave, NGW = C.G * NWAVES;
    const float* slab = (const float*)(C.ws + WS_SLAB); float* XE = (float*)(C.ws + WS_XE); bf16* XB = (bf16*)(C.ws + WS_XB);
    for (int job = gw; job < 256 * 4; job += NGW) {
        const int r = job >> 2, pn = job & 3;
        const float* sp = slab + (size_t)(pn * nparts) * 65536 + (size_t)r * 256 + 4 * C.lane;
        f32x4 a = (f32x4){0.f, 0.f, 0.f, 0.f};
        for (int p = 0; p < nparts; ++p) a = a + *(const f32x4*)(sp + (size_t)p * 65536);
        float* xp = XE + (size_t)r * DM + 256 * pn + 4 * C.lane;
        const f32x4 x = *(const f32x4*)xp + a * scale;
        *(f32x4*)xp = x;
        u32x2 w; w.x = pk2(x.x, x.y); w.y = pk2(x.z, x.w); *(u32x2*)(XB + (size_t)(NPROMPT + r) * DM + 256 * pn + 4 * C.lane) = w;
        const float sq = wave_sum((x.x * x.x + x.y * x.y) + (x.z * x.z + x.w * x.w), C.lane);
        if (C.lane == 0) atomicAdd(ssn + NPROMPT + r, (unsigned long long)(sq * 1048576.0f + 0.5f));
    }
}

DI void final_fix_norm(const Ctx& C) {
    const int gw = C.bid * NWAVES + C.wave, NGW = C.G * NWAVES;
    const unsigned long long* ss = (const unsigned long long*)(C.ws + WS_SS) + 6 * NROWS; const float* nw = inp(I_NFIN);
    const float* slab = (const float*)(C.ws + WS_SLAB); const float* XE = (const float*)(C.ws + WS_XE); const bf16* XB = (const bf16*)(C.ws + WS_XB);
    f32x4 w[4];
#pragma unroll
    for (int j = 0; j < 4; ++j) w[j] = *(const f32x4*)(nw + 4 * C.lane + 256 * j);
    if (gw < NSAMP) {
        const int it = gw, r = 128 + it;
        const float rs = 1.0f / sqrtf((float)ss[NPROMPT + r] * (1.0f / (1024.0f * 1048576.0f)) + EPS);
#pragma unroll
        for (int pn = 0; pn < 4; ++pn) *(f32x4*)(C.out + O_YS + (size_t)it * DM + 256 * pn + 4 * C.lane) = *(const f32x4*)(XE + (size_t)r * DM + 256 * pn + 4 * C.lane) * rs * w[pn];
    }
    u32x2 v[2][4], vn[2][4]; unsigned long long sv[2], svn[2];
#define FN_LOAD(V, SV, base) do { _Pragma("unroll") for (int q = 0; q < 2; ++q) { const int row_ = (base) + q * NGW; if (row_ < NPROMPT) { SV[q] = ss[row_]; \
        _Pragma("unroll") for (int j = 0; j < 4; ++j) V[q][j] = *(const u32x2*)(XB + (size_t)row_ * DM + 4 * C.lane + 256 * j); } } } while (0)
    FN_LOAD(v, sv, gw);
    for (int row = gw; row < NPROMPT; row += 2 * NGW) {
        if (row + 2 * NGW < NPROMPT) FN_LOAD(vn, svn, row + 2 * NGW);
#pragma unroll
        for (int q = 0; q < 2; ++q) { const int rw = row + q * NGW;
            if (rw < NPROMPT) { const float rs = 1.0f / sqrtf((float)sv[q] * (1.0f / (1024.0f * 1048576.0f)) + EPS);
#pragma unroll
                for (int j = 0; j < 4; ++j) { const f32x4 x = (f32x4){bflo(v[q][j].x), bfhi(v[q][j].x), bflo(v[q][j].y), bfhi(v[q][j].y)}; *(f32x4*)(C.out + O_YP + (size_t)rw * DM + 4 * C.lane + 256 * j) = x * rs * w[j]; } } }
#pragma unroll
        for (int q = 0; q < 2; ++q) { sv[q] = svn[q];
#pragma unroll
            for (int j = 0; j < 4; ++j) v[q][j] = vn[q][j]; }
    }
#undef FN_LOAD
}
DI int chunk_row0(int b, int c) { return c == 0 ? NPROMPT + 16 * b : b * 2048 + 64 * (c - 1); }
DI int halo_row(int b, int c, int back) { return c == 0 ? -1 : (c == 1 ? NPROMPT + 16 * b + 16 - back : b * 2048 + 64 * (c - 1) - back); }

constexpr int N1_R = 0, N1_QB = 52736, N1_KB = 70144, N1_RT = 87552, N1_SM = 124416, N1_CW = 126464, N1_AB = 0, N1_AD = 9216, N1_TD = 14336, N1_WS = 18432;
#define MFMA16(a, b, c) __builtin_amdgcn_mfma_f32_16x16x32_bf16((a), (b), (c), 0, 0, 0)
DI void m1_dn_load(const Ctx& C, int b, int c, int h, u32x4 (&rv)[7]) {
    const bf16* PA = (const bf16*)(C.ws + WS_PA);
    const int L = (c == 0) ? 16 : 64, row0 = chunk_row0(b, c);
#pragma unroll
    for (int k = 0; k < 7; ++k) { const int p = C.tid + 512 * k; rv[k] = (u32x4){0u, 0u, 0u, 0u};
        if (p < 67 * 48) { const int ri = p / 48, pc = p % 48, t = ri - 3; int row = -1;
            if (t < 0) row = halo_row(b, c, -t); else if (t < L) row = row0 + t;
            if (row >= 0) rv[k] = *(const u32x4*)(PA + (size_t)row * PA_LD + (pc >> 4) * 512 + h * 128 + 8 * (pc & 15)); } }
}
DI void m1_dn_item(const Ctx& C, int l, int b, int c, int h, u32x4 (&rv)[7], int nb, int nc, int nh) {
    const int tid = C.tid, lane = C.lane, wid = C.wave;
    bf16* R = (bf16*)(C.lds + N1_R); bf16* QB = (bf16*)(C.lds + N1_QB); bf16* KB = (bf16*)(C.lds + N1_KB); bf16* RT = (bf16*)(C.lds + N1_RT);
    float* sm = (float*)(C.lds + N1_SM); float* CW = (float*)(C.lds + N1_CW);
    bf16* AB = (bf16*)(C.lds + N1_AB); float* AD = (float*)(C.lds + N1_AD); bf16* TD = (bf16*)(C.lds + N1_TD); bf16* WS = (bf16*)(C.lds + N1_WS);
    const bf16* PA = (const bf16*)(C.ws + WS_PA);
    const int L = (c == 0) ? 16 : 64, row0 = chunk_row0(b, c), item = (b * NCHUNK + c) * 4 + h;
    unsigned char* dni = C.ws + WS_DNI + (size_t)item * DNI_ITEM;
    const float* vcw = inp(I_DNCW) + (size_t)l * 4 * 1536 + 2 * 512 + h * 128 + 4 * (tid & 31);
    const f32x4 vw0 = *(const f32x4*)(vcw), vw1 = *(const f32x4*)(vcw + 1536), vw2 = *(const f32x4*)(vcw + 2 * 1536), vw3 = *(const f32x4*)(vcw + 3 * 1536);
    {
      f32x4 cwv = (f32x4){0.f, 0.f, 0.f, 0.f};
      if (tid < 384) { const int tap = tid / 96, q4 = tid % 96; cwv = *(const f32x4*)(inp(I_DNCW) + (size_t)l * 4 * 1536 + tap * 1536 + (q4 >> 5) * 512 + h * 128 + 4 * (q4 & 31)); }
      if (wid == 7) {
          const int t = lane; float g = 0.f, be = 0.f;
          if (t < L) { const bf16* pr = PA + (size_t)(row0 + t) * PA_LD + 1536 + h; const float a = bf1(pr[0]), bb = bf1(pr[4]);
              g = -__expf(inp(I_ALOG)[l * 4 + h]) * softplus(a + inp(I_DTB)[l * 4 + h]); be = sigm(bb); }
          float G = g;
#pragma unroll
          for (int o = 1; o < 64; o <<= 1) { const float v = xshfl(G, (lane - o) & 63); if (lane >= o) G += v; }
          const float GC = xshfl(G, 63);
          sm[t] = G; sm[64 + t] = be; sm[128 + t] = __expf(G); sm[192 + t] = __expf(GC - G);
          if (lane == 0) ((float*)(C.ws + WS_GCA))[item] = __expf(GC);
      }
#pragma unroll
      for (int k = 0; k < 7; ++k) { const int p = tid + 512 * k; if (p < 67 * 48) *(u32x4*)((unsigned char*)R + (p / 48) * 784 + (p % 48) * 16) = rv[k]; }
      if (tid < 384) { const int tap = tid / 96, q4 = tid % 96; *(f32x4*)(CW + tap * 384 + 4 * q4) = cwv; } }
    __syncthreads();
    { const int t = tid >> 3, cg = tid & 7; const bool live = t < L;
#pragma unroll
      for (int part = 0; part < 2; ++part) {
          float y[16];
#pragma unroll
          for (int j = 0; j < 16; ++j) y[j] = 0.f;
          u32x4 x3[2] = {(u32x4){0u, 0u, 0u, 0u}, (u32x4){0u, 0u, 0u, 0u}};
#pragma unroll
          for (int tap = 0; tap < 4; ++tap)
#pragma unroll
              for (int hf = 0; hf < 2; ++hf) { const u32x4 xv = *(const u32x4*)(R + (t + tap) * 392 + part * 128 + 16 * cg + 8 * hf); if (tap == 3) x3[hf] = xv;
                  const f32x4 w0 = *(const f32x4*)(CW + tap * 384 + part * 128 + 16 * cg + 8 * hf), w1 = *(const f32x4*)(CW + tap * 384 + part * 128 + 16 * cg + 8 * hf + 4);
                  y[8 * hf + 0] += w0.x * bflo(xv.x); y[8 * hf + 1] += w0.y * bfhi(xv.x); y[8 * hf + 2] += w0.z * bflo(xv.y); y[8 * hf + 3] += w0.w * bfhi(xv.y);
                  y[8 * hf + 4] += w1.x * bflo(xv.z); y[8 * hf + 5] += w1.y * bfhi(xv.z); y[8 * hf + 6] += w1.z * bflo(xv.w); y[8 * hf + 7] += w1.w * bfhi(xv.w); }
          float ss = 0.f;
#pragma unroll
          for (int j = 0; j < 16; ++j) { y[j] = live ? silu(y[j]) : 0.f; ss += y[j] * y[j]; }
          ss += xshfl(ss, lane ^ 1); ss += xshfl(ss, lane ^ 2); ss += xshfl(ss, lane ^ 4);
          const float sc = __builtin_amdgcn_rsqf(ss + EPS) * (part == 0 ? 0.08838834764831845f : 1.0f);
          bf16* dst = (part == 0 ? QB : KB) + t * 136 + 16 * cg;
          *(u32x4*)(dst) = (u32x4){pk2(y[0] * sc, y[1] * sc), pk2(y[2] * sc, y[3] * sc), pk2(y[4] * sc, y[5] * sc), pk2(y[6] * sc, y[7] * sc)};
          *(u32x4*)(dst + 8) = (u32x4){pk2(y[8] * sc, y[9] * sc), pk2(y[10] * sc, y[11] * sc), pk2(y[12] * sc, y[13] * sc), pk2(y[14] * sc, y[15] * sc)};
          if (part == 0) { const float sq = sc * sm[128 + t]; bf16* qo = (bf16*)(dni + DNI_QG) + t * 128 + 16 * cg;
              *(u32x4*)(qo) = (u32x4){pk2(y[0] * sq, y[1] * sq), pk2(y[2] * sq, y[3] * sq), pk2(y[4] * sq, y[5] * sq), pk2(y[6] * sq, y[7] * sq)};
              *(u32x4*)(qo + 8) = (u32x4){pk2(y[8] * sq, y[9] * sq), pk2(y[10] * sq, y[11] * sq), pk2(y[12] * sq, y[13] * sq), pk2(y[14] * sq, y[15] * sq)}; }
          else if (cg == 0) sm[256 + t] = sc;
          if (c == NCHUNK - 1 && t >= 61) { float* co = C.out + O_DNCP + ((size_t)(l * NB + b) * 3 + (t - 61)) * 1536 + part * 512 + h * 128 + 16 * cg;
#pragma unroll
              for (int hf = 0; hf < 2; ++hf) { *(f32x4*)(co + 8 * hf) = (f32x4){bflo(x3[hf].x), bfhi(x3[hf].x), bflo(x3[hf].y), bfhi(x3[hf].y)}; *(f32x4*)(co + 8 * hf + 4) = (f32x4){bflo(x3[hf].z), bfhi(x3[hf].z), bflo(x3[hf].w), bfhi(x3[hf].w)}; } }
      } }
    __syncthreads();
    { const int cq = tid & 31, tq = tid >> 5, t0 = 4 * tq;
      const bf16* rp = R + 2 * 128 + 4 * cq;
      f32x4 x0 = ld4bf(rp + (t0 + 0) * 392), x1 = ld4bf(rp + (t0 + 1) * 392), x2 = ld4bf(rp + (t0 + 2) * 392);
      f32x4 vv[4], ra[4], kd[4];
#pragma unroll
      for (int u = 0; u < 4; ++u) { const int t = t0 + u; const f32x4 x3 = ld4bf(rp + (t + 3) * 392);
          f32x4 y = vw0 * x0 + vw1 * x1 + vw2 * x2 + vw3 * x3; x0 = x1; x1 = x2; x2 = x3;
          y = (t < L) ? (f32x4){silu(y.x), silu(y.y), silu(y.z), silu(y.w)} : (f32x4){0.f, 0.f, 0.f, 0.f};
          if (c == NCHUNK - 1 && t >= 61) *(f32x4*)(C.out + O_DNCP + ((size_t)(l * NB + b) * 3 + (t - 61)) * 1536 + 1024 + h * 128 + 4 * cq) = x3;
          vv[u] = y * sm[64 + t];
          const f32x4 n = ld4bf(KB + t * 136 + 4 * cq);
          ra[u] = n * (sm[64 + t] * sm[128 + t]); kd[u] = n * sm[192 + t]; }
#pragma unroll
      for (int jj = 0; jj < 4; ++jj) {
          *(u32x2*)(RT + (4 * cq + jj) * 72 + t0) = (u32x2){pk2(vv[0][jj], vv[1][jj]), pk2(vv[2][jj], vv[3][jj])};
          *(u32x2*)(RT + (128 + 4 * cq + jj) * 72 + t0) = (u32x2){pk2(ra[0][jj], ra[1][jj]), pk2(ra[2][jj], ra[3][jj])};
          *(u32x2*)((bf16*)(dni + DNI_KDT) + (4 * cq + jj) * 64 + t0) = (u32x2){pk2(kd[0][jj], kd[1][jj]), pk2(kd[2][jj], kd[3][jj])}; }
    }
    __syncthreads();
    if (nb >= 0) m1_dn_load(C, nb, nc, nh, rv);
    { const int kind = wid >> 2, ti = (wid >> 1) & 1, tj = wid & 1, r = lane & 31, hh = lane >> 5;
      const bf16* Aop = KB + (32 * ti + r) * 136 + 8 * hh; const bf16* Bop = (kind ? QB : KB) + (32 * tj + r) * 136 + 8 * hh;
      f32x16 acc;
#pragma unroll
      for (int i = 0; i < 16; ++i) acc[i] = 0.f;
#pragma unroll
      for (int ks = 0; ks < 8; ++ks) { const bf16x8 a = *(const bf16x8*)(Aop + 16 * ks), bq = *(const bf16x8*)(Bop + 16 * ks); acc = MFMA32(a, bq, acc); }
      const int t = 32 * tj + r; const float Gt = sm[t], bet = sm[64 + t];
#pragma unroll
      for (int g4 = 0; g4 < 4; ++g4) { const int i0 = 32 * ti + 8 * g4 + 4 * hh; float o[4];
          const f32x4 Gi = *(const f32x4*)(sm + i0);
#pragma unroll
          for (int e = 0; e < 4; ++e) { const int i = i0 + e; const float dec = __expf(Gt - Gi[e]); const float v = acc[4 * g4 + e] * dec;
              o[e] = kind ? (t >= i ? v : 0.f) : (t > i ? bet * v : 0.f); }
          if (kind == 0) { const bool diag = (i0 >> 4) == (t >> 4);
              u32x2 w; w.x = diag ? 0u : pk2(-o[0], -o[1]); w.y = diag ? 0u : pk2(-o[2], -o[3]); *(u32x2*)(AB + t * 72 + i0) = w;
              if (diag) *(f32x4*)(AD + ((t >> 4) * 16 + (t & 15)) * 20 + (i0 & 15)) = (f32x4){o[0], o[1], o[2], o[3]}; }
          else { u32x2 w; w.x = pk2(o[0], o[1]); w.y = pk2(o[2], o[3]); *(u32x2*)((bf16*)(dni + DNI_P) + t * 64 + i0) = w; } } }
    __syncthreads();
    if (wid == 0) { const int blk = lane >> 4, j = lane & 15;
        f32x4 ar[16][4];
#pragma unroll
        for (int t = 1; t < 16; ++t)
#pragma unroll
            for (int s4 = 0; s4 < (t + 3) / 4; ++s4) ar[t][s4] = *(const f32x4*)(AD + (blk * 16 + t) * 20 + 4 * s4);
        asm volatile("" : "+v"(ar[1][0]), "+v"(ar[2][0]), "+v"(ar[3][0]), "+v"(ar[4][0]), "+v"(ar[5][0]), "+v"(ar[5][1]), "+v"(ar[6][0]), "+v"(ar[6][1]), "+v"(ar[7][0]), "+v"(ar[7][1]), "+v"(ar[8][0]), "+v"(ar[8][1]));
        asm volatile("" : "+v"(ar[9][0]), "+v"(ar[9][1]), "+v"(ar[9][2]), "+v"(ar[10][0]), "+v"(ar[10][1]), "+v"(ar[10][2]), "+v"(ar[11][0]), "+v"(ar[11][1]), "+v"(ar[11][2]), "+v"(ar[12][0]), "+v"(ar[12][1]), "+v"(ar[12][2]));
        asm volatile("" : "+v"(ar[13][0]), "+v"(ar[13][1]), "+v"(ar[13][2]), "+v"(ar[13][3]), "+v"(ar[14][0]), "+v"(ar[14][1]), "+v"(ar[14][2]), "+v"(ar[14][3]), "+v"(ar[15][0]), "+v"(ar[15][1]), "+v"(ar[15][2]), "+v"(ar[15][3]));
        float x[16];
#pragma unroll
        for (int t = 0; t < 16; ++t) x[t] = (t == j) ? 1.0f : 0.f;
#pragma unroll
        for (int sI = 0; sI < 15; ++sI) { const float xs = x[sI];
#pragma unroll
            for (int t = sI + 1; t < 16; ++t) x[t] -= ar[t][sI >> 2][sI & 3] * xs; }
#pragma unroll
        for (int t = 0; t < 16; ++t) { TD[(blk * 16 + t) * 32 + j] = (bf16)f2bf(x[t] - ((t == j) ? 1.0f : 0.f)); TD[(blk * 16 + t) * 32 + 16 + j] = (bf16)0; } }
    __syncthreads();
    { const int cl = lane & 15, kq = lane >> 4, c0 = 32 * wid;
#pragma unroll
      for (int i = 0; i < 4; ++i) {
          f32x4 acc[2];
#pragma unroll
          for (int nf = 0; nf < 2; ++nf) acc[nf] = ld4bf(RT + (c0 + 16 * nf + cl) * 72 + 16 * i + 4 * kq);
          if (i >= 1) {
#pragma unroll
              for (int ks = 0; ks < (i == 3 ? 2 : 1); ++ks) { const bf16x8 a = *(const bf16x8*)(AB + (16 * i + cl) * 72 + 32 * ks + 8 * kq);
#pragma unroll
                  for (int nf = 0; nf < 2; ++nf) { const bf16x8 bb = *(const bf16x8*)(RT + (c0 + 16 * nf + cl) * 72 + 32 * ks + 8 * kq); acc[nf] = MFMA16(a, bb, acc[nf]); } } }
#pragma unroll
          for (int nf = 0; nf < 2; ++nf) { u32x2 w; w.x = pk2(acc[nf].x, acc[nf].y); w.y = pk2(acc[nf].z, acc[nf].w); *(u32x2*)(RT + (c0 + 16 * nf + cl) * 72 + 16 * i + 4 * kq) = w; }
          asm volatile("" ::: "memory");
          const bf16x8 a2 = *(const bf16x8*)(TD + (i * 16 + cl) * 32 + 8 * kq);
#pragma unroll
          for (int nf = 0; nf < 2; ++nf) { bf16x8 b2 = *(const bf16x8*)(RT + (c0 + 16 * nf + cl) * 72 + 16 * i + 8 * (kq & 1));
              if (kq >= 2) b2 = (bf16x8){0, 0, 0, 0, 0, 0, 0, 0};
              acc[nf] = MFMA16(a2, b2, acc[nf]);
              u32x2 w; w.x = pk2(acc[nf].x, acc[nf].y); w.y = pk2(acc[nf].z, acc[nf].w); *(u32x2*)(RT + (c0 + 16 * nf + cl) * 72 + 16 * i + 4 * kq) = w;
              if (wid >= 4) { const int d = c0 - 128 + 16 * nf + cl; bf16* wp = WS + (16 * i + 4 * kq) * 136 + d;
                  wp[0] = (bf16)(w.x & 0xffffu); wp[136] = (bf16)(w.x >> 16); wp[272] = (bf16)(w.y & 0xffffu); wp[408] = (bf16)(w.y >> 16); } }
          asm volatile("" ::: "memory");
      } }
    __syncthreads();
#pragma unroll
    for (int k = 0; k < 2; ++k) { const int p = tid + 512 * k;
        *(u32x4*)(dni + DNI_UVT + 16 * p) = *(const u32x4*)((const unsigned char*)RT + (p >> 3) * 144 + (p & 7) * 16);
        *(u32x4*)(dni + DNI_W + 16 * p) = *(const u32x4*)((const unsigned char*)WS + (p >> 4) * 272 + (p & 15) * 16); }
    __syncthreads();
}

constexpr int L1_XL = 0, L1_WT = 33792, L1_LA = 33792, L1_LB = 70656, L1_XCH = 107520;
DI void m1_lru_item(const Ctx& C, int l, int b, int c) {
    const int tid = C.tid, lane = C.lane, wid = C.wave, r = lane & 31, hh = lane >> 5;
    bf16* XL = (bf16*)(C.lds + L1_XL); bf16* WT = (bf16*)(C.lds + L1_WT); bf16* LA = (bf16*)(C.lds + L1_LA); bf16* LB = (bf16*)(C.lds + L1_LB); float* xch = (float*)(C.lds + L1_XCH);
    const bf16* PB = (const bf16*)(C.ws + WS_PB);
    const int L = (c == 0) ? 16 : 64, row0 = chunk_row0(b, c);
    const int e_g = (wid >> 1) * 64 + 32 * (wid & 1) + r;
    const float ba_g = inp(I_LBA)[l * 256 + e_g], bx_g = inp(I_LBX)[l * 256 + e_g], lam_g = inp(I_LLAM)[l * 256 + e_g];
    {
      u32x4 wv[8];
#pragma unroll
      for (int k = 0; k < 8; ++k) wv[k] = *(const u32x4*)(C.ws + WS_LWT + (size_t)l * 65536 + (size_t)(tid + 512 * k) * 16);
      const int cq = tid & 63, tq = tid >> 6, col = 4 * cq, t0 = 8 * tq;
      const float* cw = inp(I_LCW) + (size_t)l * 4 * 256 + col;
      const f32x4 w0 = *(const f32x4*)(cw), w1 = *(const f32x4*)(cw + 256), w2 = *(const f32x4*)(cw + 512), w3 = *(const f32x4*)(cw + 768), bias = *(const f32x4*)(inp(I_LCB) + l * 256 + col);
      f32x4 x0 = (f32x4){0.f, 0.f, 0.f, 0.f}, x1 = x0, x2 = x0;
      if (t0 < L) {
          if (t0 == 0) { const int r3 = halo_row(b, c, 3); if (r3 >= 0) { x0 = ld4bf(PB + (size_t)r3 * PB_LD + 512 + col); x1 = ld4bf(PB + (size_t)(r3 + 1) * PB_LD + 512 + col); x2 = ld4bf(PB + (size_t)(r3 + 2) * PB_LD + 512 + col); } }
          else { x0 = ld4bf(PB + (size_t)(row0 + t0 - 3) * PB_LD + 512 + col); x1 = ld4bf(PB + (size_t)(row0 + t0 - 2) * PB_LD + 512 + col); x2 = ld4bf(PB + (size_t)(row0 + t0 - 1) * PB_LD + 512 + col); }
      }
#pragma unroll
      for (int i = 0; i < 8; ++i) { const int t = t0 + i; f32x4 y = (f32x4){0.f, 0.f, 0.f, 0.f};
          if (t < L) { const f32x4 x3 = ld4bf(PB + (size_t)(row0 + t) * PB_LD + 512 + col); y = w0 * x0 + w1 * x1 + w2 * x2 + w3 * x3 + bias;
              if (c == NCHUNK - 1 && t >= 61) *(f32x4*)(C.out + O_LRUCP + ((size_t)(l * NB + b) * 3 + (t - 61)) * 256 + col) = x3;
              x0 = x1; x1 = x2; x2 = x3; }
          u32x2 w; w.x = pk2(y.x, y.y); w.y = pk2(y.z, y.w); *(u32x2*)(XL + t * 264 + col) = w; }
#pragma unroll
      for (int k = 0; k < 8; ++k) { const int p = tid + 512 * k; *(u32x4*)((unsigned char*)WT + (p >> 3) * 144 + (p & 7) * 16) = wv[k]; } }
    __syncthreads();
    const int n = wid >> 1, eh = wid & 1, e = n * 64 + 32 * eh + r;
    f32x16 pa[2], px[2];
#pragma unroll
    for (int th = 0; th < 2; ++th)
#pragma unroll
        for (int i = 0; i < 16; ++i) { pa[th][i] = 0.f; px[th][i] = 0.f; }
#pragma unroll
    for (int ks = 0; ks < 4; ++ks) {
        const bf16x8 ba_ = *(const bf16x8*)(WT + ((0 * 4 + n) * 64 + 32 * eh + r) * 72 + 16 * ks + 8 * hh), bx_ = *(const bf16x8*)(WT + ((1 * 4 + n) * 64 + 32 * eh + r) * 72 + 16 * ks + 8 * hh);
#pragma unroll
        for (int th = 0; th < 2; ++th) { const bf16x8 a = *(const bf16x8*)(XL + (32 * th + r) * 264 + n * 64 + 16 * ks + 8 * hh); pa[th] = MFMA32(a, ba_, pa[th]); px[th] = MFMA32(a, bx_, px[th]); } }
    __syncthreads();
    { const float ba = ba_g, bx = bx_g, sp = softplus(-lam_g);
#pragma unroll
      for (int th = 0; th < 2; ++th)
#pragma unroll
          for (int g4 = 0; g4 < 4; ++g4) { float la4[4], bm4[4];
#pragma unroll
              for (int k = 0; k < 4; ++k) { const int t = 32 * th + 8 * g4 + 4 * hh + k; const float xv = bf1(XL[t * 264 + e]);
                  const float rg = sigm(pa[th][4 * g4 + k] + ba), ig = sigm(px[th][4 * g4 + k] + bx), la = -8.0f * rg * sp;
                  la4[k] = (t < L) ? la : 0.f; bm4[k] = (t < L) ? sqrtf(fmaxf(1.0f - __expf(2.0f * la), 0.f)) * (ig * xv) : 0.f; }
              u32x2 w; w.x = pk2(la4[0], la4[1]); w.y = pk2(la4[2], la4[3]); *(u32x2*)(LA + e * 72 + 32 * th + 8 * g4 + 4 * hh) = w;
              w.x = pk2(bm4[0], bm4[1]); w.y = pk2(bm4[2], bm4[3]); *(u32x2*)(LB + e * 72 + 32 * th + 8 * g4 + 4 * hh) = w; } }
    __syncthreads();
    { const int ec = tid & 255, th = tid >> 8; float ar[32], ai[32];
#pragma unroll
      for (int i = 0; i < 4; ++i) { const u32x4 la = *(const u32x4*)(LA + ec * 72 + 32 * th + 8 * i), lb = *(const u32x4*)(LB + ec * 72 + 32 * th + 8 * i);
          const unsigned lw[4] = {la.x, la.y, la.z, la.w}, bw[4] = {lb.x, lb.y, lb.z, lb.w};
#pragma unroll
          for (int k = 0; k < 4; ++k) { ar[8 * i + 2 * k] = __expf(bflo(lw[k])); ar[8 * i + 2 * k + 1] = __expf(bfhi(lw[k])); ai[8 * i + 2 * k] = bflo(bw[k]); ai[8 * i + 2 * k + 1] = bfhi(bw[k]); } }
      { float hl = 0.f, ac = 1.f;
#pragma unroll
        for (int t = 0; t < 32; ++t) { hl = ar[t] * hl + ai[t]; ac *= ar[t]; ai[t] = hl; ar[t] = ac; } }
      if (th == 0) { xch[2 * ec] = ai[31]; xch[2 * ec + 1] = ar[31]; }
      __syncthreads();
      if (th == 1) { const float h0 = xch[2 * ec], a0 = xch[2 * ec + 1];
#pragma unroll
        for (int t = 0; t < 32; ++t) { ai[t] = ar[t] * h0 + ai[t]; ar[t] = ar[t] * a0; }
        ((float*)(C.ws + WS_CA))[(size_t)(b * NCHUNK + c) * 256 + ec] = ar[31]; ((float*)(C.ws + WS_CB))[(size_t)(b * NCHUNK + c) * 256 + ec] = ai[31]; }
      bf16* OA = (bf16*)(C.lds + L1_LA); bf16* OH = OA + 64 * 264;
#pragma unroll
      for (int t = 0; t < 32; ++t) { const int tt = 32 * th + t; OA[tt * 264 + ec] = (bf16)f2bf(ar[t]); OH[tt * 264 + ec] = (bf16)f2bf(ai[t]); } }
    __syncthreads();
    { bf16* AC = (bf16*)(C.ws + WS_LA); bf16* HL = (bf16*)(C.ws + WS_LB); const bf16* OA = (const bf16*)(C.lds + L1_LA); const bf16* OH = OA + 64 * 264;
#pragma unroll
      for (int k = 0; k < 4; ++k) { const int p = tid + 512 * k, row = p >> 5, c16 = p & 31;
          if (row < L) { *(u32x4*)(AC + (size_t)(row0 + row) * 256 + 8 * c16) = *(const u32x4*)(OA + row * 264 + 8 * c16); *(u32x4*)(HL + (size_t)(row0 + row) * 256 + 8 * c16) = *(const u32x4*)(OH + row * 264 + 8 * c16); } } }
    __syncthreads();
}
DI void m1_phase(const Ctx& C0, int l) {
    constexpr int NDN = NB * NCHUNK * 4, NLRU = NB * NCHUNK;
#ifndef M1_SUB
#define M1_SUB 3
#endif
    u32x4 rv[7]; bool have = false;
    for (int it = C0.bid; it < NDN + NLRU; it += C0.G) {
        const Ctx C = fresh(C0);
#ifndef M1_DUP
#define M1_DUP 0
#endif
        if (it < NDN) { const int h = it & 3, bc = it >> 2, itn = it + C0.G; const bool nx = itn < NDN;
            if (!have) m1_dn_load(C, bc / NCHUNK, bc % NCHUNK, h, rv);
            m1_dn_item(C, l, bc / NCHUNK, bc % NCHUNK, h, rv, nx ? (itn >> 2) / NCHUNK : -1, nx ? (itn >> 2) % NCHUNK : 0, nx ? (itn & 3) : 0); have = nx; }
        else if (M1_SUB & 2) { const int bc = it - NDN; for (int rep = 0; rep < ((M1_DUP & 2) ? 2 : 1); ++rep) { const Ctx Cr = fresh(C0); m1_lru_item(Cr, l, bc / NCHUNK, bc % NCHUNK); } }
    }
}
constexpr int M2_WL = 0, M2_QL = 17408, M2_PL = 34816, M2_KL = 44032, M2_UT = 62464, M2_ST = 80896, M2_OS = 115712;
DI void m2_dn(const Ctx& C, int l, int b, int h) {
    const int tid = C.tid, lane = C.lane, wid = C.wave, tm = wid >> 2, tn = wid & 3, r = lane & 31, hh = lane >> 5;
    bf16* WL = (bf16*)(C.lds + M2_WL); bf16* QL = (bf16*)(C.lds + M2_QL); bf16* PL = (bf16*)(C.lds + M2_PL); bf16* KL = (bf16*)(C.lds + M2_KL);
    bf16* UT = (bf16*)(C.lds + M2_UT); bf16* ST = (bf16*)(C.lds + M2_ST); float* OS = (float*)(C.lds + M2_OS);
    const bf16* PB = (const bf16*)(C.ws + WS_PB); bf16* O = (bf16*)(C.ws + WS_O); const float* GCA = (const float*)(C.ws + WS_GCA);
    f32x16 S0, S1;
#pragma unroll
    for (int i = 0; i < 16; ++i) { S0[i] = 0.f; S1[i] = 0.f; }
    for (int i = tid; i < 128 * 136 / 2; i += NTHREADS) ((unsigned*)ST)[i] = 0u;
    u32x4 pre[7];
    const unsigned char* dni0 = C.ws + WS_DNI + (size_t)((b * NCHUNK) * 4 + h) * DNI_ITEM;
#define M2_LOAD(dn) do { \
        pre[0] = *(const u32x4*)((dn) + DNI_W + 16 * tid); pre[1] = *(const u32x4*)((dn) + DNI_W + 16 * (tid + 512)); \
        pre[2] = *(const u32x4*)((dn) + DNI_QG + 16 * tid); pre[3] = *(const u32x4*)((dn) + DNI_QG + 16 * (tid + 512)); \
        pre[4] = *(const u32x4*)((dn) + DNI_P + 16 * tid); \
        pre[5] = *(const u32x4*)((dn) + DNI_KDT + 16 * tid); pre[6] = *(const u32x4*)((dn) + DNI_KDT + 16 * (tid + 512)); } while (0)
#define M2_STORE_A() do { \
        { const int p = tid; *(u32x4*)((unsigned char*)WL + (p >> 4) * 272 + (p & 15) * 16) = pre[0]; *(u32x4*)((unsigned char*)QL + (p >> 4) * 272 + (p & 15) * 16) = pre[2]; } \
        { const int p = tid + 512; *(u32x4*)((unsigned char*)WL + (p >> 4) * 272 + (p & 15) * 16) = pre[1]; *(u32x4*)((unsigned char*)QL + (p >> 4) * 272 + (p & 15) * 16) = pre[3]; } } while (0)
#define M2_STORE_B() do { \
        { const int p = tid; *(u32x4*)((unsigned char*)PL + (p >> 3) * 144 + (p & 7) * 16) = pre[4]; *(u32x4*)((unsigned char*)KL + (p >> 3) * 144 + (p & 7) * 16) = pre[5]; } \
        { const int p = tid + 512; *(u32x4*)((unsigned char*)KL + (p >> 3) * 144 + (p & 7) * 16) = pre[6]; } } while (0)
#define M2_STORE() do { M2_STORE_A(); M2_STORE_B(); } while (0)
    M2_LOAD(dni0);
    M2_STORE();
    const int nt_ = tid >> 3, nsg = tid & 7;
    u32x2 uv[4], uvn[4]; u32x4 zz[2], zzn[2]; float egc, egcn;
#define M2_LOAD2(cc, UV, ZZ, EG) do { const unsigned char* dn_ = C.ws + WS_DNI + (size_t)((b * NCHUNK + (cc)) * 4 + h) * DNI_ITEM; \
        const bf16* uvt_ = (const bf16*)(dn_ + DNI_UVT) + (32 * tn + r) * 64 + 32 * tm + 4 * hh; \
        _Pragma("unroll") for (int g4 = 0; g4 < 4; ++g4) UV[g4] = *(const u32x2*)(uvt_ + 8 * g4); \
        EG = GCA[(b * NCHUNK + (cc)) * 4 + h]; \
        const int vr_ = ((cc) > 0 || nt_ < 16) ? chunk_row0(b, (cc)) + nt_ : chunk_row0(b, (cc)); \
        const bf16* zp_ = PB + (size_t)vr_ * PB_LD + h * 128 + 16 * nsg; ZZ[0] = *(const u32x4*)(zp_); ZZ[1] = *(const u32x4*)(zp_ + 8); } while (0)
    M2_LOAD2(0, uv, zz, egc);
    asm volatile("" :: "v"(uv[0]), "v"(uv[1]), "v"(uv[2]), "v"(uv[3]), "v"(zz[0]), "v"(zz[1]), "v"(egc));
    __syncthreads();
    u32x4 zzp[2] = {zz[0], zz[1]};
#define M2_NORM(cc) do { const int t = tid >> 3, sg = tid & 7; f32x4 v[4]; float s = 0.f; \
        _Pragma("unroll") for (int i = 0; i < 4; ++i) { v[i] = *(const f32x4*)(OS + t * 132 + 16 * sg + 4 * i); s += (v[i].x * v[i].x + v[i].y * v[i].y) + (v[i].z * v[i].z + v[i].w * v[i].w); } \
        s += xshfl(s, lane ^ 1); s += xshfl(s, lane ^ 2); s += xshfl(s, lane ^ 4); \
        const float rs = __builtin_amdgcn_rsqf(s * (1.0f / 128.0f) + EPS); \
        if ((cc) > 0 || t < 16) { const int row = chunk_row0(b, (cc)) + t; unsigned w[8]; \
            const unsigned zw[8] = {zzp[0].x, zzp[0].y, zzp[0].z, zzp[0].w, zzp[1].x, zzp[1].y, zzp[1].z, zzp[1].w}; \
            _Pragma("unroll") for (int i = 0; i < 4; ++i) { const f32x4 z = (f32x4){bflo(zw[2 * i]), bfhi(zw[2 * i]), bflo(zw[2 * i + 1]), bfhi(zw[2 * i + 1])};     \
                w[2 * i] = pk2(v[i].x * rs * z.x, v[i].y * rs * z.y); w[2 * i + 1] = pk2(v[i].z * rs * z.z, v[i].w * rs * z.w); } \
            bf16* op = O + (size_t)row * DM + h * 128 + 16 * sg; \
            *(u32x4*)(op) = (u32x4){w[0], w[1], w[2], w[3]}; *(u32x4*)(op + 8) = (u32x4){w[4], w[5], w[6], w[7]}; } } while (0)
    for (int c = 0; c < NCHUNK; ++c) {
        const int item = (b * NCHUNK + c) * 4 + h;
        const unsigned char* dni = C.ws + WS_DNI + (size_t)item * DNI_ITEM;
        if (c + 1 < NCHUNK) { M2_LOAD(dni + 4 * DNI_ITEM); M2_LOAD2(c + 1, uvn, zzn, egcn); }
        f32x16 ws, qs;
#pragma unroll
        for (int i = 0; i < 16; ++i) { ws[i] = 0.f; qs[i] = 0.f; }
#pragma unroll
        for (int ks = 0; ks < 4; ++ks) {
            const bf16x8 bfr = *(const bf16x8*)(ST + (32 * tn + r) * 136 + 16 * ks + 8 * hh);
            const bf16x8 aw = *(const bf16x8*)(WL + (32 * tm + r) * 136 + 16 * ks + 8 * hh), aq = *(const bf16x8*)(QL + (32 * tm + r) * 136 + 16 * ks + 8 * hh);
            ws = MFMA32(aw, bfr, ws); qs = MFMA32(aq, bfr, qs); }
        if (c > 0) M2_NORM(c - 1);
#pragma unroll
        for (int ks = 4; ks < 8; ++ks) {
            const bf16x8 bfr = *(const bf16x8*)(ST + (32 * tn + r) * 136 + 16 * ks + 8 * hh);
            const bf16x8 aw = *(const bf16x8*)(WL + (32 * tm + r) * 136 + 16 * ks + 8 * hh), aq = *(const bf16x8*)(QL + (32 * tm + r) * 136 + 16 * ks + 8 * hh);
            ws = MFMA32(aw, bfr, ws); qs = MFMA32(aq, bfr, qs); }
        {
#pragma unroll
          for (int g4 = 0; g4 < 4; ++g4) { const f32x4 uf = (f32x4){bflo(uv[g4].x), bfhi(uv[g4].x), bflo(uv[g4].y), bfhi(uv[g4].y)};
              u32x2 w; w.x = pk2(uf.x - ws[4 * g4], uf.y - ws[4 * g4 + 1]); w.y = pk2(uf.z - ws[4 * g4 + 2], uf.w - ws[4 * g4 + 3]);
              *(u32x2*)(UT + (32 * tn + r) * 72 + 32 * tm + 8 * g4 + 4 * hh) = w; } }
        __syncthreads();
        if (c + 1 < NCHUNK) M2_STORE_A();
        { S0 = S0 * egc; S1 = S1 * egc;
#pragma unroll
          for (int ks = 0; ks < 4; ++ks) {
              const bf16x8 bfr = *(const bf16x8*)(UT + (32 * tn + r) * 72 + 16 * ks + 8 * hh);
              const bf16x8 ap = *(const bf16x8*)(PL + (32 * tm + r) * 72 + 16 * ks + 8 * hh);
              const bf16x8 a0 = *(const bf16x8*)(KL + (64 * tm + r) * 72 + 16 * ks + 8 * hh), a1 = *(const bf16x8*)(KL + (64 * tm + 32 + r) * 72 + 16 * ks + 8 * hh);
              qs = MFMA32(ap, bfr, qs); S0 = MFMA32(a0, bfr, S0); S1 = MFMA32(a1, bfr, S1); } }
        __syncthreads();
#pragma unroll
        for (int g4 = 0; g4 < 4; ++g4) {
            u32x2 w; w.x = pk2(S0[4 * g4], S0[4 * g4 + 1]); w.y = pk2(S0[4 * g4 + 2], S0[4 * g4 + 3]); *(u32x2*)(ST + (32 * tn + r) * 136 + 64 * tm + 8 * g4 + 4 * hh) = w;
            w.x = pk2(S1[4 * g4], S1[4 * g4 + 1]); w.y = pk2(S1[4 * g4 + 2], S1[4 * g4 + 3]); *(u32x2*)(ST + (32 * tn + r) * 136 + 64 * tm + 32 + 8 * g4 + 4 * hh) = w; }
#pragma unroll
        for (int i = 0; i < 16; ++i) OS[(32 * tm + crow(i, hh)) * 132 + 32 * tn + r] = qs[i];
        zzp[0] = zz[0]; zzp[1] = zz[1];
        if (c + 1 < NCHUNK) { M2_STORE_B();
#pragma unroll
            for (int g4 = 0; g4 < 4; ++g4) uv[g4] = uvn[g4];
            zz[0] = zzn[0]; zz[1] = zzn[1]; egc = egcn; }
        __syncthreads();
    }
    M2_NORM(NCHUNK - 1);
#undef M2_NORM
#undef M2_LOAD
#undef M2_LOAD2
#undef M2_STORE
#undef M2_STORE_A
#undef M2_STORE_B
    { float* so = C.out + O_DNP + ((size_t)((l * NB + b) * 4 + h)) * 16384;
#pragma unroll
      for (int i = 0; i < 16; ++i) { so[(size_t)(64 * tm + crow(i, hh)) * 128 + 32 * tn + r] = S0[i]; so[(size_t)(64 * tm + 32 + crow(i, hh)) * 128 + 32 * tn + r] = S1[i]; } }
}

constexpr int M2_EG = 149504;
DI void m2_dn2(const Ctx& C, int l, int b, int h) {
    const int tid = C.tid, lane = C.lane, wid = C.wave, r = lane & 31, hh = lane >> 5;
    bf16* WL = (bf16*)(C.lds + M2_WL); bf16* QL = (bf16*)(C.lds + M2_QL); bf16* PL = (bf16*)(C.lds + M2_PL); bf16* KL = (bf16*)(C.lds + M2_KL);
    bf16* UT = (bf16*)(C.lds + M2_UT); bf16* ST = (bf16*)(C.lds + M2_ST); float* OS = (float*)(C.lds + M2_OS); float* EGS = (float*)(C.lds + M2_EG);
    const bf16* PB = (const bf16*)(C.ws + WS_PB); bf16* O = (bf16*)(C.ws + WS_O); const float* GCA = (const float*)(C.ws + WS_GCA);
    for (int i = tid; i < 128 * 136 / 2; i += NTHREADS) ((unsigned*)ST)[i] = 0u;
#define D2_BAR() do { asm volatile("s_waitcnt lgkmcnt(0)" ::: "memory"); __builtin_amdgcn_s_barrier(); asm volatile("" ::: "memory"); } while (0)
#define D2_PTR(cc) (C.ws + WS_DNI + (size_t)((b * NCHUNK + (cc)) * 4 + h) * DNI_ITEM)
    if (wid < 4) {
        const int tn = wid;
        f32x16 S_[4];
#pragma unroll
        for (int j = 0; j < 4; ++j)
#pragma unroll
            for (int i = 0; i < 16; ++i) S_[j][i] = 0.f;
        D2_BAR();
        for (int c = 0; c < NCHUNK; ++c) {
            f32x16 ws[2], qs[2];
#pragma unroll
            for (int mq = 0; mq < 2; ++mq)
#pragma unroll
                for (int i = 0; i < 16; ++i) { ws[mq][i] = 0.f; qs[mq][i] = 0.f; }
#pragma unroll
            for (int ks = 0; ks < 8; ++ks) {
                const bf16x8 bfr = *(const bf16x8*)(ST + (32 * tn + r) * 136 + 16 * ks + 8 * hh);
#pragma unroll
                for (int mq = 0; mq < 2; ++mq) { const bf16x8 aw = *(const bf16x8*)(WL + (32 * mq + r) * 136 + 16 * ks + 8 * hh), aq = *(const bf16x8*)(QL + (32 * mq + r) * 136 + 16 * ks + 8 * hh);
                    ws[mq] = MFMA32(aw, bfr, ws[mq]); qs[mq] = MFMA32(aq, bfr, qs[mq]); } }
#pragma unroll
            for (int mq = 0; mq < 2; ++mq)
#pragma unroll
                for (int g4 = 0; g4 < 4; ++g4) { bf16* up = UT + (32 * tn + r) * 72 + 32 * mq + 8 * g4 + 4 * hh; const u32x2 u0 = *(const u32x2*)up;
                    u32x2 w; w.x = pk2(bflo(u0.x) - ws[mq][4 * g4], bfhi(u0.x) - ws[mq][4 * g4 + 1]); w.y = pk2(bflo(u0.y) - ws[mq][4 * g4 + 2], bfhi(u0.y) - ws[mq][4 * g4 + 3]); *(u32x2*)up = w; }
            D2_BAR();
            { const float egc = EGS[0];
#pragma unroll
              for (int j = 0; j < 4; ++j) S_[j] = S_[j] * egc;
              bf16x8 ub[4];
#pragma unroll
              for (int ks = 0; ks < 4; ++ks) ub[ks] = *(const bf16x8*)(UT + (32 * tn + r) * 72 + 16 * ks + 8 * hh);
#pragma unroll
              for (int ks = 0; ks < 4; ++ks)
#pragma unroll
                  for (int mq = 0; mq < 2; ++mq) { const bf16x8 ap = *(const bf16x8*)(PL + (32 * mq + r) * 72 + 16 * ks + 8 * hh); qs[mq] = MFMA32(ap, ub[ks], qs[mq]); }
#pragma unroll
              for (int ks = 0; ks < 4; ++ks)
#pragma unroll
                  for (int j = 0; j < 4; ++j) { const bf16x8 ak = *(const bf16x8*)(KL + (32 * j + r) * 72 + 16 * ks + 8 * hh); S_[j] = MFMA32(ak, ub[ks], S_[j]); }
#pragma unroll
              for (int mq = 0; mq < 2; ++mq)
#pragma unroll
                  for (int i = 0; i < 16; ++i) OS[(32 * mq + crow(i, hh)) * 132 + 32 * tn + r] = qs[mq][i]; }
            D2_BAR();
#pragma unroll
            for (int j = 0; j < 4; ++j)
#pragma unroll
                for (int g4 = 0; g4 < 4; ++g4) { u32x2 w; w.x = pk2(S_[j][4 * g4], S_[j][4 * g4 + 1]); w.y = pk2(S_[j][4 * g4 + 2], S_[j][4 * g4 + 3]); *(u32x2*)(ST + (32 * tn + r) * 136 + 32 * j + 8 * g4 + 4 * hh) = w; }
            D2_BAR();
        }
        float* so = C.out + O_DNP + ((size_t)((l * NB + b) * 4 + h)) * 16384;
#pragma unroll
        for (int j = 0; j < 4; ++j)
#pragma unroll
            for (int i = 0; i < 16; ++i) so[(size_t)(32 * j + crow(i, hh)) * 128 + 32 * tn + r] = S_[j][i];
    } else {
        const int ta = tid & 255, nt = ta >> 2, nq = ta & 3;
        u32x4 wq[8], uvr[4], pk[6], zr[4]; float egr;
#define D2_LD_WQ(dn) do { _Pragma("unroll") for (int k = 0; k < 4; ++k) { wq[k] = *(const u32x4*)((dn) + DNI_W + 16 * (ta + 256 * k)); wq[4 + k] = *(const u32x4*)((dn) + DNI_QG + 16 * (ta + 256 * k)); } } while (0)
#define D2_LD_U(dn) do { _Pragma("unroll") for (int k = 0; k < 4; ++k) uvr[k] = *(const u32x4*)((dn) + DNI_UVT + 16 * (ta + 256 * k)); } while (0)
#define D2_LD_PK(dn) do { pk[0] = *(const u32x4*)((dn) + DNI_P + 16 * ta); pk[1] = *(const u32x4*)((dn) + DNI_P + 16 * (ta + 256)); \
        _Pragma("unroll") for (int k = 0; k < 4; ++k) pk[2 + k] = *(const u32x4*)((dn) + DNI_KDT + 16 * (ta + 256 * k)); } while (0)
#define D2_LD_Z(cc) do { const int vr_ = ((cc) > 0 || nt < 16) ? chunk_row0(b, (cc)) + nt : chunk_row0(b, (cc)); const bf16* zp_ = PB + (size_t)vr_ * PB_LD + h * 128 + 32 * nq; \
        _Pragma("unroll") for (int k = 0; k < 4; ++k) zr[k] = *(const u32x4*)(zp_ + 8 * k); } while (0)
#define D2_ST_WQ() do { _Pragma("unroll") for (int k = 0; k < 4; ++k) { const int p = ta + 256 * k; *(u32x4*)((unsigned char*)WL + (p >> 4) * 272 + (p & 15) * 16) = wq[k]; *(u32x4*)((unsigned char*)QL + (p >> 4) * 272 + (p & 15) * 16) = wq[4 + k]; } } while (0)
#define D2_ST_U() do { _Pragma("unroll") for (int k = 0; k < 4; ++k) { const int p = ta + 256 * k; *(u32x4*)((unsigned char*)UT + (p >> 3) * 144 + (p & 7) * 16) = uvr[k]; } } while (0)
#define D2_ST_PK() do { { const int p = ta; *(u32x4*)((unsigned char*)PL + (p >> 3) * 144 + (p & 7) * 16) = pk[0]; } { const int p = ta + 256; *(u32x4*)((unsigned char*)PL + (p >> 3) * 144 + (p & 7) * 16) = pk[1]; } \
        _Pragma("unroll") for (int k = 0; k < 4; ++k) { const int p = ta + 256 * k; *(u32x4*)((unsigned char*)KL + (p >> 3) * 144 + (p & 7) * 16) = pk[2 + k]; } } while (0)
#define D2_NORM(cc) do { f32x4 v[8]; float s = 0.f; \
        _Pragma("unroll") for (int i = 0; i < 8; ++i) { v[i] = *(const f32x4*)(OS + nt * 132 + 32 * nq + 4 * i); s += (v[i].x * v[i].x + v[i].y * v[i].y) + (v[i].z * v[i].z + v[i].w * v[i].w); } \
        s += xshfl(s, lane ^ 1); s += xshfl(s, lane ^ 2); \
        const float rs = __builtin_amdgcn_rsqf(s * (1.0f / 128.0f) + EPS); \
        if ((cc) > 0 || nt < 16) { const int row = chunk_row0(b, (cc)) + nt; bf16* op = O + (size_t)row * DM + h * 128 + 32 * nq; \
            _Pragma("unroll") for (int k = 0; k < 4; ++k) { const unsigned zw[4] = {zr[k].x, zr[k].y, zr[k].z, zr[k].w}; unsigned w[4]; \
                _Pragma("unroll") for (int e = 0; e < 4; ++e) { const f32x4 vv = v[2 * k + (e >> 1)]; const float a0 = (e & 1) ? vv.z : vv.x, a1 = (e & 1) ? vv.w : vv.y; \
                    w[e] = pk2(a0 * rs * bflo(zw[e]), a1 * rs * bfhi(zw[e])); }     \
                *(u32x4*)(op + 8 * k) = (u32x4){w[0], w[1], w[2], w[3]}; } } } while (0)
        { const unsigned char* d0 = D2_PTR(0); D2_LD_WQ(d0); D2_LD_U(d0); D2_LD_PK(d0); egr = GCA[(b * NCHUNK) * 4 + h];
          D2_ST_WQ(); D2_ST_U(); D2_ST_PK(); if (ta == 0) EGS[0] = egr;
          const unsigned char* d1 = D2_PTR(1); D2_LD_WQ(d1); D2_LD_U(d1); D2_LD_PK(d1); }
        D2_BAR();
        for (int c = 0; c < NCHUNK; ++c) {
            const int cn = (c + 1 < NCHUNK) ? c + 1 : NCHUNK - 1, cn2 = (c + 2 < NCHUNK) ? c + 2 : NCHUNK - 1;
            if (c > 0) D2_NORM(c - 1);
            D2_LD_Z(c);
            egr = GCA[(b * NCHUNK + cn) * 4 + h];
            D2_BAR();
            D2_ST_WQ();
            { const unsigned char* dn = D2_PTR(cn2); D2_LD_WQ(dn); }
            D2_BAR();
            D2_ST_U(); D2_ST_PK();
            { const unsigned char* dn = D2_PTR(cn2); D2_LD_U(dn); D2_LD_PK(dn); }
            if (ta == 0) EGS[0] = egr;
            D2_BAR();
        }
        D2_NORM(NCHUNK - 1);
#undef D2_LD_WQ
#undef D2_LD_U
#undef D2_LD_PK
#undef D2_LD_Z
#undef D2_ST_WQ
#undef D2_ST_U
#undef D2_ST_PK
#undef D2_NORM
    }
#undef D2_PTR
#undef D2_BAR
}

constexpr int R_QL = 0, R_QG = 9216, R_KL = 18432, R_KDT = 27648, R_VT = 36864, R_ST = 46080, R_PL = 55296, R_OS = 64512, R_GL = 81920;
DI void m2_ret(const Ctx& C, int l, int b, int h) {
    const int tid = C.tid, lane = C.lane, wid = C.wave, r = lane & 31, hh = lane >> 5;
    bf16* QL = (bf16*)(C.lds + R_QL); bf16* QG = (bf16*)(C.lds + R_QG); bf16* KL = (bf16*)(C.lds + R_KL); bf16* KDT = (bf16*)(C.lds + R_KDT); bf16* VT = (bf16*)(C.lds + R_VT);
    bf16* ST = (bf16*)(C.lds + R_ST); bf16* PL = (bf16*)(C.lds + R_PL); float* OS = (float*)(C.lds + R_OS); bf16* GL = (bf16*)(C.lds + R_GL);
    const bf16* PB = (const bf16*)(C.ws + WS_PB); bf16* O = (bf16*)(C.ws + WS_O); const float* rope = (const float*)(C.ws + WS_ROPE);
    const float lg = (h == 0) ? -0.0317486983145803f : (h == 1) ? -0.015748356968139168f : (h == 2) ? -0.007843177461025893f : -0.003913899321136329f;
    f32x16 acc;
#pragma unroll
    for (int i = 0; i < 16; ++i) acc[i] = 0.f;
    for (int i = tid; i < 64 * 72 / 2; i += NTHREADS) ((unsigned*)ST)[i] = 0u;
    __syncthreads();
    u32x2 rq1, rq2, rk1, rk2; u32x4 rv, rg; f32x4 rc0, rc1;
    u32x2 nq1, nq2, nk1, nk2; u32x4 nv, ng; f32x4 nc0, nc1;
#define R_LOAD(cc, Q1, Q2, K1, K2, VV, GV, C0_, C1_) do { const int t_ = tid >> 3, j_ = tid & 7; const int L_ = ((cc) == 0) ? 16 : 64; \
        const bf16* pr_ = PB + (size_t)(chunk_row0(b, (cc)) + (t_ < L_ ? t_ : 0)) * PB_LD; \
        Q1 = *(const u32x2*)(pr_ + 1024 + 64 * h + 4 * j_); Q2 = *(const u32x2*)(pr_ + 1024 + 64 * h + 32 + 4 * j_); K1 = *(const u32x2*)(pr_ + 1280 + 64 * h + 4 * j_); K2 = *(const u32x2*)(pr_ + 1280 + 64 * h + 32 + 4 * j_); \
        VV = *(const u32x4*)(pr_ + 1536 + 64 * h + 8 * j_); GV = *(const u32x4*)(pr_ + 1792 + 64 * h + 8 * j_); \
        const float* rp_ = rope + ((size_t)((((cc) == 0) ? 0 : 16 + 64 * ((cc) - 1)) + t_) * 32 + 4 * j_) * 2; C0_ = *(const f32x4*)(rp_); C1_ = *(const f32x4*)(rp_ + 4); } while (0)
    R_LOAD(0, rq1, rq2, rk1, rk2, rv, rg, rc0, rc1);
    asm volatile("" :: "v"(rq1), "v"(rq2), "v"(rk1), "v"(rk2), "v"(rv), "v"(rg), "v"(rc0), "v"(rc1));
    for (int c = 0; c < NCHUNK; ++c) {
        const int L = (c == 0) ? 16 : 64, row0 = chunk_row0(b, c);
        if (c + 1 < NCHUNK) R_LOAD(c + 1, nq1, nq2, nk1, nk2, nv, ng, nc0, nc1);
        { const int t = tid >> 3, j = tid & 7;
          f32x4 q1 = (f32x4){0.f, 0.f, 0.f, 0.f}, q2 = q1, k1 = q1, k2 = q1; u32x4 vv = (u32x4){0u, 0u, 0u, 0u}, gv = vv;
          if (t < L) { q1 = (f32x4){bflo(rq1.x), bfhi(rq1.x), bflo(rq1.y), bfhi(rq1.y)}; q2 = (f32x4){bflo(rq2.x), bfhi(rq2.x), bflo(rq2.y), bfhi(rq2.y)};
              k1 = (f32x4){bflo(rk1.x), bfhi(rk1.x), bflo(rk1.y), bfhi(rk1.y)}; k2 = (f32x4){bflo(rk2.x), bfhi(rk2.x), bflo(rk2.y), bfhi(rk2.y)}; vv = rv; gv = rg; }
          const f32x4 cs0 = rc0, cs1 = rc1;
          const float cc[4] = {cs0.x, cs0.z, cs1.x, cs1.z}, sn[4] = {cs0.y, cs0.w, cs1.y, cs1.w};
          const float dq = __expf(lg * (float)(t + 1)), dk = (t < L) ? 0.125f * __expf(lg * (float)(L - 1 - t)) : 0.f;
          float qa[4], qb[4], ka[4], kb[4];
#pragma unroll
          for (int e = 0; e < 4; ++e) { qa[e] = q1[e] * cc[e] - q2[e] * sn[e]; qb[e] = q1[e] * sn[e] + q2[e] * cc[e]; ka[e] = k1[e] * cc[e] - k2[e] * sn[e]; kb[e] = k1[e] * sn[e] + k2[e] * cc[e]; }
          u32x2 w;
          w.x = pk2(qa[0], qa[1]); w.y = pk2(qa[2], qa[3]); *(u32x2*)(QL + t * 72 + 4 * j) = w; w.x = pk2(qb[0], qb[1]); w.y = pk2(qb[2], qb[3]); *(u32x2*)(QL + t * 72 + 32 + 4 * j) = w;
          w.x = pk2(qa[0] * dq, qa[1] * dq); w.y = pk2(qa[2] * dq, qa[3] * dq); *(u32x2*)(QG + t * 72 + 4 * j) = w; w.x = pk2(qb[0] * dq, qb[1] * dq); w.y = pk2(qb[2] * dq, qb[3] * dq); *(u32x2*)(QG + t * 72 + 32 + 4 * j) = w;
          w.x = pk2(ka[0] * 0.125f, ka[1] * 0.125f); w.y = pk2(ka[2] * 0.125f, ka[3] * 0.125f); *(u32x2*)(KL + t * 72 + 4 * j) = w;
          w.x = pk2(kb[0] * 0.125f, kb[1] * 0.125f); w.y = pk2(kb[2] * 0.125f, kb[3] * 0.125f); *(u32x2*)(KL + t * 72 + 32 + 4 * j) = w;
#pragma unroll
          for (int e = 0; e < 4; ++e) { KDT[(4 * j + e) * 72 + t] = (bf16)f2bf(ka[e] * dk); KDT[(32 + 4 * j + e) * 72 + t] = (bf16)f2bf(kb[e] * dk); }
          const unsigned vw[4] = {vv.x, vv.y, vv.z, vv.w};
#pragma unroll
          for (int e = 0; e < 4; ++e) { VT[(8 * j + 2 * e) * 72 + t] = (bf16)(vw[e] & 0xffffu); VT[(8 * j + 2 * e + 1) * 72 + t] = (bf16)(vw[e] >> 16); }
          *(u32x4*)(GL + t * 72 + 8 * j) = gv; }
        __syncthreads();
        if (wid < 4) { const int ti = wid >> 1, tj = wid & 1; f32x16 p;
#pragma unroll
            for (int i = 0; i < 16; ++i) p[i] = 0.f;
#pragma unroll
            for (int ks = 0; ks < 4; ++ks) { const bf16x8 a = *(const bf16x8*)(KL + (32 * ti + r) * 72 + 16 * ks + 8 * hh), bq = *(const bf16x8*)(QL + (32 * tj + r) * 72 + 16 * ks + 8 * hh); p = MFMA32(a, bq, p); }
            const int t = 32 * tj + r;
#pragma unroll
            for (int g4 = 0; g4 < 4; ++g4) { const int i0 = 32 * ti + 8 * g4 + 4 * hh; float o[4];
#pragma unroll
                for (int e = 0; e < 4; ++e) { const int i = i0 + e; o[e] = (t >= i) ? p[4 * g4 + e] * __expf(lg * (float)(t - i)) : 0.f; }
                u32x2 w; w.x = pk2(o[0], o[1]); w.y = pk2(o[2], o[3]); *(u32x2*)(PL + t * 72 + i0) = w; }
        } else { const int tm = (wid >> 1) & 1, en = wid & 1;
#pragma unroll
            for (int i = 0; i < 16; ++i) acc[i] = 0.f;
#pragma unroll
            for (int ks = 0; ks < 4; ++ks) { const bf16x8 a = *(const bf16x8*)(QG + (32 * tm + r) * 72 + 16 * ks + 8 * hh), bs = *(const bf16x8*)(ST + (32 * en + r) * 72 + 16 * ks + 8 * hh); acc = MFMA32(a, bs, acc); }
        }
        __syncthreads();
        if (wid < 4) { const int dm = wid >> 1, en = wid & 1; acc = acc * __expf(lg * (float)L);
#pragma unroll
            for (int ks = 0; ks < 4; ++ks) { const bf16x8 a = *(const bf16x8*)(KDT + (32 * dm + r) * 72 + 16 * ks + 8 * hh), bv = *(const bf16x8*)(VT + (32 * en + r) * 72 + 16 * ks + 8 * hh); acc = MFMA32(a, bv, acc); }
        } else { const int tm = (wid >> 1) & 1, en = wid & 1;
#pragma unroll
            for (int ks = 0; ks < 4; ++ks) { const bf16x8 a = *(const bf16x8*)(PL + (32 * tm + r) * 72 + 16 * ks + 8 * hh), bv = *(const bf16x8*)(VT + (32 * en + r) * 72 + 16 * ks + 8 * hh); acc = MFMA32(a, bv, acc); }
        }
        __syncthreads();
        if (wid < 4) { const int dm = wid >> 1, en = wid & 1;
#pragma unroll
            for (int g4 = 0; g4 < 4; ++g4) { u32x2 w; w.x = pk2(acc[4 * g4], acc[4 * g4 + 1]); w.y = pk2(acc[4 * g4 + 2], acc[4 * g4 + 3]); *(u32x2*)(ST + (32 * en + r) * 72 + 32 * dm + 8 * g4 + 4 * hh) = w; }
        } else { const int tm = (wid >> 1) & 1, en = wid & 1;
#pragma unroll
            for (int i = 0; i < 16; ++i) OS[(32 * tm + crow(i, hh)) * 68 + 32 * en + r] = acc[i];
        }
        __syncthreads();
        { const int t = tid >> 3, sg = tid & 7; const f32x4 v0 = *(const f32x4*)(OS + t * 68 + 8 * sg), v1 = *(const f32x4*)(OS + t * 68 + 8 * sg + 4);
          float s = (v0.x + v0.y) + (v0.z + v0.w) + (v1.x + v1.y) + (v1.z + v1.w);
          s += xshfl(s, lane ^ 1); s += xshfl(s, lane ^ 2); s += xshfl(s, lane ^ 4);
          const float mu = s * (1.0f / 64.0f);
          const f32x4 d0 = v0 - mu, d1 = v1 - mu; float q = (d0.x * d0.x + d0.y * d0.y) + (d0.z * d0.z + d0.w * d0.w) + (d1.x * d1.x + d1.y * d1.y) + (d1.z * d1.z + d1.w * d1.w);
          q += xshfl(q, lane ^ 1); q += xshfl(q, lane ^ 2); q += xshfl(q, lane ^ 4);
          const float rs = __builtin_amdgcn_rsqf(q * (1.0f / 64.0f) + EPS);
          if (t < L) { const u32x4 gv = *(const u32x4*)(GL + t * 72 + 8 * sg); u32x4 w;
              w.x = pk2(d0.x * rs * silu(bflo(gv.x)), d0.y * rs * silu(bfhi(gv.x))); w.y = pk2(d0.z * rs * silu(bflo(gv.y)), d0.w * rs * silu(bfhi(gv.y)));
              w.z = pk2(d1.x * rs * silu(bflo(gv.z)), d1.y * rs * silu(bfhi(gv.z))); w.w = pk2(d1.z * rs * silu(bflo(gv.w)), d1.w * rs * silu(bfhi(gv.w)));
              *(u32x4*)(O + (size_t)(row0 + t) * DM + 768 + 64 * h + 8 * sg) = w; } }
        if (c + 1 < NCHUNK) { rq1 = nq1; rq2 = nq2; rk1 = nk1; rk2 = nk2; rv = nv; rg = ng; rc0 = nc0; rc1 = nc1; }
        __syncthreads();
    }
#undef R_LOAD
    if (wid < 4) { const int dm = wid >> 1, en = wid & 1; float* so = C.out + O_RETP + ((size_t)((l * NB + b) * 4 + h)) * 4096;
#pragma unroll
        for (int i = 0; i < 16; ++i) so[(size_t)(32 * dm + crow(i, hh)) * 64 + 32 * en + r] = acc[i]; }
}

DI void m2_lru_item(const Ctx& C, int l, int b, int c) {
    const int e = C.tid & 255, th = C.tid >> 8;
    const bf16* AC = (const bf16*)(C.ws + WS_LA); const bf16* HL = (const bf16*)(C.ws + WS_LB); const bf16* PB = (const bf16*)(C.ws + WS_PB); bf16* O = (bf16*)(C.ws + WS_O);
    const float* CA = (const float*)(C.ws + WS_CA) + (size_t)(b * NCHUNK) * 256 + e; const float* CB = (const float*)(C.ws + WS_CB) + (size_t)(b * NCHUNK) * 256 + e;
    float hin = 0.f;
#pragma unroll 8
    for (int cc = 0; cc < c; ++cc) hin = CA[cc * 256] * hin + CB[cc * 256];
    const int L = (c == 0) ? 16 : 64, row0 = chunk_row0(b, c);
#pragma unroll 8
    for (int t = 0; t < 32; ++t) { const int tt = 32 * th + t;
        if (tt < L) { const size_t row = (size_t)(row0 + tt);
            const float hv = bf1(AC[row * 256 + e]) * hin + bf1(HL[row * 256 + e]);
            O[row * DM + 512 + e] = (bf16)f2bf(hv * gelu_tanh(bf1(PB[row * PB_LD + 768 + e]))); } }
    if (c == NCHUNK - 1 && th == 1) C.out[O_LRUP + (size_t)(l * NB + b) * 256 + e] = CA[c * 256] * hin + CB[c * 256];
}
DI void ms_dn(const Ctx& C, int l, int s, int h) {
    const int tid = C.tid, lane = C.lane, wid = C.wave, row = SROW0 + s;
    float* sh = (float*)C.lds; float* scal = sh + 384; float* Ush = sh + 400; float* osh = sh + 528; float* red = sh + 1024;
    const bf16* PA = (const bf16*)(C.ws + WS_PA); const bf16* PB = (const bf16*)(C.ws + WS_PB); bf16* O = (bf16*)(C.ws + WS_O);
    const int e4 = tid & 31, dg = tid >> 5;
    const float* S0p = inp(I_SDN) + ((size_t)((l * NSAMP + s) * 4 + h) * 128) * 128;
    f32x4 sv[8];
#pragma unroll
    for (int i = 0; i < 8; ++i) sv[i] = *(const f32x4*)(S0p + (size_t)(8 * dg + i) * 128 + 4 * e4);
    const int part = tid >> 7, d_ = tid & 127, col = (part < 3 ? part : 0) * 512 + h * 128 + d_;
    const float* buf = inp(I_SDNC) + ((size_t)(l * NSAMP + s) * 3) * 1536 + col; const float* cw = inp(I_DNCW) + (size_t)l * 4 * 1536 + col;
    const float x0 = buf[0], x1 = buf[1536], x2 = buf[3072], x3 = bf1(PA[(size_t)row * PA_LD + col]), c0 = cw[0], c1 = cw[1536], c2 = cw[3072], c3 = cw[4608];
    const float a_ = bf1(PA[(size_t)row * PA_LD + 1536 + h]), b_ = bf1(PA[(size_t)row * PA_LD + 1540 + h]), alog = inp(I_ALOG)[l * 4 + h], dtb = inp(I_DTB)[l * 4 + h];
    const float z0 = bf1(PB[(size_t)row * PB_LD + h * 128 + lane]), z1 = bf1(PB[(size_t)row * PB_LD + h * 128 + 64 + lane]);
    if (tid < 384) { sh[part * 128 + d_] = silu(c0 * x0 + c1 * x1 + c2 * x2 + c3 * x3);
        float* co = C.out + O_DNCS + ((size_t)(l * NSAMP + s) * 3) * 1536 + col; co[0] = x1; co[1536] = x2; co[3072] = x3; }
    __syncthreads();
    if (wid < 2) { const float v0 = sh[wid * 128 + lane], v1 = sh[wid * 128 + 64 + lane]; const float ss = wave_sum(v0 * v0 + v1 * v1, lane);
        const float sc = __builtin_amdgcn_rsqf(ss + EPS) * (wid == 0 ? 0.08838834764831845f : 1.0f); sh[wid * 128 + lane] = v0 * sc; sh[wid * 128 + 64 + lane] = v1 * sc; }
    __syncthreads();
    if (wid == 0) { const float qk = wave_sum(sh[lane] * sh[128 + lane] + sh[64 + lane] * sh[192 + lane], lane);
        if (lane == 0) { const float g = -__expf(alog) * softplus(a_ + dtb); scal[0] = qk; scal[1] = __expf(g); scal[2] = sigm(b_); } }
    f32x4 kS = (f32x4){0.f, 0.f, 0.f, 0.f}, qS = kS;
#pragma unroll
    for (int i = 0; i < 8; ++i) { const int d = 8 * dg + i; kS = kS + sv[i] * sh[128 + d]; qS = qS + sv[i] * sh[d]; }
    *(f32x4*)(red + dg * 256 + 4 * e4) = kS; *(f32x4*)(red + dg * 256 + 128 + 4 * e4) = qS;
    __syncthreads();
    if (tid < 128) { float ks = 0.f, qs = 0.f;
#pragma unroll
        for (int g = 0; g < 16; ++g) { ks += red[g * 256 + tid]; qs += red[g * 256 + 128 + tid]; }
        const float eG = scal[1], U = scal[2] * (sh[256 + tid] - eG * ks); Ush[tid] = U; osh[tid] = eG * qs + scal[0] * U; }
    __syncthreads();
    { const f32x4 U4 = *(const f32x4*)(Ush + 4 * e4); const float eG = scal[1];
      float* So = C.out + O_DNS + ((size_t)((l * NSAMP + s) * 4 + h) * 128) * 128;
#pragma unroll
      for (int i = 0; i < 8; ++i) { const int d = 8 * dg + i; *(f32x4*)(So + (size_t)d * 128 + 4 * e4) = sv[i] * eG + U4 * sh[128 + d]; } }
    if (wid == 0) { const float o0 = osh[lane], o1 = osh[lane + 64]; const float ss = wave_sum(o0 * o0 + o1 * o1, lane); const float rs = __builtin_amdgcn_rsqf(ss * (1.0f / 128.0f) + EPS);
        bf16* op = O + (size_t)row * DM + h * 128;
        op[lane] = (bf16)f2bf(o0 * rs * z0); op[lane + 64] = (bf16)f2bf(o1 * rs * z1); }
    __syncthreads();
}
DI void ms_ret(const Ctx& C, int l, int s, int h) {
    const int tid = C.tid, lane = C.lane, wid = C.wave, row = SROW0 + s;
    float* sh = (float*)C.lds; float* osh = sh + 256; float* red = sh + 1024;
    const bf16* PB = (const bf16*)(C.ws + WS_PB); bf16* O = (bf16*)(C.ws + WS_O); const float* rope = (const float*)(C.ws + WS_ROPE) + (size_t)2064 * 32 * 2;
    const float gam = 1.0f - exp2f(-5.0f - (float)h);
    const bf16* pr = PB + (size_t)row * PB_LD;
    const int e4 = tid & 15, dg = tid >> 4;
    const float* S0p = inp(I_SRET) + ((size_t)((l * NSAMP + s) * 4 + h) * 64) * 64;
    f32x4 sv[2];
#pragma unroll
    for (int i = 0; i < 2; ++i) sv[i] = *(const f32x4*)(S0p + (size_t)(2 * dg + i) * 64 + 4 * e4);
    const int i_ = tid & 31;
    const float q1 = bf1(pr[1024 + 64 * h + i_]), q2 = bf1(pr[1024 + 64 * h + 32 + i_]), k1 = bf1(pr[1280 + 64 * h + i_]), k2 = bf1(pr[1280 + 64 * h + 32 + i_]), cr = rope[2 * i_], sr = rope[2 * i_ + 1];
    const float vv = bf1(pr[1536 + 64 * h + lane]), gg = bf1(pr[1792 + 64 * h + lane]);
    if (tid < 32) { sh[i_] = q1 * cr - q2 * sr; sh[32 + i_] = q1 * sr + q2 * cr; sh[64 + i_] = 0.125f * (k1 * cr - k2 * sr); sh[96 + i_] = 0.125f * (k1 * sr + k2 * cr); }
    else if (tid >= 64 && tid < 128) sh[128 + lane] = vv;
    __syncthreads();
    if (wid == 0) { const float qk = wave_sum(sh[lane] * sh[64 + lane], lane); if (lane == 0) sh[192] = qk; }
    f32x4 qS = (f32x4){0.f, 0.f, 0.f, 0.f};
#pragma unroll
    for (int i = 0; i < 2; ++i) { const int d = 2 * dg + i; qS = qS + sv[i] * sh[d]; }
    *(f32x4*)(red + dg * 64 + 4 * e4) = qS;
    __syncthreads();
    if (tid < 64) { float qs = 0.f;
#pragma unroll
        for (int g = 0; g < 32; ++g) qs += red[g * 64 + tid];
        osh[tid] = gam * qs + sh[192] * sh[128 + tid]; }
    { const f32x4 v4 = *(const f32x4*)(sh + 128 + 4 * e4); float* So = C.out + O_RETS + ((size_t)((l * NSAMP + s) * 4 + h) * 64) * 64;
#pragma unroll
      for (int i = 0; i < 2; ++i) { const int d = 2 * dg + i; *(f32x4*)(So + (size_t)d * 64 + 4 * e4) = sv[i] * gam + v4 * sh[64 + d]; } }
    __syncthreads();
    if (wid == 0) { const float o = osh[lane]; const float mu = wave_sum(o, lane) * (1.0f / 64.0f); const float d = o - mu; const float var = wave_sum(d * d, lane) * (1.0f / 64.0f);
        O[(size_t)row * DM + 768 + 64 * h + lane] = (bf16)f2bf(d * __builtin_amdgcn_rsqf(var + EPS) * silu(gg)); }
    __syncthreads();
}
DI void ms_lru(const Ctx& C, int l, int s) {
    const int tid = C.tid, row = SROW0 + s; float* sh = (float*)C.lds;
    const bf16* PB = (const bf16*)(C.ws + WS_PB); bf16* O = (bf16*)(C.ws + WS_O);
    const int e = tid & 255, n = e >> 6, ee = e & 63;
    u32x4 wa8[8], wx8[8];
    { const unsigned char* wp = C.ws + WS_LWT + (size_t)l * 65536 + (size_t)((n * 64 + ee) * 64) * 2;
#pragma unroll
      for (int i = 0; i < 8; ++i) { wa8[i] = *(const u32x4*)(wp + 16 * i); wx8[i] = *(const u32x4*)(wp + 32768 + 16 * i); } }
    const float* buf = inp(I_SLRUC) + ((size_t)(l * NSAMP + s) * 3) * 256 + e; const float* cw = inp(I_LCW) + (size_t)l * 4 * 256 + e;
    const float x0 = buf[0], x1 = buf[256], x2 = buf[512], x3 = bf1(PB[(size_t)row * PB_LD + 512 + e]);
    const float xl = cw[0] * x0 + cw[256] * x1 + cw[512] * x2 + cw[768] * x3 + inp(I_LCB)[l * 256 + e];
    const float ba = inp(I_LBA)[l * 256 + e], bx = inp(I_LBX)[l * 256 + e], lam = inp(I_LLAM)[l * 256 + e], h0 = inp(I_SLRU)[(size_t)(l * NSAMP + s) * 256 + e], yv = bf1(PB[(size_t)row * PB_LD + 768 + e]);
    if (tid < 256) { sh[e] = xl; float* co = C.out + O_LRUCS + ((size_t)(l * NSAMP + s) * 3) * 256 + e; co[0] = x1; co[256] = x2; co[512] = x3; }
    __syncthreads();
    if (tid < 256) { float ar = 0.f, ai = 0.f;
#pragma unroll
        for (int i = 0; i < 8; ++i) { const unsigned aw[4] = {wa8[i].x, wa8[i].y, wa8[i].z, wa8[i].w}, xw[4] = {wx8[i].x, wx8[i].y, wx8[i].z, wx8[i].w};
#pragma unroll
            for (int k = 0; k < 4; ++k) { const float xa = sh[n * 64 + 8 * i + 2 * k], xb = sh[n * 64 + 8 * i + 2 * k + 1];
                ar += xa * bflo(aw[k]) + xb * bfhi(aw[k]); ai += xa * bflo(xw[k]) + xb * bfhi(xw[k]); } }
        const float rg = sigm(ar + ba), ig = sigm(ai + bx), la = -8.0f * rg * softplus(-lam);
        const float a = __expf(la), bm = sqrtf(fmaxf(1.0f - __expf(2.0f * la), 0.f)) * (ig * xl);
        const float hn = a * h0 + bm;
        C.out[O_LRUS + (size_t)(l * NSAMP + s) * 256 + e] = hn;
        O[(size_t)row * DM + 512 + e] = (bf16)f2bf(hn * gelu_tanh(yv)); }
    __syncthreads();
}
DI void m2_phase(const Ctx& C0, int l) {
    const int bid = C0.bid;
#ifndef M2_SUB
#define M2_SUB 0xf
#endif
#ifndef M2_DUP
#define M2_DUP 0
#endif
    if (bid < 32) { if (M2_SUB & 1) { for (int rep = 0; rep < ((M2_DUP & 1) ? 2 : 1); ++rep) { const Ctx Cr = fresh(C0); m2_dn2(Cr, l, bid >> 2, bid & 3); __syncthreads(); } } return; }
    if (bid < 64) { if (M2_SUB & 2) { for (int rep = 0; rep < ((M2_DUP & 2) ? 2 : 1); ++rep) { const Ctx Cr = fresh(C0); m2_ret(Cr, l, (bid - 32) >> 2, (bid - 32) & 3); __syncthreads(); } } }
    else if (M2_SUB & 8) { const int nb = C0.G - 64;
        for (int rep = 0; rep < ((M2_DUP & 8) ? 2 : 1); ++rep)
        for (int it = bid - 64; it < NB * NCHUNK + NSAMP * 9; it += nb) { const Ctx C = fresh(C0);
            if (it < NB * NCHUNK) { m2_lru_item(C, l, it / NCHUNK, it % NCHUNK); }
            else { const int s = (it - NB * NCHUNK) / 9, k = (it - NB * NCHUNK) % 9;
                if (k < 4) ms_dn(C, l, s, k); else if (k < 8) ms_ret(C, l, s, k - 4); else ms_lru(C, l, s); } } }
    { const Ctx C = fresh(C0); __syncthreads();
      const int gw = (bid - 32) * NWAVES + C.wave, nw = (C0.G - 32) * NWAVES;
      convert_set(C, l, 1, gw, nw);
      if (l + 1 < 2) convert_set(C, l + 1, 0, gw, nw); }
}
constexpr int N_PHASES = 17;
#ifndef PH_MASK
#define PH_MASK 0x3ff
#endif
#define PH_EN(k) ((PH_MASK >> (k)) & 1)
#ifndef MK_PER_PHASE
#define MK_PER_PHASE 0
#endif
__global__ void __launch_bounds__(NTHREADS, 2) hybrid_fwd(Args args) {
    extern __shared__ __attribute__((aligned(16))) unsigned char lds[];
    Ctx C0;
    C0.out = args.out; C0.ws = args.ws; C0.lds = lds;
    C0.tid = threadIdx.x; C0.lane = C0.tid & 63; C0.wave = __builtin_amdgcn_readfirstlane(C0.tid >> 6); C0.G = gridDim.x; C0.bid = blockIdx.x;
    const int wave0 = C0.wave;
    volatile LAS unsigned* MISC = (volatile LAS unsigned*)((LAS unsigned char*)lds + MISC_OFF);
    if (C0.tid < 64) MISC[C0.tid] = 0u;
    __syncthreads();
    XcdBarrier bar; bar.bar = (unsigned*)(C0.ws + WS_CTL) + CW_BAR; bar.x = 0; bar.st = nullptr;
    const int lo = args.ph_lo, hi = args.ph_hi;
    if (hi - lo > 1) bar = xcd_barrier_post((unsigned*)(C0.ws + WS_CTL) + CW_BAR, MISC + 8);
    LAS unsigned char* ldsl = (LAS unsigned char*)lds;
    if (lo == 0) {
#ifndef AMP_K
#define AMP_K 0
#define AMP_PH 0
#endif
        unsigned long long amp_p0 = 0; if (AMP_K && AMP_PH == 8) amp_p0 = __builtin_amdgcn_s_memrealtime();
        if (PH_EN(9)) { const Ctx C = fresh(C0); p0_rows(C); convert_lru_weights(C); convert_set(C, 0, 0, C.bid * NWAVES + C.wave, C.G * NWAVES, 0, 16 * 176 + 44 * 32); }
        if (AMP_K && AMP_PH == 8) { __syncthreads(); const unsigned long long t1 = __builtin_amdgcn_s_memrealtime(), te = t1 + (unsigned long long)AMP_K * (t1 - amp_p0); while (__builtin_amdgcn_s_memrealtime() < te) __builtin_amdgcn_s_sleep(16); }
        if (1 < hi) { XcdBarrier b2 = bar; asm volatile("" : "+s"(b2.bar), "+s"(b2.x)); int t0 = C0.tid; asm volatile("" : "+v"(t0)); xcd_barrier(b2, t0); }
    }
#define GRID_BAR_IN() do { XcdBarrier b4 = bar; asm volatile("" : "+s"(b4.bar), "+s"(b4.x)); xcd_barrier(b4, C.tid); } while (0)
    for (int ph = (lo == 0 ? 1 : lo); ph < hi; ++ph) {
#ifndef DUP_MASK
#define DUP_MASK 0
#endif
        const int nrep = ((DUP_MASK >> ((ph - 1) % 8)) & 1) ? 2 : 1;
#ifndef AMP_K
#define AMP_K 0
#define AMP_PH 0
#endif
        unsigned long long amp_t0 = 0;
        if (AMP_K && (ph - 1) % 8 == AMP_PH) amp_t0 = __builtin_amdgcn_s_memrealtime();
        for (int rep = 0; rep < nrep; ++rep) {
        Ctx C = C0;
        { int ln = (int)__builtin_amdgcn_mbcnt_hi(~0u, __builtin_amdgcn_mbcnt_lo(~0u, 0u)); int wv = wave0; asm volatile("" : "+v"(ln), "+s"(wv)); C.lane = ln; C.wave = wv; C.tid = wv * 64 + ln; }
        { unsigned long long w = (unsigned long long)C0.ws, o = (unsigned long long)C0.out; asm volatile("" : "+s"(w), "+s"(o));
          C.ws = (unsigned char*)(GAS unsigned char*)w; C.out = (float*)(GAS float*)o; }
        { int bb = C0.bid, gg = C0.G; asm volatile("" : "+s"(bb), "+s"(gg)); C.bid = bb; C.G = gg; }
        unsigned long long* SS = (unsigned long long*)(C.ws + WS_SS);
        bf16* XB = (bf16*)(C.ws + WS_XB); bf16* H = (bf16*)(C.ws + WS_H); bf16* PA = (bf16*)(C.ws + WS_PA); bf16* PB = (bf16*)(C.ws + WS_PB); bf16* O = (bf16*)(C.ws + WS_O);
        float* XE = (float*)(C.ws + WS_XE); unsigned char* wt = C.ws + WS_WT;
            if (rep) { XcdBarrier b3 = bar; asm volatile("" : "+s"(b3.bar), "+s"(b3.x)); xcd_barrier(b3, C.tid); }
            const int l = (ph - 1) / 8, k = (ph - 1) % 8;
            unsigned long long* ss_in1 = SS + (size_t)(3 * l) * NROWS;
            if ((k == 0 || k == 6) && PH_EN(k)) {
                const bool f1 = (k == 0);
                pg8::Gemm g{XB, (const bf16*)(wt + (f1 ? WT_F1I : WT_F2I)), NROWS, 2 * DFF, DM, nullptr, 0}; pg8::StaticOrder S; S.init(NROWS, 2 * DFF, C.G, C.bid);
                pg8::EpiSwiglu E{H, DFF, f1 ? ss_in1 : ss_in1 + 2 * NROWS};
                pg8::gemm_phase<pg8::EpiSwiglu, pg8::StaticOrder, true, true>(ldsl, g, S, E, C.tid);
                { const int nfull = S.nwg % C.G; if (f1 && l == 0 && nfull > 0 && C.bid >= nfull) { __syncthreads(); convert_set(C, 0, 0, (C.bid - nfull) * NWAVES + C.wave, (C.G - nfull) * NWAVES, 16 * 176 + 44 * 32, 16 * 176 + 44 * 32 + 16 * 120); } }
            } else if ((k == 1 || k == 5 || k == 7) && PH_EN(k)) {
                const bool mix = (k == 5);
                const bf16* Aop = mix ? O : H; const bf16* Wop = (const bf16*)(wt + (k == 1 ? WT_F1O : (mix ? WT_WOUT : WT_F2O)));
                unsigned long long* ssn = ss_in1 + (size_t)(k == 1 ? 1 : (mix ? 2 : 3)) * NROWS; const float scale = mix ? 1.0f : 0.5f;
                pg8::Gemm g{Aop, Wop, NROWS, DM, mix ? DM : DFF, nullptr, 0}; pg8::StaticOrder S; S.init(64 * 256, DM, C.G, C.bid);
                pg8::EpiResid E{(k == 1 && l == 0) ? inp(I_XP) : nullptr, XB, ssn, scale};
                pg8::gemm_phase<pg8::EpiResid, pg8::StaticOrder, true, true>(ldsl, g, S, E, C.tid);
                if (mix) tail_gemm<DM>(C, Aop, Wop, scale, ssn); else tail_gemm<DFF>(C, Aop, Wop, scale, ssn);
                if (k == 7 && l == 1) { GRID_BAR_IN(); final_fix_norm(C); }
            } else if (k == 2 && PH_EN(2)) {
                pg8::Gemm g{XB, (const bf16*)(wt + WT_WIN), NROWS, DIN_PAD, DM, nullptr, 0}; pg8::StaticOrder S; S.init(NROWS, DIN_PAD, C.G, C.bid);
                pg8::EpiProj E{PA, PB, ss_in1 + NROWS, inp(I_DNNW) + l * 128};
                pg8::gemm_phase<pg8::EpiProj, pg8::StaticOrder, true, true>(ldsl, g, S, E, C.tid);
            } else if (k == 3 && PH_EN(3)) { m1_phase(C, l);
            } else if (k == 4 && PH_EN(4)) { m2_phase(C, l);
            }
        }
        if (AMP_K && (ph - 1) % 8 == AMP_PH) { __syncthreads(); const unsigned long long t1 = __builtin_amdgcn_s_memrealtime(), te = t1 + (unsigned long long)AMP_K * (t1 - amp_t0); while (__builtin_amdgcn_s_memrealtime() < te) __builtin_amdgcn_s_sleep(16); }
        if (ph + 1 < hi) { XcdBarrier b2 = bar; asm volatile("" : "+s"(b2.bar), "+s"(b2.x)); int ln = (int)__builtin_amdgcn_mbcnt_hi(~0u, __builtin_amdgcn_mbcnt_lo(~0u, 0u)); int wv = wave0; asm volatile("" : "+v"(ln), "+s"(wv)); xcd_barrier(b2, wv * 64 + ln); }
    }
}

extern "C" void kernel_launch(void* const* d_in, const int* in_sizes, int n_in, void* d_out, int out_size, void* d_ws, size_t ws_size, hipStream_t stream) {
    static int grid = 0;
    if (grid == 0) {
        if (n_in != 29 || out_size != (int)O_END || ws_size < WS_END) { fprintf(stderr, "kernel_launch: unexpected shapes: n_in %d out %d ws %zu (need %zu)\n", n_in, out_size, ws_size, (size_t)WS_END); grid = -1; return; }
        int dev = 0, cus = 0, per_cu = 0;
        if (hipGetDevice(&dev) != hipSuccess || hipDeviceGetAttribute(&cus, hipDeviceAttributeMultiprocessorCount, dev) != hipSuccess) { grid = -1; return; }
        if (hipFuncSetAttribute((const void*)hybrid_fwd, hipFuncAttributeMaxDynamicSharedMemorySize, LDS_BYTES) != hipSuccess) { fprintf(stderr, "kernel_launch: hipFuncSetAttribute failed\n"); grid = -1; return; }
        if (hipOccupancyMaxActiveBlocksPerMultiprocessor(&per_cu, (const void*)hybrid_fwd, NTHREADS, LDS_BYTES) != hipSuccess || per_cu < 1) { fprintf(stderr, "kernel_launch: occupancy query says %d blocks per CU\n", per_cu); grid = -1; return; }
        (void)hipGetLastError();
        grid = cus;
        if (grid < 128) { fprintf(stderr, "kernel_launch: %d CUs: too few for this kernel's phase-role split\n", grid); grid = -1; return; }
    }
    if (grid < 0) return;
    if (hipMemsetAsync((char*)d_ws + WS_CTL, 0, CTL_ZERO_BYTES, stream) != hipSuccess) return;
    Args a{};
    for (int i = 0; i < 29; ++i) a.in[i] = (const float*)d_in[i];
    a.out = (float*)d_out; a.ws = (unsigned char*)d_ws;
#if MK_PER_PHASE
    for (int ph = 0; ph < N_PHASES; ++ph) { a.ph_lo = ph; a.ph_hi = ph + 1; hipLaunchKernelGGL(hybrid_fwd, dim3(grid), dim3(NTHREADS), LDS_BYTES, stream, a); }
#else
    a.ph_lo = 0; a.ph_hi = N_PHASES; hipLaunchKernelGGL(hybrid_fwd, dim3(grid), dim3(NTHREADS), LDS_BYTES, stream, a);
#endif
}
```
